# Optimizing an MI355X kernel written in HIP

```python
import math
import jax
import jax.numpy as jnp
from jax import lax
import numpy as np

D_MODEL = 1024
BATCH = 8
SEQ = 2048
DEPTH = 1

HEAD_DIM = 64
MIX_WIDTH = D_MODEL
A_WIDTH = MIX_WIDTH // 2
B_WIDTH = MIX_WIDTH - A_WIDTH
A_HEADS = A_WIDTH // HEAD_DIM
B_HEADS = B_WIDTH // (2 * HEAD_DIM)
DIL_PATTERNS = ((128, 1), (512, 4), (2048, 16))
BAND_BLOCK = 128
Q_BLOCK = 128
N_EXPERTS = 32
TOP_K = 4
D_FF = D_MODEL
SWIGLU_LIMIT = 7.0
SWIGLU_ALPHA = 1.702
MOE_BLOCK = 128
RMS_EPS = 1e-6
ATTN_SCALE = HEAD_DIM ** -0.5
IN_SIZES = (A_WIDTH, A_WIDTH, A_WIDTH, B_WIDTH, B_WIDTH, B_WIDTH)
IN_WIDTH = sum(IN_SIZES)
IN_SPLITS = tuple(int(v) for v in np.cumsum(IN_SIZES)[:-1])

kernel_name = 'hymba_style_dilated_diffattn_moe_block'


def rms_norm(x, g):
    xf = x.astype(jnp.float32)
    y = xf * lax.rsqrt(jnp.mean(xf * xf, axis=-1, keepdims=True) + RMS_EPS)
    return (y * g.astype(jnp.float32)).astype(x.dtype)


def alibi_slopes(n):
    return 2.0 ** (-8.0 * jnp.arange(1, n + 1, dtype=jnp.float32) / n)


def dilated_band_attention(q, k, v, slopes, window, dil):
    bsz, nh, n_tok, hd = q.shape
    L = n_tok // dil
    w_sub = window // dil
    nb = -(-L // BAND_BLOCK)
    Lp = nb * BAND_BLOCK

    def to_sub(t):
        t = jnp.swapaxes(t.reshape(bsz, nh, L, dil, hd), 2, 3)
        return jnp.pad(t, ((0, 0), (0, 0), (0, 0), (0, Lp - L), (0, 0)))

    def key_band(t):
        t = jnp.pad(to_sub(t), ((0, 0), (0, 0), (0, 0), (BAND_BLOCK, 0), (0, 0)))
        t = t.reshape(bsz, nh, dil, nb + 1, BAND_BLOCK, hd)
        return jnp.concatenate([t[:, :, :, :-1], t[:, :, :, 1:]], axis=4)

    qs = to_sub(q).reshape(bsz, nh, dil, nb, BAND_BLOCK, hd)
    ks, vs = key_band(k), key_band(v)
    iq = jnp.arange(BAND_BLOCK)[:, None]
    ik = jnp.arange(2 * BAND_BLOCK)[None, :]
    delta = iq - ik + BAND_BLOCK
    k_sub = (jnp.arange(nb)[:, None] * BAND_BLOCK - BAND_BLOCK
             + jnp.arange(2 * BAND_BLOCK)[None, :])
    valid = ((delta >= 0) & (delta <= w_sub))[None] & (k_sub >= 0)[:, None, :]
    bias = -slopes[:, None, None] * (delta * dil).astype(jnp.float32)[None]
    s = jnp.einsum('bhrnqd,bhrnkd->bhrnqk', qs, ks).astype(jnp.float32) * ATTN_SCALE
    s = s + bias[None, :, None, None]
    s = jnp.where(valid[None, None, None], s, -jnp.inf)
    m = jnp.max(s, axis=-1, keepdims=True)
    e = jnp.exp(s - m)
    den = jnp.sum(e, axis=-1, keepdims=True)
    o = jnp.einsum('bhrnqk,bhrnkd->bhrnqd', (e / den).astype(v.dtype), vs)
    lse = (m + jnp.log(den))[..., 0]

    def from_sub(t):
        tail = t.shape[5:]
        t = t.reshape((bsz, nh, dil, Lp) + tail)[:, :, :, :L]
        t = jnp.swapaxes(t, 2, 3)
        return t.reshape((bsz, nh, n_tok) + tail)

    return from_sub(o), from_sub(lse)


def dilated_mixture_attention(q, k, v, slopes):
    outs, lses = [], []
    for window, dil in DIL_PATTERNS:
        o, lse = dilated_band_attention(q, k, v, slopes, window, dil)
        outs.append(o)
        lses.append(lse)
    w = jax.nn.softmax(jnp.stack(lses, axis=0), axis=0)
    return jnp.einsum('pbhs,pbhsd->bhsd', w.astype(q.dtype), jnp.stack(outs, axis=0))


def differential_attention(q, k, v, slopes, lam):
    bsz, nh, n_tok, _, hd = q.shape
    nqb = n_tok // Q_BLOCK
    qb = jnp.moveaxis(q.reshape(bsz, nh, nqb, Q_BLOCK, 2, hd), 2, 0)
    k_pos = jnp.arange(n_tok)

    def block(args):
        q_blk, start = args
        dist = (start + jnp.arange(Q_BLOCK))[:, None] - k_pos[None, :]
        sc = jnp.einsum('bhqcd,bhkcd->bhcqk', q_blk, k).astype(jnp.float32) * ATTN_SCALE
        sc = sc - slopes[None, :, None, None, None] * dist.astype(jnp.float32)
        sc = jnp.where(dist >= 0, sc, -jnp.inf)
        p = jax.nn.softmax(sc, axis=-1)
        a = p[:, :, 0] - lam * p[:, :, 1]
        return jnp.einsum('bhqk,bhkd->bhqd', a.astype(v.dtype), v)

    o = lax.map(block, (qb, jnp.arange(nqb) * Q_BLOCK))
    return jnp.moveaxis(o, 0, 2).reshape(bsz, nh, n_tok, 2 * hd)


def moe_ffn(h, w_router, b_router, w_gate_up, b_gate_up, w_down, b_down):
    n, d = h.shape
    logits = (h @ w_router).astype(jnp.float32) + b_router.astype(jnp.float32)
    top_val, top_idx = lax.top_k(logits, TOP_K)
    gates = jax.nn.softmax(top_val, axis=-1)
    n_assign = n * TOP_K
    flat_e = top_idx.reshape(-1)
    order = jnp.argsort(flat_e)
    e_sorted = flat_e[order]
    tok_sorted = order // TOP_K
    gate_sorted = gates.reshape(-1)[order]
    counts = jnp.zeros((N_EXPERTS,), jnp.int32).at[flat_e].add(1)
    padded = (counts + MOE_BLOCK - 1) // MOE_BLOCK * MOE_BLOCK
    pad_end = jnp.cumsum(padded)
    pad_start = pad_end - padded
    grp_start = jnp.cumsum(counts) - counts
    dest = pad_start[e_sorted] + jnp.arange(n_assign) - grp_start[e_sorted]
    n_blocks = -(-(n_assign + N_EXPERTS * (MOE_BLOCK - 1)) // MOE_BLOCK)
    buf_tok = jnp.zeros((n_blocks * MOE_BLOCK,), jnp.int32).at[dest].set(tok_sorted)
    block_e = jnp.minimum(jnp.searchsorted(pad_end, jnp.arange(n_blocks) * MOE_BLOCK, side='right'),
                          N_EXPERTS - 1)
    xb = h[buf_tok].reshape(n_blocks, MOE_BLOCK, d)

    def expert_block(args):
        xe, e = args
        gu = xe @ w_gate_up[e] + b_gate_up[e]
        g = jnp.minimum(gu[:, :D_FF], SWIGLU_LIMIT)
        u = jnp.clip(gu[:, D_FF:], -SWIGLU_LIMIT, SWIGLU_LIMIT)
        act = (u + 1.0) * (g * jax.nn.sigmoid(SWIGLU_ALPHA * g))
        return act @ w_down[e] + b_down[e]

    yb = lax.map(expert_block, (xb, block_e)).reshape(-1, d)
    y = yb[dest] * gate_sorted[:, None].astype(yb.dtype)
    return jax.ops.segment_sum(y, tok_sorted, num_segments=n)


def hybrid_layer(x, c, w_ada, b_ada, norm1_g, w_in, a_q_norm_g, a_k_norm_g, b_q_norm_g,
                 b_k_norm_g, lambda_q1, lambda_k1, lambda_q2, lambda_k2, diff_norm_g, w_out,
                 norm2_g, w_router, b_router, w_gate_up, b_gate_up, w_down, b_down, lambda_init):
    bsz, n_tok, d = x.shape
    mod = jax.nn.silu(c) @ w_ada + b_ada
    shift1, scale1, gate1, shift2, scale2, gate2 = jnp.split(mod[:, None, :], 6, axis=-1)

    h = rms_norm(x, norm1_g) * (1.0 + scale1) + shift1
    proj = h @ w_in
    aq, ak, av, bq, bk, bv = jnp.split(proj, IN_SPLITS, axis=-1)

    def heads_a(t):
        return jnp.swapaxes(t.reshape(bsz, n_tok, A_HEADS, HEAD_DIM), 1, 2)

    aq = rms_norm(heads_a(aq), a_q_norm_g)
    ak = rms_norm(heads_a(ak), a_k_norm_g)
    o_a = dilated_mixture_attention(aq, ak, heads_a(av), alibi_slopes(A_HEADS))
    o_a = jnp.swapaxes(o_a, 1, 2).reshape(bsz, n_tok, A_WIDTH)

    def heads_b(t):
        return jnp.swapaxes(t.reshape(bsz, n_tok, B_HEADS, 2, HEAD_DIM), 1, 2)

    bq = rms_norm(heads_b(bq), b_q_norm_g)
    bk = rms_norm(heads_b(bk), b_k_norm_g)
    bv = jnp.swapaxes(bv.reshape(bsz, n_tok, B_HEADS, 2 * HEAD_DIM), 1, 2)
    lam = (jnp.exp(jnp.sum(lambda_q1.astype(jnp.float32) * lambda_k1.astype(jnp.float32)))
           - jnp.exp(jnp.sum(lambda_q2.astype(jnp.float32) * lambda_k2.astype(jnp.float32)))
           + lambda_init)
    o_b = differential_attention(bq, bk, bv, alibi_slopes(B_HEADS), lam)
    o_b = rms_norm(o_b, diff_norm_g) * (1.0 - lambda_init)
    o_b = jnp.swapaxes(o_b, 1, 2).reshape(bsz, n_tok, B_WIDTH)

    mixed = jnp.concatenate([o_a, o_b], axis=-1) @ w_out
    x = x + gate1 * mixed

    h2 = rms_norm(x, norm2_g) * (1.0 + scale2) + shift2
    y = moe_ffn(h2.reshape(bsz * n_tok, d), w_router, b_router, w_gate_up, b_gate_up,
                w_down, b_down).reshape(bsz, n_tok, d)
    return x + gate2 * y


def setup_inputs(seed: int = 0) -> dict:
    key = jax.random.key(seed)
    ks = jax.random.split(key, 24)

    def nrm(k, shape, scale):
        return jax.random.normal(k, shape, jnp.float32) * scale

    def gain(k, shape):
        return 1.0 + nrm(k, shape, 0.05)

    L = DEPTH
    return {
        'x': nrm(ks[0], (BATCH, SEQ, D_MODEL), 1.0),
        'c': nrm(ks[1], (BATCH, D_MODEL), 1.0),
        'w_ada': nrm(ks[2], (L, D_MODEL, 6 * D_MODEL), 0.5 * D_MODEL ** -0.5),
        'b_ada': nrm(ks[3], (L, 6 * D_MODEL), 0.02),
        'norm1_g': gain(ks[4], (L, D_MODEL)),
        'w_in': nrm(ks[5], (L, D_MODEL, IN_WIDTH), D_MODEL ** -0.5),
        'a_q_norm_g': gain(ks[6], (L, HEAD_DIM)),
        'a_k_norm_g': gain(ks[7], (L, HEAD_DIM)),
        'b_q_norm_g': gain(ks[8], (L, HEAD_DIM)),
        'b_k_norm_g': gain(ks[9], (L, HEAD_DIM)),
        'lambda_q1': nrm(ks[10], (L, HEAD_DIM), 0.1),
        'lambda_k1': nrm(ks[11], (L, HEAD_DIM), 0.1),
        'lambda_q2': nrm(ks[12], (L, HEAD_DIM), 0.1),
        'lambda_k2': nrm(ks[13], (L, HEAD_DIM), 0.1),
        'diff_norm_g': gain(ks[14], (L, 2 * HEAD_DIM)),
        'w_out': nrm(ks[15], (L, MIX_WIDTH, D_MODEL), MIX_WIDTH ** -0.5),
        'norm2_g': gain(ks[16], (L, D_MODEL)),
        'w_router': nrm(ks[17], (L, D_MODEL, N_EXPERTS), D_MODEL ** -0.5),
        'b_router': nrm(ks[18], (L, N_EXPERTS), 0.01),
        'w_gate_up': nrm(ks[19], (L, N_EXPERTS, D_MODEL, 2 * D_FF), D_MODEL ** -0.5),
        'b_gate_up': nrm(ks[20], (L, N_EXPERTS, 2 * D_FF), 0.01),
        'w_down': nrm(ks[21], (L, N_EXPERTS, D_FF, D_MODEL), D_FF ** -0.5),
        'b_down': nrm(ks[22], (L, N_EXPERTS, D_MODEL), 0.01),
    }


def reference(x, c, w_ada, b_ada, norm1_g, w_in, a_q_norm_g, a_k_norm_g, b_q_norm_g, b_k_norm_g,
              lambda_q1, lambda_k1, lambda_q2, lambda_k2, diff_norm_g, w_out, norm2_g, w_router,
              b_router, w_gate_up, b_gate_up, w_down, b_down):
    for l in range(DEPTH):
        lambda_init = 0.8 - 0.6 * math.exp(-0.3 * l)
        x = hybrid_layer(x, c, w_ada[l], b_ada[l], norm1_g[l], w_in[l], a_q_norm_g[l],
                         a_k_norm_g[l], b_q_norm_g[l], b_k_norm_g[l], lambda_q1[l], lambda_k1[l],
                         lambda_q2[l], lambda_k2[l], diff_norm_g[l], w_out[l], norm2_g[l],
                         w_router[l], b_router[l], w_gate_up[l], b_gate_up[l], w_down[l],
                         b_down[l], lambda_init)
    return x
```

```cpp
#include <hip/hip_runtime.h>
#include <cstdio>
#include <cstdint>

typedef unsigned short bf16_t;
typedef short bf16x8 __attribute__((ext_vector_type(8)));
typedef float f32x4 __attribute__((ext_vector_type(4)));
typedef unsigned u32x4 __attribute__((ext_vector_type(4)));
typedef unsigned u32x2 __attribute__((ext_vector_type(2)));

constexpr int D = 1024, NB = 8, S = 2048, M = NB * S;
constexpr int NIN = 3072, NE = 32, TOPK = 4, DFF = 1024;
constexpr int NASSIGN = M * TOPK;
constexpr int PADROWS = NASSIGN + NE * 256;
constexpr float RMS_EPS = 1e-6f;
constexpr float LOG2E = 1.4426950408889634f;
constexpr float QSCALE = 0.125f * LOG2E;
constexpr float LAMBDA_INIT = 0.2f;

constexpr size_t MiB = 1u << 20;
constexpr size_t WS_CTL = 0;
constexpr size_t CTL_BYTES = 1 * MiB;
constexpr size_t CTL_COUNTS = 0;
constexpr size_t CTL_PADSTART = 256;
constexpr size_t CTL_MOD = 64 * 1024;
constexpr size_t WS_WIN = 2 * MiB;
constexpr size_t WS_WOUT = 8 * MiB;
constexpr size_t WS_WGU = 10 * MiB;
constexpr size_t WS_WD = 138 * MiB;
constexpr size_t WS_XN = 202 * MiB;
constexpr size_t WS_QKV = 234 * MiB;
constexpr size_t WS_AO = 330 * MiB;
constexpr size_t WS_H2 = 362 * MiB;
constexpr size_t WS_TOPE = 394 * MiB;
constexpr size_t WS_TOPS = 395 * MiB;
constexpr size_t WS_TOPG = 396 * MiB;
constexpr size_t WS_LIST = 397 * MiB;
constexpr size_t WS_ACT = 400 * MiB;
constexpr size_t WS_Y = 544 * MiB;
constexpr size_t WS_OBN = 688 * MiB;
constexpr size_t WS_END = 752 * MiB;

__device__ __forceinline__ bf16_t f2bf(float f) { unsigned u = __float_as_uint(f); return (bf16_t)((u + 0x7fffu + ((u >> 16) & 1u)) >> 16); }
__device__ __forceinline__ float bf2f(bf16_t h) { return __uint_as_float(((unsigned)h) << 16); }
__device__ __forceinline__ unsigned pk2(float lo, float hi) { return (unsigned)f2bf(lo) | ((unsigned)f2bf(hi) << 16); }
__device__ __forceinline__ float wave_sum(float v) {
#pragma unroll
    for (int o = 1; o < 64; o <<= 1) v += __shfl_xor(v, o);
    return v;
}

__global__ void __launch_bounds__(256) k_transpose(const float* __restrict__ W, bf16_t* __restrict__ WT, int K, int N) {
    __shared__ float t[64][65];
    const int nb = N / 64, kb = K / 64;
    const int per = nb * kb;
    const int g = blockIdx.x / per, r = blockIdx.x % per;
    const int k0 = (r / nb) * 64, n0 = (r % nb) * 64;
    const float* Wg = W + (size_t)g * K * N; bf16_t* WTg = WT + (size_t)g * K * N;
    const int tx = threadIdx.x & 63, ty = threadIdx.x >> 6;
    for (int i = ty; i < 64; i += 4) t[i][tx] = Wg[(size_t)(k0 + i) * N + n0 + tx];
    __syncthreads();
    for (int i = ty; i < 64; i += 4) WTg[(size_t)(n0 + i) * K + k0 + tx] = f2bf(t[tx][i]);
}

__global__ void __launch_bounds__(256) k_adaln(const float* __restrict__ c, const float* __restrict__ w_ada, const float* __restrict__ b_ada, float* mod) {
    const int col = blockIdx.x * 256 + threadIdx.x, ks = blockIdx.y;
    float acc[NB];
#pragma unroll
    for (int b = 0; b < NB; ++b) acc[b] = (ks == 0) ? b_ada[col] : 0.f;
    for (int k = ks * 64; k < ks * 64 + 64; ++k) {
        const float w = w_ada[(size_t)k * 6144 + col];
#pragma unroll
        for (int b = 0; b < NB; ++b) { const float cv = c[b * D + k]; const float sl = cv / (1.f + __expf(-cv)); acc[b] += sl * w; }
    }
#pragma unroll
    for (int b = 0; b < NB; ++b) atomicAdd(&mod[b * 6144 + col], acc[b]);
}

__global__ void __launch_bounds__(256) k_xn(const float* __restrict__ x, const float* __restrict__ g1, const float* __restrict__ mod, bf16_t* __restrict__ XN) {
    const int lane = threadIdx.x & 63, row = blockIdx.x * 4 + (threadIdx.x >> 6), b = row / S;
    const f32x4* xr = (const f32x4*)(x + (size_t)row * D) + lane;
    f32x4 v[4]; float ss = 0.f;
#pragma unroll
    for (int j = 0; j < 4; ++j) { v[j] = xr[64 * j]; ss += (v[j].x * v[j].x + v[j].y * v[j].y) + (v[j].z * v[j].z + v[j].w * v[j].w); }
    const float rstd = rsqrtf(wave_sum(ss) * (1.f / D) + RMS_EPS);
    const float* shift = mod + b * 6144, *scale = mod + b * 6144 + 1024;
#pragma unroll
    for (int j = 0; j < 4; ++j) {
        const int c0 = 4 * lane + 256 * j;
        const f32x4 g = *(const f32x4*)(g1 + c0), sc = *(const f32x4*)(scale + c0), sh = *(const f32x4*)(shift + c0);
        f32x4 o;
        o.x = v[j].x * rstd * g.x * (1.f + sc.x) + sh.x; o.y = v[j].y * rstd * g.y * (1.f + sc.y) + sh.y;
        o.z = v[j].z * rstd * g.z * (1.f + sc.z) + sh.z; o.w = v[j].w * rstd * g.w * (1.f + sc.w) + sh.w;
        u32x2 w; w.x = pk2(o.x, o.y); w.y = pk2(o.z, o.w);
        *(u32x2*)(XN + (size_t)row * D + c0) = w;
    }
}

template <class P> __global__ void __launch_bounds__(256) k_gemm(P p) {
    const int wid = threadIdx.x >> 6, lane = threadIdx.x & 63, wr = wid >> 1, wc = wid & 1, fr = lane & 15, fq = lane >> 4;
    typename P::Unit u;
    if (!p.unit(blockIdx.x, u)) return;
    const bf16_t* ap[4]; const bf16_t* bp[4];
#pragma unroll
    for (int m = 0; m < 4; ++m) ap[m] = p.a_row(u, wr * 64 + 16 * m + fr) + 8 * fq;
#pragma unroll
    for (int n = 0; n < 4; ++n) bp[n] = p.b_row(u, wc, n, fr) + 8 * fq;
    f32x4 acc[4][4];
#pragma unroll
    for (int m = 0; m < 4; ++m)
#pragma unroll
        for (int n = 0; n < 4; ++n) acc[m][n] = (f32x4){0.f, 0.f, 0.f, 0.f};
    for (int k0 = 0; k0 < P::K; k0 += 32) {
        bf16x8 a[4], b[4];
#pragma unroll
        for (int m = 0; m < 4; ++m) a[m] = *(const bf16x8*)(ap[m] + k0);
#pragma unroll
        for (int n = 0; n < 4; ++n) b[n] = *(const bf16x8*)(bp[n] + k0);
#pragma unroll
        for (int m = 0; m < 4; ++m)
#pragma unroll
            for (int n = 0; n < 4; ++n) acc[m][n] = __builtin_amdgcn_mfma_f32_16x16x32_bf16(a[m], b[n], acc[m][n], 0, 0, 0);
    }
    p.epi(u, acc, wr, wc, fr, fq);
}

struct InProj {
    static constexpr int K = 1024;
    struct Unit { int bm, bn; };
    const bf16_t* XN; const bf16_t* Wt; bf16_t* QKV; const float *gaq, *gak, *gbq, *gbk;
    __device__ bool unit(int bid, Unit& u) const { u.bm = bid / 24; u.bn = bid % 24; return true; }
    __device__ const bf16_t* a_row(const Unit& u, int r) const { return XN + (size_t)(u.bm * 128 + r) * K; }
    __device__ const bf16_t* b_row(const Unit& u, int wc, int n, int fr) const { return Wt + (size_t)(u.bn * 128 + wc * 64 + 16 * n + fr) * K; }
    __device__ void epi(const Unit& u, f32x4 (&acc)[4][4], int wr, int wc, int fr, int fq) const {
        const int c0 = u.bn * 128 + wc * 64, r0 = u.bm * 128 + wr * 64;
        const float* g = nullptr; float post = 1.f;
        if (c0 < 512) { g = gaq; post = QSCALE; } else if (c0 < 1024) g = gak; else if (c0 < 1536) g = nullptr;
        else if (c0 < 2048) { g = gbq; post = QSCALE; } else if (c0 < 2560) g = gbk;
#pragma unroll
        for (int m = 0; m < 4; ++m)
#pragma unroll
            for (int j = 0; j < 4; ++j) {
                float sc[4] = {1.f, 1.f, 1.f, 1.f};
                if (g) {
                    float ss = 0.f;
#pragma unroll
                    for (int n = 0; n < 4; ++n) ss += acc[m][n][j] * acc[m][n][j];
                    ss += __shfl_xor(ss, 1); ss += __shfl_xor(ss, 2); ss += __shfl_xor(ss, 4); ss += __shfl_xor(ss, 8);
                    const float rstd = rsqrtf(ss * (1.f / 64.f) + RMS_EPS) * post;
#pragma unroll
                    for (int n = 0; n < 4; ++n) sc[n] = rstd * g[16 * n + fr];
                }
                const int row = r0 + 16 * m + 4 * fq + j;
#pragma unroll
                for (int n = 0; n < 4; ++n) QKV[(size_t)row * NIN + c0 + 16 * n + fr] = f2bf(acc[m][n][j] * sc[n]);
            }
    }
};

struct OutProj {
    static constexpr int K = 1024;
    struct Unit { int bm, bn; };
    const bf16_t* AO; const bf16_t* Wt; const float* x; const float* mod; float* x1;
    __device__ bool unit(int bid, Unit& u) const { u.bm = bid / 8; u.bn = bid % 8; return true; }
    __device__ const bf16_t* a_row(const Unit& u, int r) const { return AO + (size_t)(u.bm * 128 + r) * K; }
    __device__ const bf16_t* b_row(const Unit& u, int wc, int n, int fr) const { return Wt + (size_t)(u.bn * 128 + wc * 64 + 16 * n + fr) * K; }
    __device__ void epi(const Unit& u, f32x4 (&acc)[4][4], int wr, int wc, int fr, int fq) const {
        const int c0 = u.bn * 128 + wc * 64, r0 = u.bm * 128 + wr * 64;
        const float* gate1 = mod + ((r0 / S) * 6144) + 2048;
#pragma unroll
        for (int m = 0; m < 4; ++m)
#pragma unroll
            for (int j = 0; j < 4; ++j) {
                const int row = r0 + 16 * m + 4 * fq + j;
#pragma unroll
                for (int n = 0; n < 4; ++n) { const int col = c0 + 16 * n + fr; x1[(size_t)row * D + col] = x[(size_t)row * D + col] + gate1[col] * acc[m][n][j]; }
            }
    }
};

struct GateUp {
    static constexpr int K = 1024;
    struct Unit { int e, mt, nt, cnt, ps; };
    const bf16_t* H2; const bf16_t* Wt; const float* bgu; const int* counts; const int* padstart; const int* list; bf16_t* ACT;
    __device__ bool unit(int bid, Unit& u) const {
        u.nt = bid % 16; u.mt = (bid / 16) % 128; u.e = bid / (16 * 128); u.cnt = counts[u.e]; u.ps = padstart[u.e];
        return u.mt * 128 < u.cnt;
    }
    __device__ const bf16_t* a_row(const Unit& u, int r) const { int rr = u.mt * 128 + r; if (rr >= u.cnt) rr = 0; return H2 + (size_t)list[u.e * M + rr] * K; }
    __device__ const bf16_t* b_row(const Unit& u, int wc, int n, int fr) const {
        const int j = u.nt * 64 + wc * 32 + 16 * (n & 1) + fr; return Wt + ((size_t)u.e * 2048 + (n >> 1) * 1024 + j) * K; }
    __device__ void epi(const Unit& u, f32x4 (&acc)[4][4], int wr, int wc, int fr, int fq) const {
        const float* bias = bgu + u.e * 2048;
#pragma unroll
        for (int m = 0; m < 4; ++m)
#pragma unroll
            for (int j = 0; j < 4; ++j) {
                const int rr = u.mt * 128 + wr * 64 + 16 * m + 4 * fq + j;
                if (rr < u.cnt) {
#pragma unroll
                    for (int n = 0; n < 2; ++n) {
                        const int col = u.nt * 64 + wc * 32 + 16 * n + fr;
                        float g = acc[m][n][j] + bias[col], uu = acc[m][n + 2][j] + bias[1024 + col];
                        g = fminf(g, 7.f); uu = fminf(fmaxf(uu, -7.f), 7.f);
                        const float a = (uu + 1.f) * (g / (1.f + __expf(-1.702f * g)));
                        ACT[(size_t)(u.ps + rr) * DFF + col] = f2bf(a);
                    }
                }
            }
    }
};

struct Down {
    static constexpr int K = 1024;
    struct Unit { int e, mt, nt, cnt, ps; };
    const bf16_t* ACT; const bf16_t* Wt; const float* bd; const int* counts; const int* padstart; bf16_t* Y;
    __device__ bool unit(int bid, Unit& u) const {
        u.nt = bid % 8; u.mt = (bid / 8) % 128; u.e = bid / (8 * 128); u.cnt = counts[u.e]; u.ps = padstart[u.e];
        return u.mt * 128 < u.cnt;
    }
    __device__ const bf16_t* a_row(const Unit& u, int r) const { int rr = u.mt * 128 + r; if (rr >= u.cnt) rr = 0; return ACT + (size_t)(u.ps + rr) * K; }
    __device__ const bf16_t* b_row(const Unit& u, int wc, int n, int fr) const { return Wt + ((size_t)u.e * 1024 + u.nt * 128 + wc * 64 + 16 * n + fr) * K; }
    __device__ void epi(const Unit& u, f32x4 (&acc)[4][4], int wr, int wc, int fr, int fq) const {
        const float* bias = bd + u.e * 1024;
#pragma unroll
        for (int m = 0; m < 4; ++m)
#pragma unroll
            for (int j = 0; j < 4; ++j) {
                const int rr = u.mt * 128 + wr * 64 + 16 * m + 4 * fq + j;
                if (rr < u.cnt) {
#pragma unroll
                    for (int n = 0; n < 4; ++n) { const int col = u.nt * 128 + wc * 64 + 16 * n + fr; Y[(size_t)(u.ps + rr) * D + col] = f2bf(acc[m][n][j] + bias[col]); }
                }
            }
    }
};

__global__ void __launch_bounds__(256) k_attn_a(const bf16_t* __restrict__ QKV, bf16_t* __restrict__ AO) {
    const int gid = blockIdx.x * 256 + threadIdx.x;
    const int t = gid % S, h = (gid / S) % 8, b = gid / (S * 8);
    const bf16_t* qp = QKV + (size_t)(b * S + t) * NIN + h * 64;
    float q[64];
#pragma unroll
    for (int d = 0; d < 64; ++d) q[d] = bf2f(qp[d]);
    const float slope2 = exp2f(-(float)(h + 1)) * LOG2E;
    float m = -INFINITY, l = 0.f, o[64];
#pragma unroll
    for (int d = 0; d < 64; ++d) o[d] = 0.f;
    for (int p = 0; p < 3; ++p) {
        const int dil = (p == 0) ? 1 : (p == 1 ? 4 : 16);
        for (int i = 0; i <= 128; ++i) {
            const int pos = t - i * dil; if (pos < 0) break;
            const bf16_t* kp = QKV + (size_t)(b * S + pos) * NIN + 512 + h * 64; const bf16_t* vp = kp + 512;
            float s = 0.f;
#pragma unroll
            for (int d = 0; d < 64; ++d) s += q[d] * bf2f(kp[d]);
            s -= slope2 * (float)(i * dil);
            const float mn = fmaxf(m, s), f = exp2f(m - mn), pe = exp2f(s - mn);
            l = l * f + pe;
#pragma unroll
            for (int d = 0; d < 64; ++d) o[d] = o[d] * f + pe * bf2f(vp[d]);
            m = mn;
        }
    }
    const float rl = 1.f / l;
    bf16_t* op = AO + (size_t)(b * S + t) * D + h * 64;
#pragma unroll
    for (int d = 0; d < 64; ++d) op[d] = f2bf(o[d] * rl);
}

__global__ void __launch_bounds__(256) k_attn_b(const bf16_t* __restrict__ QKV, float* __restrict__ OBN) {
    const int gid = blockIdx.x * 256 + threadIdx.x;
    const int t = gid % S, dh = (gid / S) & 1, c = (gid / (2 * S)) & 1, h = (gid / (4 * S)) & 3, b = gid / (16 * S);
    const bf16_t* qp = QKV + (size_t)(b * S + t) * NIN + 1536 + h * 128 + c * 64;
    float q[64];
#pragma unroll
    for (int d = 0; d < 64; ++d) q[d] = bf2f(qp[d]);
    const float slope2 = exp2f(-2.f * (float)(h + 1)) * LOG2E;
    float m = -INFINITY, l = 0.f, o[64];
#pragma unroll
    for (int d = 0; d < 64; ++d) o[d] = 0.f;
    const int tmax = __shfl(t, 63);
    for (int pos = 0; pos <= tmax; ++pos) {
        const bf16_t* kp = QKV + (size_t)(b * S + pos) * NIN + 2048 + h * 128 + c * 64;
        const bf16_t* vp = QKV + (size_t)(b * S + pos) * NIN + 2560 + h * 128 + dh * 64;
        float s = 0.f;
#pragma unroll
        for (int d = 0; d < 64; ++d) s += q[d] * bf2f(kp[d]);
        s -= slope2 * (float)(t - pos);
        if (pos <= t) {
            const float mn = fmaxf(m, s), f = exp2f(m - mn), pe = exp2f(s - mn);
            l = l * f + pe;
#pragma unroll
            for (int d = 0; d < 64; ++d) o[d] = o[d] * f + pe * bf2f(vp[d]);
            m = mn;
        }
    }
    const float rl = 1.f / l;
    float* op = OBN + ((size_t)c * M + (b * S + t)) * 512 + h * 128 + dh * 64;
#pragma unroll
    for (int d = 0; d < 64; ++d) op[d] = o[d] * rl;
}
__global__ void __launch_bounds__(256) k_diff_combine(const float* __restrict__ OBN, const float* lq1, const float* lk1, const float* lq2, const float* lk2, const float* __restrict__ gd, bf16_t* __restrict__ AO) {
    const int lane = threadIdx.x & 63, w = blockIdx.x * 4 + (threadIdx.x >> 6);
    const int tok = w >> 2, h = w & 3;
    const float s1 = wave_sum(lq1[lane] * lk1[lane]), s2 = wave_sum(lq2[lane] * lk2[lane]);
    const float lam = __expf(s1) - __expf(s2) + LAMBDA_INIT;
    const float* p0 = OBN + (size_t)tok * 512 + h * 128 + 2 * lane; const float* p1 = p0 + (size_t)M * 512;
    const float a = p0[0] - lam * p1[0], bq = p0[1] - lam * p1[1];
    const float rstd = rsqrtf(wave_sum(a * a + bq * bq) * (1.f / 128.f) + RMS_EPS) * (1.f - LAMBDA_INIT);
    *(unsigned*)(AO + (size_t)tok * D + 512 + h * 128 + 2 * lane) = pk2(a * rstd * gd[2 * lane], bq * rstd * gd[2 * lane + 1]);
}

__global__ void __launch_bounds__(256) k_router(const float* __restrict__ x1, const float* __restrict__ g2, const float* __restrict__ mod, const float* __restrict__ wr, const float* __restrict__ br,
                                                bf16_t* __restrict__ H2, int* counts, int* tope, int* tops, float* topg, int* list) {
    const int lane = threadIdx.x & 63, row = blockIdx.x * 4 + (threadIdx.x >> 6), b = row / S;
    const f32x4* xr = (const f32x4*)(x1 + (size_t)row * D) + lane;
    f32x4 v[4]; float ss = 0.f;
#pragma unroll
    for (int j = 0; j < 4; ++j) { v[j] = xr[64 * j]; ss += (v[j].x * v[j].x + v[j].y * v[j].y) + (v[j].z * v[j].z + v[j].w * v[j].w); }
    const float rstd = rsqrtf(wave_sum(ss) * (1.f / D) + RMS_EPS);
    const float* shift = mod + b * 6144 + 3072, *scale = mod + b * 6144 + 4096;
    float lg[NE];
#pragma unroll
    for (int e = 0; e < NE; ++e) lg[e] = 0.f;
#pragma unroll
    for (int j = 0; j < 4; ++j) {
        const int c0 = 4 * lane + 256 * j;
        const f32x4 g = *(const f32x4*)(g2 + c0), sc = *(const f32x4*)(scale + c0), sh = *(const f32x4*)(shift + c0);
        float o[4];
        o[0] = v[j].x * rstd * g.x * (1.f + sc.x) + sh.x; o[1] = v[j].y * rstd * g.y * (1.f + sc.y) + sh.y;
        o[2] = v[j].z * rstd * g.z * (1.f + sc.z) + sh.z; o[3] = v[j].w * rstd * g.w * (1.f + sc.w) + sh.w;
        u32x2 w; w.x = pk2(o[0], o[1]); w.y = pk2(o[2], o[3]);
        *(u32x2*)(H2 + (size_t)row * D + c0) = w;
#pragma unroll
        for (int i = 0; i < 4; ++i) {
            const f32x4* wrow = (const f32x4*)(wr + (size_t)(c0 + i) * NE);
#pragma unroll
            for (int e4 = 0; e4 < 8; ++e4) { const f32x4 wv = wrow[e4]; lg[4 * e4] += o[i] * wv.x; lg[4 * e4 + 1] += o[i] * wv.y; lg[4 * e4 + 2] += o[i] * wv.z; lg[4 * e4 + 3] += o[i] * wv.w; }
        }
    }
#pragma unroll
    for (int e = 0; e < NE; ++e) lg[e] = wave_sum(lg[e]) + br[e];
    if (lane == 0) {
        int idx[4]; float val[4];
#pragma unroll
        for (int k = 0; k < 4; ++k) {
            float best = -INFINITY; int bi = 0;
#pragma unroll
            for (int e = 0; e < NE; ++e) { bool taken = false;
#pragma unroll
                for (int kk = 0; kk < k; ++kk) taken |= (idx[kk] == e);
                if (!taken && lg[e] > best) { best = lg[e]; bi = e; } }
            idx[k] = bi; val[k] = best;
        }
        float den = 0.f, ex[4];
#pragma unroll
        for (int k = 0; k < 4; ++k) { ex[k] = __expf(val[k] - val[0]); den += ex[k]; }
#pragma unroll
        for (int k = 0; k < 4; ++k) {
            const int slot = atomicAdd(&counts[idx[k]], 1);
            tope[row * 4 + k] = idx[k]; tops[row * 4 + k] = slot; topg[row * 4 + k] = ex[k] / den;
            list[idx[k] * M + slot] = row;
        }
    }
}
__global__ void k_padstart(const int* counts, int* padstart) {
    if (threadIdx.x == 0) { int acc = 0; for (int e = 0; e < NE; ++e) { padstart[e] = acc; acc += (counts[e] + 255) / 256 * 256; } padstart[NE] = acc; }
}
__global__ void __launch_bounds__(256) k_combine(float* out, const float* __restrict__ mod, const bf16_t* __restrict__ Y, const int* __restrict__ tope, const int* __restrict__ tops, const float* __restrict__ topg, const int* __restrict__ padstart) {
    const int lane = threadIdx.x & 63, row = blockIdx.x * 4 + (threadIdx.x >> 6), b = row / S;
    const float* gate2 = mod + b * 6144 + 5120;
    const bf16_t* yr[4]; float gk[4];
#pragma unroll
    for (int k = 0; k < 4; ++k) { yr[k] = Y + (size_t)(padstart[tope[row * 4 + k]] + tops[row * 4 + k]) * D; gk[k] = topg[row * 4 + k]; }
#pragma unroll
    for (int j = 0; j < 4; ++j) {
        const int c0 = 4 * lane + 256 * j;
        f32x4 acc = (f32x4){0.f, 0.f, 0.f, 0.f};
#pragma unroll
        for (int k = 0; k < 4; ++k) { const u32x2 w = *(const u32x2*)(yr[k] + c0);
            acc.x += gk[k] * __uint_as_float(w.x << 16); acc.y += gk[k] * __uint_as_float(w.x & 0xffff0000u);
            acc.z += gk[k] * __uint_as_float(w.y << 16); acc.w += gk[k] * __uint_as_float(w.y & 0xffff0000u); }
        const f32x4 g = *(const f32x4*)(gate2 + c0);
        f32x4* op = (f32x4*)(out + (size_t)row * D + c0);
        f32x4 xv = *op;
        xv.x += g.x * acc.x; xv.y += g.y * acc.y; xv.z += g.z * acc.z; xv.w += g.w * acc.w;
        *op = xv;
    }
}

extern "C" void kernel_launch(void* const* d_in, const int* in_sizes, int n_in, void* d_out, int out_size, void* d_ws, size_t ws_size, hipStream_t stream) {
    if (n_in != 23 || out_size != M * D || ws_size < WS_END) { fprintf(stderr, "kernel_launch: unexpected problem (n_in %d out %d ws %zu)\n", n_in, out_size, ws_size); return; }
    const float* x = (const float*)d_in[0]; const float* c = (const float*)d_in[1]; const float* w_ada = (const float*)d_in[2]; const float* b_ada = (const float*)d_in[3];
    const float* g1 = (const float*)d_in[4]; const float* w_in = (const float*)d_in[5];
    const float* gaq = (const float*)d_in[6]; const float* gak = (const float*)d_in[7]; const float* gbq = (const float*)d_in[8]; const float* gbk = (const float*)d_in[9];
    const float* lq1 = (const float*)d_in[10]; const float* lk1 = (const float*)d_in[11]; const float* lq2 = (const float*)d_in[12]; const float* lk2 = (const float*)d_in[13];
    const float* gd = (const float*)d_in[14]; const float* w_out = (const float*)d_in[15]; const float* g2 = (const float*)d_in[16];
    const float* w_router = (const float*)d_in[17]; const float* b_router = (const float*)d_in[18];
    const float* w_gu = (const float*)d_in[19]; const float* b_gu = (const float*)d_in[20]; const float* w_d = (const float*)d_in[21]; const float* b_d = (const float*)d_in[22];
    unsigned char* ws = (unsigned char*)d_ws; float* out = (float*)d_out;
    int* counts = (int*)(ws + WS_CTL + CTL_COUNTS); int* padstart = (int*)(ws + WS_CTL + CTL_PADSTART); float* mod = (float*)(ws + WS_CTL + CTL_MOD);
    bf16_t* Win_t = (bf16_t*)(ws + WS_WIN); bf16_t* Wout_t = (bf16_t*)(ws + WS_WOUT); bf16_t* Wgu_t = (bf16_t*)(ws + WS_WGU); bf16_t* Wd_t = (bf16_t*)(ws + WS_WD);
    bf16_t* XN = (bf16_t*)(ws + WS_XN); bf16_t* QKV = (bf16_t*)(ws + WS_QKV); bf16_t* AO = (bf16_t*)(ws + WS_AO); bf16_t* H2 = (bf16_t*)(ws + WS_H2);
    int* tope = (int*)(ws + WS_TOPE); int* tops = (int*)(ws + WS_TOPS); float* topg = (float*)(ws + WS_TOPG); int* list = (int*)(ws + WS_LIST);
    bf16_t* ACT = (bf16_t*)(ws + WS_ACT); bf16_t* Y = (bf16_t*)(ws + WS_Y); float* OBN = (float*)(ws + WS_OBN);

    hipMemsetAsync(ws + WS_CTL, 0, CTL_BYTES, stream);
    k_transpose<<<(1024 / 64) * (3072 / 64), 256, 0, stream>>>(w_in, Win_t, 1024, 3072);
    k_transpose<<<(1024 / 64) * (1024 / 64), 256, 0, stream>>>(w_out, Wout_t, 1024, 1024);
    k_transpose<<<32 * (1024 / 64) * (2048 / 64), 256, 0, stream>>>(w_gu, Wgu_t, 1024, 2048);
    k_transpose<<<32 * (1024 / 64) * (1024 / 64), 256, 0, stream>>>(w_d, Wd_t, 1024, 1024);
    k_adaln<<<dim3(24, 16), 256, 0, stream>>>(c, w_ada, b_ada, mod);
    k_xn<<<M / 4, 256, 0, stream>>>(x, g1, mod, XN);
    { InProj p{XN, Win_t, QKV, gaq, gak, gbq, gbk}; k_gemm<InProj><<<128 * 24, 256, 0, stream>>>(p); }
    k_attn_a<<<NB * 8 * S / 256, 256, 0, stream>>>(QKV, AO);
    k_attn_b<<<NB * 4 * 2 * 2 * S / 256, 256, 0, stream>>>(QKV, OBN);
    k_diff_combine<<<M * 4 / 4, 256, 0, stream>>>(OBN, lq1, lk1, lq2, lk2, gd, AO);
    { OutProj p{AO, Wout_t, x, mod, out}; k_gemm<OutProj><<<128 * 8, 256, 0, stream>>>(p); }
    k_router<<<M / 4, 256, 0, stream>>>(out, g2, mod, w_router, b_router, H2, counts, tope, tops, topg, list);
    k_padstart<<<1, 64, 0, stream>>>(counts, padstart);
    { GateUp p{H2, Wgu_t, b_gu, counts, padstart, list, ACT}; k_gemm<GateUp><<<32 * 128 * 16, 256, 0, stream>>>(p); }
    { Down p{ACT, Wd_t, b_d, counts, padstart, Y}; k_gemm<Down><<<32 * 128 * 8, 256, 0, stream>>>(p); }
    k_combine<<<M / 4, 256, 0, stream>>>(out, mod, Y, tope, tops, topg, padstart);
}
```

```cpp
#include <hip/hip_runtime.h>
#include <cstdio>
#include <cstdint>

typedef unsigned short bf16_t;
typedef short bf16x8 __attribute__((ext_vector_type(8)));
typedef float f32x4 __attribute__((ext_vector_type(4)));
typedef unsigned u32x4 __attribute__((ext_vector_type(4)));
typedef unsigned u32x2 __attribute__((ext_vector_type(2)));

constexpr int D = 1024, NB = 8, S = 2048, M = NB * S;
constexpr int NIN = 3072, NE = 32, TOPK = 4, DFF = 1024;
constexpr int NASSIGN = M * TOPK;
constexpr int PADROWS = NASSIGN + NE * 256;
constexpr float RMS_EPS = 1e-6f;
constexpr float LOG2E = 1.4426950408889634f;
constexpr float QSCALE = 0.125f * LOG2E;
constexpr float LAMBDA_INIT = 0.2f;

constexpr size_t MiB = 1u << 20;
constexpr size_t WS_CTL = 0;
constexpr size_t CTL_BYTES = 1 * MiB;
constexpr size_t CTL_COUNTS = 0;
constexpr size_t CTL_PADSTART = 256;
constexpr size_t CTL_MOD = 64 * 1024;
constexpr size_t WS_WIN = 2 * MiB;
constexpr size_t WS_WOUT = 8 * MiB;
constexpr size_t WS_WGU = 10 * MiB;
constexpr size_t WS_WD = 138 * MiB;
constexpr size_t WS_XN = 202 * MiB;
constexpr size_t WS_QKV = 234 * MiB;
constexpr size_t WS_AO = 330 * MiB;
constexpr size_t WS_H2 = 362 * MiB;
constexpr size_t WS_TOPE = 394 * MiB;
constexpr size_t WS_TOPS = 395 * MiB;
constexpr size_t WS_TOPG = 396 * MiB;
constexpr size_t WS_LIST = 397 * MiB;
constexpr size_t WS_ACT = 400 * MiB;
constexpr size_t WS_Y = 544 * MiB;
constexpr size_t WS_OBN = 688 * MiB;
constexpr size_t WS_END = 752 * MiB;

__device__ __forceinline__ bf16_t f2bf(float f) { unsigned u = __float_as_uint(f); return (bf16_t)((u + 0x7fffu + ((u >> 16) & 1u)) >> 16); }
__device__ __forceinline__ float bf2f(bf16_t h) { return __uint_as_float(((unsigned)h) << 16); }
__device__ __forceinline__ unsigned pk2(float lo, float hi) { return (unsigned)f2bf(lo) | ((unsigned)f2bf(hi) << 16); }
__device__ __forceinline__ float wave_sum(float v) {
#pragma unroll
    for (int o = 1; o < 64; o <<= 1) v += __shfl_xor(v, o);
    return v;
}

__global__ void __launch_bounds__(256) k_transpose(const float* __restrict__ W, bf16_t* __restrict__ WT, int K, int N) {
    __shared__ float t[64][65];
    const int nb = N / 64, kb = K / 64;
    const int per = nb * kb;
    const int g = blockIdx.x / per, r = blockIdx.x % per;
    const int k0 = (r / nb) * 64, n0 = (r % nb) * 64;
    const float* Wg = W + (size_t)g * K * N; bf16_t* WTg = WT + (size_t)g * K * N;
    const int tx = threadIdx.x & 63, ty = threadIdx.x >> 6;
    for (int i = ty; i < 64; i += 4) t[i][tx] = Wg[(size_t)(k0 + i) * N + n0 + tx];
    __syncthreads();
    for (int i = ty; i < 64; i += 4) WTg[(size_t)(n0 + i) * K + k0 + tx] = f2bf(t[tx][i]);
}

__global__ void __launch_bounds__(256) k_adaln(const float* __restrict__ c, const float* __restrict__ w_ada, const float* __restrict__ b_ada, float* mod) {
    const int col = blockIdx.x * 256 + threadIdx.x, ks = blockIdx.y;
    float acc[NB];
#pragma unroll
    for (int b = 0; b < NB; ++b) acc[b] = (ks == 0) ? b_ada[col] : 0.f;
    for (int k = ks * 64; k < ks * 64 + 64; ++k) {
        const float w = w_ada[(size_t)k * 6144 + col];
#pragma unroll
        for (int b = 0; b < NB; ++b) { const float cv = c[b * D + k]; const float sl = cv / (1.f + __expf(-cv)); acc[b] += sl * w; }
    }
#pragma unroll
    for (int b = 0; b < NB; ++b) atomicAdd(&mod[b * 6144 + col], acc[b]);
}

__global__ void __launch_bounds__(256) k_xn(const float* __restrict__ x, const float* __restrict__ g1, const float* __restrict__ mod, bf16_t* __restrict__ XN) {
    const int lane = threadIdx.x & 63, row = blockIdx.x * 4 + (threadIdx.x >> 6), b = row / S;
    const f32x4* xr = (const f32x4*)(x + (size_t)row * D) + lane;
    f32x4 v[4]; float ss = 0.f;
#pragma unroll
    for (int j = 0; j < 4; ++j) { v[j] = xr[64 * j]; ss += (v[j].x * v[j].x + v[j].y * v[j].y) + (v[j].z * v[j].z + v[j].w * v[j].w); }
    const float rstd = rsqrtf(wave_sum(ss) * (1.f / D) + RMS_EPS);
    const float* shift = mod + b * 6144, *scale = mod + b * 6144 + 1024;
#pragma unroll
    for (int j = 0; j < 4; ++j) {
        const int c0 = 4 * lane + 256 * j;
        const f32x4 g = *(const f32x4*)(g1 + c0), sc = *(const f32x4*)(scale + c0), sh = *(const f32x4*)(shift + c0);
        f32x4 o;
        o.x = v[j].x * rstd * g.x * (1.f + sc.x) + sh.x; o.y = v[j].y * rstd * g.y * (1.f + sc.y) + sh.y;
        o.z = v[j].z * rstd * g.z * (1.f + sc.z) + sh.z; o.w = v[j].w * rstd * g.w * (1.f + sc.w) + sh.w;
        u32x2 w; w.x = pk2(o.x, o.y); w.y = pk2(o.z, o.w);
        *(u32x2*)(XN + (size_t)row * D + c0) = w;
    }
}

template <class P> __global__ void __launch_bounds__(256) k_gemm(P p) {
    const int wid = threadIdx.x >> 6, lane = threadIdx.x & 63, wr = wid >> 1, wc = wid & 1, fr = lane & 15, fq = lane >> 4;
    typename P::Unit u;
    if (!p.unit(blockIdx.x, u)) return;
    const bf16_t* ap[4]; const bf16_t* bp[4];
#pragma unroll
    for (int m = 0; m < 4; ++m) ap[m] = p.a_row(u, wr * 64 + 16 * m + fr) + 8 * fq;
#pragma unroll
    for (int n = 0; n < 4; ++n) bp[n] = p.b_row(u, wc, n, fr) + 8 * fq;
    f32x4 acc[4][4];
#pragma unroll
    for (int m = 0; m < 4; ++m)
#pragma unroll
        for (int n = 0; n < 4; ++n) acc[m][n] = (f32x4){0.f, 0.f, 0.f, 0.f};
    for (int k0 = 0; k0 < P::K; k0 += 32) {
        bf16x8 a[4], b[4];
#pragma unroll
        for (int m = 0; m < 4; ++m) a[m] = *(const bf16x8*)(ap[m] + k0);
#pragma unroll
        for (int n = 0; n < 4; ++n) b[n] = *(const bf16x8*)(bp[n] + k0);
#pragma unroll
        for (int m = 0; m < 4; ++m)
#pragma unroll
            for (int n = 0; n < 4; ++n) acc[m][n] = __builtin_amdgcn_mfma_f32_16x16x32_bf16(a[m], b[n], acc[m][n], 0, 0, 0);
    }
    p.epi(u, acc, wr, wc, fr, fq);
}

struct InProj {
    static constexpr int K = 1024;
    struct Unit { int bm, bn; };
    const bf16_t* XN; const bf16_t* Wt; bf16_t* QKV; const float *gaq, *gak, *gbq, *gbk;
    __device__ bool unit(int bid, Unit& u) const { u.bm = bid / 24; u.bn = bid % 24; return true; }
    __device__ const bf16_t* a_row(const Unit& u, int r) const { return XN + (size_t)(u.bm * 128 + r) * K; }
    __device__ const bf16_t* b_row(const Unit& u, int wc, int n, int fr) const { return Wt + (size_t)(u.bn * 128 + wc * 64 + 16 * n + fr) * K; }
    __device__ void epi(const Unit& u, f32x4 (&acc)[4][4], int wr, int wc, int fr, int fq) const {
        const int c0 = u.bn * 128 + wc * 64, r0 = u.bm * 128 + wr * 64;
        const float* g = nullptr; float post = 1.f;
        if (c0 < 512) { g = gaq; post = QSCALE; } else if (c0 < 1024) g = gak; else if (c0 < 1536) g = nullptr;
        else if (c0 < 2048) { g = gbq; post = QSCALE; } else if (c0 < 2560) g = gbk;
#pragma unroll
        for (int m = 0; m < 4; ++m)
#pragma unroll
            for (int j = 0; j < 4; ++j) {
                float sc[4] = {1.f, 1.f, 1.f, 1.f};
                if (g) {
                    float ss = 0.f;
#pragma unroll
                    for (int n = 0; n < 4; ++n) ss += acc[m][n][j] * acc[m][n][j];
                    ss += __shfl_xor(ss, 1); ss += __shfl_xor(ss, 2); ss += __shfl_xor(ss, 4); ss += __shfl_xor(ss, 8);
                    const float rstd = rsqrtf(ss * (1.f / 64.f) + RMS_EPS) * post;
#pragma unroll
                    for (int n = 0; n < 4; ++n) sc[n] = rstd * g[16 * n + fr];
                }
                const int row = r0 + 16 * m + 4 * fq + j;
#pragma unroll
                for (int n = 0; n < 4; ++n) QKV[(size_t)row * NIN + c0 + 16 * n + fr] = f2bf(acc[m][n][j] * sc[n]);
            }
    }
};

struct OutProj {
    static constexpr int K = 1024;
    struct Unit { int bm, bn; };
    const bf16_t* AO; const bf16_t* Wt; const float* x; const float* mod; float* x1;
    __device__ bool unit(int bid, Unit& u) const { u.bm = bid / 8; u.bn = bid % 8; return true; }
    __device__ const bf16_t* a_row(const Unit& u, int r) const { return AO + (size_t)(u.bm * 128 + r) * K; }
    __device__ const bf16_t* b_row(const Unit& u, int wc, int n, int fr) const { return Wt + (size_t)(u.bn * 128 + wc * 64 + 16 * n + fr) * K; }
    __device__ void epi(const Unit& u, f32x4 (&acc)[4][4], int wr, int wc, int fr, int fq) const {
        const int c0 = u.bn * 128 + wc * 64, r0 = u.bm * 128 + wr * 64;
        const float* gate1 = mod + ((r0 / S) * 6144) + 2048;
#pragma unroll
        for (int m = 0; m < 4; ++m)
#pragma unroll
            for (int j = 0; j < 4; ++j) {
                const int row = r0 + 16 * m + 4 * fq + j;
#pragma unroll
                for (int n = 0; n < 4; ++n) { const int col = c0 + 16 * n + fr; x1[(size_t)row * D + col] = x[(size_t)row * D + col] + gate1[col] * acc[m][n][j]; }
            }
    }
};

struct GateUp {
    static constexpr int K = 1024;
    struct Unit { int e, mt, nt, cnt, ps; };
    const bf16_t* H2; const bf16_t* Wt; const float* bgu; const int* counts; const int* padstart; const int* list; bf16_t* ACT;
    __device__ bool unit(int bid, Unit& u) const {
        u.nt = bid % 16; u.mt = (bid / 16) % 128; u.e = bid / (16 * 128); u.cnt = counts[u.e]; u.ps = padstart[u.e];
        return u.mt * 128 < u.cnt;
    }
    __device__ const bf16_t* a_row(const Unit& u, int r) const { int rr = u.mt * 128 + r; if (rr >= u.cnt) rr = 0; return H2 + (size_t)list[u.e * M + rr] * K; }
    __device__ const bf16_t* b_row(const Unit& u, int wc, int n, int fr) const {
        const int j = u.nt * 64 + wc * 32 + 16 * (n & 1) + fr; return Wt + ((size_t)u.e * 2048 + (n >> 1) * 1024 + j) * K; }
    __device__ void epi(const Unit& u, f32x4 (&acc)[4][4], int wr, int wc, int fr, int fq) const {
        const float* bias = bgu + u.e * 2048;
#pragma unroll
        for (int m = 0; m < 4; ++m)
#pragma unroll
            for (int j = 0; j < 4; ++j) {
                const int rr = u.mt * 128 + wr * 64 + 16 * m + 4 * fq + j;
                if (rr < u.cnt) {
#pragma unroll
                    for (int n = 0; n < 2; ++n) {
                        const int col = u.nt * 64 + wc * 32 + 16 * n + fr;
                        float g = acc[m][n][j] + bias[col], uu = acc[m][n + 2][j] + bias[1024 + col];
                        g = fminf(g, 7.f); uu = fminf(fmaxf(uu, -7.f), 7.f);
                        const float a = (uu + 1.f) * (g / (1.f + __expf(-1.702f * g)));
                        ACT[(size_t)(u.ps + rr) * DFF + col] = f2bf(a);
                    }
                }
            }
    }
};

struct Down {
    static constexpr int K = 1024;
    struct Unit { int e, mt, nt, cnt, ps; };
    const bf16_t* ACT; const bf16_t* Wt; const float* bd; const int* counts; const int* padstart; bf16_t* Y;
    __device__ bool unit(int bid, Unit& u) const {
        u.nt = bid % 8; u.mt = (bid / 8) % 128; u.e = bid / (8 * 128); u.cnt = counts[u.e]; u.ps = padstart[u.e];
        return u.mt * 128 < u.cnt;
    }
    __device__ const bf16_t* a_row(const Unit& u, int r) const { int rr = u.mt * 128 + r; if (rr >= u.cnt) rr = 0; return ACT + (size_t)(u.ps + rr) * K; }
    __device__ const bf16_t* b_row(const Unit& u, int wc, int n, int fr) const { return Wt + ((size_t)u.e * 1024 + u.nt * 128 + wc * 64 + 16 * n + fr) * K; }
    __device__ void epi(const Unit& u, f32x4 (&acc)[4][4], int wr, int wc, int fr, int fq) const {
        const float* bias = bd + u.e * 1024;
#pragma unroll
        for (int m = 0; m < 4; ++m)
#pragma unroll
            for (int j = 0; j < 4; ++j) {
                const int rr = u.mt * 128 + wr * 64 + 16 * m + 4 * fq + j;
                if (rr < u.cnt) {
#pragma unroll
                    for (int n = 0; n < 4; ++n) { const int col = u.nt * 128 + wc * 64 + 16 * n + fr; Y[(size_t)(u.ps + rr) * D + col] = f2bf(acc[m][n][j] + bias[col]); }
                }
            }
    }
};

__global__ void __launch_bounds__(256) k_attn_a(const bf16_t* __restrict__ QKV, bf16_t* __restrict__ AO) {
    const int gid = blockIdx.x * 256 + threadIdx.x;
    const int t = gid % S, h = (gid / S) % 8, b = gid / (S * 8);
    const bf16_t* qp = QKV + (size_t)(b * S + t) * NIN + h * 64;
    float q[64];
#pragma unroll
    for (int d = 0; d < 64; ++d) q[d] = bf2f(qp[d]);
    const float slope2 = exp2f(-(float)(h + 1)) * LOG2E;
    float m = -INFINITY, l = 0.f, o[64];
#pragma unroll
    for (int d = 0; d < 64; ++d) o[d] = 0.f;
    for (int p = 0; p < 3; ++p) {
        const int dil = (p == 0) ? 1 : (p == 1 ? 4 : 16);
        for (int i = 0; i <= 128; ++i) {
            const int pos = t - i * dil; if (pos < 0) break;
            const bf16_t* kp = QKV + (size_t)(b * S + pos) * NIN + 512 + h * 64; const bf16_t* vp = kp + 512;
            float s = 0.f;
#pragma unroll
            for (int d = 0; d < 64; ++d) s += q[d] * bf2f(kp[d]);
            s -= slope2 * (float)(i * dil);
            const float mn = fmaxf(m, s), f = exp2f(m - mn), pe = exp2f(s - mn);
            l = l * f + pe;
#pragma unroll
            for (int d = 0; d < 64; ++d) o[d] = o[d] * f + pe * bf2f(vp[d]);
            m = mn;
        }
    }
    const float rl = 1.f / l;
    bf16_t* op = AO + (size_t)(b * S + t) * D + h * 64;
#pragma unroll
    for (int d = 0; d < 64; ++d) op[d] = f2bf(o[d] * rl);
}

__global__ void __launch_bounds__(256) k_attn_b(const bf16_t* __restrict__ QKV, float* __restrict__ OBN) {
    const int gid = blockIdx.x * 256 + threadIdx.x;
    const int t = gid % S, dh = (gid / S) & 1, c = (gid / (2 * S)) & 1, h = (gid / (4 * S)) & 3, b = gid / (16 * S);
    const bf16_t* qp = QKV + (size_t)(b * S + t) * NIN + 1536 + h * 128 + c * 64;
    float q[64];
#pragma unroll
    for (int d = 0; d < 64; ++d) q[d] = bf2f(qp[d]);
    const float slope2 = exp2f(-2.f * (float)(h + 1)) * LOG2E;
    float m = -INFINITY, l = 0.f, o[64];
#pragma unroll
    for (int d = 0; d < 64; ++d) o[d] = 0.f;
    const int tmax = __shfl(t, 63);
    for (int pos = 0; pos <= tmax; ++pos) {
        const bf16_t* kp = QKV + (size_t)(b * S + pos) * NIN + 2048 + h * 128 + c * 64;
        const bf16_t* vp = QKV + (size_t)(b * S + pos) * NIN + 2560 + h * 128 + dh * 64;
        float s = 0.f;
#pragma unroll
        for (int d = 0; d < 64; ++d) s += q[d] * bf2f(kp[d]);
        s -= slope2 * (float)(t - pos);
        if (pos <= t) {
            const float mn = fmaxf(m, s), f = exp2f(m - mn), pe = exp2f(s - mn);
            l = l * f + pe;
#pragma unroll
            for (int d = 0; d < 64; ++d) o[d] = o[d] * f + pe * bf2f(vp[d]);
            m = mn;
        }
    }
    const float rl = 1.f / l;
    float* op = OBN + ((size_t)c * M + (b * S + t)) * 512 + h * 128 + dh * 64;
#pragma unroll
    for (int d = 0; d < 64; ++d) op[d] = o[d] * rl;
}
__global__ void __launch_bounds__(256) k_diff_combine(const float* __restrict__ OBN, const float* lq1, const float* lk1, const float* lq2, const float* lk2, const float* __restrict__ gd, bf16_t* __restrict__ AO) {
    const int lane = threadIdx.x & 63, w = blockIdx.x * 4 + (threadIdx.x >> 6);
    const int tok = w >> 2, h = w & 3;
    const float s1 = wave_sum(lq1[lane] * lk1[lane]), s2 = wave_sum(lq2[lane] * lk2[lane]);
    const float lam = __expf(s1) - __expf(s2) + LAMBDA_INIT;
    const float* p0 = OBN + (size_t)tok * 512 + h * 128 + 2 * lane; const float* p1 = p0 + (size_t)M * 512;
    const float a = p0[0] - lam * p1[0], bq = p0[1] - lam * p1[1];
    const float rstd = rsqrtf(wave_sum(a * a + bq * bq) * (1.f / 128.f) + RMS_EPS) * (1.f - LAMBDA_INIT);
    *(unsigned*)(AO + (size_t)tok * D + 512 + h * 128 + 2 * lane) = pk2(a * rstd * gd[2 * lane], bq * rstd * gd[2 * lane + 1]);
}

__global__ void __launch_bounds__(256) k_router(const float* __restrict__ x1, const float* __restrict__ g2, const float* __restrict__ mod, const float* __restrict__ wr, const float* __restrict__ br,
                                                bf16_t* __restrict__ H2, int* counts, int* tope, int* tops, float* topg, int* list) {
    const int lane = threadIdx.x & 63, row = blockIdx.x * 4 + (threadIdx.x >> 6), b = row / S;
    const f32x4* xr = (const f32x4*)(x1 + (size_t)row * D) + lane;
    f32x4 v[4]; float ss = 0.f;
#pragma unroll
    for (int j = 0; j < 4; ++j) { v[j] = xr[64 * j]; ss += (v[j].x * v[j].x + v[j].y * v[j].y) + (v[j].z * v[j].z + v[j].w * v[j].w); }
    const float rstd = rsqrtf(wave_sum(ss) * (1.f / D) + RMS_EPS);
    const float* shift = mod + b * 6144 + 3072, *scale = mod + b * 6144 + 4096;
    float lg[NE];
#pragma unroll
    for (int e = 0; e < NE; ++e) lg[e] = 0.f;
#pragma unroll
    for (int j = 0; j < 4; ++j) {
        const int c0 = 4 * lane + 256 * j;
        const f32x4 g = *(const f32x4*)(g2 + c0), sc = *(const f32x4*)(scale + c0), sh = *(const f32x4*)(shift + c0);
        float o[4];
        o[0] = v[j].x * rstd * g.x * (1.f + sc.x) + sh.x; o[1] = v[j].y * rstd * g.y * (1.f + sc.y) + sh.y;
        o[2] = v[j].z * rstd * g.z * (1.f + sc.z) + sh.z; o[3] = v[j].w * rstd * g.w * (1.f + sc.w) + sh.w;
        u32x2 w; w.x = pk2(o[0], o[1]); w.y = pk2(o[2], o[3]);
        *(u32x2*)(H2 + (size_t)row * D + c0) = w;
#pragma unroll
        for (int i = 0; i < 4; ++i) {
            const f32x4* wrow = (const f32x4*)(wr + (size_t)(c0 + i) * NE);
#pragma unroll
            for (int e4 = 0; e4 < 8; ++e4) { const f32x4 wv = wrow[e4]; lg[4 * e4] += o[i] * wv.x; lg[4 * e4 + 1] += o[i] * wv.y; lg[4 * e4 + 2] += o[i] * wv.z; lg[4 * e4 + 3] += o[i] * wv.w; }
        }
    }
#pragma unroll
    for (int e = 0; e < NE; ++e) lg[e] = wave_sum(lg[e]) + br[e];
    if (lane == 0) {
        int idx[4]; float val[4];
#pragma unroll
        for (int k = 0; k < 4; ++k) {
            float best = -INFINITY; int bi = 0;
#pragma unroll
            for (int e = 0; e < NE; ++e) { bool taken = false;
#pragma unroll
                for (int kk = 0; kk < k; ++kk) taken |= (idx[kk] == e);
                if (!taken && lg[e] > best) { best = lg[e]; bi = e; } }
            idx[k] = bi; val[k] = best;
        }
        float den = 0.f, ex[4];
#pragma unroll
        for (int k = 0; k < 4; ++k) { ex[k] = __expf(val[k] - val[0]); den += ex[k]; }
#pragma unroll
        for (int k = 0; k < 4; ++k) {
            const int slot = atomicAdd(&counts[idx[k]], 1);
            tope[row * 4 + k] = idx[k]; tops[row * 4 + k] = slot; topg[row * 4 + k] = ex[k] / den;
            list[idx[k] * M + slot] = row;
        }
    }
}
__global__ void k_padstart(const int* counts, int* padstart) {
    if (threadIdx.x == 0) { int acc = 0; for (int e = 0; e < NE; ++e) { padstart[e] = acc; acc += (counts[e] + 255) / 256 * 256; } padstart[NE] = acc; }
}
__global__ void __launch_bounds__(256) k_combine(float* out, const float* __restrict__ mod, const bf16_t* __restrict__ Y, const int* __restrict__ tope, const int* __restrict__ tops, const float* __restrict__ topg, const int* __restrict__ padstart) {
    const int lane = threadIdx.x & 63, row = blockIdx.x * 4 + (threadIdx.x >> 6), b = row / S;
    const float* gate2 = mod + b * 6144 + 5120;
    const bf16_t* yr[4]; float gk[4];
#pragma unroll
    for (int k = 0; k < 4; ++k) { yr[k] = Y + (size_t)(padstart[tope[row * 4 + k]] + tops[row * 4 + k]) * D; gk[k] = topg[row * 4 + k]; }
#pragma unroll
    for (int j = 0; j < 4; ++j) {
        const int c0 = 4 * lane + 256 * j;
        f32x4 acc = (f32x4){0.f, 0.f, 0.f, 0.f};
#pragma unroll
        for (int k = 0; k < 4; ++k) { const u32x2 w = *(const u32x2*)(yr[k] + c0);
            acc.x += gk[k] * __uint_as_float(w.x << 16); acc.y += gk[k] * __uint_as_float(w.x & 0xffff0000u);
            acc.z += gk[k] * __uint_as_float(w.y << 16); acc.w += gk[k] * __uint_as_float(w.y & 0xffff0000u); }
        const f32x4 g = *(const f32x4*)(gate2 + c0);
        f32x4* op = (f32x4*)(out + (size_t)row * D + c0);
        f32x4 xv = *op;
        xv.x += g.x * acc.x; xv.y += g.y * acc.y; xv.z += g.z * acc.z; xv.w += g.w * acc.w;
        *op = xv;
    }
}


#define LAS __attribute__((address_space(3)))
#define GAS __attribute__((address_space(1)))
#define RLX_AGENT __ATOMIC_RELAXED, __HIP_MEMORY_SCOPE_AGENT
#define LDS_WAIT() asm volatile("s_waitcnt lgkmcnt(0)" ::: "memory")
#define VM_WAIT() asm volatile("s_waitcnt vmcnt(0)" ::: "memory")

constexpr int NWAVES = 8, NTHREADS = 512;
constexpr int RING_BYTES = 131072, LDSCTL_OFF = RING_BYTES, MISC_OFF = LDSCTL_OFF + 320, PT_OFF = LDSCTL_OFF + 512, CNT_OFF = LDSCTL_OFF + 768, LDS_BYTES = 147456;
constexpr size_t CTL_BAR = 16384;
constexpr int NPHASE = 10;

#define XB_TMO      128
#define XB_XCNT(j)  (256  + 64 * (j))
#define XB_XSUB(j)  (1280 + 64 * (j))
#define XB_XGEN(j)  (2304 + 64 * (j))
#define XB_TOP      3328
#define XB_TOPGEN   3392
#define XCD_BAR_WORDS 3456
#define XB_SPIN_CAP (1u << 22)
__device__ __forceinline__ unsigned xb_ld(unsigned* p)              { return __hip_atomic_load(p, __ATOMIC_RELAXED, __HIP_MEMORY_SCOPE_AGENT); }
__device__ __forceinline__ unsigned xb_add(unsigned* p, unsigned v) { return __hip_atomic_fetch_add(p, v, __ATOMIC_RELAXED, __HIP_MEMORY_SCOPE_AGENT); }
__device__ __forceinline__ unsigned xb_xcc_id() { return (unsigned)__builtin_amdgcn_s_getreg((3 << 11) | 20) & 0xFu; }
#define XB_SPIN(cond, bar) do { unsigned _sp = 0; while (cond) { __builtin_amdgcn_s_sleep(1); \
    if ((++_sp & 255u) == 0u) { if (xb_ld(&(bar)[XB_TMO])) break; if (_sp > XB_SPIN_CAP) { atomicAdd(&(bar)[XB_TMO], 1u); break; } } } } while (0)
struct XcdBarrier { unsigned* bar; unsigned x; volatile LAS unsigned* st; };
__device__ __forceinline__ XcdBarrier xcd_barrier_post(unsigned* bar, volatile LAS unsigned* st) {
    XcdBarrier b; b.bar = bar; b.x = xb_xcc_id(); b.st = st;
    if (threadIdx.x == 0) (void)xb_add(&bar[XB_XCNT(b.x)], 1u);
    return b;
}
__device__ __forceinline__ void xcd_barrier_complete(unsigned* bar, unsigned x, unsigned& nloc, unsigned& nx) {
    const unsigned G = gridDim.x * gridDim.y * gridDim.z;
    unsigned sum, cnt, mine, sp = 0u;
    for (;;) {
        sum = 0u; cnt = 0u; mine = 0u;
#pragma unroll
        for (unsigned j = 0; j < 16; ++j) { const unsigned c = xb_ld(&bar[XB_XCNT(j)]); sum += c; cnt += (c > 0u) ? 1u : 0u; mine = (j == x) ? c : mine; }
        if (sum == G) break;
        __builtin_amdgcn_s_sleep(1);
        if ((++sp & 255u) == 0u) { if (xb_ld(&bar[XB_TMO])) break; if (sp > XB_SPIN_CAP) { atomicAdd(&bar[XB_TMO], 1u); break; } }
    }
    nloc = mine > 0u ? mine : 1u; nx = cnt > 0u ? cnt : 1u;
}
__device__ __forceinline__ void xcd_barrier(const XcdBarrier& b, int wave) {
    asm volatile("s_waitcnt vmcnt(0)" ::: "memory");
    __syncthreads();
    if (wave == 0 && __builtin_amdgcn_mbcnt_hi(~0u, __builtin_amdgcn_mbcnt_lo(~0u, 0u)) == 0u) {
        unsigned* bar = b.bar;
        __builtin_amdgcn_s_waitcnt(0);
        unsigned nloc = b.st[0], nx = b.st[1];
        if (nloc == 0u) { xcd_barrier_complete(bar, b.x, nloc, nx); b.st[0] = nloc; b.st[1] = nx; }
        const unsigned old = xb_add(&bar[XB_XSUB(b.x)], 1u);
        const unsigned gen = old / nloc;
        if (old + 1u == (gen + 1u) * nloc) {
            __builtin_amdgcn_fence(__ATOMIC_RELEASE, "agent");
            asm volatile("s_waitcnt vmcnt(0)" ::: "memory");
            const unsigned og = xb_add(&bar[XB_TOP], 1u);
            const unsigned tg = og / nx;
            if (og + 1u == (tg + 1u) * nx) xb_add(&bar[XB_TOPGEN], 1u);
            else XB_SPIN(xb_ld(&bar[XB_TOPGEN]) == tg, bar);
            __builtin_amdgcn_fence(__ATOMIC_ACQUIRE, "agent");
            xb_add(&bar[XB_XGEN(b.x)], 1u);
            asm volatile("s_waitcnt vmcnt(0)" ::: "memory");
        } else {
            XB_SPIN(xb_ld(&bar[XB_XGEN(b.x)]) == gen, bar);
            __builtin_amdgcn_fence(__ATOMIC_ACQUIRE, "agent");
            asm volatile("s_waitcnt vmcnt(0)" ::: "memory");
        }
    }
    __syncthreads();
}

namespace pg8 {
constexpr int BM = 256, BK = 64, HALF = 128, HTB = HALF * BK * 2, STAGE_BYTES = 8 * HTB, NXCD = 8, WGM = 8;
__host__ __device__ __forceinline__ int lds_byte(int r, int c) { const int st = (r >> 4) * 2 + (c >> 5), rr = r & 15, cc = c & 31, ob = rr * 64 + cc * 2; return st * 1024 + (ob ^ (((ob >> 9) & 1) << 5)); }
__host__ __device__ __forceinline__ void stage_rc(int b, int& R, int& C) { const int st = b / 1024, sb = b % 1024, swz = sb ^ (((sb >> 9) & 1) << 5); R = (st >> 1) * 16 + swz / 64; C = (st & 1) * 32 + (swz % 64) / 2; }
__host__ __device__ __forceinline__ int perm32(int rho) { const int n = rho >> 4, i = rho & 15; return 8 * (i >> 2) + 4 * n + (i & 3); }
__device__ __forceinline__ unsigned cvt_pk_bf16(float lo, float hi) { unsigned r; asm volatile("v_cvt_pk_bf16_f32 %0, %1, %2" : "=v"(r) : "v"(lo), "v"(hi)); return r; }

struct Unit { int pm, pn, e, cnt; };

template <class P>
__device__ __forceinline__ void gemm_phase(LAS unsigned char* lds, const P& p, int wid) {
    int lane = (int)__builtin_amdgcn_mbcnt_hi(~0u, __builtin_amdgcn_mbcnt_lo(~0u, 0u)); asm volatile("" : "+v"(lane));
    const int tid = wid * 64 + lane, wr = wid >> 2, wc = wid & 3, fr = lane & 15, fq = lane >> 4;
    constexpr int K = P::K, nt = K / BK;
    int Rr[2], Cc[2];
#pragma unroll
    for (int i = 0; i < 2; ++i) stage_rc(tid * 16 + i * 8192, Rr[i], Cc[i]);
    unsigned voffB[2][2], voffA[2][2], voffAn[2][2];
#pragma unroll
    for (int h = 0; h < 2; ++h)
#pragma unroll
        for (int i = 0; i < 2; ++i) { voffB[h][i] = (unsigned)(P::brow(h, Rr[i]) * K + Cc[i]) * 2u; voffA[h][i] = (unsigned)((h * HALF + Rr[i]) * K + Cc[i]) * 2u; voffAn[h][i] = voffA[h][i]; }
    const size_t kstep = (size_t)(BK * 2);
    const unsigned ldsw = (unsigned)wid * 1024u;
    const int aoff = lds_byte(wr * 64 + fr, fq * 8), boff = lds_byte(wc * 32 + fr, fq * 8);
#define PG8_SA(b, h) (((b) * 2 + (h)) * HTB)
#define PG8_SB(b, h) ((4 + (b) * 2 + (h)) * HTB)
#define PG8_STAGE(bufoff, gbase, voff) do { _Pragma("unroll") for (int _i = 0; _i < 2; ++_i) \
        __builtin_amdgcn_global_load_lds((const unsigned*)((const char*)(gbase) + (voff)[_i]), (LAS unsigned*)(lds + (bufoff) + ldsw + _i * 8192), 16, 0, 0); } while (0)
#define PG8_LDA(dst, b, h) do { _Pragma("unroll") for (int m = 0; m < 4; ++m) _Pragma("unroll") for (int k = 0; k < 2; ++k) dst[m][k] = *(const LAS bf16x8*)(lds + PG8_SA(b, h) + aoff + m * 2048 + k * 1024); } while (0)
#define PG8_LDB(dst, b, h) do { _Pragma("unroll") for (int n = 0; n < 2; ++n) _Pragma("unroll") for (int k = 0; k < 2; ++k) dst[n][k] = *(const LAS bf16x8*)(lds + PG8_SB(b, h) + boff + n * 2048 + k * 1024); } while (0)
#define PG8_MMA(ai, bj, At, Bt) do { __builtin_amdgcn_s_setprio(1); _Pragma("unroll") for (int m = 0; m < 4; ++m) _Pragma("unroll") for (int n = 0; n < 2; ++n) _Pragma("unroll") for (int k = 0; k < 2; ++k) \
        acc[ai][bj][m][n] = __builtin_amdgcn_mfma_f32_16x16x32_bf16(Bt[n][k], At[m][k], acc[ai][bj][m][n], 0, 0, 0); __builtin_amdgcn_s_setprio(0); } while (0)
#define PG8_WAIT_V(n) asm volatile("s_waitcnt vmcnt(" #n ")" ::: "memory")
#define PG8_WAIT_L(n) asm volatile("s_waitcnt lgkmcnt(" #n ")" ::: "memory")
#define PG8_BAR __builtin_amdgcn_s_barrier()
#define PG8_SCHED __builtin_amdgcn_sched_barrier(0)
    Unit cur, nxt; int ui = 0;
    if (!p.next(0, cur)) return;
    f32x4 acc[2][2][4][2];
#pragma unroll
    for (int a = 0; a < 2; ++a)
#pragma unroll
        for (int b = 0; b < 2; ++b)
#pragma unroll
            for (int m = 0; m < 4; ++m)
#pragma unroll
                for (int n = 0; n < 2; ++n) acc[a][b][m][n] = (f32x4){0.f, 0.f, 0.f, 0.f};
    bf16x8 At[4][2], B0[2][2], B1[2][2];
    const char* cA = p.a_base(cur); const char* cB = p.b_base(cur);
    if constexpr (P::GATHER) p.a_offsets(cur, Rr, Cc, voffA);
    PG8_STAGE(PG8_SB(0, 0), cB, voffB[0]); PG8_STAGE(PG8_SB(0, 1), cB, voffB[1]); PG8_STAGE(PG8_SA(0, 0), cA, voffA[0]); PG8_STAGE(PG8_SA(0, 1), cA, voffA[1]);
    if (wr == 1) PG8_BAR;
    PG8_WAIT_V(2); PG8_BAR;
    PG8_STAGE(PG8_SB(1, 0), cB + kstep, voffB[0]); PG8_STAGE(PG8_SA(1, 0), cA + kstep, voffA[0]); PG8_STAGE(PG8_SB(1, 1), cB + kstep, voffB[1]);
    PG8_WAIT_V(6); PG8_BAR;
    for (;;) {
        const bool has_next = p.next(ui + 1, nxt);
        const char* nA = has_next ? p.a_base(nxt) : cA; const char* nB = has_next ? p.b_base(nxt) : cB;
        if constexpr (P::GATHER) { if (has_next) p.a_offsets(nxt, Rr, Cc, voffAn); else {
#pragma unroll
            for (int h = 0; h < 2; ++h)
#pragma unroll
                for (int i = 0; i < 2; ++i) voffAn[h][i] = voffA[h][i]; } }
        for (int t = 0; t < nt; t += 2) {
            const bool last = (t == nt - 2);
            const char* a1 = cA + (size_t)(t + 1) * kstep;
            const char* a2 = last ? nA : cA + (size_t)(t + 2) * kstep; const char* b2 = last ? nB : cB + (size_t)(t + 2) * kstep;
            const char* a3 = a2 + kstep; const char* b3 = b2 + kstep;
            unsigned va2[2][2];
#pragma unroll
            for (int h = 0; h < 2; ++h)
#pragma unroll
                for (int i = 0; i < 2; ++i) va2[h][i] = (P::GATHER && last) ? voffAn[h][i] : voffA[h][i];
            PG8_LDB(B0, 0, 0); PG8_LDB(B1, 0, 1); PG8_SCHED; PG8_LDA(At, 0, 0); PG8_STAGE(PG8_SA(1, 1), a1, voffA[1]);
            PG8_WAIT_V(8); PG8_WAIT_L(0); PG8_BAR; PG8_MMA(0, 0, At, B0); PG8_MMA(0, 1, At, B1); PG8_BAR; PG8_SCHED;
            PG8_LDA(At, 0, 1); PG8_STAGE(PG8_SB(0, 0), b2, voffB[0]); PG8_STAGE(PG8_SB(0, 1), b2, voffB[1]); PG8_STAGE(PG8_SA(0, 0), a2, va2[0]);
            PG8_WAIT_V(8); PG8_WAIT_L(0); PG8_BAR; PG8_MMA(1, 0, At, B0); PG8_MMA(1, 1, At, B1); PG8_BAR; PG8_SCHED;
            PG8_LDB(B0, 1, 0); PG8_LDB(B1, 1, 1); PG8_SCHED; PG8_LDA(At, 1, 0); PG8_STAGE(PG8_SA(0, 1), a2, va2[1]);
            PG8_WAIT_V(8); PG8_WAIT_L(0); PG8_BAR; PG8_MMA(0, 0, At, B0); PG8_MMA(0, 1, At, B1); PG8_BAR; PG8_SCHED;
            PG8_LDA(At, 1, 1); PG8_STAGE(PG8_SB(1, 0), b3, voffB[0]); PG8_STAGE(PG8_SB(1, 1), b3, voffB[1]); PG8_STAGE(PG8_SA(1, 0), a3, va2[0]);
            PG8_WAIT_V(8); PG8_WAIT_L(0); PG8_BAR; PG8_MMA(1, 0, At, B0); PG8_MMA(1, 1, At, B1); PG8_BAR; PG8_SCHED;
        }
        if (wr == 0) PG8_BAR;
        p.epi(acc, cur, wr, wc, fr, fq);
        if (!has_next) break;
#pragma unroll
        for (int a = 0; a < 2; ++a)
#pragma unroll
            for (int b = 0; b < 2; ++b)
#pragma unroll
                for (int m = 0; m < 4; ++m)
#pragma unroll
                    for (int n = 0; n < 2; ++n) acc[a][b][m][n] = (f32x4){0.f, 0.f, 0.f, 0.f};
        cur = nxt; cA = nA; cB = nB; ++ui;
        if constexpr (P::GATHER) {
#pragma unroll
            for (int h = 0; h < 2; ++h)
#pragma unroll
                for (int i = 0; i < 2; ++i) voffA[h][i] = voffAn[h][i]; }
        if (wr == 1) PG8_BAR;
    }
    PG8_WAIT_V(0);
    PG8_BAR;
#undef PG8_SA
#undef PG8_SB
#undef PG8_STAGE
#undef PG8_LDA
#undef PG8_LDB
#undef PG8_MMA
#undef PG8_WAIT_V
#undef PG8_WAIT_L
#undef PG8_BAR
#undef PG8_SCHED
}

struct DenseOrder {
    int nM, nN, nwg, G, c;
    __device__ void init(int M_, int N_, int G_, int c_) { nM = M_ / BM; nN = N_ / BM; nwg = nM * nN; G = G_; c = c_; }
    __device__ bool next(int i, Unit& u) const {
        const long L = (long)i * G + c; if (L >= nwg) return false;
        int wgid = (int)L; { const int q = nwg / NXCD, r = nwg % NXCD, xcd = wgid % NXCD, off = wgid / NXCD; wgid = (xcd < r ? xcd * (q + 1) : r * (q + 1) + (xcd - r) * q) + off; }
        const int nig = WGM * nN, gid = wgid / nig, fm = gid * WGM, gsz = (nM - fm) < WGM ? (nM - fm) : WGM;
        u.pm = fm + ((wgid % nig) % gsz); u.pn = (wgid % nig) / gsz; u.e = 0; u.cnt = 0; return true;
    }
};
struct GroupOrder {
    const LAS int* pt; const LAS int* cn; int npn, total, G, c;
    __device__ void init(const LAS int* pt_, const LAS int* cn_, int npn_, int G_, int c_) { pt = pt_; cn = cn_; npn = npn_; total = __builtin_amdgcn_readfirstlane(pt_[NE] * npn_); G = G_; c = c_; }
    __device__ bool next(int i, Unit& u) const {
        const long L = (long)i * G + c; if (L >= total) return false;
        int wgid = (int)L; { const int q = total / NXCD, r = total % NXCD, xcd = wgid % NXCD, off = wgid / NXCD; wgid = (xcd < r ? xcd * (q + 1) : r * (q + 1) + (xcd - r) * q) + off; }
        int e = 0;
        for (int j = 1; j < NE; ++j) e += (pt[j] * npn <= wgid) ? 1 : 0;
        const int t0 = pt[e], te = pt[e + 1] - t0, local = wgid - t0 * npn;
        const int mt = local % te;
        u.e = __builtin_amdgcn_readfirstlane(e); u.pn = __builtin_amdgcn_readfirstlane(local / te); u.pm = __builtin_amdgcn_readfirstlane(t0 + mt);
        u.cnt = __builtin_amdgcn_readfirstlane(cn[e] - mt * 256); return true;
    }
};
}

struct PInProj : pg8::DenseOrder {
    static constexpr int K = 1024; static constexpr bool GATHER = false;
    const bf16_t* XN; const bf16_t* Wt; bf16_t* QKV; const float *gaq, *gak, *gbq, *gbk;
    static __device__ __forceinline__ int brow(int bj, int R) { return 64 * (R >> 5) + 32 * bj + pg8::perm32(R & 31); }
    __device__ __forceinline__ const char* a_base(const pg8::Unit& u) const { return (const char*)(XN + (size_t)u.pm * 256 * K); }
    __device__ __forceinline__ const char* b_base(const pg8::Unit& u) const { return (const char*)(Wt + (size_t)u.pn * 256 * K); }
    __device__ __forceinline__ void epi(const f32x4 (&acc)[2][2][4][2], const pg8::Unit& u, int wr, int wc, int fr, int fq) const {
        const int ty = u.pn >> 1;
        const float* g = (ty == 0) ? gaq : (ty == 1) ? gak : (ty == 3) ? gbq : (ty == 4) ? gbk : nullptr;
        const float post = (ty == 0 || ty == 3) ? QSCALE : 1.f;
        const int row0 = u.pm * 256 + wr * 64 + fr, col0 = u.pn * 256 + wc * 64 + 8 * fq;
        f32x4 gv[2][2];
#pragma unroll
        for (int bj = 0; bj < 2; ++bj)
#pragma unroll
            for (int n = 0; n < 2; ++n) gv[bj][n] = g ? *(const f32x4*)(g + 32 * bj + 8 * fq + 4 * n) : (f32x4){1.f, 1.f, 1.f, 1.f};
#pragma unroll
        for (int ai = 0; ai < 2; ++ai)
#pragma unroll
            for (int m = 0; m < 4; ++m) {
                float rs = 1.f;
                if (g) {
                    float ss = 0.f;
#pragma unroll
                    for (int bj = 0; bj < 2; ++bj)
#pragma unroll
                        for (int n = 0; n < 2; ++n) { const f32x4 v = acc[ai][bj][m][n]; ss += (v[0] * v[0] + v[1] * v[1]) + (v[2] * v[2] + v[3] * v[3]); }
                    ss += __shfl_xor(ss, 16); ss += __shfl_xor(ss, 32);
                    rs = rsqrtf(ss * (1.f / 64.f) + RMS_EPS) * post;
                }
                bf16_t* rowp = QKV + (size_t)(row0 + ai * 128 + m * 16) * NIN + col0;
#pragma unroll
                for (int bj = 0; bj < 2; ++bj) {
                    const f32x4 v0 = acc[ai][bj][m][0] * gv[bj][0] * rs, v1 = acc[ai][bj][m][1] * gv[bj][1] * rs;
                    u32x4 w; w.x = pg8::cvt_pk_bf16(v0[0], v0[1]); w.y = pg8::cvt_pk_bf16(v0[2], v0[3]); w.z = pg8::cvt_pk_bf16(v1[0], v1[1]); w.w = pg8::cvt_pk_bf16(v1[2], v1[3]);
                    *(u32x4*)(rowp + 32 * bj) = w;
                }
            }
    }
};
struct POutProj : pg8::DenseOrder {
    static constexpr int K = 1024; static constexpr bool GATHER = false;
    const bf16_t* AO; const bf16_t* Wt; const float* x; const float* mod; float* x1;
    static __device__ __forceinline__ int brow(int bj, int R) { return 128 * bj + R; }
    __device__ __forceinline__ const char* a_base(const pg8::Unit& u) const { return (const char*)(AO + (size_t)u.pm * 256 * K); }
    __device__ __forceinline__ const char* b_base(const pg8::Unit& u) const { return (const char*)(Wt + (size_t)u.pn * 256 * K); }
    __device__ __forceinline__ void epi(const f32x4 (&acc)[2][2][4][2], const pg8::Unit& u, int wr, int wc, int fr, int fq) const {
        const int row0 = u.pm * 256 + wr * 64 + fr, col0 = u.pn * 256 + wc * 32 + 4 * fq;
        const float* gate1 = mod + ((u.pm * 256) / S) * 6144 + 2048;
        f32x4 gv[2][2];
#pragma unroll
        for (int bj = 0; bj < 2; ++bj)
#pragma unroll
            for (int n = 0; n < 2; ++n) gv[bj][n] = *(const f32x4*)(gate1 + col0 + bj * 128 + n * 16);
#pragma unroll
        for (int ai = 0; ai < 2; ++ai)
#pragma unroll
            for (int m = 0; m < 4; ++m) { const size_t off = (size_t)(row0 + ai * 128 + m * 16) * D + col0;
#pragma unroll
                for (int bj = 0; bj < 2; ++bj)
#pragma unroll
                    for (int n = 0; n < 2; ++n) { const f32x4 xv = *(const f32x4*)(x + off + bj * 128 + n * 16); *(f32x4*)(x1 + off + bj * 128 + n * 16) = xv + gv[bj][n] * acc[ai][bj][m][n]; }
                if (m & 1) asm volatile("" ::: "memory"); }
    }
};
struct PGateUp : pg8::GroupOrder {
    static constexpr int K = 1024; static constexpr bool GATHER = true;
    const bf16_t* H2; const bf16_t* Wt; const float* bgu; const int* list; bf16_t* ACT;
    static __device__ __forceinline__ int brow(int bj, int R) { return 1024 * bj + (R & ~31) + pg8::perm32(R & 31); }
    __device__ __forceinline__ const char* a_base(const pg8::Unit&) const { return (const char*)H2; }
    __device__ __forceinline__ const char* b_base(const pg8::Unit& u) const { return (const char*)(Wt + ((size_t)u.e * 2048 + u.pn * 128) * K); }
    __device__ __forceinline__ void a_offsets(const pg8::Unit& u, const int (&R)[2], const int (&C)[2], unsigned (&voff)[2][2]) const {
        const int* lp = list + (size_t)u.e * M + (size_t)(u.pm - pt[u.e]) * 256;
#pragma unroll
        for (int h = 0; h < 2; ++h)
#pragma unroll
            for (int i = 0; i < 2; ++i) { int r = h * 128 + R[i]; r = r < u.cnt ? r : 0; const int tok = lp[r]; voff[h][i] = (unsigned)(tok * K + C[i]) * 2u; }
    }
    __device__ __forceinline__ void epi(const f32x4 (&acc)[2][2][4][2], const pg8::Unit& u, int wr, int wc, int fr, int fq) const {
        const int row0 = u.pm * 256 + wr * 64 + fr, col0 = u.pn * 128 + wc * 32 + 8 * fq;
        const float* bias = bgu + u.e * 2048 + col0;
        f32x4 bg[2], bu[2];
#pragma unroll
        for (int n = 0; n < 2; ++n) { bg[n] = *(const f32x4*)(bias + 4 * n); bu[n] = *(const f32x4*)(bias + 1024 + 4 * n); }
#pragma unroll
        for (int ai = 0; ai < 2; ++ai)
#pragma unroll
            for (int m = 0; m < 4; ++m) {
                float a[2][4];
#pragma unroll
                for (int n = 0; n < 2; ++n)
#pragma unroll
                    for (int r = 0; r < 4; ++r) {
                        float g = acc[ai][0][m][n][r] + bg[n][r], uu = acc[ai][1][m][n][r] + bu[n][r];
                        g = fminf(g, 7.f); uu = fminf(fmaxf(uu, -7.f), 7.f);
                        a[n][r] = (uu + 1.f) * g * __builtin_amdgcn_rcpf(1.f + __builtin_amdgcn_exp2f(-1.702f * LOG2E * g));
                    }
                u32x4 w; w.x = pg8::cvt_pk_bf16(a[0][0], a[0][1]); w.y = pg8::cvt_pk_bf16(a[0][2], a[0][3]); w.z = pg8::cvt_pk_bf16(a[1][0], a[1][1]); w.w = pg8::cvt_pk_bf16(a[1][2], a[1][3]);
                *(u32x4*)(ACT + (size_t)(row0 + ai * 128 + m * 16) * DFF + col0) = w;
            }
    }
};
struct PDown : pg8::GroupOrder {
    static constexpr int K = 1024; static constexpr bool GATHER = false;
    const bf16_t* ACT; const bf16_t* Wt; const float* bd; bf16_t* Y;
    static __device__ __forceinline__ int brow(int bj, int R) { return 128 * bj + (R & ~31) + pg8::perm32(R & 31); }
    __device__ __forceinline__ const char* a_base(const pg8::Unit& u) const { return (const char*)(ACT + (size_t)u.pm * 256 * K); }
    __device__ __forceinline__ const char* b_base(const pg8::Unit& u) const { return (const char*)(Wt + ((size_t)u.e * 1024 + u.pn * 256) * K); }
    __device__ __forceinline__ void epi(const f32x4 (&acc)[2][2][4][2], const pg8::Unit& u, int wr, int wc, int fr, int fq) const {
        const int row0 = u.pm * 256 + wr * 64 + fr, col0 = u.pn * 256 + wc * 32 + 8 * fq;
        const float* bias = bd + u.e * 1024 + col0;
        f32x4 bv[2][2];
#pragma unroll
        for (int bj = 0; bj < 2; ++bj)
#pragma unroll
            for (int n = 0; n < 2; ++n) bv[bj][n] = *(const f32x4*)(bias + bj * 128 + 4 * n);
#pragma unroll
        for (int ai = 0; ai < 2; ++ai)
#pragma unroll
            for (int m = 0; m < 4; ++m) { bf16_t* rowp = Y + (size_t)(row0 + ai * 128 + m * 16) * D + col0;
#pragma unroll
                for (int bj = 0; bj < 2; ++bj) { const f32x4 v0 = acc[ai][bj][m][0] + bv[bj][0], v1 = acc[ai][bj][m][1] + bv[bj][1];
                    u32x4 w; w.x = pg8::cvt_pk_bf16(v0[0], v0[1]); w.y = pg8::cvt_pk_bf16(v0[2], v0[3]); w.z = pg8::cvt_pk_bf16(v1[0], v1[1]); w.w = pg8::cvt_pk_bf16(v1[2], v1[3]);
                    *(u32x4*)(rowp + bj * 128) = w; } }
    }
};

struct MArgs {
    const float *x, *c, *w_ada, *b_ada, *g1, *w_in, *gaq, *gak, *gbq, *gbk, *lq1, *lk1, *lq2, *lk2, *gd, *w_out, *g2, *w_router, *b_router, *w_gu, *b_gu, *w_d, *b_d;
    float* out; unsigned char* ws; int ph_lo, ph_hi;
};

__device__ __forceinline__ void p0_transpose_item(const float* W, int K, int N, bf16_t* WT, LAS float* scr, int item, int lane) {
    const int nblk = N / 32, kb = item / nblk, nb = item % nblk, k0 = 64 * kb, n0 = 32 * nb;
#pragma unroll 8
    for (int i = 0; i < 32; ++i) { const int kk = 2 * i + (lane >> 5); scr[kk * 33 + (lane & 31)] = W[(size_t)(k0 + kk) * N + n0 + (lane & 31)]; }
    LDS_WAIT(); asm volatile("" ::: "memory");
    const int c = lane & 7;
#pragma unroll
    for (int j = 0; j < 4; ++j) { const int n = (lane >> 3) + 8 * j; const LAS float* s = scr + (8 * c) * 33 + n;
        u32x4 o; o.x = pk2(s[0 * 33], s[1 * 33]); o.y = pk2(s[2 * 33], s[3 * 33]); o.z = pk2(s[4 * 33], s[5 * 33]); o.w = pk2(s[6 * 33], s[7 * 33]);
        *(u32x4*)(WT + (size_t)(n0 + n) * K + k0 + 8 * c) = o; }
    LDS_WAIT(); asm volatile("" ::: "memory");
}

__global__ void __launch_bounds__(NTHREADS, 2) mega(MArgs a) {
    extern __shared__ __attribute__((aligned(16))) unsigned char lds_raw[];
    LAS unsigned char* lds = (LAS unsigned char*)lds_raw;
    const int G = gridDim.x, bx = blockIdx.x, vcu = (G % 8 == 0) ? (bx % 8) * (G / 8) + bx / 8 : bx, NGW = G * NWAVES;
    const int wave = __builtin_amdgcn_readfirstlane((int)threadIdx.x >> 6);
#define PHASE_IDS() int lane = (int)__builtin_amdgcn_mbcnt_hi(~0u, __builtin_amdgcn_mbcnt_lo(~0u, 0u)); asm volatile("" : "+v"(lane)); const int tid = wave * 64 + lane, gw = vcu * NWAVES + wave; (void)tid; (void)gw
    volatile LAS unsigned* MISC = (volatile LAS unsigned*)(lds + MISC_OFF);
    LAS int* PT = (LAS int*)(lds + PT_OFF); LAS int* CN = (LAS int*)(lds + CNT_OFF);
#define w_counts ((int*)(a.ws + WS_CTL + CTL_COUNTS))
#define w_mod ((float*)(a.ws + WS_CTL + CTL_MOD))
#define w_Win_t ((bf16_t*)(a.ws + WS_WIN))
#define w_Wout_t ((bf16_t*)(a.ws + WS_WOUT))
#define w_Wgu_t ((bf16_t*)(a.ws + WS_WGU))
#define w_Wd_t ((bf16_t*)(a.ws + WS_WD))
#define w_XN ((bf16_t*)(a.ws + WS_XN))
#define w_QKV ((bf16_t*)(a.ws + WS_QKV))
#define w_AO ((bf16_t*)(a.ws + WS_AO))
#define w_H2 ((bf16_t*)(a.ws + WS_H2))
#define w_tope ((int*)(a.ws + WS_TOPE))
#define w_tops ((int*)(a.ws + WS_TOPS))
#define w_topg ((float*)(a.ws + WS_TOPG))
#define w_list ((int*)(a.ws + WS_LIST))
#define w_ACT ((bf16_t*)(a.ws + WS_ACT))
#define w_Y ((bf16_t*)(a.ws + WS_Y))
#define w_OBN ((float*)(a.ws + WS_OBN))
    for (int u = threadIdx.x; u < (LDS_BYTES - LDSCTL_OFF) / 4; u += NTHREADS) ((LAS unsigned*)(lds + LDSCTL_OFF))[u] = 0u;
    __syncthreads();
    const int lo = a.ph_lo, hi = a.ph_hi;
    XcdBarrier bar; bar.bar = (unsigned*)(a.ws + WS_CTL + CTL_BAR); bar.x = 0; bar.st = nullptr;
    if (hi - lo > 1) bar = xcd_barrier_post((unsigned*)(a.ws + WS_CTL + CTL_BAR), MISC + 8);
#define IN(k) (lo <= (k) && (k) < hi)
#define SEAM(k) do { if (IN(k) && IN((k) + 1)) xcd_barrier(bar, wave); } while (0)
#define LOAD_PT() do { if (wave == 0) { int cv = (lane < NE) ? w_counts[lane] : 0; int tl = (cv + 255) >> 8; int sc = tl; \
        _Pragma("unroll") for (int o = 1; o < 32; o <<= 1) { const int t_ = __shfl_up(sc, o); if ((lane & 31) >= o) sc += t_; } \
        if (lane < NE) { PT[lane + 1] = sc; CN[lane] = cv; } if (lane == 0) PT[0] = 0; } __syncthreads(); } while (0)

    if (IN(0)) {
        PHASE_IDS();
        LAS float* silu = (LAS float*)(lds + 98304);
        for (int i = tid; i < NB * D; i += NTHREADS) { const float cv = a.c[i]; silu[i] = cv / (1.f + __expf(-cv)); }
        __syncthreads();
        if (gw < 24 * 32) {
            const int cc = gw % 24, ks = gw / 24, col = cc * 256 + 4 * lane;
            f32x4 acc[NB];
#pragma unroll
            for (int b = 0; b < NB; ++b) acc[b] = (ks == 0) ? *(const f32x4*)(a.b_ada + col) : (f32x4){0.f, 0.f, 0.f, 0.f};
            for (int k = ks * 32; k < ks * 32 + 32; ++k) {
                const f32x4 w = *(const f32x4*)(a.w_ada + (size_t)k * 6144 + col);
#pragma unroll
                for (int b = 0; b < NB; ++b) acc[b] += w * silu[b * D + k];
            }
#pragma unroll
            for (int b = 0; b < NB; ++b)
#pragma unroll
                for (int r = 0; r < 4; ++r) atomicAdd(&w_mod[b * 6144 + col + r], acc[b][r]);
        }
        LAS float* scr = (LAS float*)(lds + wave * 10240);
        constexpr int I_IN = 16 * 96, I_OUT = 16 * 32, I_GU = 16 * 64, I_D = 16 * 32;
        constexpr int NITEMS = I_IN + I_OUT + NE * I_GU + NE * I_D;
        for (int it = gw; it < NITEMS; it += NGW) {
            int r = it;
            if (r < I_IN) { p0_transpose_item(a.w_in, 1024, 3072, w_Win_t, scr, r, lane); continue; } r -= I_IN;
            if (r < I_OUT) { p0_transpose_item(a.w_out, 1024, 1024, w_Wout_t, scr, r, lane); continue; } r -= I_OUT;
            if (r < NE * I_GU) { const int e = r / I_GU; p0_transpose_item(a.w_gu + (size_t)e * 1024 * 2048, 1024, 2048, w_Wgu_t + (size_t)e * 1024 * 2048, scr, r % I_GU, lane); continue; } r -= NE * I_GU;
            { const int e = r / I_D; p0_transpose_item(a.w_d + (size_t)e * 1024 * 1024, 1024, 1024, w_Wd_t + (size_t)e * 1024 * 1024, scr, r % I_D, lane); }
        }
    }
    SEAM(0);
    if (IN(1)) {
        PHASE_IDS();
        for (int row = gw; row < M; row += NGW) {
            const int b = row / S;
            const f32x4* xr = (const f32x4*)(a.x + (size_t)row * D) + lane;
            f32x4 v[4]; float ss = 0.f;
#pragma unroll
            for (int j = 0; j < 4; ++j) { v[j] = xr[64 * j]; ss += (v[j].x * v[j].x + v[j].y * v[j].y) + (v[j].z * v[j].z + v[j].w * v[j].w); }
            const float rstd = rsqrtf(wave_sum(ss) * (1.f / D) + RMS_EPS);
            const float* shift = w_mod + b * 6144, *scale = w_mod + b * 6144 + 1024;
#pragma unroll
            for (int j = 0; j < 4; ++j) {
                const int c0 = 4 * lane + 256 * j;
                const f32x4 g = *(const f32x4*)(a.g1 + c0), sc = *(const f32x4*)(scale + c0), sh = *(const f32x4*)(shift + c0);
                const f32x4 o = v[j] * rstd * g * (sc + 1.f) + sh;
                u32x2 w; w.x = pk2(o.x, o.y); w.y = pk2(o.z, o.w);
                *(u32x2*)(w_XN + (size_t)row * D + c0) = w;
            }
        }
    }
    SEAM(1);
    if (IN(2)) {
        PHASE_IDS();
        PInProj p; p.init(M, NIN, G, bx); p.XN = w_XN; p.Wt = w_Win_t; p.QKV = w_QKV; p.gaq = a.gaq; p.gak = a.gak; p.gbq = a.gbq; p.gbk = a.gbk;
        pg8::gemm_phase<PInProj>(lds, p, wave);
    }
    SEAM(2);
    if (IN(3)) {
        PHASE_IDS();
        for (int gid = bx * NTHREADS + tid; gid < NB * 8 * S; gid += G * NTHREADS) {
            const int t = gid % S, h = (gid / S) % 8, b = gid / (S * 8);
            const bf16_t* qp = w_QKV + (size_t)(b * S + t) * NIN + h * 64;
            float q[64];
#pragma unroll
            for (int d = 0; d < 64; ++d) q[d] = bf2f(qp[d]);
            const float slope2 = exp2f(-(float)(h + 1)) * LOG2E;
            float m = -INFINITY, l = 0.f, o[64];
#pragma unroll
            for (int d = 0; d < 64; ++d) o[d] = 0.f;
            for (int pp = 0; pp < 3; ++pp) {
                const int dil = (pp == 0) ? 1 : (pp == 1 ? 4 : 16);
                for (int i = 0; i <= 128; ++i) {
                    const int pos = t - i * dil; if (pos < 0) break;
                    const bf16_t* kp = w_QKV + (size_t)(b * S + pos) * NIN + 512 + h * 64; const bf16_t* vp = kp + 512;
                    float s = 0.f;
#pragma unroll
                    for (int d = 0; d < 64; ++d) s += q[d] * bf2f(kp[d]);
                    s -= slope2 * (float)(i * dil);
                    const float mn = fmaxf(m, s), f = exp2f(m - mn), pe = exp2f(s - mn);
                    l = l * f + pe;
#pragma unroll
                    for (int d = 0; d < 64; ++d) o[d] = o[d] * f + pe * bf2f(vp[d]);
                    m = mn;
                }
            }
            const float rl = 1.f / l;
            bf16_t* op = w_AO + (size_t)(b * S + t) * D + h * 64;
#pragma unroll
            for (int d = 0; d < 64; ++d) op[d] = f2bf(o[d] * rl);
        }
        for (int gid = bx * NTHREADS + tid; gid < NB * 4 * 2 * 2 * S; gid += G * NTHREADS) {
            const int t = gid % S, dh = (gid / S) & 1, c = (gid / (2 * S)) & 1, h = (gid / (4 * S)) & 3, b = gid / (16 * S);
            const bf16_t* qp = w_QKV + (size_t)(b * S + t) * NIN + 1536 + h * 128 + c * 64;
            float q[64];
#pragma unroll
            for (int d = 0; d < 64; ++d) q[d] = bf2f(qp[d]);
            const float slope2 = exp2f(-2.f * (float)(h + 1)) * LOG2E;
            float m = -INFINITY, l = 0.f, o[64];
#pragma unroll
            for (int d = 0; d < 64; ++d) o[d] = 0.f;
            const int tmax = __shfl(t, 63);
            for (int pos = 0; pos <= tmax; ++pos) {
                const bf16_t* kp = w_QKV + (size_t)(b * S + pos) * NIN + 2048 + h * 128 + c * 64;
                const bf16_t* vp = w_QKV + (size_t)(b * S + pos) * NIN + 2560 + h * 128 + dh * 64;
                float s = 0.f;
#pragma unroll
                for (int d = 0; d < 64; ++d) s += q[d] * bf2f(kp[d]);
                s -= slope2 * (float)(t - pos);
                if (pos <= t) {
                    const float mn = fmaxf(m, s), f = exp2f(m - mn), pe = exp2f(s - mn);
                    l = l * f + pe;
#pragma unroll
                    for (int d = 0; d < 64; ++d) o[d] = o[d] * f + pe * bf2f(vp[d]);
                    m = mn;
                }
            }
            const float rl = 1.f / l;
            float* op = w_OBN + ((size_t)c * M + (b * S + t)) * 512 + h * 128 + dh * 64;
#pragma unroll
            for (int d = 0; d < 64; ++d) op[d] = o[d] * rl;
        }
    }
    SEAM(3);
    if (IN(4)) {
        PHASE_IDS();
        const float s1 = wave_sum(a.lq1[lane] * a.lk1[lane]), s2 = wave_sum(a.lq2[lane] * a.lk2[lane]);
        const float lam = __expf(s1) - __expf(s2) + LAMBDA_INIT;
        for (int w = gw; w < M * 4; w += NGW) {
            const int tok = w >> 2, h = w & 3;
            const float* p0 = w_OBN + (size_t)tok * 512 + h * 128 + 2 * lane; const float* p1 = p0 + (size_t)M * 512;
            const float va = p0[0] - lam * p1[0], vb = p0[1] - lam * p1[1];
            const float rstd = rsqrtf(wave_sum(va * va + vb * vb) * (1.f / 128.f) + RMS_EPS) * (1.f - LAMBDA_INIT);
            *(unsigned*)(w_AO + (size_t)tok * D + 512 + h * 128 + 2 * lane) = pk2(va * rstd * a.gd[2 * lane], vb * rstd * a.gd[2 * lane + 1]);
        }
    }
    SEAM(4);
    if (IN(5)) {
        PHASE_IDS();
        POutProj p; p.init(M, D, G, bx); p.AO = w_AO; p.Wt = w_Wout_t; p.x = a.x; p.mod = w_mod; p.x1 = a.out;
        pg8::gemm_phase<POutProj>(lds, p, wave);
    }
    SEAM(5);
    if (IN(6)) {
        PHASE_IDS();
        for (int row = gw; row < M; row += NGW) {
            const int b = row / S;
            const f32x4* xr = (const f32x4*)(a.out + (size_t)row * D) + lane;
            f32x4 v[4]; float ss = 0.f;
#pragma unroll
            for (int j = 0; j < 4; ++j) { v[j] = xr[64 * j]; ss += (v[j].x * v[j].x + v[j].y * v[j].y) + (v[j].z * v[j].z + v[j].w * v[j].w); }
            const float rstd = rsqrtf(wave_sum(ss) * (1.f / D) + RMS_EPS);
            const float* shift = w_mod + b * 6144 + 3072, *scale = w_mod + b * 6144 + 4096;
            float lg[NE];
#pragma unroll
            for (int e = 0; e < NE; ++e) lg[e] = 0.f;
#pragma unroll
            for (int j = 0; j < 4; ++j) {
                const int c0 = 4 * lane + 256 * j;
                const f32x4 g = *(const f32x4*)(a.g2 + c0), sc = *(const f32x4*)(scale + c0), sh = *(const f32x4*)(shift + c0);
                const f32x4 o = v[j] * rstd * g * (sc + 1.f) + sh;
                u32x2 w; w.x = pk2(o.x, o.y); w.y = pk2(o.z, o.w);
                *(u32x2*)(w_H2 + (size_t)row * D + c0) = w;
#pragma unroll
                for (int i = 0; i < 4; ++i) {
                    const f32x4* wrow = (const f32x4*)(a.w_router + (size_t)(c0 + i) * NE);
#pragma unroll
                    for (int e4 = 0; e4 < 8; ++e4) { const f32x4 wv = wrow[e4]; lg[4 * e4] += o[i] * wv.x; lg[4 * e4 + 1] += o[i] * wv.y; lg[4 * e4 + 2] += o[i] * wv.z; lg[4 * e4 + 3] += o[i] * wv.w; }
                }
            }
#pragma unroll
            for (int e = 0; e < NE; ++e) lg[e] = wave_sum(lg[e]) + a.b_router[e];
            if (lane == 0) {
                int idx[4]; float val[4];
#pragma unroll
                for (int k = 0; k < 4; ++k) {
                    float best = -INFINITY; int bi = 0;
#pragma unroll
                    for (int e = 0; e < NE; ++e) { bool taken = false;
#pragma unroll
                        for (int kk = 0; kk < k; ++kk) taken |= (idx[kk] == e);
                        if (!taken && lg[e] > best) { best = lg[e]; bi = e; } }
                    idx[k] = bi; val[k] = best;
                }
                float den = 0.f, ex[4];
#pragma unroll
                for (int k = 0; k < 4; ++k) { ex[k] = __expf(val[k] - val[0]); den += ex[k]; }
#pragma unroll
                for (int k = 0; k < 4; ++k) {
                    const int slot = atomicAdd(&w_counts[idx[k]], 1);
                    w_tope[row * 4 + k] = idx[k]; w_tops[row * 4 + k] = slot; w_topg[row * 4 + k] = ex[k] / den;
                    w_list[idx[k] * M + slot] = row;
                }
            }
        }
    }
    SEAM(6);
    if (IN(7)) {
        PHASE_IDS();
        LOAD_PT();
        PGateUp p; p.init(PT, CN, 8, G, bx); p.H2 = w_H2; p.Wt = w_Wgu_t; p.bgu = a.b_gu; p.list = w_list; p.ACT = w_ACT;
        pg8::gemm_phase<PGateUp>(lds, p, wave);
    }
    SEAM(7);
    if (IN(8)) {
        PHASE_IDS();
        LOAD_PT();
        PDown p; p.init(PT, CN, 4, G, bx); p.ACT = w_ACT; p.Wt = w_Wd_t; p.bd = a.b_d; p.Y = w_Y;
        pg8::gemm_phase<PDown>(lds, p, wave);
    }
    SEAM(8);
    if (IN(9)) {
        PHASE_IDS();
        LOAD_PT();
        for (int row = gw; row < M; row += NGW) {
            const int b = row / S;
            const float* gate2 = w_mod + b * 6144 + 5120;
            const bf16_t* yr[4]; float gk[4];
#pragma unroll
            for (int k = 0; k < 4; ++k) { yr[k] = w_Y + (size_t)(PT[w_tope[row * 4 + k]] * 256 + w_tops[row * 4 + k]) * D; gk[k] = w_topg[row * 4 + k]; }
#pragma unroll
            for (int j = 0; j < 4; ++j) {
                const int c0 = 4 * lane + 256 * j;
                f32x4 acc = (f32x4){0.f, 0.f, 0.f, 0.f};
#pragma unroll
                for (int k = 0; k < 4; ++k) { const u32x2 w = *(const u32x2*)(yr[k] + c0);
                    acc.x += gk[k] * __uint_as_float(w.x << 16); acc.y += gk[k] * __uint_as_float(w.x & 0xffff0000u);
                    acc.z += gk[k] * __uint_as_float(w.y << 16); acc.w += gk[k] * __uint_as_float(w.y & 0xffff0000u); }
                const f32x4 g = *(const f32x4*)(gate2 + c0);
                f32x4* op = (f32x4*)(a.out + (size_t)row * D + c0);
                *op = *op + g * acc;
            }
        }
    }
#undef IN
#undef PHASE_IDS
#undef SEAM
#undef LOAD_PT
#undef w_counts
#undef w_mod
#undef w_Win_t
#undef w_Wout_t
#undef w_Wgu_t
#undef w_Wd_t
#undef w_XN
#undef w_QKV
#undef w_AO
#undef w_H2
#undef w_tope
#undef w_tops
#undef w_topg
#undef w_list
#undef w_ACT
#undef w_Y
#undef w_OBN
}

#ifndef RUN_MODE
#define RUN_MODE 1
#endif
#ifndef PH_MASK
#define PH_MASK 0x3ff
#endif
extern "C" void kernel_launch(void* const* d_in, const int* in_sizes, int n_in, void* d_out, int out_size, void* d_ws, size_t ws_size, hipStream_t stream) {
    static int grid = 0;
    if (grid == 0) {
        if (n_in != 23 || out_size != M * D || ws_size < WS_END) { fprintf(stderr, "kernel_launch: unexpected problem (n_in %d out %d ws %zu)\n", n_in, out_size, ws_size); grid = -1; return; }
        int dev = 0, cus = 0;
        if (hipGetDevice(&dev) != hipSuccess || hipDeviceGetAttribute(&cus, hipDeviceAttributeMultiprocessorCount, dev) != hipSuccess) { grid = -1; return; }
        if (hipFuncSetAttribute((const void*)mega, hipFuncAttributeMaxDynamicSharedMemorySize, LDS_BYTES) != hipSuccess) { fprintf(stderr, "kernel_launch: hipFuncSetAttribute failed\n"); grid = -1; return; }
        int per_cu = 0;
        if (hipOccupancyMaxActiveBlocksPerMultiprocessor(&per_cu, (const void*)mega, NTHREADS, LDS_BYTES) != hipSuccess || per_cu < 1) fprintf(stderr, "kernel_launch: occupancy query says %d blocks/CU\n", per_cu);
        (void)hipGetLastError();
        grid = cus;
    }
    if (grid < 0) return;
    const float* x = (const float*)d_in[0]; const float* c = (const float*)d_in[1]; const float* w_ada = (const float*)d_in[2]; const float* b_ada = (const float*)d_in[3];
    const float* g1 = (const float*)d_in[4]; const float* w_in = (const float*)d_in[5];
    const float* gaq = (const float*)d_in[6]; const float* gak = (const float*)d_in[7]; const float* gbq = (const float*)d_in[8]; const float* gbk = (const float*)d_in[9];
    const float* lq1 = (const float*)d_in[10]; const float* lk1 = (const float*)d_in[11]; const float* lq2 = (const float*)d_in[12]; const float* lk2 = (const float*)d_in[13];
    const float* gd = (const float*)d_in[14]; const float* w_out = (const float*)d_in[15]; const float* g2 = (const float*)d_in[16];
    const float* w_router = (const float*)d_in[17]; const float* b_router = (const float*)d_in[18];
    const float* w_gu = (const float*)d_in[19]; const float* b_gu = (const float*)d_in[20]; const float* w_d = (const float*)d_in[21]; const float* b_d = (const float*)d_in[22];
    unsigned char* ws = (unsigned char*)d_ws; float* out = (float*)d_out;
    int* counts = (int*)(ws + WS_CTL + CTL_COUNTS); int* padstart = (int*)(ws + WS_CTL + CTL_PADSTART); float* mod = (float*)(ws + WS_CTL + CTL_MOD);
    bf16_t* Win_t = (bf16_t*)(ws + WS_WIN); bf16_t* Wout_t = (bf16_t*)(ws + WS_WOUT); bf16_t* Wgu_t = (bf16_t*)(ws + WS_WGU); bf16_t* Wd_t = (bf16_t*)(ws + WS_WD);
    bf16_t* XN = (bf16_t*)(ws + WS_XN); bf16_t* QKV = (bf16_t*)(ws + WS_QKV); bf16_t* AO = (bf16_t*)(ws + WS_AO); bf16_t* H2 = (bf16_t*)(ws + WS_H2);
    int* tope = (int*)(ws + WS_TOPE); int* tops = (int*)(ws + WS_TOPS); float* topg = (float*)(ws + WS_TOPG); int* list = (int*)(ws + WS_LIST);
    bf16_t* ACT = (bf16_t*)(ws + WS_ACT); bf16_t* Y = (bf16_t*)(ws + WS_Y); float* OBN = (float*)(ws + WS_OBN);

    (void)hipMemsetAsync(ws + WS_CTL, 0, CTL_BYTES, stream);
    MArgs a{};
    a.x = x; a.c = c; a.w_ada = w_ada; a.b_ada = b_ada; a.g1 = g1; a.w_in = w_in; a.gaq = gaq; a.gak = gak; a.gbq = gbq; a.gbk = gbk; a.lq1 = lq1; a.lk1 = lk1; a.lq2 = lq2; a.lk2 = lk2;
    a.gd = gd; a.w_out = w_out; a.g2 = g2; a.w_router = w_router; a.b_router = b_router; a.w_gu = w_gu; a.b_gu = b_gu; a.w_d = w_d; a.b_d = b_d; a.out = out; a.ws = ws;
    if (RUN_MODE == 1) { a.ph_lo = 0; a.ph_hi = NPHASE; hipLaunchKernelGGL(mega, dim3(grid), dim3(NTHREADS), LDS_BYTES, stream, a); return; }
    const unsigned mask = (RUN_MODE == 0) ? 0u : (RUN_MODE == 2) ? 0x3ffu : (unsigned)PH_MASK;
    for (int ph = 0; ph < NPHASE; ++ph) {
        if (mask & (1u << ph)) { a.ph_lo = ph; a.ph_hi = ph + 1; hipLaunchKernelGGL(mega, dim3(grid), dim3(NTHREADS), LDS_BYTES, stream, a); }
        else switch (ph) {
            case 0:
                k_transpose<<<(1024 / 64) * (3072 / 64), 256, 0, stream>>>(w_in, Win_t, 1024, 3072);
                k_transpose<<<(1024 / 64) * (1024 / 64), 256, 0, stream>>>(w_out, Wout_t, 1024, 1024);
                k_transpose<<<32 * (1024 / 64) * (2048 / 64), 256, 0, stream>>>(w_gu, Wgu_t, 1024, 2048);
                k_transpose<<<32 * (1024 / 64) * (1024 / 64), 256, 0, stream>>>(w_d, Wd_t, 1024, 1024);
                k_adaln<<<dim3(24, 16), 256, 0, stream>>>(c, w_ada, b_ada, mod); break;
            case 1: k_xn<<<M / 4, 256, 0, stream>>>(x, g1, mod, XN); break;
            case 2: { InProj p{XN, Win_t, QKV, gaq, gak, gbq, gbk}; k_gemm<InProj><<<128 * 24, 256, 0, stream>>>(p); } break;
            case 3: k_attn_a<<<NB * 8 * S / 256, 256, 0, stream>>>(QKV, AO); k_attn_b<<<NB * 4 * 2 * 2 * S / 256, 256, 0, stream>>>(QKV, OBN); break;
            case 4: k_diff_combine<<<M * 4 / 4, 256, 0, stream>>>(OBN, lq1, lk1, lq2, lk2, gd, AO); break;
            case 5: { OutProj p{AO, Wout_t, x, mod, out}; k_gemm<OutProj><<<128 * 8, 256, 0, stream>>>(p); } break;
            case 6: k_router<<<M / 4, 256, 0, stream>>>(out, g2, mod, w_router, b_router, H2, counts, tope, tops, topg, list); break;
            case 7: { GateUp p{H2, Wgu_t, b_gu, counts, padstart, list, ACT}; k_gemm<GateUp><<<32 * 128 * 16, 256, 0, stream>>>(p); } break;
            case 8: { Down p{ACT, Wd_t, b_d, counts, padstart, Y}; k_gemm<Down><<<32 * 128 * 8, 256, 0, stream>>>(p); } break;
            case 9: k_combine<<<M / 4, 256, 0, stream>>>(out, mod, Y, tope, tops, topg, padstart); break;
        }
        if (ph == 6) k_padstart<<<1, 64, 0, stream>>>(counts, padstart);
    }
}
```

```cpp
#include <hip/hip_runtime.h>
#include <cstdio>
#include <cstdint>

typedef unsigned short bf16_t;
typedef short bf16x8 __attribute__((ext_vector_type(8)));
typedef float f32x4 __attribute__((ext_vector_type(4)));
typedef unsigned u32x4 __attribute__((ext_vector_type(4)));
typedef unsigned u32x2 __attribute__((ext_vector_type(2)));

constexpr int D = 1024, NB = 8, S = 2048, M = NB * S;
constexpr int NIN = 3072, NE = 32, TOPK = 4, DFF = 1024;
constexpr int NASSIGN = M * TOPK;
constexpr int PADROWS = NASSIGN + NE * 256;
constexpr float RMS_EPS = 1e-6f;
constexpr float LOG2E = 1.4426950408889634f;
constexpr float QSCALE = 0.125f * LOG2E;
constexpr float LAMBDA_INIT = 0.2f;

constexpr size_t MiB = 1u << 20;
constexpr size_t WS_CTL = 0;
constexpr size_t CTL_BYTES = 1 * MiB;
constexpr size_t CTL_COUNTS = 0;
constexpr size_t CTL_PADSTART = 256;
constexpr size_t CTL_MOD = 64 * 1024;
constexpr size_t WS_WIN = 2 * MiB;
constexpr size_t WS_WOUT = 8 * MiB;
constexpr size_t WS_WGU = 10 * MiB;
constexpr size_t WS_WD = 138 * MiB;
constexpr size_t WS_XN = 202 * MiB;
constexpr size_t WS_QKV = 234 * MiB;
constexpr size_t WS_AO = 330 * MiB;
constexpr size_t WS_H2 = 362 * MiB;
constexpr size_t WS_TOPE = 394 * MiB;
constexpr size_t WS_TOPS = 395 * MiB;
constexpr size_t WS_TOPG = 396 * MiB;
constexpr size_t WS_LIST = 397 * MiB;
constexpr size_t WS_ACT = 400 * MiB;
constexpr size_t WS_Y = 544 * MiB;
constexpr size_t WS_OBN = 688 * MiB;
constexpr size_t WS_END = 752 * MiB;

__device__ __forceinline__ bf16_t f2bf(float f) { unsigned u = __float_as_uint(f); return (bf16_t)((u + 0x7fffu + ((u >> 16) & 1u)) >> 16); }
__device__ __forceinline__ float bf2f(bf16_t h) { return __uint_as_float(((unsigned)h) << 16); }
__device__ __forceinline__ unsigned pk2(float lo, float hi) { return (unsigned)f2bf(lo) | ((unsigned)f2bf(hi) << 16); }
__device__ __forceinline__ float wave_sum(float v) {
#pragma unroll
    for (int o = 1; o < 64; o <<= 1) v += __shfl_xor(v, o);
    return v;
}

__global__ void __launch_bounds__(256) k_transpose(const float* __restrict__ W, bf16_t* __restrict__ WT, int K, int N) {
    __shared__ float t[64][65];
    const int nb = N / 64, kb = K / 64;
    const int per = nb * kb;
    const int g = blockIdx.x / per, r = blockIdx.x % per;
    const int k0 = (r / nb) * 64, n0 = (r % nb) * 64;
    const float* Wg = W + (size_t)g * K * N; bf16_t* WTg = WT + (size_t)g * K * N;
    const int tx = threadIdx.x & 63, ty = threadIdx.x >> 6;
    for (int i = ty; i < 64; i += 4) t[i][tx] = Wg[(size_t)(k0 + i) * N + n0 + tx];
    __syncthreads();
    for (int i = ty; i < 64; i += 4) WTg[(size_t)(n0 + i) * K + k0 + tx] = f2bf(t[tx][i]);
}

__global__ void __launch_bounds__(256) k_adaln(const float* __restrict__ c, const float* __restrict__ w_ada, const float* __restrict__ b_ada, float* mod) {
    const int col = blockIdx.x * 256 + threadIdx.x, ks = blockIdx.y;
    float acc[NB];
#pragma unroll
    for (int b = 0; b < NB; ++b) acc[b] = (ks == 0) ? b_ada[col] : 0.f;
    for (int k = ks * 64; k < ks * 64 + 64; ++k) {
        const float w = w_ada[(size_t)k * 6144 + col];
#pragma unroll
        for (int b = 0; b < NB; ++b) { const float cv = c[b * D + k]; const float sl = cv / (1.f + __expf(-cv)); acc[b] += sl * w; }
    }
#pragma unroll
    for (int b = 0; b < NB; ++b) atomicAdd(&mod[b * 6144 + col], acc[b]);
}

__global__ void __launch_bounds__(256) k_xn(const float* __restrict__ x, const float* __restrict__ g1, const float* __restrict__ mod, bf16_t* __restrict__ XN) {
    const int lane = threadIdx.x & 63, row = blockIdx.x * 4 + (threadIdx.x >> 6), b = row / S;
    const f32x4* xr = (const f32x4*)(x + (size_t)row * D) + lane;
    f32x4 v[4]; float ss = 0.f;
#pragma unroll
    for (int j = 0; j < 4; ++j) { v[j] = xr[64 * j]; ss += (v[j].x * v[j].x + v[j].y * v[j].y) + (v[j].z * v[j].z + v[j].w * v[j].w); }
    const float rstd = rsqrtf(wave_sum(ss) * (1.f / D) + RMS_EPS);
    const float* shift = mod + b * 6144, *scale = mod + b * 6144 + 1024;
#pragma unroll
    for (int j = 0; j < 4; ++j) {
        const int c0 = 4 * lane + 256 * j;
        const f32x4 g = *(const f32x4*)(g1 + c0), sc = *(const f32x4*)(scale + c0), sh = *(const f32x4*)(shift + c0);
        f32x4 o;
        o.x = v[j].x * rstd * g.x * (1.f + sc.x) + sh.x; o.y = v[j].y * rstd * g.y * (1.f + sc.y) + sh.y;
        o.z = v[j].z * rstd * g.z * (1.f + sc.z) + sh.z; o.w = v[j].w * rstd * g.w * (1.f + sc.w) + sh.w;
        u32x2 w; w.x = pk2(o.x, o.y); w.y = pk2(o.z, o.w);
        *(u32x2*)(XN + (size_t)row * D + c0) = w;
    }
}

template <class P> __global__ void __launch_bounds__(256) k_gemm(P p) {
    const int wid = threadIdx.x >> 6, lane = threadIdx.x & 63, wr = wid >> 1, wc = wid & 1, fr = lane & 15, fq = lane >> 4;
    typename P::Unit u;
    if (!p.unit(blockIdx.x, u)) return;
    const bf16_t* ap[4]; const bf16_t* bp[4];
#pragma unroll
    for (int m = 0; m < 4; ++m) ap[m] = p.a_row(u, wr * 64 + 16 * m + fr) + 8 * fq;
#pragma unroll
    for (int n = 0; n < 4; ++n) bp[n] = p.b_row(u, wc, n, fr) + 8 * fq;
    f32x4 acc[4][4];
#pragma unroll
    for (int m = 0; m < 4; ++m)
#pragma unroll
        for (int n = 0; n < 4; ++n) acc[m][n] = (f32x4){0.f, 0.f, 0.f, 0.f};
    for (int k0 = 0; k0 < P::K; k0 += 32) {
        bf16x8 a[4], b[4];
#pragma unroll
        for (int m = 0; m < 4; ++m) a[m] = *(const bf16x8*)(ap[m] + k0);
#pragma unroll
        for (int n = 0; n < 4; ++n) b[n] = *(const bf16x8*)(bp[n] + k0);
#pragma unroll
        for (int m = 0; m < 4; ++m)
#pragma unroll
            for (int n = 0; n < 4; ++n) acc[m][n] = __builtin_amdgcn_mfma_f32_16x16x32_bf16(a[m], b[n], acc[m][n], 0, 0, 0);
    }
    p.epi(u, acc, wr, wc, fr, fq);
}

struct InProj {
    static constexpr int K = 1024;
    struct Unit { int bm, bn; };
    const bf16_t* XN; const bf16_t* Wt; bf16_t* QKV; const float *gaq, *gak, *gbq, *gbk;
    __device__ bool unit(int bid, Unit& u) const { u.bm = bid / 24; u.bn = bid % 24; return true; }
    __device__ const bf16_t* a_row(const Unit& u, int r) const { return XN + (size_t)(u.bm * 128 + r) * K; }
    __device__ const bf16_t* b_row(const Unit& u, int wc, int n, int fr) const { return Wt + (size_t)(u.bn * 128 + wc * 64 + 16 * n + fr) * K; }
    __device__ void epi(const Unit& u, f32x4 (&acc)[4][4], int wr, int wc, int fr, int fq) const {
        const int c0 = u.bn * 128 + wc * 64, r0 = u.bm * 128 + wr * 64;
        const float* g = nullptr; float post = 1.f;
        if (c0 < 512) { g = gaq; post = QSCALE; } else if (c0 < 1024) g = gak; else if (c0 < 1536) g = nullptr;
        else if (c0 < 2048) { g = gbq; post = QSCALE; } else if (c0 < 2560) g = gbk;
#pragma unroll
        for (int m = 0; m < 4; ++m)
#pragma unroll
            for (int j = 0; j < 4; ++j) {
                float sc[4] = {1.f, 1.f, 1.f, 1.f};
                if (g) {
                    float ss = 0.f;
#pragma unroll
                    for (int n = 0; n < 4; ++n) ss += acc[m][n][j] * acc[m][n][j];
                    ss += __shfl_xor(ss, 1); ss += __shfl_xor(ss, 2); ss += __shfl_xor(ss, 4); ss += __shfl_xor(ss, 8);
                    const float rstd = rsqrtf(ss * (1.f / 64.f) + RMS_EPS) * post;
#pragma unroll
                    for (int n = 0; n < 4; ++n) sc[n] = rstd * g[16 * n + fr];
                }
                const int row = r0 + 16 * m + 4 * fq + j;
#pragma unroll
                for (int n = 0; n < 4; ++n) QKV[(size_t)row * NIN + c0 + 16 * n + fr] = f2bf(acc[m][n][j] * sc[n]);
            }
    }
};

struct OutProj {
    static constexpr int K = 1024;
    struct Unit { int bm, bn; };
    const bf16_t* AO; const bf16_t* Wt; const float* x; const float* mod; float* x1;
    __device__ bool unit(int bid, Unit& u) const { u.bm = bid / 8; u.bn = bid % 8; return true; }
    __device__ const bf16_t* a_row(const Unit& u, int r) const { return AO + (size_t)(u.bm * 128 + r) * K; }
    __device__ const bf16_t* b_row(const Unit& u, int wc, int n, int fr) const { return Wt + (size_t)(u.bn * 128 + wc * 64 + 16 * n + fr) * K; }
    __device__ void epi(const Unit& u, f32x4 (&acc)[4][4], int wr, int wc, int fr, int fq) const {
        const int c0 = u.bn * 128 + wc * 64, r0 = u.bm * 128 + wr * 64;
        const float* gate1 = mod + ((r0 / S) * 6144) + 2048;
#pragma unroll
        for (int m = 0; m < 4; ++m)
#pragma unroll
            for (int j = 0; j < 4; ++j) {
                const int row = r0 + 16 * m + 4 * fq + j;
#pragma unroll
                for (int n = 0; n < 4; ++n) { const int col = c0 + 16 * n + fr; x1[(size_t)row * D + col] = x[(size_t)row * D + col] + gate1[col] * acc[m][n][j]; }
            }
    }
};

struct GateUp {
    static constexpr int K = 1024;
    struct Unit { int e, mt, nt, cnt, ps; };
    const bf16_t* H2; const bf16_t* Wt; const float* bgu; const int* counts; const int* padstart; const int* list; bf16_t* ACT;
    __device__ bool unit(int bid, Unit& u) const {
        u.nt = bid % 16; u.mt = (bid / 16) % 128; u.e = bid / (16 * 128); u.cnt = counts[u.e]; u.ps = padstart[u.e];
        return u.mt * 128 < u.cnt;
    }
    __device__ const bf16_t* a_row(const Unit& u, int r) const { int rr = u.mt * 128 + r; if (rr >= u.cnt) rr = 0; return H2 + (size_t)list[u.e * M + rr] * K; }
    __device__ const bf16_t* b_row(const Unit& u, int wc, int n, int fr) const {
        const int j = u.nt * 64 + wc * 32 + 16 * (n & 1) + fr; return Wt + ((size_t)u.e * 2048 + (n >> 1) * 1024 + j) * K; }
    __device__ void epi(const Unit& u, f32x4 (&acc)[4][4], int wr, int wc, int fr, int fq) const {
        const float* bias = bgu + u.e * 2048;
#pragma unroll
        for (int m = 0; m < 4; ++m)
#pragma unroll
            for (int j = 0; j < 4; ++j) {
                const int rr = u.mt * 128 + wr * 64 + 16 * m + 4 * fq + j;
                if (rr < u.cnt) {
#pragma unroll
                    for (int n = 0; n < 2; ++n) {
                        const int col = u.nt * 64 + wc * 32 + 16 * n + fr;
                        float g = acc[m][n][j] + bias[col], uu = acc[m][n + 2][j] + bias[1024 + col];
                        g = fminf(g, 7.f); uu = fminf(fmaxf(uu, -7.f), 7.f);
                        const float a = (uu + 1.f) * (g / (1.f + __expf(-1.702f * g)));
                        ACT[(size_t)(u.ps + rr) * DFF + col] = f2bf(a);
                    }
                }
            }
    }
};

struct Down {
    static constexpr int K = 1024;
    struct Unit { int e, mt, nt, cnt, ps; };
    const bf16_t* ACT; const bf16_t* Wt; const float* bd; const int* counts; const int* padstart; bf16_t* Y;
    __device__ bool unit(int bid, Unit& u) const {
        u.nt = bid % 8; u.mt = (bid / 8) % 128; u.e = bid / (8 * 128); u.cnt = counts[u.e]; u.ps = padstart[u.e];
        return u.mt * 128 < u.cnt;
    }
    __device__ const bf16_t* a_row(const Unit& u, int r) const { int rr = u.mt * 128 + r; if (rr >= u.cnt) rr = 0; return ACT + (size_t)(u.ps + rr) * K; }
    __device__ const bf16_t* b_row(const Unit& u, int wc, int n, int fr) const { return Wt + ((size_t)u.e * 1024 + u.nt * 128 + wc * 64 + 16 * n + fr) * K; }
    __device__ void epi(const Unit& u, f32x4 (&acc)[4][4], int wr, int wc, int fr, int fq) const {
        const float* bias = bd + u.e * 1024;
#pragma unroll
        for (int m = 0; m < 4; ++m)
#pragma unroll
            for (int j = 0; j < 4; ++j) {
                const int rr = u.mt * 128 + wr * 64 + 16 * m + 4 * fq + j;
                if (rr < u.cnt) {
#pragma unroll
                    for (int n = 0; n < 4; ++n) { const int col = u.nt * 128 + wc * 64 + 16 * n + fr; Y[(size_t)(u.ps + rr) * D + col] = f2bf(acc[m][n][j] + bias[col]); }
                }
            }
    }
};

__global__ void __launch_bounds__(256) k_attn_a(const bf16_t* __restrict__ QKV, bf16_t* __restrict__ AO) {
    const int gid = blockIdx.x * 256 + threadIdx.x;
    const int t = gid % S, h = (gid / S) % 8, b = gid / (S * 8);
    const bf16_t* qp = QKV + (size_t)(b * S + t) * NIN + h * 64;
    float q[64];
#pragma unroll
    for (int d = 0; d < 64; ++d) q[d] = bf2f(qp[d]);
    const float slope2 = exp2f(-(float)(h + 1)) * LOG2E;
    float m = -INFINITY, l = 0.f, o[64];
#pragma unroll
    for (int d = 0; d < 64; ++d) o[d] = 0.f;
    for (int p = 0; p < 3; ++p) {
        const int dil = (p == 0) ? 1 : (p == 1 ? 4 : 16);
        for (int i = 0; i <= 128; ++i) {
            const int pos = t - i * dil; if (pos < 0) break;
            const bf16_t* kp = QKV + (size_t)(b * S + pos) * NIN + 512 + h * 64; const bf16_t* vp = kp + 512;
            float s = 0.f;
#pragma unroll
            for (int d = 0; d < 64; ++d) s += q[d] * bf2f(kp[d]);
            s -= slope2 * (float)(i * dil);
            const float mn = fmaxf(m, s), f = exp2f(m - mn), pe = exp2f(s - mn);
            l = l * f + pe;
#pragma unroll
            for (int d = 0; d < 64; ++d) o[d] = o[d] * f + pe * bf2f(vp[d]);
            m = mn;
        }
    }
    const float rl = 1.f / l;
    bf16_t* op = AO + (size_t)(b * S + t) * D + h * 64;
#pragma unroll
    for (int d = 0; d < 64; ++d) op[d] = f2bf(o[d] * rl);
}

__global__ void __launch_bounds__(256) k_attn_b(const bf16_t* __restrict__ QKV, float* __restrict__ OBN) {
    const int gid = blockIdx.x * 256 + threadIdx.x;
    const int t = gid % S, dh = (gid / S) & 1, c = (gid / (2 * S)) & 1, h = (gid / (4 * S)) & 3, b = gid / (16 * S);
    const bf16_t* qp = QKV + (size_t)(b * S + t) * NIN + 1536 + h * 128 + c * 64;
    float q[64];
#pragma unroll
    for (int d = 0; d < 64; ++d) q[d] = bf2f(qp[d]);
    const float slope2 = exp2f(-2.f * (float)(h + 1)) * LOG2E;
    float m = -INFINITY, l = 0.f, o[64];
#pragma unroll
    for (int d = 0; d < 64; ++d) o[d] = 0.f;
    const int tmax = __shfl(t, 63);
    for (int pos = 0; pos <= tmax; ++pos) {
        const bf16_t* kp = QKV + (size_t)(b * S + pos) * NIN + 2048 + h * 128 + c * 64;
        const bf16_t* vp = QKV + (size_t)(b * S + pos) * NIN + 2560 + h * 128 + dh * 64;
        float s = 0.f;
#pragma unroll
        for (int d = 0; d < 64; ++d) s += q[d] * bf2f(kp[d]);
        s -= slope2 * (float)(t - pos);
        if (pos <= t) {
            const float mn = fmaxf(m, s), f = exp2f(m - mn), pe = exp2f(s - mn);
            l = l * f + pe;
#pragma unroll
            for (int d = 0; d < 64; ++d) o[d] = o[d] * f + pe * bf2f(vp[d]);
            m = mn;
        }
    }
    const float rl = 1.f / l;
    float* op = OBN + ((size_t)c * M + (b * S + t)) * 512 + h * 128 + dh * 64;
#pragma unroll
    for (int d = 0; d < 64; ++d) op[d] = o[d] * rl;
}
__global__ void __launch_bounds__(256) k_diff_combine(const float* __restrict__ OBN, const float* lq1, const float* lk1, const float* lq2, const float* lk2, const float* __restrict__ gd, bf16_t* __restrict__ AO) {
    const int lane = threadIdx.x & 63, w = blockIdx.x * 4 + (threadIdx.x >> 6);
    const int tok = w >> 2, h = w & 3;
    const float s1 = wave_sum(lq1[lane] * lk1[lane]), s2 = wave_sum(lq2[lane] * lk2[lane]);
    const float lam = __expf(s1) - __expf(s2) + LAMBDA_INIT;
    const float* p0 = OBN + (size_t)tok * 512 + h * 128 + 2 * lane; const float* p1 = p0 + (size_t)M * 512;
    const float a = p0[0] - lam * p1[0], bq = p0[1] - lam * p1[1];
    const float rstd = rsqrtf(wave_sum(a * a + bq * bq) * (1.f / 128.f) + RMS_EPS) * (1.f - LAMBDA_INIT);
    *(unsigned*)(AO + (size_t)tok * D + 512 + h * 128 + 2 * lane) = pk2(a * rstd * gd[2 * lane], bq * rstd * gd[2 * lane + 1]);
}

__global__ void __launch_bounds__(256) k_router(const float* __restrict__ x1, const float* __restrict__ g2, const float* __restrict__ mod, const float* __restrict__ wr, const float* __restrict__ br,
                                                bf16_t* __restrict__ H2, int* counts, int* tope, int* tops, float* topg, int* list) {
    const int lane = threadIdx.x & 63, row = blockIdx.x * 4 + (threadIdx.x >> 6), b = row / S;
    const f32x4* xr = (const f32x4*)(x1 + (size_t)row * D) + lane;
    f32x4 v[4]; float ss = 0.f;
#pragma unroll
    for (int j = 0; j < 4; ++j) { v[j] = xr[64 * j]; ss += (v[j].x * v[j].x + v[j].y * v[j].y) + (v[j].z * v[j].z + v[j].w * v[j].w); }
    const float rstd = rsqrtf(wave_sum(ss) * (1.f / D) + RMS_EPS);
    const float* shift = mod + b * 6144 + 3072, *scale = mod + b * 6144 + 4096;
    float lg[NE];
#pragma unroll
    for (int e = 0; e < NE; ++e) lg[e] = 0.f;
#pragma unroll
    for (int j = 0; j < 4; ++j) {
        const int c0 = 4 * lane + 256 * j;
        const f32x4 g = *(const f32x4*)(g2 + c0), sc = *(const f32x4*)(scale + c0), sh = *(const f32x4*)(shift + c0);
        float o[4];
        o[0] = v[j].x * rstd * g.x * (1.f + sc.x) + sh.x; o[1] = v[j].y * rstd * g.y * (1.f + sc.y) + sh.y;
        o[2] = v[j].z * rstd * g.z * (1.f + sc.z) + sh.z; o[3] = v[j].w * rstd * g.w * (1.f + sc.w) + sh.w;
        u32x2 w; w.x = pk2(o[0], o[1]); w.y = pk2(o[2], o[3]);
        *(u32x2*)(H2 + (size_t)row * D + c0) = w;
#pragma unroll
        for (int i = 0; i < 4; ++i) {
            const f32x4* wrow = (const f32x4*)(wr + (size_t)(c0 + i) * NE);
#pragma unroll
            for (int e4 = 0; e4 < 8; ++e4) { const f32x4 wv = wrow[e4]; lg[4 * e4] += o[i] * wv.x; lg[4 * e4 + 1] += o[i] * wv.y; lg[4 * e4 + 2] += o[i] * wv.z; lg[4 * e4 + 3] += o[i] * wv.w; }
        }
    }
#pragma unroll
    for (int e = 0; e < NE; ++e) lg[e] = wave_sum(lg[e]) + br[e];
    if (lane == 0) {
        int idx[4]; float val[4];
#pragma unroll
        for (int k = 0; k < 4; ++k) {
            float best = -INFINITY; int bi = 0;
#pragma unroll
            for (int e = 0; e < NE; ++e) { bool taken = false;
#pragma unroll
                for (int kk = 0; kk < k; ++kk) taken |= (idx[kk] == e);
                if (!taken && lg[e] > best) { best = lg[e]; bi = e; } }
            idx[k] = bi; val[k] = best;
        }
        float den = 0.f, ex[4];
#pragma unroll
        for (int k = 0; k < 4; ++k) { ex[k] = __expf(val[k] - val[0]); den += ex[k]; }
#pragma unroll
        for (int k = 0; k < 4; ++k) {
            const int slot = atomicAdd(&counts[idx[k]], 1);
            tope[row * 4 + k] = idx[k]; tops[row * 4 + k] = slot; topg[row * 4 + k] = ex[k] / den;
            list[idx[k] * M + slot] = row;
        }
    }
}
__global__ void k_padstart(const int* counts, int* padstart) {
    if (threadIdx.x == 0) { int acc = 0; for (int e = 0; e < NE; ++e) { padstart[e] = acc; acc += (counts[e] + 255) / 256 * 256; } padstart[NE] = acc; }
}
__global__ void __launch_bounds__(256) k_combine(float* out, const float* __restrict__ mod, const bf16_t* __restrict__ Y, const int* __restrict__ tope, const int* __restrict__ tops, const float* __restrict__ topg, const int* __restrict__ padstart) {
    const int lane = threadIdx.x & 63, row = blockIdx.x * 4 + (threadIdx.x >> 6), b = row / S;
    const float* gate2 = mod + b * 6144 + 5120;
    const bf16_t* yr[4]; float gk[4];
#pragma unroll
    for (int k = 0; k < 4; ++k) { yr[k] = Y + (size_t)(padstart[tope[row * 4 + k]] + tops[row * 4 + k]) * D; gk[k] = topg[row * 4 + k]; }
#pragma unroll
    for (int j = 0; j < 4; ++j) {
        const int c0 = 4 * lane + 256 * j;
        f32x4 acc = (f32x4){0.f, 0.f, 0.f, 0.f};
#pragma unroll
        for (int k = 0; k < 4; ++k) { const u32x2 w = *(const u32x2*)(yr[k] + c0);
            acc.x += gk[k] * __uint_as_float(w.x << 16); acc.y += gk[k] * __uint_as_float(w.x & 0xffff0000u);
            acc.z += gk[k] * __uint_as_float(w.y << 16); acc.w += gk[k] * __uint_as_float(w.y & 0xffff0000u); }
        const f32x4 g = *(const f32x4*)(gate2 + c0);
        f32x4* op = (f32x4*)(out + (size_t)row * D + c0);
        f32x4 xv = *op;
        xv.x += g.x * acc.x; xv.y += g.y * acc.y; xv.z += g.z * acc.z; xv.w += g.w * acc.w;
        *op = xv;
    }
}


#define LAS __attribute__((address_space(3)))
#define GAS __attribute__((address_space(1)))
#define RLX_AGENT __ATOMIC_RELAXED, __HIP_MEMORY_SCOPE_AGENT
#define LDS_WAIT() asm volatile("s_waitcnt lgkmcnt(0)" ::: "memory")
#define VM_WAIT() asm volatile("s_waitcnt vmcnt(0)" ::: "memory")

constexpr int NWAVES = 8, NTHREADS = 512;
constexpr int RING_BYTES = 131072, LDSCTL_OFF = RING_BYTES, MISC_OFF = LDSCTL_OFF + 320, PT_OFF = LDSCTL_OFF + 512, CNT_OFF = LDSCTL_OFF + 768, LDS_BYTES = 147456;
constexpr size_t CTL_BAR = 16384;
constexpr int NPHASE = 10;

#define XB_TMO      128
#define XB_XCNT(j)  (256  + 64 * (j))
#define XB_XSUB(j)  (1280 + 64 * (j))
#define XB_XGEN(j)  (2304 + 64 * (j))
#define XB_TOP      3328
#define XB_TOPGEN   3392
#define XCD_BAR_WORDS 3456
#define XB_SPIN_CAP (1u << 22)
__device__ __forceinline__ unsigned xb_ld(unsigned* p)              { return __hip_atomic_load(p, __ATOMIC_RELAXED, __HIP_MEMORY_SCOPE_AGENT); }
__device__ __forceinline__ unsigned xb_add(unsigned* p, unsigned v) { return __hip_atomic_fetch_add(p, v, __ATOMIC_RELAXED, __HIP_MEMORY_SCOPE_AGENT); }
__device__ __forceinline__ unsigned xb_xcc_id() { return (unsigned)__builtin_amdgcn_s_getreg((3 << 11) | 20) & 0xFu; }
#define XB_SPIN(cond, bar) do { unsigned _sp = 0; while (cond) { __builtin_amdgcn_s_sleep(1); \
    if ((++_sp & 255u) == 0u) { if (xb_ld(&(bar)[XB_TMO])) break; if (_sp > XB_SPIN_CAP) { atomicAdd(&(bar)[XB_TMO], 1u); break; } } } } while (0)
struct XcdBarrier { unsigned* bar; unsigned x; volatile LAS unsigned* st; };
__device__ __forceinline__ XcdBarrier xcd_barrier_post(unsigned* bar, volatile LAS unsigned* st) {
    XcdBarrier b; b.bar = bar; b.x = xb_xcc_id(); b.st = st;
    if (threadIdx.x == 0) (void)xb_add(&bar[XB_XCNT(b.x)], 1u);
    return b;
}
__device__ __forceinline__ void xcd_barrier_complete(unsigned* bar, unsigned x, unsigned& nloc, unsigned& nx) {
    const unsigned G = gridDim.x * gridDim.y * gridDim.z;
    unsigned sum, cnt, mine, sp = 0u;
    for (;;) {
        sum = 0u; cnt = 0u; mine = 0u;
#pragma unroll
        for (unsigned j = 0; j < 16; ++j) { const unsigned c = xb_ld(&bar[XB_XCNT(j)]); sum += c; cnt += (c > 0u) ? 1u : 0u; mine = (j == x) ? c : mine; }
        if (sum == G) break;
        __builtin_amdgcn_s_sleep(1);
        if ((++sp & 255u) == 0u) { if (xb_ld(&bar[XB_TMO])) break; if (sp > XB_SPIN_CAP) { atomicAdd(&bar[XB_TMO], 1u); break; } }
    }
    nloc = mine > 0u ? mine : 1u; nx = cnt > 0u ? cnt : 1u;
}
__device__ __forceinline__ void xcd_barrier(const XcdBarrier& b, int wave) {
    asm volatile("s_waitcnt vmcnt(0)" ::: "memory");
    __syncthreads();
    if (wave == 0 && __builtin_amdgcn_mbcnt_hi(~0u, __builtin_amdgcn_mbcnt_lo(~0u, 0u)) == 0u) {
        unsigned* bar = b.bar;
        __builtin_amdgcn_s_waitcnt(0);
        unsigned nloc = b.st[0], nx = b.st[1];
        if (nloc == 0u) { xcd_barrier_complete(bar, b.x, nloc, nx); b.st[0] = nloc; b.st[1] = nx; }
        const unsigned old = xb_add(&bar[XB_XSUB(b.x)], 1u);
        const unsigned gen = old / nloc;
        if (old + 1u == (gen + 1u) * nloc) {
            __builtin_amdgcn_fence(__ATOMIC_RELEASE, "agent");
            asm volatile("s_waitcnt vmcnt(0)" ::: "memory");
            const unsigned og = xb_add(&bar[XB_TOP], 1u);
            const unsigned tg = og / nx;
            if (og + 1u == (tg + 1u) * nx) xb_add(&bar[XB_TOPGEN], 1u);
            else XB_SPIN(xb_ld(&bar[XB_TOPGEN]) == tg, bar);
            __builtin_amdgcn_fence(__ATOMIC_ACQUIRE, "agent");
            xb_add(&bar[XB_XGEN(b.x)], 1u);
            asm volatile("s_waitcnt vmcnt(0)" ::: "memory");
        } else {
            XB_SPIN(xb_ld(&bar[XB_XGEN(b.x)]) == gen, bar);
            __builtin_amdgcn_fence(__ATOMIC_ACQUIRE, "agent");
            asm volatile("s_waitcnt vmcnt(0)" ::: "memory");
        }
    }
    __syncthreads();
}

namespace pg8 {
constexpr int BM = 256, BK = 64, HALF = 128, HTB = HALF * BK * 2, STAGE_BYTES = 8 * HTB, NXCD = 8, WGM = 8;
__host__ __device__ __forceinline__ int lds_byte(int r, int c) { const int st = (r >> 4) * 2 + (c >> 5), rr = r & 15, cc = c & 31, ob = rr * 64 + cc * 2; return st * 1024 + (ob ^ (((ob >> 9) & 1) << 5)); }
__host__ __device__ __forceinline__ void stage_rc(int b, int& R, int& C) { const int st = b / 1024, sb = b % 1024, swz = sb ^ (((sb >> 9) & 1) << 5); R = (st >> 1) * 16 + swz / 64; C = (st & 1) * 32 + (swz % 64) / 2; }
__host__ __device__ __forceinline__ int perm32(int rho) { const int n = rho >> 4, i = rho & 15; return 8 * (i >> 2) + 4 * n + (i & 3); }
__device__ __forceinline__ unsigned cvt_pk_bf16(float lo, float hi) { unsigned r; asm volatile("v_cvt_pk_bf16_f32 %0, %1, %2" : "=v"(r) : "v"(lo), "v"(hi)); return r; }

struct Unit { int pm, pn, e, cnt; };

template <class P>
__device__ __forceinline__ void gemm_phase(LAS unsigned char* lds, const P& p, int wid) {
    int lane = (int)__builtin_amdgcn_mbcnt_hi(~0u, __builtin_amdgcn_mbcnt_lo(~0u, 0u)); asm volatile("" : "+v"(lane));
    const int tid = wid * 64 + lane, wr = wid >> 2, wc = wid & 3, fr = lane & 15, fq = lane >> 4;
    constexpr int K = P::K, nt = K / BK;
    int Rr[2], Cc[2];
#pragma unroll
    for (int i = 0; i < 2; ++i) stage_rc(tid * 16 + i * 8192, Rr[i], Cc[i]);
    unsigned voffB[2][2], voffA[2][2], voffAn[2][2];
#pragma unroll
    for (int h = 0; h < 2; ++h)
#pragma unroll
        for (int i = 0; i < 2; ++i) { voffB[h][i] = (unsigned)(P::brow(h, Rr[i]) * K + Cc[i]) * 2u; voffA[h][i] = (unsigned)((h * HALF + Rr[i]) * K + Cc[i]) * 2u; voffAn[h][i] = voffA[h][i]; }
    const size_t kstep = (size_t)(BK * 2);
    const unsigned ldsw = (unsigned)wid * 1024u;
    const int aoff = lds_byte(wr * 64 + fr, fq * 8), boff = lds_byte(wc * 32 + fr, fq * 8);
#define PG8_SA(b, h) (((b) * 2 + (h)) * HTB)
#define PG8_SB(b, h) ((4 + (b) * 2 + (h)) * HTB)
#define PG8_STAGE(bufoff, gbase, voff) do { _Pragma("unroll") for (int _i = 0; _i < 2; ++_i) \
        __builtin_amdgcn_global_load_lds((const unsigned*)((const char*)(gbase) + (voff)[_i]), (LAS unsigned*)(lds + (bufoff) + ldsw + _i * 8192), 16, 0, 0); } while (0)
#define PG8_LDA(dst, b, h) do { _Pragma("unroll") for (int m = 0; m < 4; ++m) _Pragma("unroll") for (int k = 0; k < 2; ++k) dst[m][k] = *(const LAS bf16x8*)(lds + PG8_SA(b, h) + aoff + m * 2048 + k * 1024); } while (0)
#define PG8_LDB(dst, b, h) do { _Pragma("unroll") for (int n = 0; n < 2; ++n) _Pragma("unroll") for (int k = 0; k < 2; ++k) dst[n][k] = *(const LAS bf16x8*)(lds + PG8_SB(b, h) + boff + n * 2048 + k * 1024); } while (0)
#define PG8_MMA(ai, bj, At, Bt) do { __builtin_amdgcn_s_setprio(1); _Pragma("unroll") for (int m = 0; m < 4; ++m) _Pragma("unroll") for (int n = 0; n < 2; ++n) _Pragma("unroll") for (int k = 0; k < 2; ++k) \
        acc[ai][bj][m][n] = __builtin_amdgcn_mfma_f32_16x16x32_bf16(Bt[n][k], At[m][k], acc[ai][bj][m][n], 0, 0, 0); __builtin_amdgcn_s_setprio(0); } while (0)
#define PG8_WAIT_V(n) asm volatile("s_waitcnt vmcnt(" #n ")" ::: "memory")
#define PG8_WAIT_L(n) asm volatile("s_waitcnt lgkmcnt(" #n ")" ::: "memory")
#define PG8_BAR __builtin_amdgcn_s_barrier()
#define PG8_SCHED __builtin_amdgcn_sched_barrier(0)
    Unit cur, nxt; int ui = 0;
    if (!p.next(0, cur)) return;
    f32x4 acc[2][2][4][2];
#pragma unroll
    for (int a = 0; a < 2; ++a)
#pragma unroll
        for (int b = 0; b < 2; ++b)
#pragma unroll
            for (int m = 0; m < 4; ++m)
#pragma unroll
                for (int n = 0; n < 2; ++n) acc[a][b][m][n] = (f32x4){0.f, 0.f, 0.f, 0.f};
    bf16x8 At[4][2], B0[2][2], B1[2][2];
    const char* cA = p.a_base(cur); const char* cB = p.b_base(cur);
    if constexpr (P::GATHER) p.a_offsets(cur, Rr, Cc, voffA);
    PG8_STAGE(PG8_SB(0, 0), cB, voffB[0]); PG8_STAGE(PG8_SB(0, 1), cB, voffB[1]); PG8_STAGE(PG8_SA(0, 0), cA, voffA[0]); PG8_STAGE(PG8_SA(0, 1), cA, voffA[1]);
    if (wr == 1) PG8_BAR;
    PG8_WAIT_V(2); PG8_BAR;
    PG8_STAGE(PG8_SB(1, 0), cB + kstep, voffB[0]); PG8_STAGE(PG8_SA(1, 0), cA + kstep, voffA[0]); PG8_STAGE(PG8_SB(1, 1), cB + kstep, voffB[1]);
    PG8_WAIT_V(6); PG8_BAR;
    for (;;) {
        const bool has_next = p.next(ui + 1, nxt);
        const char* nA = has_next ? p.a_base(nxt) : cA; const char* nB = has_next ? p.b_base(nxt) : cB;
        if constexpr (P::GATHER) { if (has_next) p.a_offsets(nxt, Rr, Cc, voffAn); else {
#pragma unroll
            for (int h = 0; h < 2; ++h)
#pragma unroll
                for (int i = 0; i < 2; ++i) voffAn[h][i] = voffA[h][i]; } }
        for (int t = 0; t < nt; t += 2) {
            const bool last = (t == nt - 2);
            const char* a1 = cA + (size_t)(t + 1) * kstep;
            const char* a2 = last ? nA : cA + (size_t)(t + 2) * kstep; const char* b2 = last ? nB : cB + (size_t)(t + 2) * kstep;
            const char* a3 = a2 + kstep; const char* b3 = b2 + kstep;
            unsigned va2[2][2];
#pragma unroll
            for (int h = 0; h < 2; ++h)
#pragma unroll
                for (int i = 0; i < 2; ++i) va2[h][i] = (P::GATHER && last) ? voffAn[h][i] : voffA[h][i];
            PG8_LDB(B0, 0, 0); PG8_LDB(B1, 0, 1); PG8_SCHED; PG8_LDA(At, 0, 0); PG8_STAGE(PG8_SA(1, 1), a1, voffA[1]);
            PG8_WAIT_V(8); PG8_WAIT_L(0); PG8_BAR; PG8_MMA(0, 0, At, B0); PG8_MMA(0, 1, At, B1); PG8_BAR; PG8_SCHED;
            PG8_LDA(At, 0, 1); PG8_STAGE(PG8_SB(0, 0), b2, voffB[0]); PG8_STAGE(PG8_SB(0, 1), b2, voffB[1]); PG8_STAGE(PG8_SA(0, 0), a2, va2[0]);
            PG8_WAIT_V(8); PG8_WAIT_L(0); PG8_BAR; PG8_MMA(1, 0, At, B0); PG8_MMA(1, 1, At, B1); PG8_BAR; PG8_SCHED;
            PG8_LDB(B0, 1, 0); PG8_LDB(B1, 1, 1); PG8_SCHED; PG8_LDA(At, 1, 0); PG8_STAGE(PG8_SA(0, 1), a2, va2[1]);
            PG8_WAIT_V(8); PG8_WAIT_L(0); PG8_BAR; PG8_MMA(0, 0, At, B0); PG8_MMA(0, 1, At, B1); PG8_BAR; PG8_SCHED;
            PG8_LDA(At, 1, 1); PG8_STAGE(PG8_SB(1, 0), b3, voffB[0]); PG8_STAGE(PG8_SB(1, 1), b3, voffB[1]); PG8_STAGE(PG8_SA(1, 0), a3, va2[0]);
            PG8_WAIT_V(8); PG8_WAIT_L(0); PG8_BAR; PG8_MMA(1, 0, At, B0); PG8_MMA(1, 1, At, B1); PG8_BAR; PG8_SCHED;
        }
        if (wr == 0) PG8_BAR;
        p.epi(acc, cur, wr, wc, fr, fq);
        if (!has_next) break;
#pragma unroll
        for (int a = 0; a < 2; ++a)
#pragma unroll
            for (int b = 0; b < 2; ++b)
#pragma unroll
                for (int m = 0; m < 4; ++m)
#pragma unroll
                    for (int n = 0; n < 2; ++n) acc[a][b][m][n] = (f32x4){0.f, 0.f, 0.f, 0.f};
        cur = nxt; cA = nA; cB = nB; ++ui;
        if constexpr (P::GATHER) {
#pragma unroll
            for (int h = 0; h < 2; ++h)
#pragma unroll
                for (int i = 0; i < 2; ++i) voffA[h][i] = voffAn[h][i]; }
        if (wr == 1) PG8_BAR;
    }
    PG8_WAIT_V(0);
    PG8_BAR;
#undef PG8_SA
#undef PG8_SB
#undef PG8_STAGE
#undef PG8_LDA
#undef PG8_LDB
#undef PG8_MMA
#undef PG8_WAIT_V
#undef PG8_WAIT_L
#undef PG8_BAR
#undef PG8_SCHED
}

struct DenseOrder {
    int nM, nN, nwg, G, c;
    __device__ void init(int M_, int N_, int G_, int c_) { nM = M_ / BM; nN = N_ / BM; nwg = nM * nN; G = G_; c = c_; }
    __device__ bool next(int i, Unit& u) const {
        const long L = (long)i * G + c; if (L >= nwg) return false;
        int wgid = (int)L; { const int q = nwg / NXCD, r = nwg % NXCD, xcd = wgid % NXCD, off = wgid / NXCD; wgid = (xcd < r ? xcd * (q + 1) : r * (q + 1) + (xcd - r) * q) + off; }
        const int nig = WGM * nN, gid = wgid / nig, fm = gid * WGM, gsz = (nM - fm) < WGM ? (nM - fm) : WGM;
        u.pm = fm + ((wgid % nig) % gsz); u.pn = (wgid % nig) / gsz; u.e = 0; u.cnt = 0; return true;
    }
};
struct GroupOrder {
    const LAS int* pt; const LAS int* cn; int npn, total, G, c;
    __device__ void init(const LAS int* pt_, const LAS int* cn_, int npn_, int G_, int c_) { pt = pt_; cn = cn_; npn = npn_; total = __builtin_amdgcn_readfirstlane(pt_[NE] * npn_); G = G_; c = c_; }
    __device__ bool next(int i, Unit& u) const {
        const long L = (long)i * G + c; if (L >= total) return false;
        int wgid = (int)L; { const int q = total / NXCD, r = total % NXCD, xcd = wgid % NXCD, off = wgid / NXCD; wgid = (xcd < r ? xcd * (q + 1) : r * (q + 1) + (xcd - r) * q) + off; }
        int e = 0;
        for (int j = 1; j < NE; ++j) e += (pt[j] * npn <= wgid) ? 1 : 0;
        const int t0 = pt[e], te = pt[e + 1] - t0, local = wgid - t0 * npn;
        const int mt = local % te;
        u.e = __builtin_amdgcn_readfirstlane(e); u.pn = __builtin_amdgcn_readfirstlane(local / te); u.pm = __builtin_amdgcn_readfirstlane(t0 + mt);
        u.cnt = __builtin_amdgcn_readfirstlane(cn[e] - mt * 256); return true;
    }
};
}

struct PInProj : pg8::DenseOrder {
    static constexpr int K = 1024; static constexpr bool GATHER = false;
    const bf16_t* XN; const bf16_t* Wt; bf16_t* QKV; const float *gaq, *gak, *gbq, *gbk;
    static __device__ __forceinline__ int brow(int bj, int R) { return 64 * (R >> 5) + 32 * bj + pg8::perm32(R & 31); }
    __device__ __forceinline__ const char* a_base(const pg8::Unit& u) const { return (const char*)(XN + (size_t)u.pm * 256 * K); }
    __device__ __forceinline__ const char* b_base(const pg8::Unit& u) const { return (const char*)(Wt + (size_t)u.pn * 256 * K); }
    __device__ __forceinline__ void epi(const f32x4 (&acc)[2][2][4][2], const pg8::Unit& u, int wr, int wc, int fr, int fq) const {
        const int ty = u.pn >> 1;
        const float* g = (ty == 0) ? gaq : (ty == 1) ? gak : (ty == 3) ? gbq : (ty == 4) ? gbk : nullptr;
        const float post = (ty == 0 || ty == 3) ? QSCALE : 1.f;
        const int row0 = u.pm * 256 + wr * 64 + fr, col0 = u.pn * 256 + wc * 64 + 8 * fq;
        f32x4 gv[2][2];
#pragma unroll
        for (int bj = 0; bj < 2; ++bj)
#pragma unroll
            for (int n = 0; n < 2; ++n) gv[bj][n] = g ? *(const f32x4*)(g + 32 * bj + 8 * fq + 4 * n) : (f32x4){1.f, 1.f, 1.f, 1.f};
#pragma unroll
        for (int ai = 0; ai < 2; ++ai)
#pragma unroll
            for (int m = 0; m < 4; ++m) {
                float rs = 1.f;
                if (g) {
                    float ss = 0.f;
#pragma unroll
                    for (int bj = 0; bj < 2; ++bj)
#pragma unroll
                        for (int n = 0; n < 2; ++n) { const f32x4 v = acc[ai][bj][m][n]; ss += (v[0] * v[0] + v[1] * v[1]) + (v[2] * v[2] + v[3] * v[3]); }
                    ss += __shfl_xor(ss, 16); ss += __shfl_xor(ss, 32);
                    rs = rsqrtf(ss * (1.f / 64.f) + RMS_EPS) * post;
                }
                bf16_t* rowp = QKV + (size_t)(row0 + ai * 128 + m * 16) * NIN + col0;
#pragma unroll
                for (int bj = 0; bj < 2; ++bj) {
                    const f32x4 v0 = acc[ai][bj][m][0] * gv[bj][0] * rs, v1 = acc[ai][bj][m][1] * gv[bj][1] * rs;
                    u32x4 w; w.x = pg8::cvt_pk_bf16(v0[0], v0[1]); w.y = pg8::cvt_pk_bf16(v0[2], v0[3]); w.z = pg8::cvt_pk_bf16(v1[0], v1[1]); w.w = pg8::cvt_pk_bf16(v1[2], v1[3]);
                    *(u32x4*)(rowp + 32 * bj) = w;
                }
            }
    }
};
struct POutProj : pg8::DenseOrder {
    static constexpr int K = 1024; static constexpr bool GATHER = false;
    const bf16_t* AO; const bf16_t* Wt; const float* x; const float* mod; float* x1;
    static __device__ __forceinline__ int brow(int bj, int R) { return 128 * bj + R; }
    __device__ __forceinline__ const char* a_base(const pg8::Unit& u) const { return (const char*)(AO + (size_t)u.pm * 256 * K); }
    __device__ __forceinline__ const char* b_base(const pg8::Unit& u) const { return (const char*)(Wt + (size_t)u.pn * 256 * K); }
    __device__ __forceinline__ void epi(const f32x4 (&acc)[2][2][4][2], const pg8::Unit& u, int wr, int wc, int fr, int fq) const {
        const int row0 = u.pm * 256 + wr * 64 + fr, col0 = u.pn * 256 + wc * 32 + 4 * fq;
        const float* gate1 = mod + ((u.pm * 256) / S) * 6144 + 2048;
        f32x4 gv[2][2];
#pragma unroll
        for (int bj = 0; bj < 2; ++bj)
#pragma unroll
            for (int n = 0; n < 2; ++n) gv[bj][n] = *(const f32x4*)(gate1 + col0 + bj * 128 + n * 16);
#pragma unroll
        for (int ai = 0; ai < 2; ++ai)
#pragma unroll
            for (int m = 0; m < 4; ++m) { const size_t off = (size_t)(row0 + ai * 128 + m * 16) * D + col0;
#pragma unroll
                for (int bj = 0; bj < 2; ++bj)
#pragma unroll
                    for (int n = 0; n < 2; ++n) { const f32x4 xv = *(const f32x4*)(x + off + bj * 128 + n * 16); *(f32x4*)(x1 + off + bj * 128 + n * 16) = xv + gv[bj][n] * acc[ai][bj][m][n]; }
                if (m & 1) asm volatile("" ::: "memory"); }
    }
};
struct PGateUp : pg8::GroupOrder {
    static constexpr int K = 1024; static constexpr bool GATHER = true;
    const bf16_t* H2; const bf16_t* Wt; const float* bgu; const int* list; bf16_t* ACT;
    static __device__ __forceinline__ int brow(int bj, int R) { return 1024 * bj + (R & ~31) + pg8::perm32(R & 31); }
    __device__ __forceinline__ const char* a_base(const pg8::Unit&) const { return (const char*)H2; }
    __device__ __forceinline__ const char* b_base(const pg8::Unit& u) const { return (const char*)(Wt + ((size_t)u.e * 2048 + u.pn * 128) * K); }
    __device__ __forceinline__ void a_offsets(const pg8::Unit& u, const int (&R)[2], const int (&C)[2], unsigned (&voff)[2][2]) const {
        const int* lp = list + (size_t)u.e * M + (size_t)(u.pm - pt[u.e]) * 256;
#pragma unroll
        for (int h = 0; h < 2; ++h)
#pragma unroll
            for (int i = 0; i < 2; ++i) { int r = h * 128 + R[i]; r = r < u.cnt ? r : 0; const int tok = lp[r]; voff[h][i] = (unsigned)(tok * K + C[i]) * 2u; }
    }
    __device__ __forceinline__ void epi(const f32x4 (&acc)[2][2][4][2], const pg8::Unit& u, int wr, int wc, int fr, int fq) const {
        const int row0 = u.pm * 256 + wr * 64 + fr, col0 = u.pn * 128 + wc * 32 + 8 * fq;
        const float* bias = bgu + u.e * 2048 + col0;
        f32x4 bg[2], bu[2];
#pragma unroll
        for (int n = 0; n < 2; ++n) { bg[n] = *(const f32x4*)(bias + 4 * n); bu[n] = *(const f32x4*)(bias + 1024 + 4 * n); }
#pragma unroll
        for (int ai = 0; ai < 2; ++ai)
#pragma unroll
            for (int m = 0; m < 4; ++m) {
                float a[2][4];
#pragma unroll
                for (int n = 0; n < 2; ++n)
#pragma unroll
                    for (int r = 0; r < 4; ++r) {
                        float g = acc[ai][0][m][n][r] + bg[n][r], uu = acc[ai][1][m][n][r] + bu[n][r];
                        g = fminf(g, 7.f); uu = fminf(fmaxf(uu, -7.f), 7.f);
                        a[n][r] = (uu + 1.f) * g * __builtin_amdgcn_rcpf(1.f + __builtin_amdgcn_exp2f(-1.702f * LOG2E * g));
                    }
                u32x4 w; w.x = pg8::cvt_pk_bf16(a[0][0], a[0][1]); w.y = pg8::cvt_pk_bf16(a[0][2], a[0][3]); w.z = pg8::cvt_pk_bf16(a[1][0], a[1][1]); w.w = pg8::cvt_pk_bf16(a[1][2], a[1][3]);
                *(u32x4*)(ACT + (size_t)(row0 + ai * 128 + m * 16) * DFF + col0) = w;
            }
    }
};
struct PDown : pg8::GroupOrder {
    static constexpr int K = 1024; static constexpr bool GATHER = false;
    const bf16_t* ACT; const bf16_t* Wt; const float* bd; bf16_t* Y;
    static __device__ __forceinline__ int brow(int bj, int R) { return 128 * bj + (R & ~31) + pg8::perm32(R & 31); }
    __device__ __forceinline__ const char* a_base(const pg8::Unit& u) const { return (const char*)(ACT + (size_t)u.pm * 256 * K); }
    __device__ __forceinline__ const char* b_base(const pg8::Unit& u) const { return (const char*)(Wt + ((size_t)u.e * 1024 + u.pn * 256) * K); }
    __device__ __forceinline__ void epi(const f32x4 (&acc)[2][2][4][2], const pg8::Unit& u, int wr, int wc, int fr, int fq) const {
        const int row0 = u.pm * 256 + wr * 64 + fr, col0 = u.pn * 256 + wc * 32 + 8 * fq;
        const float* bias = bd + u.e * 1024 + col0;
        f32x4 bv[2][2];
#pragma unroll
        for (int bj = 0; bj < 2; ++bj)
#pragma unroll
            for (int n = 0; n < 2; ++n) bv[bj][n] = *(const f32x4*)(bias + bj * 128 + 4 * n);
#pragma unroll
        for (int ai = 0; ai < 2; ++ai)
#pragma unroll
            for (int m = 0; m < 4; ++m) { bf16_t* rowp = Y + (size_t)(row0 + ai * 128 + m * 16) * D + col0;
#pragma unroll
                for (int bj = 0; bj < 2; ++bj) { const f32x4 v0 = acc[ai][bj][m][0] + bv[bj][0], v1 = acc[ai][bj][m][1] + bv[bj][1];
                    u32x4 w; w.x = pg8::cvt_pk_bf16(v0[0], v0[1]); w.y = pg8::cvt_pk_bf16(v0[2], v0[3]); w.z = pg8::cvt_pk_bf16(v1[0], v1[1]); w.w = pg8::cvt_pk_bf16(v1[2], v1[3]);
                    *(u32x4*)(rowp + bj * 128) = w; } }
    }
};


namespace att {
typedef float f32x16 __attribute__((ext_vector_type(16)));
typedef short s16x4 __attribute__((ext_vector_type(4)));
typedef short v4i16_t __attribute__((ext_vector_type(4)));
typedef float f32x2_t __attribute__((ext_vector_type(2))); typedef __bf16 bf16x2_t __attribute__((ext_vector_type(2)));
__device__ __forceinline__ unsigned cvtpk(float lo, float hi) { f32x2_t v = {lo, hi}; bf16x2_t b = __builtin_convertvector(v, bf16x2_t); return __builtin_bit_cast(unsigned, b); }
__device__ __forceinline__ s16x4 vtr(const LAS unsigned char* p) { return __builtin_bit_cast(s16x4, __builtin_amdgcn_ds_read_tr16_b64_v4i16((LAS v4i16_t*)p)); }
__device__ __forceinline__ void glds16(const void* gsrc, LAS unsigned char* dst) { __builtin_amdgcn_global_load_lds((const unsigned*)gsrc, (LAS unsigned*)dst, 16, 0, 0); }
#define ATT_CR(r) (((r) & 3) + 8 * ((r) >> 2))
#define ATT_WAIT_V(n) asm volatile("s_waitcnt vmcnt(" #n ")" ::: "memory")
#define ATT_WAIT_L0() asm volatile("s_waitcnt lgkmcnt(0)" ::: "memory")

template <int MODE> __device__ __forceinline__ float soft_tile(f32x16& p0, f32x16& p1, float sl, int dqh) {
    float sum = 0.f;
#pragma unroll
    for (int r = 0; r < 16; ++r) {
        float x0 = __builtin_fmaf(sl, (float)ATT_CR(r), p0[r]), x1 = __builtin_fmaf(sl, (float)(ATT_CR(r) + 32), p1[r]);
        if (MODE == 1) { x0 = (ATT_CR(r) <= dqh) ? x0 : -INFINITY; x1 = (ATT_CR(r) + 32 <= dqh) ? x1 : -INFINITY; }
        if (MODE == 2) { x0 = ((unsigned)(dqh - ATT_CR(r)) <= 128u) ? x0 : -INFINITY; x1 = ((unsigned)(dqh - ATT_CR(r) - 32) <= 128u) ? x1 : -INFINITY; }
        p0[r] = __builtin_amdgcn_exp2f(x0); p1[r] = __builtin_amdgcn_exp2f(x1);
        sum += p0[r] + p1[r];
    }
    return sum;
}
__device__ __forceinline__ void pack_p(const f32x16& p0, const f32x16& p1, bf16x8 (&pa)[4]) {
    u32x4 w0 = {cvtpk(p0[0], p0[1]), cvtpk(p0[2], p0[3]), cvtpk(p0[4], p0[5]), cvtpk(p0[6], p0[7])};
    u32x4 w1 = {cvtpk(p0[8], p0[9]), cvtpk(p0[10], p0[11]), cvtpk(p0[12], p0[13]), cvtpk(p0[14], p0[15])};
    u32x4 w2 = {cvtpk(p1[0], p1[1]), cvtpk(p1[2], p1[3]), cvtpk(p1[4], p1[5]), cvtpk(p1[6], p1[7])};
    u32x4 w3 = {cvtpk(p1[8], p1[9]), cvtpk(p1[10], p1[11]), cvtpk(p1[12], p1[13]), cvtpk(p1[14], p1[15])};
    pa[0] = __builtin_bit_cast(bf16x8, w0); pa[1] = __builtin_bit_cast(bf16x8, w1); pa[2] = __builtin_bit_cast(bf16x8, w2); pa[3] = __builtin_bit_cast(bf16x8, w3);
}
template <int NDB> __device__ __forceinline__ void pv_tile(f32x16 (&o)[NDB], const LAS unsigned char* vrd, const bf16x8 (&pa)[4]) {
#pragma unroll
    for (int db = 0; db < NDB; ++db) {
        s16x4 lo[4], hh[4];
#pragma unroll
        for (int g = 0; g < 4; ++g) { lo[g] = vtr(vrd + db * 4096 + g * 1024); hh[g] = vtr(vrd + db * 4096 + g * 1024 + 512); }
#pragma unroll
        for (int g = 0; g < 4; ++g) { const bf16x8 vf = {lo[g][0], lo[g][1], lo[g][2], lo[g][3], hh[g][0], hh[g][1], hh[g][2], hh[g][3]};
            o[db] = __builtin_amdgcn_mfma_f32_32x32x16_bf16(pa[g], vf, o[db], 0, 0, 0); }
    }
}
__device__ __forceinline__ float gain_bound(const float* ga, const float* gb, int lane) {
    float a = fabsf(ga[lane & 63]), b = fabsf(gb[lane & 63]);
#pragma unroll
    for (int o = 1; o < 64; o <<= 1) { a = fmaxf(a, __shfl_xor(a, o)); b = fmaxf(b, __shfl_xor(b, o)); }
    return QSCALE * 64.f * a * b * 1.02f + 0.25f;
}

constexpr int B_SLOT = 24576;
__device__ __forceinline__ void attn_b_unit(LAS unsigned char* lds, LAS float* wsf, const bf16_t* QKV, float* OBN, int b, int h, int c, int qb, float Mb, int wave, int lane) {
    const int r32 = lane & 31, hi = lane >> 5;
    const int q0 = qb * 256, tq = q0 + wave * 32 + r32;
    const size_t rowbase = (size_t)b * S;
    const bf16_t* Qp = QKV + (rowbase + tq) * NIN + 1536 + h * 128 + c * 64;
    const bf16_t* Kh = QKV + rowbase * NIN + 2048 + h * 128 + c * 64;
    const bf16_t* Vh = QKV + rowbase * NIN + 2560 + h * 128;
    const float sl = exp2f(-2.f * (float)(h + 1)) * LOG2E;
    bf16x8 qr[4];
#pragma unroll
    for (int d0 = 0; d0 < 4; ++d0) qr[d0] = *(const bf16x8*)(Qp + d0 * 16 + hi * 8);
    const int NT = (q0 + 256) / 64;
    const bf16_t* ksrc = Kh + (size_t)lane * NIN + wave * 8;
    const int i0 = wave, i1 = wave + 8;
    const bf16_t* vsrc0 = Vh + (size_t)(16 * (i0 & 3) + (lane >> 2)) * NIN + (i0 >> 2) * 32 + (lane & 3) * 8;
    const bf16_t* vsrc1 = Vh + (size_t)(16 * (i1 & 3) + (lane >> 2)) * NIN + (i1 >> 2) * 32 + (lane & 3) * 8;
#define ATT_DMA(t, s) do { const size_t to_ = (size_t)(t) * 64 * NIN; LAS unsigned char* sb_ = lds + (s) * B_SLOT; \
        glds16(ksrc + to_, sb_ + wave * 1024); glds16(vsrc0 + to_, sb_ + 8192 + i0 * 1024); glds16(vsrc1 + to_, sb_ + 8192 + i1 * 1024); } while (0)
    const int kfo = hi * 1024 + r32 * 16;
    const int vro = 8192 + ((lane >> 4) & 1) * 32 + (lane & 3) * 8 + (4 * hi + ((lane & 15) >> 2)) * 64;
    f32x16 o[4]; float lsum = 0.f;
#pragma unroll
    for (int d = 0; d < 4; ++d) o[d] = f32x16{};
    ATT_WAIT_L0(); __builtin_amdgcn_s_barrier();
    ATT_DMA(0, 0); ATT_DMA(1, 1);
    const int qmax_w = q0 + wave * 32 + 31, qmin_w = q0 + wave * 32;
    int slot = 0;
    for (int t = 0; t < NT; ++t) {
        if (t + 1 < NT) ATT_WAIT_V(3); else ATT_WAIT_V(0);
        ATT_WAIT_L0(); __builtin_amdgcn_s_barrier();
        if (t + 2 < NT) { const int s2 = (slot >= 1) ? slot - 1 : 2; ATT_DMA(t + 2, s2); }
        const int k0 = 64 * t;
        if (k0 <= qmax_w) {
            const LAS unsigned char* sb = lds + slot * B_SLOT;
            bf16x8 kf[8];
#pragma unroll
            for (int d0 = 0; d0 < 4; ++d0) { kf[2 * d0] = *(const LAS bf16x8*)(sb + kfo + d0 * 2048); kf[2 * d0 + 1] = *(const LAS bf16x8*)(sb + kfo + d0 * 2048 + 512); }
            const int dqh = tq - k0 - 4 * hi;
            const float ci = -sl * (float)dqh - Mb;
            f32x16 p0, p1;
#pragma unroll
            for (int r = 0; r < 16; ++r) { p0[r] = ci; p1[r] = ci; }
#pragma unroll
            for (int d0 = 0; d0 < 4; ++d0) { p0 = __builtin_amdgcn_mfma_f32_32x32x16_bf16(kf[2 * d0], qr[d0], p0, 0, 0, 0); p1 = __builtin_amdgcn_mfma_f32_32x32x16_bf16(kf[2 * d0 + 1], qr[d0], p1, 0, 0, 0); }
            if (k0 + 63 <= qmin_w) lsum += soft_tile<0>(p0, p1, sl, dqh); else lsum += soft_tile<1>(p0, p1, sl, dqh);
            bf16x8 pa[4]; pack_p(p0, p1, pa);
            pv_tile<4>(o, sb + vro, pa);
        }
        slot = (slot == 2) ? 0 : slot + 1;
    }
#undef ATT_DMA
    { auto rr = __builtin_amdgcn_permlane32_swap(__float_as_uint(lsum), __float_as_uint(lsum), false, false); lsum = __uint_as_float(rr[0]) + __uint_as_float(rr[1]); }
    if (hi == 0) wsf[r32] = lsum;
    ATT_WAIT_L0();
    float* ob = OBN + ((size_t)c * M + rowbase + q0 + wave * 32) * 512 + h * 128 + r32;
#pragma unroll
    for (int r = 0; r < 16; ++r) { const int q = ATT_CR(r) + 4 * hi; const float rl = __builtin_amdgcn_rcpf(wsf[q]);
#pragma unroll
        for (int db = 0; db < 4; ++db) ob[(size_t)q * 512 + db * 32] = o[db][r] * rl; }
    ATT_WAIT_L0();
}
__device__ __forceinline__ void attn_b_phase(LAS unsigned char* lds, LAS float* wsf, const bf16_t* QKV, float* OBN, const float* gbq, const float* gbk, int vcu, int wave, int lane) {
    const float Mb = gain_bound(gbq, gbk, lane);
    const int bhc = vcu >> 2, s = vcu & 3, b = bhc >> 3, h = (bhc >> 1) & 3, c = bhc & 1;
    attn_b_unit(lds, wsf, QKV, OBN, b, h, c, 7 - s, Mb, wave, lane);
    attn_b_unit(lds, wsf, QKV, OBN, b, h, c, s, Mb, wave, lane);
    ATT_WAIT_L0(); __builtin_amdgcn_s_barrier();
}

struct ATile { const bf16_t* kbase; int step, dq0; float sl; };
__device__ __forceinline__ void attn_a_task(LAS unsigned char* vbuf, LAS float* wsf, const bf16_t* QKV, bf16_t* AO, int b, int h, int r, int jb, float Mb, int lane) {
    const int r32 = lane & 31, hi = lane >> 5;
    const int j = 32 * jb + r32, tq = r + 16 * j;
    const size_t rowbase = (size_t)b * S;
    const bf16_t* Qp = QKV + (rowbase + tq) * NIN + h * 64;
    const bf16_t* Kh = QKV + rowbase * NIN + 512 + h * 64;
    const float sl1 = exp2f(-(float)(h + 1)) * LOG2E;
    bf16x8 qr[4];
#pragma unroll
    for (int d0 = 0; d0 < 4; ++d0) qr[d0] = *(const bf16x8*)(Qp + d0 * 16 + hi * 8);
    const int n3 = (jb >= 2) ? 2 : 1, n2 = (jb == 0) ? 2 : 4, n1 = (jb == 0) ? 8 : 10, ntile = n3 + n2 + n1;
    auto tile_step = [&](int idx) -> int { return idx < n3 ? 16 : (idx < n3 + n2 ? 4 : 1); };
    auto tile_k0 = [&](int idx) -> int { return idx < n3 ? 64 * idx : (idx < n3 + n2 ? 64 * ((jb == 0 ? 0 : 2 * jb - 2) + idx - n3) : 64 * ((jb == 0 ? 0 : 8 * jb - 2) + idx - n3 - n2)); };
    auto tile_uq = [&](int step) -> int { return step == 16 ? j : (step == 4 ? (r >> 2) + 4 * j : tq); };
    auto tile_pos0 = [&](int step, int k0) -> int { return (r & (step - 1)) + step * k0; };
    const int kfr = r32, vr16 = lane >> 2;
    bf16x8 kfn[8];
#define ATT_PREF(idx, buf) do { const int st_ = tile_step(idx), k0_ = tile_k0(idx); const bf16_t* kb_ = Kh + (size_t)tile_pos0(st_, k0_) * NIN; const size_t rs_ = (size_t)st_ * NIN; \
        _Pragma("unroll") for (int d0 = 0; d0 < 4; ++d0) { kfn[2 * d0] = *(const bf16x8*)(kb_ + (size_t)kfr * rs_ + d0 * 16 + hi * 8); kfn[2 * d0 + 1] = *(const bf16x8*)(kb_ + (size_t)(kfr + 32) * rs_ + d0 * 16 + hi * 8); } \
        _Pragma("unroll") for (int i = 0; i < 8; ++i) glds16(kb_ + 512 + (size_t)(16 * (i & 3) + vr16) * rs_ + (i >> 2) * 32 + (lane & 3) * 8, vbuf + (buf) * 8192 + i * 1024); } while (0)
    const int vro = ((lane >> 4) & 1) * 32 + (lane & 3) * 8 + (4 * hi + ((lane & 15) >> 2)) * 64;
    f32x16 o[2]; o[0] = f32x16{}; o[1] = f32x16{}; float lsum = 0.f;
    ATT_WAIT_L0();
    ATT_PREF(0, 0);
    for (int idx = 0; idx < ntile; ++idx) {
        ATT_WAIT_V(0);
        bf16x8 kf[8];
#pragma unroll
        for (int i = 0; i < 8; ++i) kf[i] = kfn[i];
        ATT_WAIT_L0();
        if (idx + 1 < ntile) ATT_PREF(idx + 1, (idx + 1) & 1);
        const int st = tile_step(idx), k0 = tile_k0(idx);
        const int dqh = tile_uq(st) - k0 - 4 * hi;
        const float sl = sl1 * (float)st;
        const float ci = -sl * (float)dqh - Mb;
        f32x16 p0, p1;
#pragma unroll
        for (int rr = 0; rr < 16; ++rr) { p0[rr] = ci; p1[rr] = ci; }
#pragma unroll
        for (int d0 = 0; d0 < 4; ++d0) { p0 = __builtin_amdgcn_mfma_f32_32x32x16_bf16(kf[2 * d0], qr[d0], p0, 0, 0, 0); p1 = __builtin_amdgcn_mfma_f32_32x32x16_bf16(kf[2 * d0 + 1], qr[d0], p1, 0, 0, 0); }
        lsum += soft_tile<2>(p0, p1, sl, dqh);
        bf16x8 pa[4]; pack_p(p0, p1, pa);
        pv_tile<2>(o, vbuf + (idx & 1) * 8192 + vro, pa);
    }
#undef ATT_PREF
    { auto rr = __builtin_amdgcn_permlane32_swap(__float_as_uint(lsum), __float_as_uint(lsum), false, false); lsum = __uint_as_float(rr[0]) + __uint_as_float(rr[1]); }
    if (hi == 0) wsf[r32] = lsum;
    ATT_WAIT_L0();
    LAS bf16_t* stg = (LAS bf16_t*)vbuf;
#pragma unroll
    for (int rr = 0; rr < 16; ++rr) { const int q = ATT_CR(rr) + 4 * hi; const float rl = __builtin_amdgcn_rcpf(wsf[q]);
#pragma unroll
        for (int db = 0; db < 2; ++db) stg[q * 64 + db * 32 + r32] = f2bf(o[db][rr] * rl); }
    ATT_WAIT_L0();
#pragma unroll
    for (int i = 0; i < 4; ++i) { const int row = i * 8 + (lane >> 3), ch = lane & 7; const u32x4 v = *(const LAS u32x4*)(stg + row * 64 + ch * 8);
        *(u32x4*)(AO + (rowbase + r + 16 * (32 * jb + row)) * D + h * 64 + ch * 8) = v; }
    ATT_WAIT_L0();
}
__device__ __forceinline__ void attn_a_phase(LAS unsigned char* lds, LAS float* wsf, const bf16_t* QKV, bf16_t* AO, const float* gaq, const float* gak, int vcu, int wave, int lane) {
    const float Mb = gain_bound(gaq, gak, lane);
    const int bh = vcu >> 2, b = bh >> 3, h = bh & 7, r = 4 * (vcu & 3) + (wave & 3);
    LAS unsigned char* vbuf = lds + wave * 16384;
    attn_a_task(vbuf, wsf, QKV, AO, b, h, r, (wave >> 2) ? 2 : 3, Mb, lane);
    attn_a_task(vbuf, wsf, QKV, AO, b, h, r, (wave >> 2) ? 1 : 0, Mb, lane);
}
#undef ATT_CR
#undef ATT_WAIT_V
#undef ATT_WAIT_L0
}

struct MArgs {
    const float *x, *c, *w_ada, *b_ada, *g1, *w_in, *gaq, *gak, *gbq, *gbk, *lq1, *lk1, *lq2, *lk2, *gd, *w_out, *g2, *w_router, *b_router, *w_gu, *b_gu, *w_d, *b_d;
    float* out; unsigned char* ws; int ph_lo, ph_hi;
};

__device__ __forceinline__ void p0_transpose_item(const float* W, int K, int N, bf16_t* WT, LAS float* scr, int item, int lane) {
    const int nblk = N / 32, kb = item / nblk, nb = item % nblk, k0 = 64 * kb, n0 = 32 * nb;
#pragma unroll 8
    for (int i = 0; i < 32; ++i) { const int kk = 2 * i + (lane >> 5); scr[kk * 33 + (lane & 31)] = W[(size_t)(k0 + kk) * N + n0 + (lane & 31)]; }
    LDS_WAIT(); asm volatile("" ::: "memory");
    const int c = lane & 7;
#pragma unroll
    for (int j = 0; j < 4; ++j) { const int n = (lane >> 3) + 8 * j; const LAS float* s = scr + (8 * c) * 33 + n;
        u32x4 o; o.x = pk2(s[0 * 33], s[1 * 33]); o.y = pk2(s[2 * 33], s[3 * 33]); o.z = pk2(s[4 * 33], s[5 * 33]); o.w = pk2(s[6 * 33], s[7 * 33]);
        *(u32x4*)(WT + (size_t)(n0 + n) * K + k0 + 8 * c) = o; }
    LDS_WAIT(); asm volatile("" ::: "memory");
}

__global__ void __launch_bounds__(NTHREADS, 2) mega(MArgs a) {
    extern __shared__ __attribute__((aligned(16))) unsigned char lds_raw[];
    LAS unsigned char* lds = (LAS unsigned char*)lds_raw;
    const int G = gridDim.x, bx = blockIdx.x, vcu = (G % 8 == 0) ? (bx % 8) * (G / 8) + bx / 8 : bx, NGW = G * NWAVES;
    const int wave = __builtin_amdgcn_readfirstlane((int)threadIdx.x >> 6);
#define PHASE_IDS() int lane = (int)__builtin_amdgcn_mbcnt_hi(~0u, __builtin_amdgcn_mbcnt_lo(~0u, 0u)); asm volatile("" : "+v"(lane)); const int tid = wave * 64 + lane, gw = vcu * NWAVES + wave; (void)tid; (void)gw
    volatile LAS unsigned* MISC = (volatile LAS unsigned*)(lds + MISC_OFF);
    LAS int* PT = (LAS int*)(lds + PT_OFF); LAS int* CN = (LAS int*)(lds + CNT_OFF);
#define w_counts ((int*)(a.ws + WS_CTL + CTL_COUNTS))
#define w_mod ((float*)(a.ws + WS_CTL + CTL_MOD))
#define w_Win_t ((bf16_t*)(a.ws + WS_WIN))
#define w_Wout_t ((bf16_t*)(a.ws + WS_WOUT))
#define w_Wgu_t ((bf16_t*)(a.ws + WS_WGU))
#define w_Wd_t ((bf16_t*)(a.ws + WS_WD))
#define w_XN ((bf16_t*)(a.ws + WS_XN))
#define w_QKV ((bf16_t*)(a.ws + WS_QKV))
#define w_AO ((bf16_t*)(a.ws + WS_AO))
#define w_H2 ((bf16_t*)(a.ws + WS_H2))
#define w_tope ((int*)(a.ws + WS_TOPE))
#define w_tops ((int*)(a.ws + WS_TOPS))
#define w_topg ((float*)(a.ws + WS_TOPG))
#define w_list ((int*)(a.ws + WS_LIST))
#define w_ACT ((bf16_t*)(a.ws + WS_ACT))
#define w_Y ((bf16_t*)(a.ws + WS_Y))
#define w_OBN ((float*)(a.ws + WS_OBN))
    for (int u = threadIdx.x; u < (LDS_BYTES - LDSCTL_OFF) / 4; u += NTHREADS) ((LAS unsigned*)(lds + LDSCTL_OFF))[u] = 0u;
    __syncthreads();
    const int lo = a.ph_lo, hi = a.ph_hi;
    XcdBarrier bar; bar.bar = (unsigned*)(a.ws + WS_CTL + CTL_BAR); bar.x = 0; bar.st = nullptr;
    if (hi - lo > 1) bar = xcd_barrier_post((unsigned*)(a.ws + WS_CTL + CTL_BAR), MISC + 8);
#define IN(k) (lo <= (k) && (k) < hi)
#define SEAM(k) do { if (IN(k) && IN((k) + 1)) xcd_barrier(bar, wave); } while (0)
#define LOAD_PT() do { if (wave == 0) { int cv = (lane < NE) ? w_counts[lane] : 0; int tl = (cv + 255) >> 8; int sc = tl; \
        _Pragma("unroll") for (int o = 1; o < 32; o <<= 1) { const int t_ = __shfl_up(sc, o); if ((lane & 31) >= o) sc += t_; } \
        if (lane < NE) { PT[lane + 1] = sc; CN[lane] = cv; } if (lane == 0) PT[0] = 0; } __syncthreads(); } while (0)

    if (IN(0)) {
        PHASE_IDS();
        LAS float* silu = (LAS float*)(lds + 98304);
        for (int i = tid; i < NB * D; i += NTHREADS) { const float cv = a.c[i]; silu[i] = cv / (1.f + __expf(-cv)); }
        __syncthreads();
        if (gw < 24 * 32) {
            const int cc = gw % 24, ks = gw / 24, col = cc * 256 + 4 * lane;
            f32x4 acc[NB];
#pragma unroll
            for (int b = 0; b < NB; ++b) acc[b] = (ks == 0) ? *(const f32x4*)(a.b_ada + col) : (f32x4){0.f, 0.f, 0.f, 0.f};
            for (int k = ks * 32; k < ks * 32 + 32; ++k) {
                const f32x4 w = *(const f32x4*)(a.w_ada + (size_t)k * 6144 + col);
#pragma unroll
                for (int b = 0; b < NB; ++b) acc[b] += w * silu[b * D + k];
            }
#pragma unroll
            for (int b = 0; b < NB; ++b)
#pragma unroll
                for (int r = 0; r < 4; ++r) atomicAdd(&w_mod[b * 6144 + col + r], acc[b][r]);
        }
        LAS float* scr = (LAS float*)(lds + wave * 10240);
        constexpr int I_IN = 16 * 96, I_OUT = 16 * 32, I_GU = 16 * 64, I_D = 16 * 32;
        constexpr int NITEMS = I_IN + I_OUT + NE * I_GU + NE * I_D;
        for (int it = gw; it < NITEMS; it += NGW) {
            int r = it;
            if (r < I_IN) { p0_transpose_item(a.w_in, 1024, 3072, w_Win_t, scr, r, lane); continue; } r -= I_IN;
            if (r < I_OUT) { p0_transpose_item(a.w_out, 1024, 1024, w_Wout_t, scr, r, lane); continue; } r -= I_OUT;
            if (r < NE * I_GU) { const int e = r / I_GU; p0_transpose_item(a.w_gu + (size_t)e * 1024 * 2048, 1024, 2048, w_Wgu_t + (size_t)e * 1024 * 2048, scr, r % I_GU, lane); continue; } r -= NE * I_GU;
            { const int e = r / I_D; p0_transpose_item(a.w_d + (size_t)e * 1024 * 1024, 1024, 1024, w_Wd_t + (size_t)e * 1024 * 1024, scr, r % I_D, lane); }
        }
    }
    SEAM(0);
    if (IN(1)) {
        PHASE_IDS();
        for (int row = gw; row < M; row += NGW) {
            const int b = row / S;
            const f32x4* xr = (const f32x4*)(a.x + (size_t)row * D) + lane;
            f32x4 v[4]; float ss = 0.f;
#pragma unroll
            for (int j = 0; j < 4; ++j) { v[j] = xr[64 * j]; ss += (v[j].x * v[j].x + v[j].y * v[j].y) + (v[j].z * v[j].z + v[j].w * v[j].w); }
            const float rstd = rsqrtf(wave_sum(ss) * (1.f / D) + RMS_EPS);
            const float* shift = w_mod + b * 6144, *scale = w_mod + b * 6144 + 1024;
#pragma unroll
            for (int j = 0; j < 4; ++j) {
                const int c0 = 4 * lane + 256 * j;
                const f32x4 g = *(const f32x4*)(a.g1 + c0), sc = *(const f32x4*)(scale + c0), sh = *(const f32x4*)(shift + c0);
                const f32x4 o = v[j] * rstd * g * (sc + 1.f) + sh;
                u32x2 w; w.x = pk2(o.x, o.y); w.y = pk2(o.z, o.w);
                *(u32x2*)(w_XN + (size_t)row * D + c0) = w;
            }
        }
    }
    SEAM(1);
    if (IN(2)) {
        PHASE_IDS();
        PInProj p; p.init(M, NIN, G, bx); p.XN = w_XN; p.Wt = w_Win_t; p.QKV = w_QKV; p.gaq = a.gaq; p.gak = a.gak; p.gbq = a.gbq; p.gbk = a.gbk;
        pg8::gemm_phase<PInProj>(lds, p, wave);
    }
    SEAM(2);
    if (IN(3)) {
        PHASE_IDS();
        LAS float* wsf = (LAS float*)(lds + LDSCTL_OFF + 2048) + wave * 64;
        att::attn_a_phase(lds, wsf, w_QKV, w_AO, a.gaq, a.gak, vcu, wave, lane);
        att::attn_b_phase(lds, wsf, w_QKV, w_OBN, a.gbq, a.gbk, vcu, wave, lane);
    }
    SEAM(3);
    if (IN(4)) {
        PHASE_IDS();
        const float s1 = wave_sum(a.lq1[lane] * a.lk1[lane]), s2 = wave_sum(a.lq2[lane] * a.lk2[lane]);
        const float lam = __expf(s1) - __expf(s2) + LAMBDA_INIT;
        for (int w = gw; w < M * 4; w += NGW) {
            const int tok = w >> 2, h = w & 3;
            const float* p0 = w_OBN + (size_t)tok * 512 + h * 128 + 2 * lane; const float* p1 = p0 + (size_t)M * 512;
            const float va = p0[0] - lam * p1[0], vb = p0[1] - lam * p1[1];
            const float rstd = rsqrtf(wave_sum(va * va + vb * vb) * (1.f / 128.f) + RMS_EPS) * (1.f - LAMBDA_INIT);
            *(unsigned*)(w_AO + (size_t)tok * D + 512 + h * 128 + 2 * lane) = pk2(va * rstd * a.gd[2 * lane], vb * rstd * a.gd[2 * lane + 1]);
        }
    }
    SEAM(4);
    if (IN(5)) {
        PHASE_IDS();
        POutProj p; p.init(M, D, G, bx); p.AO = w_AO; p.Wt = w_Wout_t; p.x = a.x; p.mod = w_mod; p.x1 = a.out;
        pg8::gemm_phase<POutProj>(lds, p, wave);
    }
    SEAM(5);
    if (IN(6)) {
        PHASE_IDS();
        for (int row = gw; row < M; row += NGW) {
            const int b = row / S;
            const f32x4* xr = (const f32x4*)(a.out + (size_t)row * D) + lane;
            f32x4 v[4]; float ss = 0.f;
#pragma unroll
            for (int j = 0; j < 4; ++j) { v[j] = xr[64 * j]; ss += (v[j].x * v[j].x + v[j].y * v[j].y) + (v[j].z * v[j].z + v[j].w * v[j].w); }
            const float rstd = rsqrtf(wave_sum(ss) * (1.f / D) + RMS_EPS);
            const float* shift = w_mod + b * 6144 + 3072, *scale = w_mod + b * 6144 + 4096;
            float lg[NE];
#pragma unroll
            for (int e = 0; e < NE; ++e) lg[e] = 0.f;
#pragma unroll
            for (int j = 0; j < 4; ++j) {
                const int c0 = 4 * lane + 256 * j;
                const f32x4 g = *(const f32x4*)(a.g2 + c0), sc = *(const f32x4*)(scale + c0), sh = *(const f32x4*)(shift + c0);
                const f32x4 o = v[j] * rstd * g * (sc + 1.f) + sh;
                u32x2 w; w.x = pk2(o.x, o.y); w.y = pk2(o.z, o.w);
                *(u32x2*)(w_H2 + (size_t)row * D + c0) = w;
#pragma unroll
                for (int i = 0; i < 4; ++i) {
                    const f32x4* wrow = (const f32x4*)(a.w_router + (size_t)(c0 + i) * NE);
#pragma unroll
                    for (int e4 = 0; e4 < 8; ++e4) { const f32x4 wv = wrow[e4]; lg[4 * e4] += o[i] * wv.x; lg[4 * e4 + 1] += o[i] * wv.y; lg[4 * e4 + 2] += o[i] * wv.z; lg[4 * e4 + 3] += o[i] * wv.w; }
                }
            }
#pragma unroll
            for (int e = 0; e < NE; ++e) lg[e] = wave_sum(lg[e]) + a.b_router[e];
            if (lane == 0) {
                int idx[4]; float val[4];
#pragma unroll
                for (int k = 0; k < 4; ++k) {
                    float best = -INFINITY; int bi = 0;
#pragma unroll
                    for (int e = 0; e < NE; ++e) { bool taken = false;
#pragma unroll
                        for (int kk = 0; kk < k; ++kk) taken |= (idx[kk] == e);
                        if (!taken && lg[e] > best) { best = lg[e]; bi = e; } }
                    idx[k] = bi; val[k] = best;
                }
                float den = 0.f, ex[4];
#pragma unroll
                for (int k = 0; k < 4; ++k) { ex[k] = __expf(val[k] - val[0]); den += ex[k]; }
#pragma unroll
                for (int k = 0; k < 4; ++k) {
                    const int slot = atomicAdd(&w_counts[idx[k]], 1);
                    w_tope[row * 4 + k] = idx[k]; w_tops[row * 4 + k] = slot; w_topg[row * 4 + k] = ex[k] / den;
                    w_list[idx[k] * M + slot] = row;
                }
            }
        }
    }
    SEAM(6);
    if (IN(7)) {
        PHASE_IDS();
        LOAD_PT();
        PGateUp p; p.init(PT, CN, 8, G, bx); p.H2 = w_H2; p.Wt = w_Wgu_t; p.bgu = a.b_gu; p.list = w_list; p.ACT = w_ACT;
        pg8::gemm_phase<PGateUp>(lds, p, wave);
    }
    SEAM(7);
    if (IN(8)) {
        PHASE_IDS();
        LOAD_PT();
        PDown p; p.init(PT, CN, 4, G, bx); p.ACT = w_ACT; p.Wt = w_Wd_t; p.bd = a.b_d; p.Y = w_Y;
        pg8::gemm_phase<PDown>(lds, p, wave);
    }
    SEAM(8);
    if (IN(9)) {
        PHASE_IDS();
        LOAD_PT();
        for (int row = gw; row < M; row += NGW) {
            const int b = row / S;
            const float* gate2 = w_mod + b * 6144 + 5120;
            const bf16_t* yr[4]; float gk[4];
#pragma unroll
            for (int k = 0; k < 4; ++k) { yr[k] = w_Y + (size_t)(PT[w_tope[row * 4 + k]] * 256 + w_tops[row * 4 + k]) * D; gk[k] = w_topg[row * 4 + k]; }
#pragma unroll
            for (int j = 0; j < 4; ++j) {
                const int c0 = 4 * lane + 256 * j;
                f32x4 acc = (f32x4){0.f, 0.f, 0.f, 0.f};
#pragma unroll
                for (int k = 0; k < 4; ++k) { const u32x2 w = *(const u32x2*)(yr[k] + c0);
                    acc.x += gk[k] * __uint_as_float(w.x << 16); acc.y += gk[k] * __uint_as_float(w.x & 0xffff0000u);
                    acc.z += gk[k] * __uint_as_float(w.y << 16); acc.w += gk[k] * __uint_as_float(w.y & 0xffff0000u); }
                const f32x4 g = *(const f32x4*)(gate2 + c0);
                f32x4* op = (f32x4*)(a.out + (size_t)row * D + c0);
                *op = *op + g * acc;
            }
        }
    }
#undef IN
#undef PHASE_IDS
#undef SEAM
#undef LOAD_PT
#undef w_counts
#undef w_mod
#undef w_Win_t
#undef w_Wout_t
#undef w_Wgu_t
#undef w_Wd_t
#undef w_XN
#undef w_QKV
#undef w_AO
#undef w_H2
#undef w_tope
#undef w_tops
#undef w_topg
#undef w_list
#undef w_ACT
#undef w_Y
#undef w_OBN
}

#ifndef RUN_MODE
#define RUN_MODE 1
#endif
#ifndef PH_MASK
#define PH_MASK 0x3ff
#endif
extern "C" void kernel_launch(void* const* d_in, const int* in_sizes, int n_in, void* d_out, int out_size, void* d_ws, size_t ws_size, hipStream_t stream) {
    static int grid = 0;
    if (grid == 0) {
        if (n_in != 23 || out_size != M * D || ws_size < WS_END) { fprintf(stderr, "kernel_launch: unexpected problem (n_in %d out %d ws %zu)\n", n_in, out_size, ws_size); grid = -1; return; }
        int dev = 0, cus = 0;
        if (hipGetDevice(&dev) != hipSuccess || hipDeviceGetAttribute(&cus, hipDeviceAttributeMultiprocessorCount, dev) != hipSuccess) { grid = -1; return; }
        if (hipFuncSetAttribute((const void*)mega, hipFuncAttributeMaxDynamicSharedMemorySize, LDS_BYTES) != hipSuccess) { fprintf(stderr, "kernel_launch: hipFuncSetAttribute failed\n"); grid = -1; return; }
        int per_cu = 0;
        if (hipOccupancyMaxActiveBlocksPerMultiprocessor(&per_cu, (const void*)mega, NTHREADS, LDS_BYTES) != hipSuccess || per_cu < 1) fprintf(stderr, "kernel_launch: occupancy query says %d blocks/CU\n", per_cu);
        (void)hipGetLastError();
        grid = cus;
    }
    if (grid < 0) return;
    const float* x = (const float*)d_in[0]; const float* c = (const float*)d_in[1]; const float* w_ada = (const float*)d_in[2]; const float* b_ada = (const float*)d_in[3];
    const float* g1 = (const float*)d_in[4]; const float* w_in = (const float*)d_in[5];
    const float* gaq = (const float*)d_in[6]; const float* gak = (const float*)d_in[7]; const float* gbq = (const float*)d_in[8]; const float* gbk = (const float*)d_in[9];
    const float* lq1 = (const float*)d_in[10]; const float* lk1 = (const float*)d_in[11]; const float* lq2 = (const float*)d_in[12]; const float* lk2 = (const float*)d_in[13];
    const float* gd = (const float*)d_in[14]; const float* w_out = (const float*)d_in[15]; const float* g2 = (const float*)d_in[16];
    const float* w_router = (const float*)d_in[17]; const float* b_router = (const float*)d_in[18];
    const float* w_gu = (const float*)d_in[19]; const float* b_gu = (const float*)d_in[20]; const float* w_d = (const float*)d_in[21]; const float* b_d = (const float*)d_in[22];
    unsigned char* ws = (unsigned char*)d_ws; float* out = (float*)d_out;
    int* counts = (int*)(ws + WS_CTL + CTL_COUNTS); int* padstart = (int*)(ws + WS_CTL + CTL_PADSTART); float* mod = (float*)(ws + WS_CTL + CTL_MOD);
    bf16_t* Win_t = (bf16_t*)(ws + WS_WIN); bf16_t* Wout_t = (bf16_t*)(ws + WS_WOUT); bf16_t* Wgu_t = (bf16_t*)(ws + WS_WGU); bf16_t* Wd_t = (bf16_t*)(ws + WS_WD);
    bf16_t* XN = (bf16_t*)(ws + WS_XN); bf16_t* QKV = (bf16_t*)(ws + WS_QKV); bf16_t* AO = (bf16_t*)(ws + WS_AO); bf16_t* H2 = (bf16_t*)(ws + WS_H2);
    int* tope = (int*)(ws + WS_TOPE); int* tops = (int*)(ws + WS_TOPS); float* topg = (float*)(ws + WS_TOPG); int* list = (int*)(ws + WS_LIST);
    bf16_t* ACT = (bf16_t*)(ws + WS_ACT); bf16_t* Y = (bf16_t*)(ws + WS_Y); float* OBN = (float*)(ws + WS_OBN);

    (void)hipMemsetAsync(ws + WS_CTL, 0, CTL_BYTES, stream);
    MArgs a{};
    a.x = x; a.c = c; a.w_ada = w_ada; a.b_ada = b_ada; a.g1 = g1; a.w_in = w_in; a.gaq = gaq; a.gak = gak; a.gbq = gbq; a.gbk = gbk; a.lq1 = lq1; a.lk1 = lk1; a.lq2 = lq2; a.lk2 = lk2;
    a.gd = gd; a.w_out = w_out; a.g2 = g2; a.w_router = w_router; a.b_router = b_router; a.w_gu = w_gu; a.b_gu = b_gu; a.w_d = w_d; a.b_d = b_d; a.out = out; a.ws = ws;
    if (RUN_MODE == 1) { a.ph_lo = 0; a.ph_hi = NPHASE; hipLaunchKernelGGL(mega, dim3(grid), dim3(NTHREADS), LDS_BYTES, stream, a); return; }
    const unsigned mask = (RUN_MODE == 0) ? 0u : (RUN_MODE == 2) ? 0x3ffu : (unsigned)PH_MASK;
    for (int ph = 0; ph < NPHASE; ++ph) {
        if (mask & (1u << ph)) { a.ph_lo = ph; a.ph_hi = ph + 1; hipLaunchKernelGGL(mega, dim3(grid), dim3(NTHREADS), LDS_BYTES, stream, a); }
        else switch (ph) {
            case 0:
                k_transpose<<<(1024 / 64) * (3072 / 64), 256, 0, stream>>>(w_in, Win_t, 1024, 3072);
                k_transpose<<<(1024 / 64) * (1024 / 64), 256, 0, stream>>>(w_out, Wout_t, 1024, 1024);
                k_transpose<<<32 * (1024 / 64) * (2048 / 64), 256, 0, stream>>>(w_gu, Wgu_t, 1024, 2048);
                k_transpose<<<32 * (1024 / 64) * (1024 / 64), 256, 0, stream>>>(w_d, Wd_t, 1024, 1024);
                k_adaln<<<dim3(24, 16), 256, 0, stream>>>(c, w_ada, b_ada, mod); break;
            case 1: k_xn<<<M / 4, 256, 0, stream>>>(x, g1, mod, XN); break;
            case 2: { InProj p{XN, Win_t, QKV, gaq, gak, gbq, gbk}; k_gemm<InProj><<<128 * 24, 256, 0, stream>>>(p); } break;
            case 3: k_attn_a<<<NB * 8 * S / 256, 256, 0, stream>>>(QKV, AO); k_attn_b<<<NB * 4 * 2 * 2 * S / 256, 256, 0, stream>>>(QKV, OBN); break;
            case 4: k_diff_combine<<<M * 4 / 4, 256, 0, stream>>>(OBN, lq1, lk1, lq2, lk2, gd, AO); break;
            case 5: { OutProj p{AO, Wout_t, x, mod, out}; k_gemm<OutProj><<<128 * 8, 256, 0, stream>>>(p); } break;
            case 6: k_router<<<M / 4, 256, 0, stream>>>(out, g2, mod, w_router, b_router, H2, counts, tope, tops, topg, list); break;
            case 7: { GateUp p{H2, Wgu_t, b_gu, counts, padstart, list, ACT}; k_gemm<GateUp><<<32 * 128 * 16, 256, 0, stream>>>(p); } break;
            case 8: { Down p{ACT, Wd_t, b_d, counts, padstart, Y}; k_gemm<Down><<<32 * 128 * 8, 256, 0, stream>>>(p); } break;
            case 9: k_combine<<<M / 4, 256, 0, stream>>>(out, mod, Y, tope, tops, topg, padstart); break;
        }
        if (ph == 6) k_padstart<<<1, 64, 0, stream>>>(counts, padstart);
    }
}
```

```cpp
#include <hip/hip_runtime.h>
#include <cstdio>
#include <cstdint>

typedef unsigned short bf16_t;
typedef short bf16x8 __attribute__((ext_vector_type(8)));
typedef float f32x4 __attribute__((ext_vector_type(4)));
typedef unsigned u32x4 __attribute__((ext_vector_type(4)));
typedef unsigned u32x2 __attribute__((ext_vector_type(2)));

constexpr int D = 1024, NB = 8, S = 2048, M = NB * S;
constexpr int NIN = 3072, NE = 32, TOPK = 4, DFF = 1024;
constexpr int NASSIGN = M * TOPK;
constexpr int PADROWS = NASSIGN + NE * 256;
constexpr float RMS_EPS = 1e-6f;
constexpr float LOG2E = 1.4426950408889634f;
constexpr float QSCALE = 0.125f * LOG2E;
constexpr float LAMBDA_INIT = 0.2f;

constexpr size_t MiB = 1u << 20;
constexpr size_t WS_CTL = 0;
constexpr size_t CTL_BYTES = 1 * MiB;
constexpr size_t CTL_COUNTS = 0;
constexpr size_t CTL_PADSTART = 256;
constexpr size_t CTL_MOD = 64 * 1024;
constexpr size_t WS_WIN = 2 * MiB;
constexpr size_t WS_WOUT = 8 * MiB;
constexpr size_t WS_WGU = 10 * MiB;
constexpr size_t WS_WD = 138 * MiB;
constexpr size_t WS_XN = 202 * MiB;
constexpr size_t WS_QKV = 234 * MiB;
constexpr size_t WS_AO = 330 * MiB;
constexpr size_t WS_H2 = 362 * MiB;
constexpr size_t WS_TOPE = 394 * MiB;
constexpr size_t WS_TOPS = 395 * MiB;
constexpr size_t WS_TOPG = 396 * MiB;
constexpr size_t WS_LIST = 397 * MiB;
constexpr size_t WS_ACT = 400 * MiB;
constexpr size_t WS_Y = 544 * MiB;
constexpr size_t WS_OBN = 688 * MiB;
constexpr size_t WS_END = 752 * MiB;

__device__ __forceinline__ bf16_t f2bf(float f) { unsigned u = __float_as_uint(f); return (bf16_t)((u + 0x7fffu + ((u >> 16) & 1u)) >> 16); }
__device__ __forceinline__ float bf2f(bf16_t h) { return __uint_as_float(((unsigned)h) << 16); }
__device__ __forceinline__ unsigned pk2(float lo, float hi) { return (unsigned)f2bf(lo) | ((unsigned)f2bf(hi) << 16); }
__device__ __forceinline__ float wave_sum(float v) {
#pragma unroll
    for (int o = 1; o < 64; o <<= 1) v += __shfl_xor(v, o);
    return v;
}

__global__ void __launch_bounds__(256) k_transpose(const float* __restrict__ W, bf16_t* __restrict__ WT, int K, int N) {
    __shared__ float t[64][65];
    const int nb = N / 64, kb = K / 64;
    const int per = nb * kb;
    const int g = blockIdx.x / per, r = blockIdx.x % per;
    const int k0 = (r / nb) * 64, n0 = (r % nb) * 64;
    const float* Wg = W + (size_t)g * K * N; bf16_t* WTg = WT + (size_t)g * K * N;
    const int tx = threadIdx.x & 63, ty = threadIdx.x >> 6;
    for (int i = ty; i < 64; i += 4) t[i][tx] = Wg[(size_t)(k0 + i) * N + n0 + tx];
    __syncthreads();
    for (int i = ty; i < 64; i += 4) WTg[(size_t)(n0 + i) * K + k0 + tx] = f2bf(t[tx][i]);
}

__global__ void __launch_bounds__(256) k_adaln(const float* __restrict__ c, const float* __restrict__ w_ada, const float* __restrict__ b_ada, float* mod) {
    const int col = blockIdx.x * 256 + threadIdx.x, ks = blockIdx.y;
    float acc[NB];
#pragma unroll
    for (int b = 0; b < NB; ++b) acc[b] = (ks == 0) ? b_ada[col] : 0.f;
    for (int k = ks * 64; k < ks * 64 + 64; ++k) {
        const float w = w_ada[(size_t)k * 6144 + col];
#pragma unroll
        for (int b = 0; b < NB; ++b) { const float cv = c[b * D + k]; const float sl = cv / (1.f + __expf(-cv)); acc[b] += sl * w; }
    }
#pragma unroll
    for (int b = 0; b < NB; ++b) atomicAdd(&mod[b * 6144 + col], acc[b]);
}

__global__ void __launch_bounds__(256) k_xn(const float* __restrict__ x, const float* __restrict__ g1, const float* __restrict__ mod, bf16_t* __restrict__ XN) {
    const int lane = threadIdx.x & 63, row = blockIdx.x * 4 + (threadIdx.x >> 6), b = row / S;
    const f32x4* xr = (const f32x4*)(x + (size_t)row * D) + lane;
    f32x4 v[4]; float ss = 0.f;
#pragma unroll
    for (int j = 0; j < 4; ++j) { v[j] = xr[64 * j]; ss += (v[j].x * v[j].x + v[j].y * v[j].y) + (v[j].z * v[j].z + v[j].w * v[j].w); }
    const float rstd = rsqrtf(wave_sum(ss) * (1.f / D) + RMS_EPS);
    const float* shift = mod + b * 6144, *scale = mod + b * 6144 + 1024;
#pragma unroll
    for (int j = 0; j < 4; ++j) {
        const int c0 = 4 * lane + 256 * j;
        const f32x4 g = *(const f32x4*)(g1 + c0), sc = *(const f32x4*)(scale + c0), sh = *(const f32x4*)(shift + c0);
        f32x4 o;
        o.x = v[j].x * rstd * g.x * (1.f + sc.x) + sh.x; o.y = v[j].y * rstd * g.y * (1.f + sc.y) + sh.y;
        o.z = v[j].z * rstd * g.z * (1.f + sc.z) + sh.z; o.w = v[j].w * rstd * g.w * (1.f + sc.w) + sh.w;
        u32x2 w; w.x = pk2(o.x, o.y); w.y = pk2(o.z, o.w);
        *(u32x2*)(XN + (size_t)row * D + c0) = w;
    }
}

template <class P> __global__ void __launch_bounds__(256) k_gemm(P p) {
    const int wid = threadIdx.x >> 6, lane = threadIdx.x & 63, wr = wid >> 1, wc = wid & 1, fr = lane & 15, fq = lane >> 4;
    typename P::Unit u;
    if (!p.unit(blockIdx.x, u)) return;
    const bf16_t* ap[4]; const bf16_t* bp[4];
#pragma unroll
    for (int m = 0; m < 4; ++m) ap[m] = p.a_row(u, wr * 64 + 16 * m + fr) + 8 * fq;
#pragma unroll
    for (int n = 0; n < 4; ++n) bp[n] = p.b_row(u, wc, n, fr) + 8 * fq;
    f32x4 acc[4][4];
#pragma unroll
    for (int m = 0; m < 4; ++m)
#pragma unroll
        for (int n = 0; n < 4; ++n) acc[m][n] = (f32x4){0.f, 0.f, 0.f, 0.f};
    for (int k0 = 0; k0 < P::K; k0 += 32) {
        bf16x8 a[4], b[4];
#pragma unroll
        for (int m = 0; m < 4; ++m) a[m] = *(const bf16x8*)(ap[m] + k0);
#pragma unroll
        for (int n = 0; n < 4; ++n) b[n] = *(const bf16x8*)(bp[n] + k0);
#pragma unroll
        for (int m = 0; m < 4; ++m)
#pragma unroll
            for (int n = 0; n < 4; ++n) acc[m][n] = __builtin_amdgcn_mfma_f32_16x16x32_bf16(a[m], b[n], acc[m][n], 0, 0, 0);
    }
    p.epi(u, acc, wr, wc, fr, fq);
}

struct InProj {
    static constexpr int K = 1024;
    struct Unit { int bm, bn; };
    const bf16_t* XN; const bf16_t* Wt; bf16_t* QKV; const float *gaq, *gak, *gbq, *gbk;
    __device__ bool unit(int bid, Unit& u) const { u.bm = bid / 24; u.bn = bid % 24; return true; }
    __device__ const bf16_t* a_row(const Unit& u, int r) const { return XN + (size_t)(u.bm * 128 + r) * K; }
    __device__ const bf16_t* b_row(const Unit& u, int wc, int n, int fr) const { return Wt + (size_t)(u.bn * 128 + wc * 64 + 16 * n + fr) * K; }
    __device__ void epi(const Unit& u, f32x4 (&acc)[4][4], int wr, int wc, int fr, int fq) const {
        const int c0 = u.bn * 128 + wc * 64, r0 = u.bm * 128 + wr * 64;
        const float* g = nullptr; float post = 1.f;
        if (c0 < 512) { g = gaq; post = QSCALE; } else if (c0 < 1024) g = gak; else if (c0 < 1536) g = nullptr;
        else if (c0 < 2048) { g = gbq; post = QSCALE; } else if (c0 < 2560) g = gbk;
#pragma unroll
        for (int m = 0; m < 4; ++m)
#pragma unroll
            for (int j = 0; j < 4; ++j) {
                float sc[4] = {1.f, 1.f, 1.f, 1.f};
                if (g) {
                    float ss = 0.f;
#pragma unroll
                    for (int n = 0; n < 4; ++n) ss += acc[m][n][j] * acc[m][n][j];
                    ss += __shfl_xor(ss, 1); ss += __shfl_xor(ss, 2); ss += __shfl_xor(ss, 4); ss += __shfl_xor(ss, 8);
                    const float rstd = rsqrtf(ss * (1.f / 64.f) + RMS_EPS) * post;
#pragma unroll
                    for (int n = 0; n < 4; ++n) sc[n] = rstd * g[16 * n + fr];
                }
                const int row = r0 + 16 * m + 4 * fq + j;
#pragma unroll
                for (int n = 0; n < 4; ++n) QKV[(size_t)row * NIN + c0 + 16 * n + fr] = f2bf(acc[m][n][j] * sc[n]);
            }
    }
};

struct OutProj {
    static constexpr int K = 1024;
    struct Unit { int bm, bn; };
    const bf16_t* AO; const bf16_t* Wt; const float* x; const float* mod; float* x1;
    __device__ bool unit(int bid, Unit& u) const { u.bm = bid / 8; u.bn = bid % 8; return true; }
    __device__ const bf16_t* a_row(const Unit& u, int r) const { return AO + (size_t)(u.bm * 128 + r) * K; }
    __device__ const bf16_t* b_row(const Unit& u, int wc, int n, int fr) const { return Wt + (size_t)(u.bn * 128 + wc * 64 + 16 * n + fr) * K; }
    __device__ void epi(const Unit& u, f32x4 (&acc)[4][4], int wr, int wc, int fr, int fq) const {
        const int c0 = u.bn * 128 + wc * 64, r0 = u.bm * 128 + wr * 64;
        const float* gate1 = mod + ((r0 / S) * 6144) + 2048;
#pragma unroll
        for (int m = 0; m < 4; ++m)
#pragma unroll
            for (int j = 0; j < 4; ++j) {
                const int row = r0 + 16 * m + 4 * fq + j;
#pragma unroll
                for (int n = 0; n < 4; ++n) { const int col = c0 + 16 * n + fr; x1[(size_t)row * D + col] = x[(size_t)row * D + col] + gate1[col] * acc[m][n][j]; }
            }
    }
};

struct GateUp {
    static constexpr int K = 1024;
    struct Unit { int e, mt, nt, cnt, ps; };
    const bf16_t* H2; const bf16_t* Wt; const float* bgu; const int* counts; const int* padstart; const int* list; bf16_t* ACT;
    __device__ bool unit(int bid, Unit& u) const {
        u.nt = bid % 16; u.mt = (bid / 16) % 128; u.e = bid / (16 * 128); u.cnt = counts[u.e]; u.ps = padstart[u.e];
        return u.mt * 128 < u.cnt;
    }
    __device__ const bf16_t* a_row(const Unit& u, int r) const { int rr = u.mt * 128 + r; if (rr >= u.cnt) rr = 0; return H2 + (size_t)list[u.e * M + rr] * K; }
    __device__ const bf16_t* b_row(const Unit& u, int wc, int n, int fr) const {
        const int j = u.nt * 64 + wc * 32 + 16 * (n & 1) + fr; return Wt + ((size_t)u.e * 2048 + (n >> 1) * 1024 + j) * K; }
    __device__ void epi(const Unit& u, f32x4 (&acc)[4][4], int wr, int wc, int fr, int fq) const {
        const float* bias = bgu + u.e * 2048;
#pragma unroll
        for (int m = 0; m < 4; ++m)
#pragma unroll
            for (int j = 0; j < 4; ++j) {
                const int rr = u.mt * 128 + wr * 64 + 16 * m + 4 * fq + j;
                if (rr < u.cnt) {
#pragma unroll
                    for (int n = 0; n < 2; ++n) {
                        const int col = u.nt * 64 + wc * 32 + 16 * n + fr;
                        float g = acc[m][n][j] + bias[col], uu = acc[m][n + 2][j] + bias[1024 + col];
                        g = fminf(g, 7.f); uu = fminf(fmaxf(uu, -7.f), 7.f);
                        const float a = (uu + 1.f) * (g / (1.f + __expf(-1.702f * g)));
                        ACT[(size_t)(u.ps + rr) * DFF + col] = f2bf(a);
                    }
                }
            }
    }
};

struct Down {
    static constexpr int K = 1024;
    struct Unit { int e, mt, nt, cnt, ps; };
    const bf16_t* ACT; const bf16_t* Wt; const float* bd; const int* counts; const int* padstart; bf16_t* Y;
    __device__ bool unit(int bid, Unit& u) const {
        u.nt = bid % 8; u.mt = (bid / 8) % 128; u.e = bid / (8 * 128); u.cnt = counts[u.e]; u.ps = padstart[u.e];
        return u.mt * 128 < u.cnt;
    }
    __device__ const bf16_t* a_row(const Unit& u, int r) const { int rr = u.mt * 128 + r; if (rr >= u.cnt) rr = 0; return ACT + (size_t)(u.ps + rr) * K; }
    __device__ const bf16_t* b_row(const Unit& u, int wc, int n, int fr) const { return Wt + ((size_t)u.e * 1024 + u.nt * 128 + wc * 64 + 16 * n + fr) * K; }
    __device__ void epi(const Unit& u, f32x4 (&acc)[4][4], int wr, int wc, int fr, int fq) const {
        const float* bias = bd + u.e * 1024;
#pragma unroll
        for (int m = 0; m < 4; ++m)
#pragma unroll
            for (int j = 0; j < 4; ++j) {
                const int rr = u.mt * 128 + wr * 64 + 16 * m + 4 * fq + j;
                if (rr < u.cnt) {
#pragma unroll
                    for (int n = 0; n < 4; ++n) { const int col = u.nt * 128 + wc * 64 + 16 * n + fr; Y[(size_t)(u.ps + rr) * D + col] = f2bf(acc[m][n][j] + bias[col]); }
                }
            }
    }
};

__global__ void __launch_bounds__(256) k_attn_a(const bf16_t* __restrict__ QKV, bf16_t* __restrict__ AO) {
    const int gid = blockIdx.x * 256 + threadIdx.x;
    const int t = gid % S, h = (gid / S) % 8, b = gid / (S * 8);
    const bf16_t* qp = QKV + (size_t)(b * S + t) * NIN + h * 64;
    float q[64];
#pragma unroll
    for (int d = 0; d < 64; ++d) q[d] = bf2f(qp[d]);
    const float slope2 = exp2f(-(float)(h + 1)) * LOG2E;
    float m = -INFINITY, l = 0.f, o[64];
#pragma unroll
    for (int d = 0; d < 64; ++d) o[d] = 0.f;
    for (int p = 0; p < 3; ++p) {
        const int dil = (p == 0) ? 1 : (p == 1 ? 4 : 16);
        for (int i = 0; i <= 128; ++i) {
            const int pos = t - i * dil; if (pos < 0) break;
            const bf16_t* kp = QKV + (size_t)(b * S + pos) * NIN + 512 + h * 64; const bf16_t* vp = kp + 512;
            float s = 0.f;
#pragma unroll
            for (int d = 0; d < 64; ++d) s += q[d] * bf2f(kp[d]);
            s -= slope2 * (float)(i * dil);
            const float mn = fmaxf(m, s), f = exp2f(m - mn), pe = exp2f(s - mn);
            l = l * f + pe;
#pragma unroll
            for (int d = 0; d < 64; ++d) o[d] = o[d] * f + pe * bf2f(vp[d]);
            m = mn;
        }
    }
    const float rl = 1.f / l;
    bf16_t* op = AO + (size_t)(b * S + t) * D + h * 64;
#pragma unroll
    for (int d = 0; d < 64; ++d) op[d] = f2bf(o[d] * rl);
}

__global__ void __launch_bounds__(256) k_attn_b(const bf16_t* __restrict__ QKV, float* __restrict__ OBN) {
    const int gid = blockIdx.x * 256 + threadIdx.x;
    const int t = gid % S, dh = (gid / S) & 1, c = (gid / (2 * S)) & 1, h = (gid / (4 * S)) & 3, b = gid / (16 * S);
    const bf16_t* qp = QKV + (size_t)(b * S + t) * NIN + 1536 + h * 128 + c * 64;
    float q[64];
#pragma unroll
    for (int d = 0; d < 64; ++d) q[d] = bf2f(qp[d]);
    const float slope2 = exp2f(-2.f * (float)(h + 1)) * LOG2E;
    float m = -INFINITY, l = 0.f, o[64];
#pragma unroll
    for (int d = 0; d < 64; ++d) o[d] = 0.f;
    const int tmax = __shfl(t, 63);
    for (int pos = 0; pos <= tmax; ++pos) {
        const bf16_t* kp = QKV + (size_t)(b * S + pos) * NIN + 2048 + h * 128 + c * 64;
        const bf16_t* vp = QKV + (size_t)(b * S + pos) * NIN + 2560 + h * 128 + dh * 64;
        float s = 0.f;
#pragma unroll
        for (int d = 0; d < 64; ++d) s += q[d] * bf2f(kp[d]);
        s -= slope2 * (float)(t - pos);
        if (pos <= t) {
            const float mn = fmaxf(m, s), f = exp2f(m - mn), pe = exp2f(s - mn);
            l = l * f + pe;
#pragma unroll
            for (int d = 0; d < 64; ++d) o[d] = o[d] * f + pe * bf2f(vp[d]);
            m = mn;
        }
    }
    const float rl = 1.f / l;
    float* op = OBN + ((size_t)c * M + (b * S + t)) * 512 + h * 128 + dh * 64;
#pragma unroll
    for (int d = 0; d < 64; ++d) op[d] = o[d] * rl;
}
__global__ void __launch_bounds__(256) k_diff_combine(const float* __restrict__ OBN, const float* lq1, const float* lk1, const float* lq2, const float* lk2, const float* __restrict__ gd, bf16_t* __restrict__ AO) {
    const int lane = threadIdx.x & 63, w = blockIdx.x * 4 + (threadIdx.x >> 6);
    const int tok = w >> 2, h = w & 3;
    const float s1 = wave_sum(lq1[lane] * lk1[lane]), s2 = wave_sum(lq2[lane] * lk2[lane]);
    const float lam = __expf(s1) - __expf(s2) + LAMBDA_INIT;
    const float* p0 = OBN + (size_t)tok * 512 + h * 128 + 2 * lane; const float* p1 = p0 + (size_t)M * 512;
    const float a = p0[0] - lam * p1[0], bq = p0[1] - lam * p1[1];
    const float rstd = rsqrtf(wave_sum(a * a + bq * bq) * (1.f / 128.f) + RMS_EPS) * (1.f - LAMBDA_INIT);
    *(unsigned*)(AO + (size_t)tok * D + 512 + h * 128 + 2 * lane) = pk2(a * rstd * gd[2 * lane], bq * rstd * gd[2 * lane + 1]);
}

__global__ void __launch_bounds__(256) k_router(const float* __restrict__ x1, const float* __restrict__ g2, const float* __restrict__ mod, const float* __restrict__ wr, const float* __restrict__ br,
                                                bf16_t* __restrict__ H2, int* counts, int* tope, int* tops, float* topg, int* list) {
    const int lane = threadIdx.x & 63, row = blockIdx.x * 4 + (threadIdx.x >> 6), b = row / S;
    const f32x4* xr = (const f32x4*)(x1 + (size_t)row * D) + lane;
    f32x4 v[4]; float ss = 0.f;
#pragma unroll
    for (int j = 0; j < 4; ++j) { v[j] = xr[64 * j]; ss += (v[j].x * v[j].x + v[j].y * v[j].y) + (v[j].z * v[j].z + v[j].w * v[j].w); }
    const float rstd = rsqrtf(wave_sum(ss) * (1.f / D) + RMS_EPS);
    const float* shift = mod + b * 6144 + 3072, *scale = mod + b * 6144 + 4096;
    float lg[NE];
#pragma unroll
    for (int e = 0; e < NE; ++e) lg[e] = 0.f;
#pragma unroll
    for (int j = 0; j < 4; ++j) {
        const int c0 = 4 * lane + 256 * j;
        const f32x4 g = *(const f32x4*)(g2 + c0), sc = *(const f32x4*)(scale + c0), sh = *(const f32x4*)(shift + c0);
        float o[4];
        o[0] = v[j].x * rstd * g.x * (1.f + sc.x) + sh.x; o[1] = v[j].y * rstd * g.y * (1.f + sc.y) + sh.y;
        o[2] = v[j].z * rstd * g.z * (1.f + sc.z) + sh.z; o[3] = v[j].w * rstd * g.w * (1.f + sc.w) + sh.w;
        u32x2 w; w.x = pk2(o[0], o[1]); w.y = pk2(o[2], o[3]);
        *(u32x2*)(H2 + (size_t)row * D + c0) = w;
#pragma unroll
        for (int i = 0; i < 4; ++i) {
            const f32x4* wrow = (const f32x4*)(wr + (size_t)(c0 + i) * NE);
#pragma unroll
            for (int e4 = 0; e4 < 8; ++e4) { const f32x4 wv = wrow[e4]; lg[4 * e4] += o[i] * wv.x; lg[4 * e4 + 1] += o[i] * wv.y; lg[4 * e4 + 2] += o[i] * wv.z; lg[4 * e4 + 3] += o[i] * wv.w; }
        }
    }
#pragma unroll
    for (int e = 0; e < NE; ++e) lg[e] = wave_sum(lg[e]) + br[e];
    if (lane == 0) {
        int idx[4]; float val[4];
#pragma unroll
        for (int k = 0; k < 4; ++k) {
            float best = -INFINITY; int bi = 0;
#pragma unroll
            for (int e = 0; e < NE; ++e) { bool taken = false;
#pragma unroll
                for (int kk = 0; kk < k; ++kk) taken |= (idx[kk] == e);
                if (!taken && lg[e] > best) { best = lg[e]; bi = e; } }
            idx[k] = bi; val[k] = best;
        }
        float den = 0.f, ex[4];
#pragma unroll
        for (int k = 0; k < 4; ++k) { ex[k] = __expf(val[k] - val[0]); den += ex[k]; }
#pragma unroll
        for (int k = 0; k < 4; ++k) {
            const int slot = atomicAdd(&counts[idx[k]], 1);
            tope[row * 4 + k] = idx[k]; tops[row * 4 + k] = slot; topg[row * 4 + k] = ex[k] / den;
            list[idx[k] * M + slot] = row;
        }
    }
}
__global__ void k_padstart(const int* counts, int* padstart) {
    if (threadIdx.x == 0) { int acc = 0; for (int e = 0; e < NE; ++e) { padstart[e] = acc; acc += (counts[e] + 255) / 256 * 256; } padstart[NE] = acc; }
}
__global__ void __launch_bounds__(256) k_combine(float* out, const float* __restrict__ mod, const bf16_t* __restrict__ Y, const int* __restrict__ tope, const int* __restrict__ tops, const float* __restrict__ topg, const int* __restrict__ padstart) {
    const int lane = threadIdx.x & 63, row = blockIdx.x * 4 + (threadIdx.x >> 6), b = row / S;
    const float* gate2 = mod + b * 6144 + 5120;
    const bf16_t* yr[4]; float gk[4];
#pragma unroll
    for (int k = 0; k < 4; ++k) { yr[k] = Y + (size_t)(padstart[tope[row * 4 + k]] + tops[row * 4 + k]) * D; gk[k] = topg[row * 4 + k]; }
#pragma unroll
    for (int j = 0; j < 4; ++j) {
        const int c0 = 4 * lane + 256 * j;
        f32x4 acc = (f32x4){0.f, 0.f, 0.f, 0.f};
#pragma unroll
        for (int k = 0; k < 4; ++k) { const u32x2 w = *(const u32x2*)(yr[k] + c0);
            acc.x += gk[k] * __uint_as_float(w.x << 16); acc.y += gk[k] * __uint_as_float(w.x & 0xffff0000u);
            acc.z += gk[k] * __uint_as_float(w.y << 16); acc.w += gk[k] * __uint_as_float(w.y & 0xffff0000u); }
        const f32x4 g = *(const f32x4*)(gate2 + c0);
        f32x4* op = (f32x4*)(out + (size_t)row * D + c0);
        f32x4 xv = *op;
        xv.x += g.x * acc.x; xv.y += g.y * acc.y; xv.z += g.z * acc.z; xv.w += g.w * acc.w;
        *op = xv;
    }
}


#define LAS __attribute__((address_space(3)))
#define GAS __attribute__((address_space(1)))
#define RLX_AGENT __ATOMIC_RELAXED, __HIP_MEMORY_SCOPE_AGENT
#define LDS_WAIT() asm volatile("s_waitcnt lgkmcnt(0)" ::: "memory")
#define VM_WAIT() asm volatile("s_waitcnt vmcnt(0)" ::: "memory")

constexpr int NWAVES = 8, NTHREADS = 512;
constexpr int RING_BYTES = 131072, LDSCTL_OFF = RING_BYTES, MISC_OFF = LDSCTL_OFF + 320, PT_OFF = LDSCTL_OFF + 512, CNT_OFF = LDSCTL_OFF + 768, LDS_BYTES = 147456;
constexpr size_t CTL_BAR = 16384;
constexpr int NPHASE = 10;

#define XB_TMO      128
#define XB_XCNT(j)  (256  + 64 * (j))
#define XB_XSUB(j)  (1280 + 64 * (j))
#define XB_XGEN(j)  (2304 + 64 * (j))
#define XB_TOP      3328
#define XB_TOPGEN   3392
#define XCD_BAR_WORDS 3456
#define XB_SPIN_CAP (1u << 22)
__device__ __forceinline__ unsigned xb_ld(unsigned* p)              { return __hip_atomic_load(p, __ATOMIC_RELAXED, __HIP_MEMORY_SCOPE_AGENT); }
__device__ __forceinline__ unsigned xb_add(unsigned* p, unsigned v) { return __hip_atomic_fetch_add(p, v, __ATOMIC_RELAXED, __HIP_MEMORY_SCOPE_AGENT); }
__device__ __forceinline__ unsigned xb_xcc_id() { return (unsigned)__builtin_amdgcn_s_getreg((3 << 11) | 20) & 0xFu; }
#define XB_SPIN(cond, bar) do { unsigned _sp = 0; while (cond) { __builtin_amdgcn_s_sleep(1); \
    if ((++_sp & 255u) == 0u) { if (xb_ld(&(bar)[XB_TMO])) break; if (_sp > XB_SPIN_CAP) { atomicAdd(&(bar)[XB_TMO], 1u); break; } } } } while (0)
struct XcdBarrier { unsigned* bar; unsigned x; volatile LAS unsigned* st; };
__device__ __forceinline__ XcdBarrier xcd_barrier_post(unsigned* bar, volatile LAS unsigned* st) {
    XcdBarrier b; b.bar = bar; b.x = xb_xcc_id(); b.st = st;
    if (threadIdx.x == 0) (void)xb_add(&bar[XB_XCNT(b.x)], 1u);
    return b;
}
__device__ __forceinline__ void xcd_barrier_complete(unsigned* bar, unsigned x, unsigned& nloc, unsigned& nx) {
    const unsigned G = gridDim.x * gridDim.y * gridDim.z;
    unsigned sum, cnt, mine, sp = 0u;
    for (;;) {
        sum = 0u; cnt = 0u; mine = 0u;
#pragma unroll
        for (unsigned j = 0; j < 16; ++j) { const unsigned c = xb_ld(&bar[XB_XCNT(j)]); sum += c; cnt += (c > 0u) ? 1u : 0u; mine = (j == x) ? c : mine; }
        if (sum == G) break;
        __builtin_amdgcn_s_sleep(1);
        if ((++sp & 255u) == 0u) { if (xb_ld(&bar[XB_TMO])) break; if (sp > XB_SPIN_CAP) { atomicAdd(&bar[XB_TMO], 1u); break; } }
    }
    nloc = mine > 0u ? mine : 1u; nx = cnt > 0u ? cnt : 1u;
}
__device__ __forceinline__ void xcd_barrier(const XcdBarrier& b, int wave) {
    asm volatile("s_waitcnt vmcnt(0)" ::: "memory");
    __syncthreads();
    if (wave == 0 && __builtin_amdgcn_mbcnt_hi(~0u, __builtin_amdgcn_mbcnt_lo(~0u, 0u)) == 0u) {
        unsigned* bar = b.bar;
        __builtin_amdgcn_s_waitcnt(0);
        unsigned nloc = b.st[0], nx = b.st[1];
        if (nloc == 0u) { xcd_barrier_complete(bar, b.x, nloc, nx); b.st[0] = nloc; b.st[1] = nx; }
        const unsigned old = xb_add(&bar[XB_XSUB(b.x)], 1u);
        const unsigned gen = old / nloc;
        if (old + 1u == (gen + 1u) * nloc) {
            __builtin_amdgcn_fence(__ATOMIC_RELEASE, "agent");
            asm volatile("s_waitcnt vmcnt(0)" ::: "memory");
            const unsigned og = xb_add(&bar[XB_TOP], 1u);
            const unsigned tg = og / nx;
            if (og + 1u == (tg + 1u) * nx) xb_add(&bar[XB_TOPGEN], 1u);
            else XB_SPIN(xb_ld(&bar[XB_TOPGEN]) == tg, bar);
            __builtin_amdgcn_fence(__ATOMIC_ACQUIRE, "agent");
            xb_add(&bar[XB_XGEN(b.x)], 1u);
            asm volatile("s_waitcnt vmcnt(0)" ::: "memory");
        } else {
            XB_SPIN(xb_ld(&bar[XB_XGEN(b.x)]) == gen, bar);
            __builtin_amdgcn_fence(__ATOMIC_ACQUIRE, "agent");
            asm volatile("s_waitcnt vmcnt(0)" ::: "memory");
        }
    }
    __syncthreads();
}

namespace pg8 {
constexpr int BM = 256, BK = 64, HALF = 128, HTB = HALF * BK * 2, STAGE_BYTES = 8 * HTB, NXCD = 8, WGM = 8;
__host__ __device__ __forceinline__ int lds_byte(int r, int c) { const int st = (r >> 4) * 2 + (c >> 5), rr = r & 15, cc = c & 31, ob = rr * 64 + cc * 2; return st * 1024 + (ob ^ (((ob >> 9) & 1) << 5)); }
__host__ __device__ __forceinline__ void stage_rc(int b, int& R, int& C) { const int st = b / 1024, sb = b % 1024, swz = sb ^ (((sb >> 9) & 1) << 5); R = (st >> 1) * 16 + swz / 64; C = (st & 1) * 32 + (swz % 64) / 2; }
__host__ __device__ __forceinline__ int perm32(int rho) { const int n = rho >> 4, i = rho & 15; return 8 * (i >> 2) + 4 * n + (i & 3); }
__device__ __forceinline__ unsigned cvt_pk_bf16(float lo, float hi) { unsigned r; asm volatile("v_cvt_pk_bf16_f32 %0, %1, %2" : "=v"(r) : "v"(lo), "v"(hi)); return r; }

struct Unit { int pm, pn, e, cnt; };

template <class P>
__device__ __forceinline__ void gemm_phase(LAS unsigned char* lds, const P& p, int wid) {
    int lane = (int)__builtin_amdgcn_mbcnt_hi(~0u, __builtin_amdgcn_mbcnt_lo(~0u, 0u)); asm volatile("" : "+v"(lane));
    const int tid = wid * 64 + lane, wr = wid >> 2, wc = wid & 3, fr = lane & 15, fq = lane >> 4;
    constexpr int K = P::K, nt = K / BK;
    int Rr[2], Cc[2];
#pragma unroll
    for (int i = 0; i < 2; ++i) stage_rc(tid * 16 + i * 8192, Rr[i], Cc[i]);
    unsigned voffB[2][2], voffA[2][2], voffAn[2][2];
#pragma unroll
    for (int h = 0; h < 2; ++h)
#pragma unroll
        for (int i = 0; i < 2; ++i) { voffB[h][i] = (unsigned)(P::brow(h, Rr[i]) * K + Cc[i]) * 2u; voffA[h][i] = (unsigned)((h * HALF + Rr[i]) * K + Cc[i]) * 2u; voffAn[h][i] = voffA[h][i]; }
    const size_t kstep = (size_t)(BK * 2);
    const unsigned ldsw = (unsigned)wid * 1024u;
    const int aoff = lds_byte(wr * 64 + fr, fq * 8), boff = lds_byte(wc * 32 + fr, fq * 8);
#define PG8_SA(b, h) (((b) * 2 + (h)) * HTB)
#define PG8_SB(b, h) ((4 + (b) * 2 + (h)) * HTB)
#define PG8_STAGE(bufoff, gbase, voff) do { _Pragma("unroll") for (int _i = 0; _i < 2; ++_i) \
        __builtin_amdgcn_global_load_lds((const unsigned*)((const char*)(gbase) + (voff)[_i]), (LAS unsigned*)(lds + (bufoff) + ldsw + _i * 8192), 16, 0, 0); } while (0)
#define PG8_LDA(dst, b, h) do { _Pragma("unroll") for (int m = 0; m < 4; ++m) _Pragma("unroll") for (int k = 0; k < 2; ++k) dst[m][k] = *(const LAS bf16x8*)(lds + PG8_SA(b, h) + aoff + m * 2048 + k * 1024); } while (0)
#define PG8_LDB(dst, b, h) do { _Pragma("unroll") for (int n = 0; n < 2; ++n) _Pragma("unroll") for (int k = 0; k < 2; ++k) dst[n][k] = *(const LAS bf16x8*)(lds + PG8_SB(b, h) + boff + n * 2048 + k * 1024); } while (0)
#define PG8_MMA(ai, bj, At, Bt) do { __builtin_amdgcn_s_setprio(1); _Pragma("unroll") for (int m = 0; m < 4; ++m) _Pragma("unroll") for (int n = 0; n < 2; ++n) _Pragma("unroll") for (int k = 0; k < 2; ++k) \
        acc[ai][bj][m][n] = __builtin_amdgcn_mfma_f32_16x16x32_bf16(Bt[n][k], At[m][k], acc[ai][bj][m][n], 0, 0, 0); __builtin_amdgcn_s_setprio(0); } while (0)
#define PG8_WAIT_V(n) asm volatile("s_waitcnt vmcnt(" #n ")" ::: "memory")
#define PG8_WAIT_L(n) asm volatile("s_waitcnt lgkmcnt(" #n ")" ::: "memory")
#define PG8_BAR __builtin_amdgcn_s_barrier()
#define PG8_SCHED __builtin_amdgcn_sched_barrier(0)
    Unit cur, nxt; int ui = 0;
    if (!p.next(0, cur)) return;
    f32x4 acc[2][2][4][2];
#pragma unroll
    for (int a = 0; a < 2; ++a)
#pragma unroll
        for (int b = 0; b < 2; ++b)
#pragma unroll
            for (int m = 0; m < 4; ++m)
#pragma unroll
                for (int n = 0; n < 2; ++n) acc[a][b][m][n] = (f32x4){0.f, 0.f, 0.f, 0.f};
    bf16x8 At[4][2], B0[2][2], B1[2][2];
    const char* cA = p.a_base(cur); const char* cB = p.b_base(cur);
    if constexpr (P::GATHER) p.a_offsets(cur, Rr, Cc, voffA);
    PG8_STAGE(PG8_SB(0, 0), cB, voffB[0]); PG8_STAGE(PG8_SB(0, 1), cB, voffB[1]); PG8_STAGE(PG8_SA(0, 0), cA, voffA[0]); PG8_STAGE(PG8_SA(0, 1), cA, voffA[1]);
    if (wr == 1) PG8_BAR;
    PG8_WAIT_V(2); PG8_BAR;
    PG8_STAGE(PG8_SB(1, 0), cB + kstep, voffB[0]); PG8_STAGE(PG8_SA(1, 0), cA + kstep, voffA[0]); PG8_STAGE(PG8_SB(1, 1), cB + kstep, voffB[1]);
    PG8_WAIT_V(6); PG8_BAR;
    for (;;) {
        const bool has_next = p.next(ui + 1, nxt);
        const char* nA = has_next ? p.a_base(nxt) : cA; const char* nB = has_next ? p.b_base(nxt) : cB;
        if constexpr (P::GATHER) { if (has_next) p.a_offsets(nxt, Rr, Cc, voffAn); else {
#pragma unroll
            for (int h = 0; h < 2; ++h)
#pragma unroll
                for (int i = 0; i < 2; ++i) voffAn[h][i] = voffA[h][i]; } }
        for (int t = 0; t < nt; t += 2) {
            const bool last = (t == nt - 2);
            const char* a1 = cA + (size_t)(t + 1) * kstep;
            const char* a2 = last ? nA : cA + (size_t)(t + 2) * kstep; const char* b2 = last ? nB : cB + (size_t)(t + 2) * kstep;
            const char* a3 = a2 + kstep; const char* b3 = b2 + kstep;
            unsigned va2[2][2];
#pragma unroll
            for (int h = 0; h < 2; ++h)
#pragma unroll
                for (int i = 0; i < 2; ++i) va2[h][i] = (P::GATHER && last) ? voffAn[h][i] : voffA[h][i];
            PG8_LDB(B0, 0, 0); PG8_LDB(B1, 0, 1); PG8_SCHED; PG8_LDA(At, 0, 0); PG8_STAGE(PG8_SA(1, 1), a1, voffA[1]);
            PG8_WAIT_V(8); PG8_WAIT_L(0); PG8_BAR; PG8_MMA(0, 0, At, B0); PG8_MMA(0, 1, At, B1); PG8_BAR; PG8_SCHED;
            PG8_LDA(At, 0, 1); PG8_STAGE(PG8_SB(0, 0), b2, voffB[0]); PG8_STAGE(PG8_SB(0, 1), b2, voffB[1]); PG8_STAGE(PG8_SA(0, 0), a2, va2[0]);
            PG8_WAIT_V(8); PG8_WAIT_L(0); PG8_BAR; PG8_MMA(1, 0, At, B0); PG8_MMA(1, 1, At, B1); PG8_BAR; PG8_SCHED;
            PG8_LDB(B0, 1, 0); PG8_LDB(B1, 1, 1); PG8_SCHED; PG8_LDA(At, 1, 0); PG8_STAGE(PG8_SA(0, 1), a2, va2[1]);
            PG8_WAIT_V(8); PG8_WAIT_L(0); PG8_BAR; PG8_MMA(0, 0, At, B0); PG8_MMA(0, 1, At, B1); PG8_BAR; PG8_SCHED;
            PG8_LDA(At, 1, 1); PG8_STAGE(PG8_SB(1, 0), b3, voffB[0]); PG8_STAGE(PG8_SB(1, 1), b3, voffB[1]); PG8_STAGE(PG8_SA(1, 0), a3, va2[0]);
            PG8_WAIT_V(8); PG8_WAIT_L(0); PG8_BAR; PG8_MMA(1, 0, At, B0); PG8_MMA(1, 1, At, B1); PG8_BAR; PG8_SCHED;
        }
        if (wr == 0) PG8_BAR;
        p.epi(acc, cur, wr, wc, fr, fq);
        if (!has_next) break;
#pragma unroll
        for (int a = 0; a < 2; ++a)
#pragma unroll
            for (int b = 0; b < 2; ++b)
#pragma unroll
                for (int m = 0; m < 4; ++m)
#pragma unroll
                    for (int n = 0; n < 2; ++n) acc[a][b][m][n] = (f32x4){0.f, 0.f, 0.f, 0.f};
        cur = nxt; cA = nA; cB = nB; ++ui;
        if constexpr (P::GATHER) {
#pragma unroll
            for (int h = 0; h < 2; ++h)
#pragma unroll
                for (int i = 0; i < 2; ++i) voffA[h][i] = voffAn[h][i]; }
        if (wr == 1) PG8_BAR;
    }
    PG8_WAIT_V(0);
    PG8_BAR;
#undef PG8_SA
#undef PG8_SB
#undef PG8_STAGE
#undef PG8_LDA
#undef PG8_LDB
#undef PG8_MMA
#undef PG8_WAIT_V
#undef PG8_WAIT_L
#undef PG8_BAR
#undef PG8_SCHED
}

struct DenseOrder {
    int nM, nN, nwg, G, c;
    __device__ void init(int M_, int N_, int G_, int c_) { nM = M_ / BM; nN = N_ / BM; nwg = nM * nN; G = G_; c = c_; }
    __device__ bool next(int i, Unit& u) const {
        const long L = (long)i * G + c; if (L >= nwg) return false;
        int wgid = (int)L; { const int q = nwg / NXCD, r = nwg % NXCD, xcd = wgid % NXCD, off = wgid / NXCD; wgid = (xcd < r ? xcd * (q + 1) : r * (q + 1) + (xcd - r) * q) + off; }
        const int nig = WGM * nN, gid = wgid / nig, fm = gid * WGM, gsz = (nM - fm) < WGM ? (nM - fm) : WGM;
        u.pm = fm + ((wgid % nig) % gsz); u.pn = (wgid % nig) / gsz; u.e = 0; u.cnt = 0; return true;
    }
};
struct GroupOrder {
    const LAS int* pt; const LAS int* cn; int npn, total, G, c;
    __device__ void init(const LAS int* pt_, const LAS int* cn_, int npn_, int G_, int c_) { pt = pt_; cn = cn_; npn = npn_; total = __builtin_amdgcn_readfirstlane(pt_[NE] * npn_); G = G_; c = c_; }
    __device__ bool next(int i, Unit& u) const {
        const long L = (long)i * G + c; if (L >= total) return false;
        int wgid = (int)L; { const int q = total / NXCD, r = total % NXCD, xcd = wgid % NXCD, off = wgid / NXCD; wgid = (xcd < r ? xcd * (q + 1) : r * (q + 1) + (xcd - r) * q) + off; }
        int e = 0;
        for (int j = 1; j < NE; ++j) e += (pt[j] * npn <= wgid) ? 1 : 0;
        const int t0 = pt[e], te = pt[e + 1] - t0, local = wgid - t0 * npn;
        const int mt = local % te;
        u.e = __builtin_amdgcn_readfirstlane(e); u.pn = __builtin_amdgcn_readfirstlane(local / te); u.pm = __builtin_amdgcn_readfirstlane(t0 + mt);
        u.cnt = __builtin_amdgcn_readfirstlane(cn[e] - mt * 256); return true;
    }
};
}

struct PInProj : pg8::DenseOrder {
    static constexpr int K = 1024; static constexpr bool GATHER = false;
    const bf16_t* XN; const bf16_t* Wt; bf16_t* QKV; const float *gaq, *gak, *gbq, *gbk;
    static __device__ __forceinline__ int brow(int bj, int R) { return 64 * (R >> 5) + 32 * bj + pg8::perm32(R & 31); }
    __device__ __forceinline__ const char* a_base(const pg8::Unit& u) const { return (const char*)(XN + (size_t)u.pm * 256 * K); }
    __device__ __forceinline__ const char* b_base(const pg8::Unit& u) const { return (const char*)(Wt + (size_t)u.pn * 256 * K); }
    __device__ __forceinline__ void epi(const f32x4 (&acc)[2][2][4][2], const pg8::Unit& u, int wr, int wc, int fr, int fq) const {
        const int ty = u.pn >> 1;
        const float* g = (ty == 0) ? gaq : (ty == 1) ? gak : (ty == 3) ? gbq : (ty == 4) ? gbk : nullptr;
        const float post = (ty == 0 || ty == 3) ? QSCALE : 1.f;
        const int row0 = u.pm * 256 + wr * 64 + fr, col0 = u.pn * 256 + wc * 64 + 8 * fq;
        f32x4 gv[2][2];
#pragma unroll
        for (int bj = 0; bj < 2; ++bj)
#pragma unroll
            for (int n = 0; n < 2; ++n) gv[bj][n] = g ? *(const f32x4*)(g + 32 * bj + 8 * fq + 4 * n) : (f32x4){1.f, 1.f, 1.f, 1.f};
#pragma unroll
        for (int ai = 0; ai < 2; ++ai)
#pragma unroll
            for (int m = 0; m < 4; ++m) {
                float rs = 1.f;
                if (g) {
                    float ss = 0.f;
#pragma unroll
                    for (int bj = 0; bj < 2; ++bj)
#pragma unroll
                        for (int n = 0; n < 2; ++n) { const f32x4 v = acc[ai][bj][m][n]; ss += (v[0] * v[0] + v[1] * v[1]) + (v[2] * v[2] + v[3] * v[3]); }
                    ss += __shfl_xor(ss, 16); ss += __shfl_xor(ss, 32);
                    rs = rsqrtf(ss * (1.f / 64.f) + RMS_EPS) * post;
                }
                bf16_t* rowp = QKV + (size_t)(row0 + ai * 128 + m * 16) * NIN + col0;
#pragma unroll
                for (int bj = 0; bj < 2; ++bj) {
                    const f32x4 v0 = acc[ai][bj][m][0] * gv[bj][0] * rs, v1 = acc[ai][bj][m][1] * gv[bj][1] * rs;
                    u32x4 w; w.x = pg8::cvt_pk_bf16(v0[0], v0[1]); w.y = pg8::cvt_pk_bf16(v0[2], v0[3]); w.z = pg8::cvt_pk_bf16(v1[0], v1[1]); w.w = pg8::cvt_pk_bf16(v1[2], v1[3]);
                    *(u32x4*)(rowp + 32 * bj) = w;
                }
            }
    }
};
struct POutProj : pg8::DenseOrder {
    static constexpr int K = 1024; static constexpr bool GATHER = false;
    const bf16_t* AO; const bf16_t* Wt; const float* x; const float* mod; float* x1;
    static __device__ __forceinline__ int brow(int bj, int R) { return 128 * bj + R; }
    __device__ __forceinline__ const char* a_base(const pg8::Unit& u) const { return (const char*)(AO + (size_t)u.pm * 256 * K); }
    __device__ __forceinline__ const char* b_base(const pg8::Unit& u) const { return (const char*)(Wt + (size_t)u.pn * 256 * K); }
    __device__ __forceinline__ void epi(const f32x4 (&acc)[2][2][4][2], const pg8::Unit& u, int wr, int wc, int fr, int fq) const {
        const int row0 = u.pm * 256 + wr * 64 + fr, col0 = u.pn * 256 + wc * 32 + 4 * fq;
        const float* gate1 = mod + ((u.pm * 256) / S) * 6144 + 2048;
        f32x4 gv[2][2];
#pragma unroll
        for (int bj = 0; bj < 2; ++bj)
#pragma unroll
            for (int n = 0; n < 2; ++n) gv[bj][n] = *(const f32x4*)(gate1 + col0 + bj * 128 + n * 16);
#pragma unroll
        for (int ai = 0; ai < 2; ++ai)
#pragma unroll
            for (int m = 0; m < 4; ++m) { const size_t off = (size_t)(row0 + ai * 128 + m * 16) * D + col0;
#pragma unroll
                for (int bj = 0; bj < 2; ++bj)
#pragma unroll
                    for (int n = 0; n < 2; ++n) { const f32x4 xv = *(const f32x4*)(x + off + bj * 128 + n * 16); *(f32x4*)(x1 + off + bj * 128 + n * 16) = xv + gv[bj][n] * acc[ai][bj][m][n]; }
                if (m & 1) asm volatile("" ::: "memory"); }
    }
};
struct PGateUp : pg8::GroupOrder {
    static constexpr int K = 1024; static constexpr bool GATHER = true;
    const bf16_t* H2; const bf16_t* Wt; const float* bgu; const int* list; bf16_t* ACT;
    static __device__ __forceinline__ int brow(int bj, int R) { return 1024 * bj + (R & ~31) + pg8::perm32(R & 31); }
    __device__ __forceinline__ const char* a_base(const pg8::Unit&) const { return (const char*)H2; }
    __device__ __forceinline__ const char* b_base(const pg8::Unit& u) const { return (const char*)(Wt + ((size_t)u.e * 2048 + u.pn * 128) * K); }
    __device__ __forceinline__ void a_offsets(const pg8::Unit& u, const int (&R)[2], const int (&C)[2], unsigned (&voff)[2][2]) const {
        const int* lp = list + (size_t)u.e * M + (size_t)(u.pm - pt[u.e]) * 256;
#pragma unroll
        for (int h = 0; h < 2; ++h)
#pragma unroll
            for (int i = 0; i < 2; ++i) { int r = h * 128 + R[i]; r = r < u.cnt ? r : 0; const int tok = lp[r]; voff[h][i] = (unsigned)(tok * K + C[i]) * 2u; }
    }
    __device__ __forceinline__ void epi(const f32x4 (&acc)[2][2][4][2], const pg8::Unit& u, int wr, int wc, int fr, int fq) const {
        const int row0 = u.pm * 256 + wr * 64 + fr, col0 = u.pn * 128 + wc * 32 + 8 * fq;
        const float* bias = bgu + u.e * 2048 + col0;
        f32x4 bg[2], bu[2];
#pragma unroll
        for (int n = 0; n < 2; ++n) { bg[n] = *(const f32x4*)(bias + 4 * n); bu[n] = *(const f32x4*)(bias + 1024 + 4 * n); }
#pragma unroll
        for (int ai = 0; ai < 2; ++ai)
#pragma unroll
            for (int m = 0; m < 4; ++m) {
                float a[2][4];
#pragma unroll
                for (int n = 0; n < 2; ++n)
#pragma unroll
                    for (int r = 0; r < 4; ++r) {
                        float g = acc[ai][0][m][n][r] + bg[n][r], uu = acc[ai][1][m][n][r] + bu[n][r];
                        g = fminf(g, 7.f); uu = fminf(fmaxf(uu, -7.f), 7.f);
                        a[n][r] = (uu + 1.f) * g * __builtin_amdgcn_rcpf(1.f + __builtin_amdgcn_exp2f(-1.702f * LOG2E * g));
                    }
                u32x4 w; w.x = pg8::cvt_pk_bf16(a[0][0], a[0][1]); w.y = pg8::cvt_pk_bf16(a[0][2], a[0][3]); w.z = pg8::cvt_pk_bf16(a[1][0], a[1][1]); w.w = pg8::cvt_pk_bf16(a[1][2], a[1][3]);
                *(u32x4*)(ACT + (size_t)(row0 + ai * 128 + m * 16) * DFF + col0) = w;
            }
    }
};
struct PDown : pg8::GroupOrder {
    static constexpr int K = 1024; static constexpr bool GATHER = false;
    const bf16_t* ACT; const bf16_t* Wt; const float* bd; bf16_t* Y;
    static __device__ __forceinline__ int brow(int bj, int R) { return 128 * bj + (R & ~31) + pg8::perm32(R & 31); }
    __device__ __forceinline__ const char* a_base(const pg8::Unit& u) const { return (const char*)(ACT + (size_t)u.pm * 256 * K); }
    __device__ __forceinline__ const char* b_base(const pg8::Unit& u) const { return (const char*)(Wt + ((size_t)u.e * 1024 + u.pn * 256) * K); }
    __device__ __forceinline__ void epi(const f32x4 (&acc)[2][2][4][2], const pg8::Unit& u, int wr, int wc, int fr, int fq) const {
        const int row0 = u.pm * 256 + wr * 64 + fr, col0 = u.pn * 256 + wc * 32 + 8 * fq;
        const float* bias = bd + u.e * 1024 + col0;
        f32x4 bv[2][2];
#pragma unroll
        for (int bj = 0; bj < 2; ++bj)
#pragma unroll
            for (int n = 0; n < 2; ++n) bv[bj][n] = *(const f32x4*)(bias + bj * 128 + 4 * n);
#pragma unroll
        for (int ai = 0; ai < 2; ++ai)
#pragma unroll
            for (int m = 0; m < 4; ++m) { bf16_t* rowp = Y + (size_t)(row0 + ai * 128 + m * 16) * D + col0;
#pragma unroll
                for (int bj = 0; bj < 2; ++bj) { const f32x4 v0 = acc[ai][bj][m][0] + bv[bj][0], v1 = acc[ai][bj][m][1] + bv[bj][1];
                    u32x4 w; w.x = pg8::cvt_pk_bf16(v0[0], v0[1]); w.y = pg8::cvt_pk_bf16(v0[2], v0[3]); w.z = pg8::cvt_pk_bf16(v1[0], v1[1]); w.w = pg8::cvt_pk_bf16(v1[2], v1[3]);
                    *(u32x4*)(rowp + bj * 128) = w; } }
    }
};


namespace att {
typedef float f32x16 __attribute__((ext_vector_type(16)));
typedef short s16x4 __attribute__((ext_vector_type(4)));
typedef short v4i16_t __attribute__((ext_vector_type(4)));
typedef float f32x2_t __attribute__((ext_vector_type(2))); typedef __bf16 bf16x2_t __attribute__((ext_vector_type(2)));
__device__ __forceinline__ unsigned cvtpk(float lo, float hi) { f32x2_t v = {lo, hi}; bf16x2_t b = __builtin_convertvector(v, bf16x2_t); return __builtin_bit_cast(unsigned, b); }
__device__ __forceinline__ s16x4 vtr(const LAS unsigned char* p) { return __builtin_bit_cast(s16x4, __builtin_amdgcn_ds_read_tr16_b64_v4i16((LAS v4i16_t*)p)); }
__device__ __forceinline__ void glds16(const void* gsrc, LAS unsigned char* dst) { __builtin_amdgcn_global_load_lds((const unsigned*)gsrc, (LAS unsigned*)dst, 16, 0, 0); }
#define ATT_CR(r) (((r) & 3) + 8 * ((r) >> 2))
#define ATT_WAIT_V(n) asm volatile("s_waitcnt vmcnt(" #n ")" ::: "memory")
#define ATT_WAIT_L0() asm volatile("s_waitcnt lgkmcnt(0)" ::: "memory")

template <int MODE> __device__ __forceinline__ float soft_tile(f32x16& p0, f32x16& p1, float sl, int dqh) {
    float sum = 0.f;
#pragma unroll
    for (int r = 0; r < 16; ++r) {
        float x0 = __builtin_fmaf(sl, (float)ATT_CR(r), p0[r]), x1 = __builtin_fmaf(sl, (float)(ATT_CR(r) + 32), p1[r]);
        if (MODE == 1) { x0 = (ATT_CR(r) <= dqh) ? x0 : -INFINITY; x1 = (ATT_CR(r) + 32 <= dqh) ? x1 : -INFINITY; }
        if (MODE == 2) { x0 = ((unsigned)(dqh - ATT_CR(r)) <= 128u) ? x0 : -INFINITY; x1 = ((unsigned)(dqh - ATT_CR(r) - 32) <= 128u) ? x1 : -INFINITY; }
        p0[r] = __builtin_amdgcn_exp2f(x0); p1[r] = __builtin_amdgcn_exp2f(x1);
        sum += p0[r] + p1[r];
    }
    return sum;
}
__device__ __forceinline__ void pack_p(const f32x16& p0, const f32x16& p1, bf16x8 (&pa)[4]) {
    u32x4 w0 = {cvtpk(p0[0], p0[1]), cvtpk(p0[2], p0[3]), cvtpk(p0[4], p0[5]), cvtpk(p0[6], p0[7])};
    u32x4 w1 = {cvtpk(p0[8], p0[9]), cvtpk(p0[10], p0[11]), cvtpk(p0[12], p0[13]), cvtpk(p0[14], p0[15])};
    u32x4 w2 = {cvtpk(p1[0], p1[1]), cvtpk(p1[2], p1[3]), cvtpk(p1[4], p1[5]), cvtpk(p1[6], p1[7])};
    u32x4 w3 = {cvtpk(p1[8], p1[9]), cvtpk(p1[10], p1[11]), cvtpk(p1[12], p1[13]), cvtpk(p1[14], p1[15])};
    pa[0] = __builtin_bit_cast(bf16x8, w0); pa[1] = __builtin_bit_cast(bf16x8, w1); pa[2] = __builtin_bit_cast(bf16x8, w2); pa[3] = __builtin_bit_cast(bf16x8, w3);
}
template <int NDB> __device__ __forceinline__ void pv_tile(f32x16 (&o)[NDB], const LAS unsigned char* vrd, const bf16x8 (&pa)[4]) {
#pragma unroll
    for (int db = 0; db < NDB; ++db) {
        s16x4 lo[4], hh[4];
#pragma unroll
        for (int g = 0; g < 4; ++g) { lo[g] = vtr(vrd + db * 4096 + g * 1024); hh[g] = vtr(vrd + db * 4096 + g * 1024 + 512); }
#pragma unroll
        for (int g = 0; g < 4; ++g) { const bf16x8 vf = {lo[g][0], lo[g][1], lo[g][2], lo[g][3], hh[g][0], hh[g][1], hh[g][2], hh[g][3]};
            o[db] = __builtin_amdgcn_mfma_f32_32x32x16_bf16(pa[g], vf, o[db], 0, 0, 0); }
    }
}
__device__ __forceinline__ float gain_bound(const float* ga, const float* gb, int lane) {
    float a = fabsf(ga[lane & 63]), b = fabsf(gb[lane & 63]);
#pragma unroll
    for (int o = 1; o < 64; o <<= 1) { a = fmaxf(a, __shfl_xor(a, o)); b = fmaxf(b, __shfl_xor(b, o)); }
    return QSCALE * 64.f * a * b * 1.02f + 0.25f;
}

constexpr int B_SLOT = 24576;
__device__ __forceinline__ void attn_b_unit(LAS unsigned char* lds, LAS float* wsf, const bf16_t* QKV, float* OBN, int b, int h, int c, int qb, float Mb, int wave, int lane) {
    const int r32 = lane & 31, hi = lane >> 5;
    const int q0 = qb * 256, tq = q0 + wave * 32 + r32;
    const size_t rowbase = (size_t)b * S;
    const bf16_t* Qp = QKV + (rowbase + tq) * NIN + 1536 + h * 128 + c * 64;
    const bf16_t* Kh = QKV + rowbase * NIN + 2048 + h * 128 + c * 64;
    const bf16_t* Vh = QKV + rowbase * NIN + 2560 + h * 128;
    const float sl = exp2f(-2.f * (float)(h + 1)) * LOG2E;
    bf16x8 qr[4];
#pragma unroll
    for (int d0 = 0; d0 < 4; ++d0) qr[d0] = *(const bf16x8*)(Qp + d0 * 16 + hi * 8);
    const int NT = (q0 + 256) / 64;
    const bf16_t* ksrc = Kh + (size_t)lane * NIN + wave * 8;
    const int i0 = wave, i1 = wave + 8;
    const bf16_t* vsrc0 = Vh + (size_t)(16 * (i0 & 3) + (lane >> 2)) * NIN + (i0 >> 2) * 32 + (lane & 3) * 8;
    const bf16_t* vsrc1 = Vh + (size_t)(16 * (i1 & 3) + (lane >> 2)) * NIN + (i1 >> 2) * 32 + (lane & 3) * 8;
#define ATT_DMA(t, s) do { const size_t to_ = (size_t)(t) * 64 * NIN; LAS unsigned char* sb_ = lds + (s) * B_SLOT; \
        glds16(ksrc + to_, sb_ + wave * 1024); glds16(vsrc0 + to_, sb_ + 8192 + i0 * 1024); glds16(vsrc1 + to_, sb_ + 8192 + i1 * 1024); } while (0)
    const int kfo = hi * 1024 + r32 * 16;
    const int vro = 8192 + ((lane >> 4) & 1) * 32 + (lane & 3) * 8 + (4 * hi + ((lane & 15) >> 2)) * 64;
    f32x16 o[4]; float lsum = 0.f;
#pragma unroll
    for (int d = 0; d < 4; ++d) o[d] = f32x16{};
    ATT_WAIT_L0(); __builtin_amdgcn_s_barrier();
    ATT_DMA(0, 0); ATT_DMA(1, 1);
    const int qmax_w = q0 + wave * 32 + 31, qmin_w = q0 + wave * 32;
    int slot = 0;
    for (int t = 0; t < NT; ++t) {
        if (t + 1 < NT) ATT_WAIT_V(3); else ATT_WAIT_V(0);
        ATT_WAIT_L0(); __builtin_amdgcn_s_barrier();
        if (t + 2 < NT) { const int s2 = (slot >= 1) ? slot - 1 : 2; ATT_DMA(t + 2, s2); }
        const int k0 = 64 * t;
        if (k0 <= qmax_w) {
            const LAS unsigned char* sb = lds + slot * B_SLOT;
            bf16x8 kf[8];
#pragma unroll
            for (int d0 = 0; d0 < 4; ++d0) { kf[2 * d0] = *(const LAS bf16x8*)(sb + kfo + d0 * 2048); kf[2 * d0 + 1] = *(const LAS bf16x8*)(sb + kfo + d0 * 2048 + 512); }
            const int dqh = tq - k0 - 4 * hi;
            const float ci = -sl * (float)dqh - Mb;
            f32x16 p0, p1;
#pragma unroll
            for (int r = 0; r < 16; ++r) { p0[r] = ci; p1[r] = ci; }
#pragma unroll
            for (int d0 = 0; d0 < 4; ++d0) { p0 = __builtin_amdgcn_mfma_f32_32x32x16_bf16(kf[2 * d0], qr[d0], p0, 0, 0, 0); p1 = __builtin_amdgcn_mfma_f32_32x32x16_bf16(kf[2 * d0 + 1], qr[d0], p1, 0, 0, 0); }
            if (k0 + 63 <= qmin_w) lsum += soft_tile<0>(p0, p1, sl, dqh); else lsum += soft_tile<1>(p0, p1, sl, dqh);
            bf16x8 pa[4]; pack_p(p0, p1, pa);
            pv_tile<4>(o, sb + vro, pa);
        }
        slot = (slot == 2) ? 0 : slot + 1;
    }
#undef ATT_DMA
    { auto rr = __builtin_amdgcn_permlane32_swap(__float_as_uint(lsum), __float_as_uint(lsum), false, false); lsum = __uint_as_float(rr[0]) + __uint_as_float(rr[1]); }
    if (hi == 0) wsf[r32] = lsum;
    ATT_WAIT_L0();
    float* ob = OBN + ((size_t)c * M + rowbase + q0 + wave * 32) * 512 + h * 128 + r32;
#pragma unroll
    for (int r = 0; r < 16; ++r) { const int q = ATT_CR(r) + 4 * hi; const float rl = __builtin_amdgcn_rcpf(wsf[q]);
#pragma unroll
        for (int db = 0; db < 4; ++db) ob[(size_t)q * 512 + db * 32] = o[db][r] * rl; }
    ATT_WAIT_L0();
}
__device__ __forceinline__ void attn_b_phase(LAS unsigned char* lds, LAS float* wsf, const bf16_t* QKV, float* OBN, const float* gbq, const float* gbk, int vcu, int wave, int lane) {
    const float Mb = gain_bound(gbq, gbk, lane);
    const int bhc = vcu >> 2, s = vcu & 3, b = bhc >> 3, h = (bhc >> 1) & 3, c = bhc & 1;
    attn_b_unit(lds, wsf, QKV, OBN, b, h, c, 7 - s, Mb, wave, lane);
    attn_b_unit(lds, wsf, QKV, OBN, b, h, c, s, Mb, wave, lane);
    ATT_WAIT_L0(); __builtin_amdgcn_s_barrier();
}

struct ATile { const bf16_t* kbase; int step, dq0; float sl; };
__device__ __forceinline__ void attn_a_task(LAS unsigned char* vbuf, LAS float* wsf, const bf16_t* QKV, bf16_t* AO, int b, int h, int r, int jb, float Mb, int lane) {
    const int r32 = lane & 31, hi = lane >> 5;
    const int j = 32 * jb + r32, tq = r + 16 * j;
    const size_t rowbase = (size_t)b * S;
    const bf16_t* Qp = QKV + (rowbase + tq) * NIN + h * 64;
    const bf16_t* Kh = QKV + rowbase * NIN + 512 + h * 64;
    const float sl1 = exp2f(-(float)(h + 1)) * LOG2E;
    bf16x8 qr[4];
#pragma unroll
    for (int d0 = 0; d0 < 4; ++d0) qr[d0] = *(const bf16x8*)(Qp + d0 * 16 + hi * 8);
    const int n3 = (jb >= 2) ? 2 : 1, n2 = (jb == 0) ? 2 : 4, n1 = (jb == 0) ? 8 : 10, ntile = n3 + n2 + n1;
    auto tile_step = [&](int idx) -> int { return idx < n3 ? 16 : (idx < n3 + n2 ? 4 : 1); };
    auto tile_k0 = [&](int idx) -> int { return idx < n3 ? 64 * idx : (idx < n3 + n2 ? 64 * ((jb == 0 ? 0 : 2 * jb - 2) + idx - n3) : 64 * ((jb == 0 ? 0 : 8 * jb - 2) + idx - n3 - n2)); };
    auto tile_uq = [&](int step) -> int { return step == 16 ? j : (step == 4 ? (r >> 2) + 4 * j : tq); };
    auto tile_pos0 = [&](int step, int k0) -> int { return (r & (step - 1)) + step * k0; };
    const int kfr = r32, vr16 = lane >> 2;
    bf16x8 kfn[8];
#define ATT_PREF(idx, buf) do { const int st_ = tile_step(idx), k0_ = tile_k0(idx); const bf16_t* kb_ = Kh + (size_t)tile_pos0(st_, k0_) * NIN; const size_t rs_ = (size_t)st_ * NIN; \
        _Pragma("unroll") for (int d0 = 0; d0 < 4; ++d0) { kfn[2 * d0] = *(const bf16x8*)(kb_ + (size_t)kfr * rs_ + d0 * 16 + hi * 8); kfn[2 * d0 + 1] = *(const bf16x8*)(kb_ + (size_t)(kfr + 32) * rs_ + d0 * 16 + hi * 8); } \
        _Pragma("unroll") for (int i = 0; i < 8; ++i) glds16(kb_ + 512 + (size_t)(16 * (i & 3) + vr16) * rs_ + (i >> 2) * 32 + (lane & 3) * 8, vbuf + (buf) * 8192 + i * 1024); } while (0)
    const int vro = ((lane >> 4) & 1) * 32 + (lane & 3) * 8 + (4 * hi + ((lane & 15) >> 2)) * 64;
    f32x16 o[2]; o[0] = f32x16{}; o[1] = f32x16{}; float lsum = 0.f;
    ATT_WAIT_L0();
    ATT_PREF(0, 0);
    for (int idx = 0; idx < ntile; ++idx) {
        ATT_WAIT_V(0);
        bf16x8 kf[8];
#pragma unroll
        for (int i = 0; i < 8; ++i) kf[i] = kfn[i];
        ATT_WAIT_L0();
        if (idx + 1 < ntile) ATT_PREF(idx + 1, (idx + 1) & 1);
        const int st = tile_step(idx), k0 = tile_k0(idx);
        const int dqh = tile_uq(st) - k0 - 4 * hi;
        const float sl = sl1 * (float)st;
        const float ci = -sl * (float)dqh - Mb;
        f32x16 p0, p1;
#pragma unroll
        for (int rr = 0; rr < 16; ++rr) { p0[rr] = ci; p1[rr] = ci; }
#pragma unroll
        for (int d0 = 0; d0 < 4; ++d0) { p0 = __builtin_amdgcn_mfma_f32_32x32x16_bf16(kf[2 * d0], qr[d0], p0, 0, 0, 0); p1 = __builtin_amdgcn_mfma_f32_32x32x16_bf16(kf[2 * d0 + 1], qr[d0], p1, 0, 0, 0); }
        lsum += soft_tile<2>(p0, p1, sl, dqh);
        bf16x8 pa[4]; pack_p(p0, p1, pa);
        pv_tile<2>(o, vbuf + (idx & 1) * 8192 + vro, pa);
    }
#undef ATT_PREF
    { auto rr = __builtin_amdgcn_permlane32_swap(__float_as_uint(lsum), __float_as_uint(lsum), false, false); lsum = __uint_as_float(rr[0]) + __uint_as_float(rr[1]); }
    if (hi == 0) wsf[r32] = lsum;
    ATT_WAIT_L0();
    LAS bf16_t* stg = (LAS bf16_t*)vbuf;
#pragma unroll
    for (int rr = 0; rr < 16; ++rr) { const int q = ATT_CR(rr) + 4 * hi; const float rl = __builtin_amdgcn_rcpf(wsf[q]);
#pragma unroll
        for (int db = 0; db < 2; ++db) stg[q * 64 + db * 32 + r32] = f2bf(o[db][rr] * rl); }
    ATT_WAIT_L0();
#pragma unroll
    for (int i = 0; i < 4; ++i) { const int row = i * 8 + (lane >> 3), ch = lane & 7; const u32x4 v = *(const LAS u32x4*)(stg + row * 64 + ch * 8);
        *(u32x4*)(AO + (rowbase + r + 16 * (32 * jb + row)) * D + h * 64 + ch * 8) = v; }
    ATT_WAIT_L0();
}
__device__ __forceinline__ void attn_a_phase(LAS unsigned char* lds, LAS float* wsf, const bf16_t* QKV, bf16_t* AO, const float* gaq, const float* gak, int vcu, int wave, int lane) {
    const float Mb = gain_bound(gaq, gak, lane);
    const int bh = vcu >> 2, b = bh >> 3, h = bh & 7, r = 4 * (vcu & 3) + (wave & 3);
    LAS unsigned char* vbuf = lds + wave * 16384;
    attn_a_task(vbuf, wsf, QKV, AO, b, h, r, (wave >> 2) ? 2 : 3, Mb, lane);
    attn_a_task(vbuf, wsf, QKV, AO, b, h, r, (wave >> 2) ? 1 : 0, Mb, lane);
}
#undef ATT_CR
#undef ATT_WAIT_V
#undef ATT_WAIT_L0
}

struct MArgs {
    const float *x, *c, *w_ada, *b_ada, *g1, *w_in, *gaq, *gak, *gbq, *gbk, *lq1, *lk1, *lq2, *lk2, *gd, *w_out, *g2, *w_router, *b_router, *w_gu, *b_gu, *w_d, *b_d;
    float* out; unsigned char* ws; int ph_lo, ph_hi;
};

__device__ __forceinline__ void p0_transpose_item(const float* W, int K, int N, bf16_t* WT, LAS float* scr, int item, int lane) {
    const int nblk = N / 32, kb = item / nblk, nb = item % nblk, k0 = 64 * kb, n0 = 32 * nb;
#pragma unroll 8
    for (int i = 0; i < 32; ++i) { const int kk = 2 * i + (lane >> 5); scr[kk * 33 + (lane & 31)] = W[(size_t)(k0 + kk) * N + n0 + (lane & 31)]; }
    LDS_WAIT(); asm volatile("" ::: "memory");
    const int c = lane & 7;
#pragma unroll
    for (int j = 0; j < 4; ++j) { const int n = (lane >> 3) + 8 * j; const LAS float* s = scr + (8 * c) * 33 + n;
        u32x4 o; o.x = pk2(s[0 * 33], s[1 * 33]); o.y = pk2(s[2 * 33], s[3 * 33]); o.z = pk2(s[4 * 33], s[5 * 33]); o.w = pk2(s[6 * 33], s[7 * 33]);
        *(u32x4*)(WT + (size_t)(n0 + n) * K + k0 + 8 * c) = o; }
    LDS_WAIT(); asm volatile("" ::: "memory");
}

__global__ void __launch_bounds__(NTHREADS, 2) mega(MArgs a) {
    extern __shared__ __attribute__((aligned(16))) unsigned char lds_raw[];
    LAS unsigned char* lds = (LAS unsigned char*)lds_raw;
    const int G = gridDim.x, bx = blockIdx.x, vcu = (G % 8 == 0) ? (bx % 8) * (G / 8) + bx / 8 : bx, NGW = G * NWAVES;
    const int wave = __builtin_amdgcn_readfirstlane((int)threadIdx.x >> 6);
#define PHASE_IDS() int lane = (int)__builtin_amdgcn_mbcnt_hi(~0u, __builtin_amdgcn_mbcnt_lo(~0u, 0u)); asm volatile("" : "+v"(lane)); const int tid = wave * 64 + lane, gw = vcu * NWAVES + wave; (void)tid; (void)gw
    volatile LAS unsigned* MISC = (volatile LAS unsigned*)(lds + MISC_OFF);
    LAS int* PT = (LAS int*)(lds + PT_OFF); LAS int* CN = (LAS int*)(lds + CNT_OFF);
#define w_counts ((int*)(a.ws + WS_CTL + CTL_COUNTS))
#define w_mod ((float*)(a.ws + WS_CTL + CTL_MOD))
#define w_Win_t ((bf16_t*)(a.ws + WS_WIN))
#define w_Wout_t ((bf16_t*)(a.ws + WS_WOUT))
#define w_Wgu_t ((bf16_t*)(a.ws + WS_WGU))
#define w_Wd_t ((bf16_t*)(a.ws + WS_WD))
#define w_XN ((bf16_t*)(a.ws + WS_XN))
#define w_QKV ((bf16_t*)(a.ws + WS_QKV))
#define w_AO ((bf16_t*)(a.ws + WS_AO))
#define w_H2 ((bf16_t*)(a.ws + WS_H2))
#define w_tope ((int*)(a.ws + WS_TOPE))
#define w_tops ((int*)(a.ws + WS_TOPS))
#define w_topg ((float*)(a.ws + WS_TOPG))
#define w_list ((int*)(a.ws + WS_LIST))
#define w_ACT ((bf16_t*)(a.ws + WS_ACT))
#define w_Y ((bf16_t*)(a.ws + WS_Y))
#define w_OBN ((float*)(a.ws + WS_OBN))
    for (int u = threadIdx.x; u < (LDS_BYTES - LDSCTL_OFF) / 4; u += NTHREADS) ((LAS unsigned*)(lds + LDSCTL_OFF))[u] = 0u;
    __syncthreads();
    const int lo = a.ph_lo, hi = a.ph_hi;
    XcdBarrier bar; bar.bar = (unsigned*)(a.ws + WS_CTL + CTL_BAR); bar.x = 0; bar.st = nullptr;
    if (hi - lo > 1) bar = xcd_barrier_post((unsigned*)(a.ws + WS_CTL + CTL_BAR), MISC + 8);
#define IN(k) (lo <= (k) && (k) < hi)
#ifndef REP_PH
#define REP_PH -1
#define REP_N 1
#endif
#define NREP(k) (((k) == REP_PH) ? REP_N : 1)
#define SEAM(k) do { if (IN(k) && IN((k) + 1)) xcd_barrier(bar, wave); } while (0)
#define LOAD_PT() do { if (wave == 0) { int cv = (lane < NE) ? w_counts[lane] : 0; int tl = (cv + 255) >> 8; int sc = tl; \
        _Pragma("unroll") for (int o = 1; o < 32; o <<= 1) { const int t_ = __shfl_up(sc, o); if ((lane & 31) >= o) sc += t_; } \
        if (lane < NE) { PT[lane + 1] = sc; CN[lane] = cv; } if (lane == 0) PT[0] = 0; } __syncthreads(); } while (0)

    if (IN(0)) for (int rep_ = 0; rep_ < NREP(0); ++rep_) {
        PHASE_IDS();
        LAS float* silu = (LAS float*)(lds + 98304);
        for (int i = tid; i < NB * D; i += NTHREADS) { const float cv = a.c[i]; silu[i] = cv / (1.f + __expf(-cv)); }
        __syncthreads();
        if (gw < 24 * 32 && rep_ == 0) {
            const int cc = gw % 24, ks = gw / 24, col = cc * 256 + 4 * lane;
            f32x4 acc[NB];
#pragma unroll
            for (int b = 0; b < NB; ++b) acc[b] = (ks == 0) ? *(const f32x4*)(a.b_ada + col) : (f32x4){0.f, 0.f, 0.f, 0.f};
            for (int k = ks * 32; k < ks * 32 + 32; ++k) {
                const f32x4 w = *(const f32x4*)(a.w_ada + (size_t)k * 6144 + col);
#pragma unroll
                for (int b = 0; b < NB; ++b) acc[b] += w * silu[b * D + k];
            }
#pragma unroll
            for (int b = 0; b < NB; ++b)
#pragma unroll
                for (int r = 0; r < 4; ++r) atomicAdd(&w_mod[b * 6144 + col + r], acc[b][r]);
        }
        LAS float* scr = (LAS float*)(lds + wave * 10240);
        constexpr int I_IN = 16 * 96, I_OUT = 16 * 32, I_GU = 16 * 64, I_D = 16 * 32;
        constexpr int NITEMS = I_IN + I_OUT + NE * I_GU + NE * I_D;
        for (int it = gw; it < NITEMS; it += NGW) {
            int r = it;
            if (r < I_IN) { p0_transpose_item(a.w_in, 1024, 3072, w_Win_t, scr, r, lane); continue; } r -= I_IN;
            if (r < I_OUT) { p0_transpose_item(a.w_out, 1024, 1024, w_Wout_t, scr, r, lane); continue; } r -= I_OUT;
            if (r < NE * I_GU) { const int e = r / I_GU; p0_transpose_item(a.w_gu + (size_t)e * 1024 * 2048, 1024, 2048, w_Wgu_t + (size_t)e * 1024 * 2048, scr, r % I_GU, lane); continue; } r -= NE * I_GU;
            { const int e = r / I_D; p0_transpose_item(a.w_d + (size_t)e * 1024 * 1024, 1024, 1024, w_Wd_t + (size_t)e * 1024 * 1024, scr, r % I_D, lane); }
        }
        if (rep_ + 1 < NREP(0)) xcd_barrier(bar, wave);
    }
    SEAM(0);
    if (IN(1)) for (int rep_ = 0; rep_ < NREP(1); ++rep_) {
        PHASE_IDS();
        for (int row = gw; row < M; row += NGW) {
            const int b = row / S;
            const f32x4* xr = (const f32x4*)(a.x + (size_t)row * D) + lane;
            f32x4 v[4]; float ss = 0.f;
#pragma unroll
            for (int j = 0; j < 4; ++j) { v[j] = xr[64 * j]; ss += (v[j].x * v[j].x + v[j].y * v[j].y) + (v[j].z * v[j].z + v[j].w * v[j].w); }
            const float rstd = rsqrtf(wave_sum(ss) * (1.f / D) + RMS_EPS);
            const float* shift = w_mod + b * 6144, *scale = w_mod + b * 6144 + 1024;
#pragma unroll
            for (int j = 0; j < 4; ++j) {
                const int c0 = 4 * lane + 256 * j;
                const f32x4 g = *(const f32x4*)(a.g1 + c0), sc = *(const f32x4*)(scale + c0), sh = *(const f32x4*)(shift + c0);
                const f32x4 o = v[j] * rstd * g * (sc + 1.f) + sh;
                u32x2 w; w.x = pk2(o.x, o.y); w.y = pk2(o.z, o.w);
                *(u32x2*)(w_XN + (size_t)row * D + c0) = w;
            }
        }
        if (rep_ + 1 < NREP(1)) xcd_barrier(bar, wave);
    }
    SEAM(1);
    if (IN(2)) for (int rep_ = 0; rep_ < NREP(2); ++rep_) {
        PHASE_IDS();
        PInProj p; p.init(M, NIN, G, bx); p.XN = w_XN; p.Wt = w_Win_t; p.QKV = w_QKV; p.gaq = a.gaq; p.gak = a.gak; p.gbq = a.gbq; p.gbk = a.gbk;
        pg8::gemm_phase<PInProj>(lds, p, wave);
        if (rep_ + 1 < NREP(2)) xcd_barrier(bar, wave);
    }
    SEAM(2);
    if (IN(3)) for (int rep_ = 0; rep_ < NREP(3); ++rep_) {
        PHASE_IDS();
        LAS float* wsf = (LAS float*)(lds + LDSCTL_OFF + 2048) + wave * 64;
        att::attn_a_phase(lds, wsf, w_QKV, w_AO, a.gaq, a.gak, vcu, wave, lane);
        att::attn_b_phase(lds, wsf, w_QKV, w_OBN, a.gbq, a.gbk, vcu, wave, lane);
        if (rep_ + 1 < NREP(3)) xcd_barrier(bar, wave);
    }
    SEAM(3);
    if (IN(4)) for (int rep_ = 0; rep_ < NREP(4); ++rep_) {
        PHASE_IDS();
        const float s1 = wave_sum(a.lq1[lane] * a.lk1[lane]), s2 = wave_sum(a.lq2[lane] * a.lk2[lane]);
        const float lam = __expf(s1) - __expf(s2) + LAMBDA_INIT;
        for (int w = gw; w < M * 4; w += NGW) {
            const int tok = w >> 2, h = w & 3;
            const float* p0 = w_OBN + (size_t)tok * 512 + h * 128 + 2 * lane; const float* p1 = p0 + (size_t)M * 512;
            const float va = p0[0] - lam * p1[0], vb = p0[1] - lam * p1[1];
            const float rstd = rsqrtf(wave_sum(va * va + vb * vb) * (1.f / 128.f) + RMS_EPS) * (1.f - LAMBDA_INIT);
            *(unsigned*)(w_AO + (size_t)tok * D + 512 + h * 128 + 2 * lane) = pk2(va * rstd * a.gd[2 * lane], vb * rstd * a.gd[2 * lane + 1]);
        }
        if (rep_ + 1 < NREP(4)) xcd_barrier(bar, wave);
    }
    SEAM(4);
    if (IN(5)) for (int rep_ = 0; rep_ < NREP(5); ++rep_) {
        PHASE_IDS();
        POutProj p; p.init(M, D, G, bx); p.AO = w_AO; p.Wt = w_Wout_t; p.x = a.x; p.mod = w_mod; p.x1 = a.out;
        pg8::gemm_phase<POutProj>(lds, p, wave);
        if (rep_ + 1 < NREP(5)) xcd_barrier(bar, wave);
    }
    SEAM(5);
    if (IN(6)) for (int rep_ = 0; rep_ < NREP(6); ++rep_) {
        PHASE_IDS();
        typedef float f32x4v __attribute__((ext_vector_type(4)));
        LAS float* Wp = (LAS float*)lds;
        LAS float* lgs = (LAS float*)(lds + LDSCTL_OFF + 4096);
        LAS float* red = (LAS float*)(lds + LDSCTL_OFF + 12288);
        LAS float* cb = (LAS float*)(lds + LDSCTL_OFF + 14336);
        LAS int* lcnt = (LAS int*)(lds + LDSCTL_OFF + 14464);
        LAS int* lbase = (LAS int*)(lds + LDSCTL_OFF + 14592);
        for (int chunk = bx; chunk < M / 64; chunk += G) {
            const int row0 = chunk * 64, b = row0 / S;
            const float* shift = w_mod + b * 6144 + 3072, *scale = w_mod + b * 6144 + 4096;
            __syncthreads();
            for (int i = tid; i < 1024 * 8; i += NTHREADS) { const int k = i >> 3, e4 = (i & 7) * 4; const float gs = a.g2[k] * (1.f + scale[k]);
                const f32x4v w = *(const f32x4v*)(a.w_router + (size_t)k * NE + e4); *(LAS f32x4v*)(Wp + k * NE + e4) = w * gs; }
            { const int e = tid & 31, kp = tid >> 5; float acc = 0.f;
              for (int k = kp * 64; k < kp * 64 + 64; ++k) acc += shift[k] * a.w_router[(size_t)k * NE + e];
              red[kp * 32 + e] = acc; }
            if (tid < 32) lcnt[tid] = 0;
            for (int rr = 0; rr < 8; ++rr) {
                const int row = row0 + wave * 8 + rr;
                const f32x4* xr = (const f32x4*)(a.out + (size_t)row * D) + lane;
                f32x4 v[4]; float ss = 0.f;
#pragma unroll
                for (int jj = 0; jj < 4; ++jj) { v[jj] = xr[64 * jj]; ss += (v[jj].x * v[jj].x + v[jj].y * v[jj].y) + (v[jj].z * v[jj].z + v[jj].w * v[jj].w); }
                const float rstd = rsqrtf(wave_sum(ss) * (1.f / D) + RMS_EPS);
#pragma unroll
                for (int jj = 0; jj < 4; ++jj) {
                    const int c0 = 4 * lane + 256 * jj;
                    const f32x4 g = *(const f32x4*)(a.g2 + c0), sc = *(const f32x4*)(scale + c0), sh = *(const f32x4*)(shift + c0);
                    const f32x4 o = v[jj] * rstd * g * (sc + 1.f) + sh;
                    u32x2 w; w.x = pk2(o.x, o.y); w.y = pk2(o.z, o.w);
                    *(u32x2*)(w_H2 + (size_t)row * D + c0) = w;
                }
            }
            __syncthreads();
            if (tid < 32) { float s_ = a.b_router[tid];
#pragma unroll
                for (int kp = 0; kp < 16; ++kp) s_ += red[kp * 32 + tid];
                cb[tid] = s_; }
            __syncthreads();
            int idx[4] = {0, 0, 0, 0}, rank[4] = {0, 0, 0, 0}; float gt[4] = {0.f, 0.f, 0.f, 0.f};
            const int tj = lane & 15, kq = lane >> 4;
            if (wave < 4) {
                const float* xp = a.out + (size_t)(row0 + 16 * wave + tj) * D + 256 * kq;
                f32x4v acc0 = {0.f, 0.f, 0.f, 0.f}, acc1 = {0.f, 0.f, 0.f, 0.f}; float ss = 0.f;
                const LAS float* wq = Wp + (256 * kq) * NE + tj;
                for (int s4 = 0; s4 < 64; ++s4) {
                    const f32x4v xv = *(const f32x4v*)(xp + 4 * s4);
                    ss += (xv.x * xv.x + xv.y * xv.y) + (xv.z * xv.z + xv.w * xv.w);
#pragma unroll
                    for (int u = 0; u < 4; ++u) { const float a0 = wq[(4 * s4 + u) * NE], a1 = wq[(4 * s4 + u) * NE + 16];
                        acc0 = __builtin_amdgcn_mfma_f32_16x16x4f32(a0, xv[u], acc0, 0, 0, 0); acc1 = __builtin_amdgcn_mfma_f32_16x16x4f32(a1, xv[u], acc1, 0, 0, 0); }
                }
                ss += __shfl_xor(ss, 16); ss += __shfl_xor(ss, 32);
                const float rstd = rsqrtf(ss * (1.f / D) + RMS_EPS);
                LAS float* lw = lgs + (wave * 16 + tj) * 32;
#pragma unroll
                for (int r = 0; r < 4; ++r) { lw[4 * kq + r] = acc0[r] * rstd + cb[4 * kq + r]; lw[16 + 4 * kq + r] = acc1[r] * rstd + cb[16 + 4 * kq + r]; }
                LDS_WAIT();
                if (lane < 16) {
                    float lg[NE];
#pragma unroll
                    for (int e = 0; e < NE; ++e) lg[e] = lgs[(wave * 16 + lane) * 32 + e];
                    float val[4];
#pragma unroll
                    for (int k = 0; k < 4; ++k) {
                        float best = -INFINITY; int bi = 0;
#pragma unroll
                        for (int e = 0; e < NE; ++e) { bool taken = false;
#pragma unroll
                            for (int kk = 0; kk < k; ++kk) taken |= (idx[kk] == e);
                            if (!taken && lg[e] > best) { best = lg[e]; bi = e; } }
                        idx[k] = bi; val[k] = best;
                    }
                    float den = 0.f;
#pragma unroll
                    for (int k = 0; k < 4; ++k) { gt[k] = __expf(val[k] - val[0]); den += gt[k]; }
                    const float rden = 1.f / den;
#pragma unroll
                    for (int k = 0; k < 4; ++k) { gt[k] *= rden; rank[k] = __hip_atomic_fetch_add(lcnt + idx[k], 1, __ATOMIC_RELAXED, __HIP_MEMORY_SCOPE_WORKGROUP); }
                }
            }
            __syncthreads();
            if (tid < 32 && rep_ == 0) lbase[tid] = atomicAdd(&w_counts[tid], lcnt[tid]);
            __syncthreads();
            if (wave < 4 && lane < 16 && rep_ == 0) {
                const int row = row0 + 16 * wave + lane;
#pragma unroll
                for (int k = 0; k < 4; ++k) { const int slot = lbase[idx[k]] + rank[k];
                    w_tope[row * 4 + k] = idx[k]; w_tops[row * 4 + k] = slot; w_topg[row * 4 + k] = gt[k]; w_list[idx[k] * M + slot] = row; }
            }
        }
        if (rep_ + 1 < NREP(6)) xcd_barrier(bar, wave);
    }
    SEAM(6);
    if (IN(7)) for (int rep_ = 0; rep_ < NREP(7); ++rep_) {
        PHASE_IDS();
        LOAD_PT();
        PGateUp p; p.init(PT, CN, 8, G, bx); p.H2 = w_H2; p.Wt = w_Wgu_t; p.bgu = a.b_gu; p.list = w_list; p.ACT = w_ACT;
        pg8::gemm_phase<PGateUp>(lds, p, wave);
        if (rep_ + 1 < NREP(7)) xcd_barrier(bar, wave);
    }
    SEAM(7);
    if (IN(8)) for (int rep_ = 0; rep_ < NREP(8); ++rep_) {
        PHASE_IDS();
        LOAD_PT();
        PDown p; p.init(PT, CN, 4, G, bx); p.ACT = w_ACT; p.Wt = w_Wd_t; p.bd = a.b_d; p.Y = w_Y;
        pg8::gemm_phase<PDown>(lds, p, wave);
        if (rep_ + 1 < NREP(8)) xcd_barrier(bar, wave);
    }
    SEAM(8);
    if (IN(9)) for (int rep_ = 0; rep_ < NREP(9); ++rep_) {
        PHASE_IDS();
        LOAD_PT();
        for (int row = gw; row < M; row += NGW) {
            const int b = row / S;
            const float* gate2 = w_mod + b * 6144 + 5120;
            const bf16_t* yr[4]; float gk[4];
#pragma unroll
            for (int k = 0; k < 4; ++k) { yr[k] = w_Y + (size_t)(PT[w_tope[row * 4 + k]] * 256 + w_tops[row * 4 + k]) * D; gk[k] = w_topg[row * 4 + k]; }
#pragma unroll
            for (int j = 0; j < 4; ++j) {
                const int c0 = 4 * lane + 256 * j;
                f32x4 acc = (f32x4){0.f, 0.f, 0.f, 0.f};
#pragma unroll
                for (int k = 0; k < 4; ++k) { const u32x2 w = *(const u32x2*)(yr[k] + c0);
                    acc.x += gk[k] * __uint_as_float(w.x << 16); acc.y += gk[k] * __uint_as_float(w.x & 0xffff0000u);
                    acc.z += gk[k] * __uint_as_float(w.y << 16); acc.w += gk[k] * __uint_as_float(w.y & 0xffff0000u); }
                const f32x4 g = *(const f32x4*)(gate2 + c0);
                f32x4* op = (f32x4*)(a.out + (size_t)row * D + c0);
                *op = *op + g * acc;
            }
        }
    }
#undef IN
#undef PHASE_IDS
#undef SEAM
#undef LOAD_PT
#undef w_counts
#undef w_mod
#undef w_Win_t
#undef w_Wout_t
#undef w_Wgu_t
#undef w_Wd_t
#undef w_XN
#undef w_QKV
#undef w_AO
#undef w_H2
#undef w_tope
#undef w_tops
#undef w_topg
#undef w_list
#undef w_ACT
#undef w_Y
#undef w_OBN
}

#ifndef RUN_MODE
#define RUN_MODE 1
#endif
#ifndef PH_MASK
#define PH_MASK 0x3ff
#endif
extern "C" void kernel_launch(void* const* d_in, const int* in_sizes, int n_in, void* d_out, int out_size, void* d_ws, size_t ws_size, hipStream_t stream) {
    static int grid = 0;
    if (grid == 0) {
        if (n_in != 23 || out_size != M * D || ws_size < WS_END) { fprintf(stderr, "kernel_launch: unexpected problem (n_in %d out %d ws %zu)\n", n_in, out_size, ws_size); grid = -1; return; }
        int dev = 0, cus = 0;
        if (hipGetDevice(&dev) != hipSuccess || hipDeviceGetAttribute(&cus, hipDeviceAttributeMultiprocessorCount, dev) != hipSuccess) { grid = -1; return; }
        if (hipFuncSetAttribute((const void*)mega, hipFuncAttributeMaxDynamicSharedMemorySize, LDS_BYTES) != hipSuccess) { fprintf(stderr, "kernel_launch: hipFuncSetAttribute failed\n"); grid = -1; return; }
        int per_cu = 0;
        if (hipOccupancyMaxActiveBlocksPerMultiprocessor(&per_cu, (const void*)mega, NTHREADS, LDS_BYTES) != hipSuccess || per_cu < 1) fprintf(stderr, "kernel_launch: occupancy query says %d blocks/CU\n", per_cu);
        (void)hipGetLastError();
        grid = cus;
    }
    if (grid < 0) return;
    const float* x = (const float*)d_in[0]; const float* c = (const float*)d_in[1]; const float* w_ada = (const float*)d_in[2]; const float* b_ada = (const float*)d_in[3];
    const float* g1 = (const float*)d_in[4]; const float* w_in = (const float*)d_in[5];
    const float* gaq = (const float*)d_in[6]; const float* gak = (const float*)d_in[7]; const float* gbq = (const float*)d_in[8]; const float* gbk = (const float*)d_in[9];
    const float* lq1 = (const float*)d_in[10]; const float* lk1 = (const float*)d_in[11]; const float* lq2 = (const float*)d_in[12]; const float* lk2 = (const float*)d_in[13];
    const float* gd = (const float*)d_in[14]; const float* w_out = (const float*)d_in[15]; const float* g2 = (const float*)d_in[16];
    const float* w_router = (const float*)d_in[17]; const float* b_router = (const float*)d_in[18];
    const float* w_gu = (const float*)d_in[19]; const float* b_gu = (const float*)d_in[20]; const float* w_d = (const float*)d_in[21]; const float* b_d = (const float*)d_in[22];
    unsigned char* ws = (unsigned char*)d_ws; float* out = (float*)d_out;
    int* counts = (int*)(ws + WS_CTL + CTL_COUNTS); int* padstart = (int*)(ws + WS_CTL + CTL_PADSTART); float* mod = (float*)(ws + WS_CTL + CTL_MOD);
    bf16_t* Win_t = (bf16_t*)(ws + WS_WIN); bf16_t* Wout_t = (bf16_t*)(ws + WS_WOUT); bf16_t* Wgu_t = (bf16_t*)(ws + WS_WGU); bf16_t* Wd_t = (bf16_t*)(ws + WS_WD);
    bf16_t* XN = (bf16_t*)(ws + WS_XN); bf16_t* QKV = (bf16_t*)(ws + WS_QKV); bf16_t* AO = (bf16_t*)(ws + WS_AO); bf16_t* H2 = (bf16_t*)(ws + WS_H2);
    int* tope = (int*)(ws + WS_TOPE); int* tops = (int*)(ws + WS_TOPS); float* topg = (float*)(ws + WS_TOPG); int* list = (int*)(ws + WS_LIST);
    bf16_t* ACT = (bf16_t*)(ws + WS_ACT); bf16_t* Y = (bf16_t*)(ws + WS_Y); float* OBN = (float*)(ws + WS_OBN);

    (void)hipMemsetAsync(ws + WS_CTL, 0, CTL_BYTES, stream);
    MArgs a{};
    a.x = x; a.c = c; a.w_ada = w_ada; a.b_ada = b_ada; a.g1 = g1; a.w_in = w_in; a.gaq = gaq; a.gak = gak; a.gbq = gbq; a.gbk = gbk; a.lq1 = lq1; a.lk1 = lk1; a.lq2 = lq2; a.lk2 = lk2;
    a.gd = gd; a.w_out = w_out; a.g2 = g2; a.w_router = w_router; a.b_router = b_router; a.w_gu = w_gu; a.b_gu = b_gu; a.w_d = w_d; a.b_d = b_d; a.out = out; a.ws = ws;
    if (RUN_MODE == 1) { a.ph_lo = 0; a.ph_hi = NPHASE; hipLaunchKernelGGL(mega, dim3(grid), dim3(NTHREADS), LDS_BYTES, stream, a); return; }
    const unsigned mask = (RUN_MODE == 0) ? 0u : (RUN_MODE == 2) ? 0x3ffu : (unsigned)PH_MASK;
    for (int ph = 0; ph < NPHASE; ++ph) {
        if (mask & (1u << ph)) { a.ph_lo = ph; a.ph_hi = ph + 1; hipLaunchKernelGGL(mega, dim3(grid), dim3(NTHREADS), LDS_BYTES, stream, a); }
        else switch (ph) {
            case 0:
                k_transpose<<<(1024 / 64) * (3072 / 64), 256, 0, stream>>>(w_in, Win_t, 1024, 3072);
                k_transpose<<<(1024 / 64) * (1024 / 64), 256, 0, stream>>>(w_out, Wout_t, 1024, 1024);
                k_transpose<<<32 * (1024 / 64) * (2048 / 64), 256, 0, stream>>>(w_gu, Wgu_t, 1024, 2048);
                k_transpose<<<32 * (1024 / 64) * (1024 / 64), 256, 0, stream>>>(w_d, Wd_t, 1024, 1024);
                k_adaln<<<dim3(24, 16), 256, 0, stream>>>(c, w_ada, b_ada, mod); break;
            case 1: k_xn<<<M / 4, 256, 0, stream>>>(x, g1, mod, XN); break;
            case 2: { InProj p{XN, Win_t, QKV, gaq, gak, gbq, gbk}; k_gemm<InProj><<<128 * 24, 256, 0, stream>>>(p); } break;
            case 3: k_attn_a<<<NB * 8 * S / 256, 256, 0, stream>>>(QKV, AO); k_attn_b<<<NB * 4 * 2 * 2 * S / 256, 256, 0, stream>>>(QKV, OBN); break;
            case 4: k_diff_combine<<<M * 4 / 4, 256, 0, stream>>>(OBN, lq1, lk1, lq2, lk2, gd, AO); break;
            case 5: { OutProj p{AO, Wout_t, x, mod, out}; k_gemm<OutProj><<<128 * 8, 256, 0, stream>>>(p); } break;
            case 6: k_router<<<M / 4, 256, 0, stream>>>(out, g2, mod, w_router, b_router, H2, counts, tope, tops, topg, list); break;
            case 7: { GateUp p{H2, Wgu_t, b_gu, counts, padstart, list, ACT}; k_gemm<GateUp><<<32 * 128 * 16, 256, 0, stream>>>(p); } break;
            case 8: { Down p{ACT, Wd_t, b_d, counts, padstart, Y}; k_gemm<Down><<<32 * 128 * 8, 256, 0, stream>>>(p); } break;
            case 9: k_combine<<<M / 4, 256, 0, stream>>>(out, mod, Y, tope, tops, topg, padstart); break;
        }
        if (ph == 6) k_padstart<<<1, 64, 0, stream>>>(counts, padstart);
    }
}
```

```cpp
#include <hip/hip_runtime.h>
#include <cstdio>
#include <cstdint>

typedef unsigned short bf16_t;
typedef short bf16x8 __attribute__((ext_vector_type(8)));
typedef float f32x4 __attribute__((ext_vector_type(4)));
typedef unsigned u32x4 __attribute__((ext_vector_type(4)));
typedef unsigned u32x2 __attribute__((ext_vector_type(2)));

constexpr int D = 1024, NB = 8, S = 2048, M = NB * S;
constexpr int NIN = 3072, NE = 32, TOPK = 4, DFF = 1024;
constexpr int NASSIGN = M * TOPK;
constexpr int PADROWS = NASSIGN + NE * 256;
constexpr float RMS_EPS = 1e-6f;
constexpr float LOG2E = 1.4426950408889634f;
constexpr float QSCALE = 0.125f * LOG2E;
constexpr float LAMBDA_INIT = 0.2f;

constexpr size_t MiB = 1u << 20;
constexpr size_t WS_CTL = 0;
constexpr size_t CTL_BYTES = 1 * MiB;
constexpr size_t CTL_COUNTS = 0;
constexpr size_t CTL_PADSTART = 256;
constexpr size_t CTL_MOD = 64 * 1024;
constexpr size_t WS_WIN = 2 * MiB;
constexpr size_t WS_WOUT = 8 * MiB;
constexpr size_t WS_WGU = 10 * MiB;
constexpr size_t WS_WD = 138 * MiB;
constexpr size_t WS_XN = 202 * MiB;
constexpr size_t WS_QKV = 234 * MiB;
constexpr size_t WS_AO = 330 * MiB;
constexpr size_t WS_H2 = 362 * MiB;
constexpr size_t WS_TOPE = 394 * MiB;
constexpr size_t WS_TOPS = 395 * MiB;
constexpr size_t WS_TOPG = 396 * MiB;
constexpr size_t WS_LIST = 397 * MiB;
constexpr size_t WS_ACT = 400 * MiB;
constexpr size_t WS_Y = 544 * MiB;
constexpr size_t WS_OBN = 688 * MiB;
constexpr size_t WS_END = 752 * MiB;

__device__ __forceinline__ bf16_t f2bf(float f) { unsigned u = __float_as_uint(f); return (bf16_t)((u + 0x7fffu + ((u >> 16) & 1u)) >> 16); }
__device__ __forceinline__ float bf2f(bf16_t h) { return __uint_as_float(((unsigned)h) << 16); }
__device__ __forceinline__ unsigned pk2(float lo, float hi) { return (unsigned)f2bf(lo) | ((unsigned)f2bf(hi) << 16); }
__device__ __forceinline__ float wave_sum(float v) {
#pragma unroll
    for (int o = 1; o < 64; o <<= 1) v += __shfl_xor(v, o);
    return v;
}


#define LAS __attribute__((address_space(3)))
#define GAS __attribute__((address_space(1)))
#define RLX_AGENT __ATOMIC_RELAXED, __HIP_MEMORY_SCOPE_AGENT
#define LDS_WAIT() asm volatile("s_waitcnt lgkmcnt(0)" ::: "memory")
#define VM_WAIT() asm volatile("s_waitcnt vmcnt(0)" ::: "memory")

constexpr int NWAVES = 8, NTHREADS = 512;
constexpr int RING_BYTES = 131072, LDSCTL_OFF = RING_BYTES, MISC_OFF = LDSCTL_OFF + 320, PT_OFF = LDSCTL_OFF + 512, CNT_OFF = LDSCTL_OFF + 768, LDS_BYTES = 147456;
constexpr size_t CTL_BAR = 16384;
constexpr int NPHASE = 10;
constexpr float W8_SCALE = 512.f, H2_SCALE = 16.f, ACT_SCALE = 8.f;

#define XB_TMO      128
#define XB_XCNT(j)  (256  + 64 * (j))
#define XB_XSUB(j)  (1280 + 64 * (j))
#define XB_XGEN(j)  (2304 + 64 * (j))
#define XB_TOP      3328
#define XB_TOPGEN   3392
#define XCD_BAR_WORDS 3456
#define XB_SPIN_CAP (1u << 22)
__device__ __forceinline__ unsigned xb_ld(unsigned* p)              { return __hip_atomic_load(p, __ATOMIC_RELAXED, __HIP_MEMORY_SCOPE_AGENT); }
__device__ __forceinline__ unsigned xb_add(unsigned* p, unsigned v) { return __hip_atomic_fetch_add(p, v, __ATOMIC_RELAXED, __HIP_MEMORY_SCOPE_AGENT); }
__device__ __forceinline__ unsigned xb_xcc_id() { return (unsigned)__builtin_amdgcn_s_getreg((3 << 11) | 20) & 0xFu; }
#define XB_SPIN(cond, bar) do { unsigned _sp = 0; while (cond) { __builtin_amdgcn_s_sleep(1); \
    if ((++_sp & 255u) == 0u) { if (xb_ld(&(bar)[XB_TMO])) break; if (_sp > XB_SPIN_CAP) { atomicAdd(&(bar)[XB_TMO], 1u); break; } } } } while (0)
struct XcdBarrier { unsigned* bar; unsigned x; volatile LAS unsigned* st; };
__device__ __forceinline__ XcdBarrier xcd_barrier_post(unsigned* bar, volatile LAS unsigned* st) {
    XcdBarrier b; b.bar = bar; b.x = xb_xcc_id(); b.st = st;
    if (threadIdx.x == 0) (void)xb_add(&bar[XB_XCNT(b.x)], 1u);
    return b;
}
__device__ __forceinline__ void xcd_barrier_complete(unsigned* bar, unsigned x, unsigned& nloc, unsigned& nx) {
    const unsigned G = gridDim.x * gridDim.y * gridDim.z;
    unsigned sum, cnt, mine, sp = 0u;
    for (;;) {
        sum = 0u; cnt = 0u; mine = 0u;
#pragma unroll
        for (unsigned j = 0; j < 16; ++j) { const unsigned c = xb_ld(&bar[XB_XCNT(j)]); sum += c; cnt += (c > 0u) ? 1u : 0u; mine = (j == x) ? c : mine; }
        if (sum == G) break;
        __builtin_amdgcn_s_sleep(1);
        if ((++sp & 255u) == 0u) { if (xb_ld(&bar[XB_TMO])) break; if (sp > XB_SPIN_CAP) { atomicAdd(&bar[XB_TMO], 1u); break; } }
    }
    nloc = mine > 0u ? mine : 1u; nx = cnt > 0u ? cnt : 1u;
}
__device__ __forceinline__ void xcd_barrier(const XcdBarrier& b, int wave) {
    asm volatile("s_waitcnt vmcnt(0)" ::: "memory");
    __syncthreads();
    if (wave == 0 && __builtin_amdgcn_mbcnt_hi(~0u, __builtin_amdgcn_mbcnt_lo(~0u, 0u)) == 0u) {
        unsigned* bar = b.bar;
        __builtin_amdgcn_s_waitcnt(0);
        unsigned nloc = b.st[0], nx = b.st[1];
        if (nloc == 0u) { xcd_barrier_complete(bar, b.x, nloc, nx); b.st[0] = nloc; b.st[1] = nx; }
        const unsigned old = xb_add(&bar[XB_XSUB(b.x)], 1u);
        const unsigned gen = old / nloc;
        if (old + 1u == (gen + 1u) * nloc) {
            __builtin_amdgcn_fence(__ATOMIC_RELEASE, "agent");
            asm volatile("s_waitcnt vmcnt(0)" ::: "memory");
            const unsigned og = xb_add(&bar[XB_TOP], 1u);
            const unsigned tg = og / nx;
            if (og + 1u == (tg + 1u) * nx) xb_add(&bar[XB_TOPGEN], 1u);
            else XB_SPIN(xb_ld(&bar[XB_TOPGEN]) == tg, bar);
            __builtin_amdgcn_fence(__ATOMIC_ACQUIRE, "agent");
            xb_add(&bar[XB_XGEN(b.x)], 1u);
            asm volatile("s_waitcnt vmcnt(0)" ::: "memory");
        } else {
            XB_SPIN(xb_ld(&bar[XB_XGEN(b.x)]) == gen, bar);
            __builtin_amdgcn_fence(__ATOMIC_ACQUIRE, "agent");
            asm volatile("s_waitcnt vmcnt(0)" ::: "memory");
        }
    }
    __syncthreads();
}

namespace pg8 {
constexpr int BM = 256, BK = 64, HALF = 128, HTB = HALF * BK * 2, STAGE_BYTES = 8 * HTB, NXCD = 8, WGM = 8;
__host__ __device__ __forceinline__ int lds_byte(int r, int c) { const int st = (r >> 4) * 2 + (c >> 5), rr = r & 15, cc = c & 31, ob = rr * 64 + cc * 2; return st * 1024 + (ob ^ (((ob >> 9) & 1) << 5)); }
__host__ __device__ __forceinline__ void stage_rc(int b, int& R, int& C) { const int st = b / 1024, sb = b % 1024, swz = sb ^ (((sb >> 9) & 1) << 5); R = (st >> 1) * 16 + swz / 64; C = (st & 1) * 32 + (swz % 64) / 2; }
constexpr __host__ __device__ __forceinline__ int perm32(int rho) { const int n = rho >> 4, i = rho & 15; return 8 * (i >> 2) + 4 * n + (i & 3); }
__device__ __forceinline__ unsigned cvt_pk_bf16(float lo, float hi) { unsigned r; asm volatile("v_cvt_pk_bf16_f32 %0, %1, %2" : "=v"(r) : "v"(lo), "v"(hi)); return r; }

typedef int v4i_t __attribute__((ext_vector_type(4))); typedef int v8i_t __attribute__((ext_vector_type(8)));
__device__ __forceinline__ v8i_t cat8(bf16x8 lo, bf16x8 hi) { const v4i_t a = __builtin_bit_cast(v4i_t, lo), b = __builtin_bit_cast(v4i_t, hi); return __builtin_shufflevector(a, b, 0, 1, 2, 3, 4, 5, 6, 7); }
__device__ __forceinline__ unsigned pk4_fp8(float a, float b, float c, float d) { int w = 0; w = __builtin_amdgcn_cvt_pk_fp8_f32(a, b, w, false); w = __builtin_amdgcn_cvt_pk_fp8_f32(c, d, w, true); return (unsigned)w; }
struct Unit { int pm, pn, e, cnt; };

template <class P>
__device__ __forceinline__ void gemm_phase(LAS unsigned char* lds, const P& p, int wid) {
    int lane = (int)__builtin_amdgcn_mbcnt_hi(~0u, __builtin_amdgcn_mbcnt_lo(~0u, 0u)); asm volatile("" : "+v"(lane));
    const int tid = wid * 64 + lane, wr = wid >> 2, wc = wid & 3, fr = lane & 15, fq = lane >> 4;
    constexpr int K = P::K, nt = K / BK;
    int Rr[2], Cc[2];
#pragma unroll
    for (int i = 0; i < 2; ++i) stage_rc(tid * 16 + i * 8192, Rr[i], Cc[i]);
    unsigned voffB[2], voffA[2][2];
#pragma unroll
    for (int i = 0; i < 2; ++i) { voffB[i] = (unsigned)(P::brow(0, Rr[i]) * K + Cc[i]) * 2u; voffA[0][i] = (unsigned)(Rr[i] * K + Cc[i]) * 2u; voffA[1][i] = voffA[0][i]; }
    constexpr size_t hB = (size_t)(P::brow(1, 0) - P::brow(0, 0)) * K * 2, hA = P::GATHER ? 0 : (size_t)HALF * K * 2;
    LAS unsigned* vpark = (LAS unsigned*)(lds + STAGE_BYTES + 4096) + tid * 4;
    const size_t kstep = (size_t)(BK * 2);
    const unsigned ldsw = (unsigned)wid * 1024u;
    const int aoff = lds_byte(wr * 64 + fr, fq * 8), boff = lds_byte(wc * 32 + fr, fq * 8);
#define PG8_SA(b, h) (((b) * 2 + (h)) * HTB)
#define PG8_SB(b, h) ((4 + (b) * 2 + (h)) * HTB)
#define PG8_STAGE(bufoff, gbase, voff) do { _Pragma("unroll") for (int _i = 0; _i < 2; ++_i) { unsigned _v = (voff)[_i]; asm volatile("" : "+v"(_v));     \
        __builtin_amdgcn_global_load_lds((const unsigned*)((const char*)(gbase) + _v), (LAS unsigned*)(lds + (bufoff) + ldsw + _i * 8192), 16, 0, 0); } } while (0)
#define PG8_STAGE_A(b, h, gbase) PG8_STAGE(PG8_SA(b, h), (gbase) + (h) * hA, voffA[P::GATHER ? (h) : 0])
#define PG8_STAGE_B(b, h, gbase) PG8_STAGE(PG8_SB(b, h), (gbase) + (h) * hB, voffB)
#define PG8_LDA(dst, b, h) do { _Pragma("unroll") for (int m = 0; m < 4; ++m) _Pragma("unroll") for (int k = 0; k < 2; ++k) dst[m][k] = *(const LAS bf16x8*)(lds + PG8_SA(b, h) + aoff + m * 2048 + k * 1024); } while (0)
#define PG8_LDB(dst, b, h) do { _Pragma("unroll") for (int n = 0; n < 2; ++n) _Pragma("unroll") for (int k = 0; k < 2; ++k) dst[n][k] = *(const LAS bf16x8*)(lds + PG8_SB(b, h) + boff + n * 2048 + k * 1024); } while (0)
#define PG8_MMA(ai, bj, At, Bt) do { __builtin_amdgcn_s_setprio(1); if constexpr (P::FP8) { _Pragma("unroll") for (int m = 0; m < 4; ++m) _Pragma("unroll") for (int n = 0; n < 2; ++n) \
        acc[ai][bj][m][n] = __builtin_amdgcn_mfma_scale_f32_16x16x128_f8f6f4(cat8(Bt[n][0], Bt[n][1]), cat8(At[m][0], At[m][1]), acc[ai][bj][m][n], 0, 0, 0, 0x7f7f7f7f, 0, 0x7f7f7f7f); } else { \
        _Pragma("unroll") for (int m = 0; m < 4; ++m) _Pragma("unroll") for (int n = 0; n < 2; ++n) _Pragma("unroll") for (int k = 0; k < 2; ++k) \
        acc[ai][bj][m][n] = __builtin_amdgcn_mfma_f32_16x16x32_bf16(Bt[n][k], At[m][k], acc[ai][bj][m][n], 0, 0, 0); } __builtin_amdgcn_s_setprio(0); } while (0)
#define PG8_WAIT_V(n) asm volatile("s_waitcnt vmcnt(" #n ")" ::: "memory")
#define PG8_WAIT_L(n) asm volatile("s_waitcnt lgkmcnt(" #n ")" ::: "memory")
#define PG8_BAR __builtin_amdgcn_s_barrier()
#define PG8_SCHED __builtin_amdgcn_sched_barrier(0)
    Unit cur, nxt; int ui = 0;
    if (!p.next(0, cur)) return;
    f32x4 acc[2][2][4][2];
#pragma unroll
    for (int a = 0; a < 2; ++a)
#pragma unroll
        for (int b = 0; b < 2; ++b)
#pragma unroll
            for (int m = 0; m < 4; ++m)
#pragma unroll
                for (int n = 0; n < 2; ++n) acc[a][b][m][n] = (f32x4){0.f, 0.f, 0.f, 0.f};
    bf16x8 At[4][2], B0[2][2], B1[2][2];
    const char* cA = p.a_base(cur); const char* cB = p.b_base(cur);
    if constexpr (P::GATHER) p.a_offsets(cur, Rr, Cc, voffA);
    PG8_STAGE_B(0, 0, cB); PG8_STAGE_B(0, 1, cB); PG8_STAGE_A(0, 0, cA); PG8_STAGE_A(0, 1, cA);
    if (wr == 1) PG8_BAR;
    PG8_WAIT_V(2); PG8_BAR;
    PG8_STAGE_B(1, 0, cB + kstep); PG8_STAGE_A(1, 0, cA + kstep); PG8_STAGE_B(1, 1, cB + kstep);
    PG8_WAIT_V(6); PG8_BAR;
    for (;;) {
        const bool has_next = p.next(ui + 1, nxt);
        const char* nA = has_next ? p.a_base(nxt) : cA; const char* nB = has_next ? p.b_base(nxt) : cB;
        if constexpr (P::GATHER) {
            unsigned vn[2][2];
            if (has_next) p.a_offsets(nxt, Rr, Cc, vn); else {
#pragma unroll
                for (int h = 0; h < 2; ++h)
#pragma unroll
                    for (int i = 0; i < 2; ++i) vn[h][i] = voffA[h][i]; }
            vpark[0] = vn[0][0]; vpark[1] = vn[0][1]; vpark[2] = vn[1][0]; vpark[3] = vn[1][1];
        }
#pragma nounroll
        for (int t = 0; t < nt; t += 2) {
            const bool last = (t == nt - 2);
            const char* a1 = cA + (size_t)(t + 1) * kstep;
            const char* a2 = last ? nA : cA + (size_t)(t + 2) * kstep; const char* b2 = last ? nB : cB + (size_t)(t + 2) * kstep;
            const char* a3 = a2 + kstep; const char* b3 = b2 + kstep;
            PG8_LDB(B0, 0, 0); PG8_LDB(B1, 0, 1); PG8_SCHED; PG8_LDA(At, 0, 0); PG8_STAGE_A(1, 1, a1);
            if constexpr (P::GATHER) { if (last) { voffA[0][0] = vpark[0]; voffA[0][1] = vpark[1]; voffA[1][0] = vpark[2]; voffA[1][1] = vpark[3]; } }
            PG8_WAIT_V(8); PG8_WAIT_L(0); PG8_BAR; PG8_MMA(0, 0, At, B0); PG8_MMA(0, 1, At, B1); PG8_BAR; PG8_SCHED;
            PG8_LDA(At, 0, 1); PG8_STAGE_B(0, 0, b2); PG8_STAGE_B(0, 1, b2); PG8_STAGE_A(0, 0, a2);
            PG8_WAIT_V(8); PG8_WAIT_L(0); PG8_BAR; PG8_MMA(1, 0, At, B0); PG8_MMA(1, 1, At, B1); PG8_BAR; PG8_SCHED;
            PG8_LDB(B0, 1, 0); PG8_LDB(B1, 1, 1); PG8_SCHED; PG8_LDA(At, 1, 0); PG8_STAGE_A(0, 1, a2);
            PG8_WAIT_V(8); PG8_WAIT_L(0); PG8_BAR; PG8_MMA(0, 0, At, B0); PG8_MMA(0, 1, At, B1); PG8_BAR; PG8_SCHED;
            PG8_LDA(At, 1, 1); PG8_STAGE_B(1, 0, b3); PG8_STAGE_B(1, 1, b3); PG8_STAGE_A(1, 0, a3);
            PG8_WAIT_V(8); PG8_WAIT_L(0); PG8_BAR; PG8_MMA(1, 0, At, B0); PG8_MMA(1, 1, At, B1); PG8_BAR; PG8_SCHED;
        }
        if (wr == 0) PG8_BAR;
        p.epi(acc, cur, wr, wc, fr, fq);
        if (!has_next) break;
#pragma unroll
        for (int a = 0; a < 2; ++a)
#pragma unroll
            for (int b = 0; b < 2; ++b)
#pragma unroll
                for (int m = 0; m < 4; ++m)
#pragma unroll
                    for (int n = 0; n < 2; ++n) acc[a][b][m][n] = (f32x4){0.f, 0.f, 0.f, 0.f};
        cur = nxt; cA = nA; cB = nB; ++ui;
        if (wr == 1) PG8_BAR;
    }
    PG8_WAIT_V(0);
    PG8_BAR;
#undef PG8_SA
#undef PG8_SB
#undef PG8_STAGE
#undef PG8_STAGE_A
#undef PG8_STAGE_B
#undef PG8_LDA
#undef PG8_LDB
#undef PG8_MMA
#undef PG8_WAIT_V
#undef PG8_WAIT_L
#undef PG8_BAR
#undef PG8_SCHED
}

struct DenseOrder {
    int nM, nN, nwg, G, c;
    __device__ void init(int M_, int N_, int G_, int c_) { nM = M_ / BM; nN = N_ / BM; nwg = nM * nN; G = G_; c = c_; }
    __device__ bool next(int i, Unit& u) const {
        const long L = (long)i * G + c; if (L >= nwg) return false;
        int wgid = (int)L; { const int q = nwg / NXCD, r = nwg % NXCD, xcd = wgid % NXCD, off = wgid / NXCD; wgid = (xcd < r ? xcd * (q + 1) : r * (q + 1) + (xcd - r) * q) + off; }
        const int nig = WGM * nN, gid = wgid / nig, fm = gid * WGM, gsz = (nM - fm) < WGM ? (nM - fm) : WGM;
        u.pm = fm + ((wgid % nig) % gsz); u.pn = (wgid % nig) / gsz; u.e = 0; u.cnt = 0; return true;
    }
};
struct GroupOrder {
    const LAS int* pt; const LAS int* cn; LAS int* ul; int npn, total, G, c;
    __device__ void init(const LAS int* pt_, const LAS int* cn_, LAS int* ul_, int npn_, int G_, int c_) { pt = pt_; cn = cn_; ul = ul_; npn = npn_; total = __builtin_amdgcn_readfirstlane(pt_[NE] * npn_); G = G_; c = c_; }
    __device__ void build(int wave, int lane) const {
        if (wave == 0 && lane < 16) {
            const long L = (long)lane * G + c; int pm = -1, pn = 0, e = 0, cnt = 0;
            if (L < total) {
                int wgid = (int)L; { const int q = total / NXCD, r = total % NXCD, xcd = wgid % NXCD, off = wgid / NXCD; wgid = (xcd < r ? xcd * (q + 1) : r * (q + 1) + (xcd - r) * q) + off; }
                for (int j = 1; j < NE; ++j) e += (pt[j] * npn <= wgid) ? 1 : 0;
                const int t0 = pt[e], te = pt[e + 1] - t0, local = wgid - t0 * npn, mt = local % te;
                pn = local / te; pm = t0 + mt; cnt = cn[e] - mt * 256;
            }
            ul[lane * 4 + 0] = pm; ul[lane * 4 + 1] = pn; ul[lane * 4 + 2] = e; ul[lane * 4 + 3] = cnt;
        }
    }
    __device__ bool next(int i, Unit& u) const {
        if (i >= 16) return false;
        u.pm = __builtin_amdgcn_readfirstlane(ul[i * 4 + 0]); u.pn = __builtin_amdgcn_readfirstlane(ul[i * 4 + 1]);
        u.e = __builtin_amdgcn_readfirstlane(ul[i * 4 + 2]); u.cnt = __builtin_amdgcn_readfirstlane(ul[i * 4 + 3]);
        return u.pm >= 0;
    }
};
}

struct PInProj : pg8::DenseOrder {
    static constexpr int K = 1024; static constexpr bool GATHER = false, FP8 = false;
    const bf16_t* XN; const bf16_t* Wt; bf16_t* QKV; const float *gaq, *gak, *gbq, *gbk;
    static constexpr __host__ __device__ __forceinline__ int brow(int bj, int R) { return 64 * (R >> 5) + 32 * bj + pg8::perm32(R & 31); }
    __device__ __forceinline__ const char* a_base(const pg8::Unit& u) const { return (const char*)(XN + (size_t)u.pm * 256 * K); }
    __device__ __forceinline__ const char* b_base(const pg8::Unit& u) const { return (const char*)(Wt + (size_t)u.pn * 256 * K); }
    __device__ __forceinline__ void epi(const f32x4 (&acc)[2][2][4][2], const pg8::Unit& u, int wr, int wc, int fr, int fq) const {
        const int ty = u.pn >> 1;
        const float* g = (ty == 0) ? gaq : (ty == 1) ? gak : (ty == 3) ? gbq : (ty == 4) ? gbk : nullptr;
        const float post = (ty == 0 || ty == 3) ? QSCALE : 1.f;
        const int row0 = u.pm * 256 + wr * 64 + fr, col0 = u.pn * 256 + wc * 64 + 8 * fq;
        f32x4 gv[2][2];
#pragma unroll
        for (int bj = 0; bj < 2; ++bj)
#pragma unroll
            for (int n = 0; n < 2; ++n) gv[bj][n] = g ? *(const f32x4*)(g + 32 * bj + 8 * fq + 4 * n) : (f32x4){1.f, 1.f, 1.f, 1.f};
#pragma unroll
        for (int ai = 0; ai < 2; ++ai)
#pragma unroll
            for (int m = 0; m < 4; ++m) {
                float rs = 1.f;
                if (g) {
                    float ss = 0.f;
#pragma unroll
                    for (int bj = 0; bj < 2; ++bj)
#pragma unroll
                        for (int n = 0; n < 2; ++n) { const f32x4 v = acc[ai][bj][m][n]; ss += (v[0] * v[0] + v[1] * v[1]) + (v[2] * v[2] + v[3] * v[3]); }
                    ss += __shfl_xor(ss, 16); ss += __shfl_xor(ss, 32);
                    rs = rsqrtf(ss * (1.f / 64.f) + RMS_EPS) * post;
                }
                bf16_t* rowp = QKV + (size_t)(row0 + ai * 128 + m * 16) * NIN + col0;
#pragma unroll
                for (int bj = 0; bj < 2; ++bj) {
                    const f32x4 v0 = acc[ai][bj][m][0] * gv[bj][0] * rs, v1 = acc[ai][bj][m][1] * gv[bj][1] * rs;
                    u32x4 w; w.x = pg8::cvt_pk_bf16(v0[0], v0[1]); w.y = pg8::cvt_pk_bf16(v0[2], v0[3]); w.z = pg8::cvt_pk_bf16(v1[0], v1[1]); w.w = pg8::cvt_pk_bf16(v1[2], v1[3]);
                    *(u32x4*)(rowp + 32 * bj) = w;
                }
            }
    }
};
struct POutProj : pg8::DenseOrder {
    static constexpr int K = 1024; static constexpr bool GATHER = false, FP8 = false;
    const bf16_t* AO; const bf16_t* Wt; const float* x; const float* mod; float* x1;
    static constexpr __host__ __device__ __forceinline__ int brow(int bj, int R) { return 128 * bj + R; }
    __device__ __forceinline__ const char* a_base(const pg8::Unit& u) const { return (const char*)(AO + (size_t)u.pm * 256 * K); }
    __device__ __forceinline__ const char* b_base(const pg8::Unit& u) const { return (const char*)(Wt + (size_t)u.pn * 256 * K); }
    __device__ __forceinline__ void epi(const f32x4 (&acc)[2][2][4][2], const pg8::Unit& u, int wr, int wc, int fr, int fq) const {
        const int row0 = u.pm * 256 + wr * 64 + fr, col0 = u.pn * 256 + wc * 32 + 4 * fq;
        const float* gate1 = mod + ((u.pm * 256) / S) * 6144 + 2048;
        f32x4 gv[2][2];
#pragma unroll
        for (int bj = 0; bj < 2; ++bj)
#pragma unroll
            for (int n = 0; n < 2; ++n) gv[bj][n] = *(const f32x4*)(gate1 + col0 + bj * 128 + n * 16);
#pragma unroll
        for (int ai = 0; ai < 2; ++ai)
#pragma unroll
            for (int m = 0; m < 4; ++m) { const size_t off = (size_t)(row0 + ai * 128 + m * 16) * D + col0;
#pragma unroll
                for (int bj = 0; bj < 2; ++bj)
#pragma unroll
                    for (int n = 0; n < 2; ++n) { const f32x4 xv = *(const f32x4*)(x + off + bj * 128 + n * 16); *(f32x4*)(x1 + off + bj * 128 + n * 16) = xv + gv[bj][n] * acc[ai][bj][m][n]; }
                if (m & 1) asm volatile("" ::: "memory"); }
    }
};
struct PGateUp : pg8::GroupOrder {
    static constexpr int K = 512; static constexpr bool GATHER = true, FP8 = true;
    const bf16_t* H2; const bf16_t* Wt; const float* bgu; const int* list; bf16_t* ACT;
    static constexpr __host__ __device__ __forceinline__ int brow(int bj, int R) { return 1024 * bj + (R & ~31) + pg8::perm32(R & 31); }
    __device__ __forceinline__ const char* a_base(const pg8::Unit&) const { return (const char*)H2; }
    __device__ __forceinline__ const char* b_base(const pg8::Unit& u) const { return (const char*)(Wt + ((size_t)u.e * 2048 + u.pn * 128) * K); }
    __device__ __forceinline__ void a_offsets(const pg8::Unit& u, const int (&R)[2], const int (&C)[2], unsigned (&voff)[2][2]) const {
        const int* lp = list + (size_t)u.e * M + (size_t)(u.pm - pt[u.e]) * 256;
#pragma unroll
        for (int h = 0; h < 2; ++h)
#pragma unroll
            for (int i = 0; i < 2; ++i) { int r = h * 128 + R[i]; r = r < u.cnt ? r : 0; const int tok = lp[r]; voff[h][i] = (unsigned)(tok * K + C[i]) * 2u; }
    }
    __device__ __forceinline__ void epi(const f32x4 (&acc)[2][2][4][2], const pg8::Unit& u, int wr, int wc, int fr, int fq) const {
        const int row0 = u.pm * 256 + wr * 64 + fr, col0 = u.pn * 128 + wc * 32 + 8 * fq;
        const float* bias = bgu + u.e * 2048 + col0;
        f32x4 bg[2], bu[2];
#pragma unroll
        for (int n = 0; n < 2; ++n) { bg[n] = *(const f32x4*)(bias + 4 * n); bu[n] = *(const f32x4*)(bias + 1024 + 4 * n); }
#pragma unroll
        for (int ai = 0; ai < 2; ++ai)
#pragma unroll
            for (int m = 0; m < 4; ++m) {
                float a[2][4];
#pragma unroll
                for (int n = 0; n < 2; ++n)
#pragma unroll
                    for (int r = 0; r < 4; ++r) {
                        float g = acc[ai][0][m][n][r] * (1.f / (H2_SCALE * W8_SCALE)) + bg[n][r], uu = acc[ai][1][m][n][r] * (1.f / (H2_SCALE * W8_SCALE)) + bu[n][r];
                        g = fminf(g, 7.f); uu = fminf(fmaxf(uu, -7.f), 7.f);
                        a[n][r] = fminf(fmaxf((uu + 1.f) * g * __builtin_amdgcn_rcpf(1.f + __builtin_amdgcn_exp2f(-1.702f * LOG2E * g)) * ACT_SCALE, -448.f), 448.f);
                    }
                u32x2 w; w.x = pg8::pk4_fp8(a[0][0], a[0][1], a[0][2], a[0][3]); w.y = pg8::pk4_fp8(a[1][0], a[1][1], a[1][2], a[1][3]);
                *(u32x2*)((unsigned char*)ACT + (size_t)(row0 + ai * 128 + m * 16) * DFF + col0) = w;
            }
    }
};
struct PDown : pg8::GroupOrder {
    static constexpr int K = 512; static constexpr bool GATHER = false, FP8 = true;
    const bf16_t* ACT; const bf16_t* Wt; const float* bd; bf16_t* Y;
    static constexpr __host__ __device__ __forceinline__ int brow(int bj, int R) { return 128 * bj + (R & ~31) + pg8::perm32(R & 31); }
    __device__ __forceinline__ const char* a_base(const pg8::Unit& u) const { return (const char*)(ACT + (size_t)u.pm * 256 * K); }
    __device__ __forceinline__ const char* b_base(const pg8::Unit& u) const { return (const char*)(Wt + ((size_t)u.e * 1024 + u.pn * 256) * K); }
    __device__ __forceinline__ void epi(const f32x4 (&acc)[2][2][4][2], const pg8::Unit& u, int wr, int wc, int fr, int fq) const {
        const int row0 = u.pm * 256 + wr * 64 + fr, col0 = u.pn * 256 + wc * 32 + 8 * fq;
        const float* bias = bd + u.e * 1024 + col0;
        f32x4 bv[2][2];
#pragma unroll
        for (int bj = 0; bj < 2; ++bj)
#pragma unroll
            for (int n = 0; n < 2; ++n) bv[bj][n] = *(const f32x4*)(bias + bj * 128 + 4 * n);
#pragma unroll
        for (int ai = 0; ai < 2; ++ai)
#pragma unroll
            for (int m = 0; m < 4; ++m) { bf16_t* rowp = Y + (size_t)(row0 + ai * 128 + m * 16) * D + col0;
#pragma unroll
                for (int bj = 0; bj < 2; ++bj) { const f32x4 v0 = acc[ai][bj][m][0] * (1.f / (ACT_SCALE * W8_SCALE)) + bv[bj][0], v1 = acc[ai][bj][m][1] * (1.f / (ACT_SCALE * W8_SCALE)) + bv[bj][1];
                    u32x4 w; w.x = pg8::cvt_pk_bf16(v0[0], v0[1]); w.y = pg8::cvt_pk_bf16(v0[2], v0[3]); w.z = pg8::cvt_pk_bf16(v1[0], v1[1]); w.w = pg8::cvt_pk_bf16(v1[2], v1[3]);
                    *(u32x4*)(rowp + bj * 128) = w; } }
    }
};


namespace att {
typedef float f32x16 __attribute__((ext_vector_type(16)));
typedef short s16x4 __attribute__((ext_vector_type(4)));
typedef short v4i16_t __attribute__((ext_vector_type(4)));
typedef float f32x2_t __attribute__((ext_vector_type(2))); typedef __bf16 bf16x2_t __attribute__((ext_vector_type(2)));
__device__ __forceinline__ unsigned cvtpk(float lo, float hi) { f32x2_t v = {lo, hi}; bf16x2_t b = __builtin_convertvector(v, bf16x2_t); return __builtin_bit_cast(unsigned, b); }
__device__ __forceinline__ s16x4 vtr(const LAS unsigned char* p) { return __builtin_bit_cast(s16x4, __builtin_amdgcn_ds_read_tr16_b64_v4i16((LAS v4i16_t*)p)); }
__device__ __forceinline__ void glds16(const void* gsrc, LAS unsigned char* dst) { __builtin_amdgcn_global_load_lds((const unsigned*)gsrc, (LAS unsigned*)dst, 16, 0, 0); }
#define ATT_CR(r) (((r) & 3) + 8 * ((r) >> 2))
#define ATT_WAIT_V(n) asm volatile("s_waitcnt vmcnt(" #n ")" ::: "memory")
#define ATT_WAIT_L0() asm volatile("s_waitcnt lgkmcnt(0)" ::: "memory")

template <int MODE> __device__ __forceinline__ float soft_tile(f32x16& p0, f32x16& p1, float sl, int dqh) {
    float sum = 0.f;
#pragma unroll
    for (int r = 0; r < 16; ++r) {
        float x0 = __builtin_fmaf(sl, (float)ATT_CR(r), p0[r]), x1 = __builtin_fmaf(sl, (float)(ATT_CR(r) + 32), p1[r]);
        if (MODE == 1) { x0 = (ATT_CR(r) <= dqh) ? x0 : -INFINITY; x1 = (ATT_CR(r) + 32 <= dqh) ? x1 : -INFINITY; }
        if (MODE == 2) { x0 = ((unsigned)(dqh - ATT_CR(r)) <= 128u) ? x0 : -INFINITY; x1 = ((unsigned)(dqh - ATT_CR(r) - 32) <= 128u) ? x1 : -INFINITY; }
        p0[r] = __builtin_amdgcn_exp2f(x0); p1[r] = __builtin_amdgcn_exp2f(x1);
        sum += p0[r] + p1[r];
    }
    return sum;
}
__device__ __forceinline__ void pack_p(const f32x16& p0, const f32x16& p1, bf16x8 (&pa)[4]) {
    u32x4 w0 = {cvtpk(p0[0], p0[1]), cvtpk(p0[2], p0[3]), cvtpk(p0[4], p0[5]), cvtpk(p0[6], p0[7])};
    u32x4 w1 = {cvtpk(p0[8], p0[9]), cvtpk(p0[10], p0[11]), cvtpk(p0[12], p0[13]), cvtpk(p0[14], p0[15])};
    u32x4 w2 = {cvtpk(p1[0], p1[1]), cvtpk(p1[2], p1[3]), cvtpk(p1[4], p1[5]), cvtpk(p1[6], p1[7])};
    u32x4 w3 = {cvtpk(p1[8], p1[9]), cvtpk(p1[10], p1[11]), cvtpk(p1[12], p1[13]), cvtpk(p1[14], p1[15])};
    pa[0] = __builtin_bit_cast(bf16x8, w0); pa[1] = __builtin_bit_cast(bf16x8, w1); pa[2] = __builtin_bit_cast(bf16x8, w2); pa[3] = __builtin_bit_cast(bf16x8, w3);
}
template <int NDB> __device__ __forceinline__ void pv_tile(f32x16 (&o)[NDB], const LAS unsigned char* vrd, const bf16x8 (&pa)[4]) {
#pragma unroll
    for (int db = 0; db < NDB; ++db) {
        s16x4 lo[4], hh[4];
#pragma unroll
        for (int g = 0; g < 4; ++g) { lo[g] = vtr(vrd + db * 4096 + g * 1024); hh[g] = vtr(vrd + db * 4096 + g * 1024 + 512); }
#pragma unroll
        for (int g = 0; g < 4; ++g) { const bf16x8 vf = {lo[g][0], lo[g][1], lo[g][2], lo[g][3], hh[g][0], hh[g][1], hh[g][2], hh[g][3]};
            o[db] = __builtin_amdgcn_mfma_f32_32x32x16_bf16(pa[g], vf, o[db], 0, 0, 0); }
    }
}
__device__ __forceinline__ float gain_bound(const float* ga, const float* gb, int lane) {
    float a = fabsf(ga[lane & 63]), b = fabsf(gb[lane & 63]);
#pragma unroll
    for (int o = 1; o < 64; o <<= 1) { a = fmaxf(a, __shfl_xor(a, o)); b = fmaxf(b, __shfl_xor(b, o)); }
    return QSCALE * 64.f * a * b * 1.02f + 0.25f;
}

constexpr int B_SLOT = 24576;
__device__ __forceinline__ void attn_b_unit(LAS unsigned char* lds, LAS float* wsf, const bf16_t* QKV, float* OBN, int b, int h, int c, int qb, float Mb, int wave, int lane) {
    const int r32 = lane & 31, hi = lane >> 5;
    const int q0 = qb * 256, tq = q0 + wave * 32 + r32;
    const size_t rowbase = (size_t)b * S;
    const bf16_t* Qp = QKV + (rowbase + tq) * NIN + 1536 + h * 128 + c * 64;
    const bf16_t* Kh = QKV + rowbase * NIN + 2048 + h * 128 + c * 64;
    const bf16_t* Vh = QKV + rowbase * NIN + 2560 + h * 128;
    const float sl = exp2f(-2.f * (float)(h + 1)) * LOG2E;
    bf16x8 qr[4];
#pragma unroll
    for (int d0 = 0; d0 < 4; ++d0) qr[d0] = *(const bf16x8*)(Qp + d0 * 16 + hi * 8);
    const int NT = (q0 + 256) / 64;
    const bf16_t* ksrc = Kh + (size_t)lane * NIN + wave * 8;
    const int i0 = wave, i1 = wave + 8;
    const bf16_t* vsrc0 = Vh + (size_t)(16 * (i0 & 3) + (lane >> 2)) * NIN + (i0 >> 2) * 32 + (lane & 3) * 8;
    const bf16_t* vsrc1 = Vh + (size_t)(16 * (i1 & 3) + (lane >> 2)) * NIN + (i1 >> 2) * 32 + (lane & 3) * 8;
#define ATT_DMA(t, s) do { const size_t to_ = (size_t)(t) * 64 * NIN; LAS unsigned char* sb_ = lds + (s) * B_SLOT; \
        glds16(ksrc + to_, sb_ + wave * 1024); glds16(vsrc0 + to_, sb_ + 8192 + i0 * 1024); glds16(vsrc1 + to_, sb_ + 8192 + i1 * 1024); } while (0)
    const int kfo = hi * 1024 + r32 * 16;
    const int vro = 8192 + ((lane >> 4) & 1) * 32 + (lane & 3) * 8 + (4 * hi + ((lane & 15) >> 2)) * 64;
    f32x16 o[4]; float lsum = 0.f;
#pragma unroll
    for (int d = 0; d < 4; ++d) o[d] = f32x16{};
    ATT_WAIT_L0(); __builtin_amdgcn_s_barrier();
    ATT_DMA(0, 0); ATT_DMA(1, 1);
    const int qmax_w = q0 + wave * 32 + 31, qmin_w = q0 + wave * 32;
    int slot = 0;
    for (int t = 0; t < NT; ++t) {
        if (t + 1 < NT) ATT_WAIT_V(3); else ATT_WAIT_V(0);
        ATT_WAIT_L0(); __builtin_amdgcn_s_barrier();
        if (t + 2 < NT) { const int s2 = (slot >= 1) ? slot - 1 : 2; ATT_DMA(t + 2, s2); }
        const int k0 = 64 * t;
        if (k0 <= qmax_w) {
            const LAS unsigned char* sb = lds + slot * B_SLOT;
            bf16x8 kf[8];
#pragma unroll
            for (int d0 = 0; d0 < 4; ++d0) { kf[2 * d0] = *(const LAS bf16x8*)(sb + kfo + d0 * 2048); kf[2 * d0 + 1] = *(const LAS bf16x8*)(sb + kfo + d0 * 2048 + 512); }
            const int dqh = tq - k0 - 4 * hi;
            const float ci = -sl * (float)dqh - Mb;
            f32x16 p0, p1;
#pragma unroll
            for (int r = 0; r < 16; ++r) { p0[r] = ci; p1[r] = ci; }
#pragma unroll
            for (int d0 = 0; d0 < 4; ++d0) { p0 = __builtin_amdgcn_mfma_f32_32x32x16_bf16(kf[2 * d0], qr[d0], p0, 0, 0, 0); p1 = __builtin_amdgcn_mfma_f32_32x32x16_bf16(kf[2 * d0 + 1], qr[d0], p1, 0, 0, 0); }
            if (k0 + 63 <= qmin_w) lsum += soft_tile<0>(p0, p1, sl, dqh); else lsum += soft_tile<1>(p0, p1, sl, dqh);
            bf16x8 pa[4]; pack_p(p0, p1, pa);
            pv_tile<4>(o, sb + vro, pa);
        }
        slot = (slot == 2) ? 0 : slot + 1;
    }
#undef ATT_DMA
    { auto rr = __builtin_amdgcn_permlane32_swap(__float_as_uint(lsum), __float_as_uint(lsum), false, false); lsum = __uint_as_float(rr[0]) + __uint_as_float(rr[1]); }
    if (hi == 0) wsf[r32] = lsum;
    ATT_WAIT_L0();
    float* ob = OBN + ((size_t)c * M + rowbase + q0 + wave * 32) * 512 + h * 128 + r32;
#pragma unroll
    for (int r = 0; r < 16; ++r) { const int q = ATT_CR(r) + 4 * hi; const float rl = __builtin_amdgcn_rcpf(wsf[q]);
#pragma unroll
        for (int db = 0; db < 4; ++db) ob[(size_t)q * 512 + db * 32] = o[db][r] * rl; }
    ATT_WAIT_L0();
}
__device__ __forceinline__ void attn_b_phase(LAS unsigned char* lds, LAS float* wsf, const bf16_t* QKV, float* OBN, const float* gbq, const float* gbk, int vcu, int wave, int lane) {
    const float Mb = gain_bound(gbq, gbk, lane);
    const int bhc = vcu >> 2, s = vcu & 3, b = bhc >> 3, h = (bhc >> 1) & 3, c = bhc & 1;
    attn_b_unit(lds, wsf, QKV, OBN, b, h, c, 7 - s, Mb, wave, lane);
    attn_b_unit(lds, wsf, QKV, OBN, b, h, c, s, Mb, wave, lane);
    ATT_WAIT_L0(); __builtin_amdgcn_s_barrier();
}

struct ATile { const bf16_t* kbase; int step, dq0; float sl; };
__device__ __forceinline__ void attn_a_task(LAS unsigned char* vbuf, LAS float* wsf, const bf16_t* QKV, bf16_t* AO, int b, int h, int r, int jb, float Mb, int lane) {
    const int r32 = lane & 31, hi = lane >> 5;
    const int j = 32 * jb + r32, tq = r + 16 * j;
    const size_t rowbase = (size_t)b * S;
    const bf16_t* Qp = QKV + (rowbase + tq) * NIN + h * 64;
    const bf16_t* Kh = QKV + rowbase * NIN + 512 + h * 64;
    const float sl1 = exp2f(-(float)(h + 1)) * LOG2E;
    bf16x8 qr[4];
#pragma unroll
    for (int d0 = 0; d0 < 4; ++d0) qr[d0] = *(const bf16x8*)(Qp + d0 * 16 + hi * 8);
    const int n3 = (jb >= 2) ? 2 : 1, n2 = (jb == 0) ? 2 : 4, n1 = (jb == 0) ? 8 : 10, ntile = n3 + n2 + n1;
    auto tile_step = [&](int idx) -> int { return idx < n3 ? 16 : (idx < n3 + n2 ? 4 : 1); };
    auto tile_k0 = [&](int idx) -> int { return idx < n3 ? 64 * idx : (idx < n3 + n2 ? 64 * ((jb == 0 ? 0 : 2 * jb - 2) + idx - n3) : 64 * ((jb == 0 ? 0 : 8 * jb - 2) + idx - n3 - n2)); };
    auto tile_uq = [&](int step) -> int { return step == 16 ? j : (step == 4 ? (r >> 2) + 4 * j : tq); };
    auto tile_pos0 = [&](int step, int k0) -> int { return (r & (step - 1)) + step * k0; };
    const int kfr = r32, vr16 = lane >> 2;
    bf16x8 kfn[8];
#define ATT_PREF(idx, buf) do { const int st_ = tile_step(idx), k0_ = tile_k0(idx); const bf16_t* kb_ = Kh + (size_t)tile_pos0(st_, k0_) * NIN; const size_t rs_ = (size_t)st_ * NIN; \
        _Pragma("unroll") for (int d0 = 0; d0 < 4; ++d0) { kfn[2 * d0] = *(const bf16x8*)(kb_ + (size_t)kfr * rs_ + d0 * 16 + hi * 8); kfn[2 * d0 + 1] = *(const bf16x8*)(kb_ + (size_t)(kfr + 32) * rs_ + d0 * 16 + hi * 8); } \
        _Pragma("unroll") for (int i = 0; i < 8; ++i) glds16(kb_ + 512 + (size_t)(16 * (i & 3) + vr16) * rs_ + (i >> 2) * 32 + (lane & 3) * 8, vbuf + (buf) * 8192 + i * 1024); } while (0)
    const int vro = ((lane >> 4) & 1) * 32 + (lane & 3) * 8 + (4 * hi + ((lane & 15) >> 2)) * 64;
    f32x16 o[2]; o[0] = f32x16{}; o[1] = f32x16{}; float lsum = 0.f;
    ATT_WAIT_L0();
    ATT_PREF(0, 0);
    for (int idx = 0; idx < ntile; ++idx) {
        ATT_WAIT_V(0);
        bf16x8 kf[8];
#pragma unroll
        for (int i = 0; i < 8; ++i) kf[i] = kfn[i];
        ATT_WAIT_L0();
        if (idx + 1 < ntile) ATT_PREF(idx + 1, (idx + 1) & 1);
        const int st = tile_step(idx), k0 = tile_k0(idx);
        const int dqh = tile_uq(st) - k0 - 4 * hi;
        const float sl = sl1 * (float)st;
        const float ci = -sl * (float)dqh - Mb;
        f32x16 p0, p1;
#pragma unroll
        for (int rr = 0; rr < 16; ++rr) { p0[rr] = ci; p1[rr] = ci; }
#pragma unroll
        for (int d0 = 0; d0 < 4; ++d0) { p0 = __builtin_amdgcn_mfma_f32_32x32x16_bf16(kf[2 * d0], qr[d0], p0, 0, 0, 0); p1 = __builtin_amdgcn_mfma_f32_32x32x16_bf16(kf[2 * d0 + 1], qr[d0], p1, 0, 0, 0); }
        lsum += soft_tile<2>(p0, p1, sl, dqh);
        bf16x8 pa[4]; pack_p(p0, p1, pa);
        pv_tile<2>(o, vbuf + (idx & 1) * 8192 + vro, pa);
    }
#undef ATT_PREF
    { auto rr = __builtin_amdgcn_permlane32_swap(__float_as_uint(lsum), __float_as_uint(lsum), false, false); lsum = __uint_as_float(rr[0]) + __uint_as_float(rr[1]); }
    if (hi == 0) wsf[r32] = lsum;
    ATT_WAIT_L0();
    LAS bf16_t* stg = (LAS bf16_t*)vbuf;
#pragma unroll
    for (int rr = 0; rr < 16; ++rr) { const int q = ATT_CR(rr) + 4 * hi; const float rl = __builtin_amdgcn_rcpf(wsf[q]);
#pragma unroll
        for (int db = 0; db < 2; ++db) stg[q * 64 + db * 32 + r32] = f2bf(o[db][rr] * rl); }
    ATT_WAIT_L0();
#pragma unroll
    for (int i = 0; i < 4; ++i) { const int row = i * 8 + (lane >> 3), ch = lane & 7; const u32x4 v = *(const LAS u32x4*)(stg + row * 64 + ch * 8);
        *(u32x4*)(AO + (rowbase + r + 16 * (32 * jb + row)) * D + h * 64 + ch * 8) = v; }
    ATT_WAIT_L0();
}
__device__ __forceinline__ void attn_a_phase(LAS unsigned char* lds, LAS float* wsf, const bf16_t* QKV, bf16_t* AO, const float* gaq, const float* gak, int vcu, int wave, int lane) {
    const float Mb = gain_bound(gaq, gak, lane);
    const int bh = vcu >> 2, b = bh >> 3, h = bh & 7, r = 4 * (vcu & 3) + (wave & 3);
    LAS unsigned char* vbuf = lds + wave * 16384;
    attn_a_task(vbuf, wsf, QKV, AO, b, h, r, (wave >> 2) ? 2 : 3, Mb, lane);
    attn_a_task(vbuf, wsf, QKV, AO, b, h, r, (wave >> 2) ? 1 : 0, Mb, lane);
}
#undef ATT_CR
#undef ATT_WAIT_V
#undef ATT_WAIT_L0
}

struct MArgs {
    const float *x, *c, *w_ada, *b_ada, *g1, *w_in, *gaq, *gak, *gbq, *gbk, *lq1, *lk1, *lq2, *lk2, *gd, *w_out, *g2, *w_router, *b_router, *w_gu, *b_gu, *w_d, *b_d;
    float* out; unsigned char* ws; int ph_lo, ph_hi;
};

__device__ __forceinline__ void p0_transpose_item(const float* W, int K, int N, bf16_t* WT, LAS float* scr, int item, int lane) {
    const int nblk = N / 32, kb = item / nblk, nb = item % nblk, k0 = 64 * kb, n0 = 32 * nb;
#pragma unroll 8
    for (int i = 0; i < 32; ++i) { const int kk = 2 * i + (lane >> 5); scr[kk * 33 + (lane & 31)] = W[(size_t)(k0 + kk) * N + n0 + (lane & 31)]; }
    LDS_WAIT(); asm volatile("" ::: "memory");
    const int c = lane & 7;
#pragma unroll
    for (int j = 0; j < 4; ++j) { const int n = (lane >> 3) + 8 * j; const LAS float* s = scr + (8 * c) * 33 + n;
        u32x4 o; o.x = pk2(s[0 * 33], s[1 * 33]); o.y = pk2(s[2 * 33], s[3 * 33]); o.z = pk2(s[4 * 33], s[5 * 33]); o.w = pk2(s[6 * 33], s[7 * 33]);
        *(u32x4*)(WT + (size_t)(n0 + n) * K + k0 + 8 * c) = o; }
    LDS_WAIT(); asm volatile("" ::: "memory");
}

__device__ __forceinline__ void p0_transpose8_item(const float* W, int K, int N, unsigned char* WT, LAS float* scr, int item, int lane) {
    const int nblk = N / 32, kb = item / nblk, nb = item % nblk, k0 = 64 * kb, n0 = 32 * nb;
#pragma unroll 8
    for (int i = 0; i < 32; ++i) { const int kk = 2 * i + (lane >> 5); scr[kk * 33 + (lane & 31)] = W[(size_t)(k0 + kk) * N + n0 + (lane & 31)]; }
    LDS_WAIT(); asm volatile("" ::: "memory");
#pragma unroll
    for (int j = 0; j < 2; ++j) { const int n = (lane >> 2) + 16 * j, c = lane & 3; const LAS float* s = scr + (16 * c) * 33 + n;
        u32x4 o;
        o.x = pg8::pk4_fp8(s[0 * 33] * W8_SCALE, s[1 * 33] * W8_SCALE, s[2 * 33] * W8_SCALE, s[3 * 33] * W8_SCALE);
        o.y = pg8::pk4_fp8(s[4 * 33] * W8_SCALE, s[5 * 33] * W8_SCALE, s[6 * 33] * W8_SCALE, s[7 * 33] * W8_SCALE);
        o.z = pg8::pk4_fp8(s[8 * 33] * W8_SCALE, s[9 * 33] * W8_SCALE, s[10 * 33] * W8_SCALE, s[11 * 33] * W8_SCALE);
        o.w = pg8::pk4_fp8(s[12 * 33] * W8_SCALE, s[13 * 33] * W8_SCALE, s[14 * 33] * W8_SCALE, s[15 * 33] * W8_SCALE);
        *(u32x4*)(WT + (size_t)(n0 + n) * K + k0 + 16 * c) = o; }
    LDS_WAIT(); asm volatile("" ::: "memory");
}

__global__ void __launch_bounds__(NTHREADS, 2) mega(MArgs a) {
    extern __shared__ __attribute__((aligned(16))) unsigned char lds_raw[];
    LAS unsigned char* lds = (LAS unsigned char*)lds_raw;
    const int G = gridDim.x, bx = blockIdx.x, vcu = (G % 8 == 0) ? (bx % 8) * (G / 8) + bx / 8 : bx, NGW = G * NWAVES;
    const int wave = __builtin_amdgcn_readfirstlane((int)threadIdx.x >> 6);
#define PHASE_IDS() int lane = (int)__builtin_amdgcn_mbcnt_hi(~0u, __builtin_amdgcn_mbcnt_lo(~0u, 0u)); asm volatile("" : "+v"(lane)); const int tid = wave * 64 + lane, gw = vcu * NWAVES + wave; (void)tid; (void)gw
    volatile LAS unsigned* MISC = (volatile LAS unsigned*)(lds + MISC_OFF);
    LAS int* PT = (LAS int*)(lds + PT_OFF); LAS int* CN = (LAS int*)(lds + CNT_OFF);
#define w_counts ((int*)(a.ws + WS_CTL + CTL_COUNTS))
#define w_mod ((float*)(a.ws + WS_CTL + CTL_MOD))
#define w_Win_t ((bf16_t*)(a.ws + WS_WIN))
#define w_Wout_t ((bf16_t*)(a.ws + WS_WOUT))
#define w_Wgu_t ((bf16_t*)(a.ws + WS_WGU))
#define w_Wd_t ((bf16_t*)(a.ws + WS_WD))
#define w_XN ((bf16_t*)(a.ws + WS_XN))
#define w_QKV ((bf16_t*)(a.ws + WS_QKV))
#define w_AO ((bf16_t*)(a.ws + WS_AO))
#define w_H2 ((bf16_t*)(a.ws + WS_H2))
#define w_tope ((int*)(a.ws + WS_TOPE))
#define w_tops ((int*)(a.ws + WS_TOPS))
#define w_topg ((float*)(a.ws + WS_TOPG))
#define w_list ((int*)(a.ws + WS_LIST))
#define w_ACT ((bf16_t*)(a.ws + WS_ACT))
#define w_Y ((bf16_t*)(a.ws + WS_Y))
#define w_OBN ((float*)(a.ws + WS_OBN))
    for (int u = threadIdx.x; u < (LDS_BYTES - LDSCTL_OFF) / 4; u += NTHREADS) ((LAS unsigned*)(lds + LDSCTL_OFF))[u] = 0u;
    __syncthreads();
    const int lo = a.ph_lo, hi = a.ph_hi;
    XcdBarrier bar; bar.bar = (unsigned*)(a.ws + WS_CTL + CTL_BAR); bar.x = 0; bar.st = nullptr;
    if (hi - lo > 1) bar = xcd_barrier_post((unsigned*)(a.ws + WS_CTL + CTL_BAR), MISC + 8);
#define IN(k) (lo <= (k) && (k) < hi)
#ifndef REP_PH
#define REP_PH -1
#define REP_N 1
#endif
#define NREP(k) (((k) == REP_PH) ? REP_N : 1)
#define SEAM(k) do { if (IN(k) && IN((k) + 1)) xcd_barrier(bar, wave); } while (0)
#define LOAD_PT() do { if (wave == 0) { int cv = (lane < NE) ? w_counts[lane] : 0; int tl = (cv + 255) >> 8; int sc = tl; \
        _Pragma("unroll") for (int o = 1; o < 32; o <<= 1) { const int t_ = __shfl_up(sc, o); if ((lane & 31) >= o) sc += t_; } \
        if (lane < NE) { PT[lane + 1] = sc; CN[lane] = cv; } if (lane == 0) PT[0] = 0; } __syncthreads(); } while (0)

    if (IN(0)) for (int rep_ = 0; rep_ < NREP(0); ++rep_) {
        PHASE_IDS();
        LAS float* silu = (LAS float*)(lds + 98304);
        for (int i = tid; i < NB * D; i += NTHREADS) { const float cv = a.c[i]; silu[i] = cv / (1.f + __expf(-cv)); }
        __syncthreads();
        if (gw < 24 * 32 && rep_ == 0) {
            const int cc = gw % 24, ks = gw / 24, col = cc * 256 + 4 * lane;
            f32x4 acc[NB];
#pragma unroll
            for (int b = 0; b < NB; ++b) acc[b] = (ks == 0) ? *(const f32x4*)(a.b_ada + col) : (f32x4){0.f, 0.f, 0.f, 0.f};
            for (int k = ks * 32; k < ks * 32 + 32; ++k) {
                const f32x4 w = *(const f32x4*)(a.w_ada + (size_t)k * 6144 + col);
#pragma unroll
                for (int b = 0; b < NB; ++b) acc[b] += w * silu[b * D + k];
            }
#pragma unroll
            for (int b = 0; b < NB; ++b)
#pragma unroll
                for (int r = 0; r < 4; ++r) atomicAdd(&w_mod[b * 6144 + col + r], acc[b][r]);
        }
        LAS float* scr = (LAS float*)(lds + wave * 10240);
        constexpr int I_IN = 16 * 96, I_OUT = 16 * 32, I_GU = 16 * 64, I_D = 16 * 32;
        constexpr int NITEMS = I_IN + I_OUT + NE * I_GU + NE * I_D;
        for (int it = gw; it < NITEMS; it += NGW) {
            int r = it;
            if (r < I_IN) { p0_transpose_item(a.w_in, 1024, 3072, w_Win_t, scr, r, lane); continue; } r -= I_IN;
            if (r < I_OUT) { p0_transpose_item(a.w_out, 1024, 1024, w_Wout_t, scr, r, lane); continue; } r -= I_OUT;
            if (r < NE * I_GU) { const int e = r / I_GU; p0_transpose8_item(a.w_gu + (size_t)e * 1024 * 2048, 1024, 2048, (unsigned char*)w_Wgu_t + (size_t)e * 1024 * 2048, scr, r % I_GU, lane); continue; } r -= NE * I_GU;
            { const int e = r / I_D; p0_transpose8_item(a.w_d + (size_t)e * 1024 * 1024, 1024, 1024, (unsigned char*)w_Wd_t + (size_t)e * 1024 * 1024, scr, r % I_D, lane); }
        }
        if (rep_ + 1 < NREP(0)) xcd_barrier(bar, wave);
    }
    SEAM(0);
    if (IN(1)) for (int rep_ = 0; rep_ < NREP(1); ++rep_) {
        PHASE_IDS();
        for (int row = gw; row < M; row += NGW) {
            const int b = row / S;
            const f32x4* xr = (const f32x4*)(a.x + (size_t)row * D) + lane;
            f32x4 v[4]; float ss = 0.f;
#pragma unroll
            for (int j = 0; j < 4; ++j) { v[j] = xr[64 * j]; ss += (v[j].x * v[j].x + v[j].y * v[j].y) + (v[j].z * v[j].z + v[j].w * v[j].w); }
            const float rstd = rsqrtf(wave_sum(ss) * (1.f / D) + RMS_EPS);
            const float* shift = w_mod + b * 6144, *scale = w_mod + b * 6144 + 1024;
#pragma unroll
            for (int j = 0; j < 4; ++j) {
                const int c0 = 4 * lane + 256 * j;
                const f32x4 g = *(const f32x4*)(a.g1 + c0), sc = *(const f32x4*)(scale + c0), sh = *(const f32x4*)(shift + c0);
                const f32x4 o = v[j] * rstd * g * (sc + 1.f) + sh;
                u32x2 w; w.x = pk2(o.x, o.y); w.y = pk2(o.z, o.w);
                *(u32x2*)(w_XN + (size_t)row * D + c0) = w;
            }
        }
        if (rep_ + 1 < NREP(1)) xcd_barrier(bar, wave);
    }
    SEAM(1);
    if (IN(2)) for (int rep_ = 0; rep_ < NREP(2); ++rep_) {
        PHASE_IDS();
        PInProj p; p.init(M, NIN, G, bx); p.XN = w_XN; p.Wt = w_Win_t; p.QKV = w_QKV; p.gaq = a.gaq; p.gak = a.gak; p.gbq = a.gbq; p.gbk = a.gbk;
        pg8::gemm_phase<PInProj>(lds, p, wave);
        if (rep_ + 1 < NREP(2)) xcd_barrier(bar, wave);
    }
    SEAM(2);
    if (IN(3)) for (int rep_ = 0; rep_ < NREP(3); ++rep_) {
        PHASE_IDS();
        LAS float* wsf = (LAS float*)(lds + LDSCTL_OFF + 2048) + wave * 64;
#ifndef ATT_REP_A
#define ATT_REP_A 1
#define ATT_REP_B 1
#endif
        att::attn_a_phase(lds, wsf, w_QKV, w_AO, a.gaq, a.gak, vcu, wave, lane);
        if (ATT_REP_A > 1) { __syncthreads(); int lane2 = lane; asm volatile("" : "+v"(lane2)); att::attn_a_phase(lds, wsf, w_QKV, w_AO, a.gaq, a.gak, vcu, wave, lane2); }
        att::attn_b_phase(lds, wsf, w_QKV, w_OBN, a.gbq, a.gbk, vcu, wave, lane);
        if (ATT_REP_B > 1) { int lane2 = lane; asm volatile("" : "+v"(lane2)); att::attn_b_phase(lds, wsf, w_QKV, w_OBN, a.gbq, a.gbk, vcu, wave, lane2); }
        if (rep_ + 1 < NREP(3)) xcd_barrier(bar, wave);
    }
    SEAM(3);
    if (IN(4)) for (int rep_ = 0; rep_ < NREP(4); ++rep_) {
        PHASE_IDS();
        const float s1 = wave_sum(a.lq1[lane] * a.lk1[lane]), s2 = wave_sum(a.lq2[lane] * a.lk2[lane]);
        const float lam = __expf(s1) - __expf(s2) + LAMBDA_INIT;
        for (int w = gw; w < M * 4; w += NGW) {
            const int tok = w >> 2, h = w & 3;
            const float* p0 = w_OBN + (size_t)tok * 512 + h * 128 + 2 * lane; const float* p1 = p0 + (size_t)M * 512;
            const float va = p0[0] - lam * p1[0], vb = p0[1] - lam * p1[1];
            const float rstd = rsqrtf(wave_sum(va * va + vb * vb) * (1.f / 128.f) + RMS_EPS) * (1.f - LAMBDA_INIT);
            *(unsigned*)(w_AO + (size_t)tok * D + 512 + h * 128 + 2 * lane) = pk2(va * rstd * a.gd[2 * lane], vb * rstd * a.gd[2 * lane + 1]);
        }
        if (rep_ + 1 < NREP(4)) xcd_barrier(bar, wave);
    }
    SEAM(4);
    if (IN(5)) for (int rep_ = 0; rep_ < NREP(5); ++rep_) {
        PHASE_IDS();
        POutProj p; p.init(M, D, G, bx); p.AO = w_AO; p.Wt = w_Wout_t; p.x = a.x; p.mod = w_mod; p.x1 = a.out;
        pg8::gemm_phase<POutProj>(lds, p, wave);
        if (rep_ + 1 < NREP(5)) xcd_barrier(bar, wave);
    }
    SEAM(5);
    if (IN(6)) for (int rep_ = 0; rep_ < NREP(6); ++rep_) {
        PHASE_IDS();
        typedef float f32x4v __attribute__((ext_vector_type(4)));
        LAS float* Wp = (LAS float*)lds;
        LAS float* lgs = (LAS float*)(lds + LDSCTL_OFF + 4096);
        LAS float* red = (LAS float*)(lds + LDSCTL_OFF + 12288);
        LAS float* cb = (LAS float*)(lds + LDSCTL_OFF + 14336);
        LAS int* lcnt = (LAS int*)(lds + LDSCTL_OFF + 14464);
        LAS int* lbase = (LAS int*)(lds + LDSCTL_OFF + 14592);
        for (int chunk = bx; chunk < M / 64; chunk += G) {
            const int row0 = chunk * 64, b = row0 / S;
            const float* shift = w_mod + b * 6144 + 3072, *scale = w_mod + b * 6144 + 4096;
            __syncthreads();
            for (int i = tid; i < 1024 * 8; i += NTHREADS) { const int k = i >> 3, e4 = (i & 7) * 4; const float gs = a.g2[k] * (1.f + scale[k]);
                const f32x4v w = *(const f32x4v*)(a.w_router + (size_t)k * NE + e4); *(LAS f32x4v*)(Wp + k * NE + e4) = w * gs; }
            { const int e = tid & 31, kp = tid >> 5; float acc = 0.f;
              for (int k = kp * 64; k < kp * 64 + 64; ++k) acc += shift[k] * a.w_router[(size_t)k * NE + e];
              red[kp * 32 + e] = acc; }
            if (tid < 32) lcnt[tid] = 0;
            for (int rr = 0; rr < 8; ++rr) {
                const int row = row0 + wave * 8 + rr;
                const f32x4* xr = (const f32x4*)(a.out + (size_t)row * D) + lane;
                f32x4 v[4]; float ss = 0.f;
#pragma unroll
                for (int jj = 0; jj < 4; ++jj) { v[jj] = xr[64 * jj]; ss += (v[jj].x * v[jj].x + v[jj].y * v[jj].y) + (v[jj].z * v[jj].z + v[jj].w * v[jj].w); }
                const float rstd = rsqrtf(wave_sum(ss) * (1.f / D) + RMS_EPS);
#pragma unroll
                for (int jj = 0; jj < 4; ++jj) {
                    const int c0 = 4 * lane + 256 * jj;
                    const f32x4 g = *(const f32x4*)(a.g2 + c0), sc = *(const f32x4*)(scale + c0), sh = *(const f32x4*)(shift + c0);
                    const f32x4 o = v[jj] * rstd * g * (sc + 1.f) + sh;
                    *(unsigned*)((unsigned char*)w_H2 + (size_t)row * D + c0) = pg8::pk4_fp8(o.x * H2_SCALE, o.y * H2_SCALE, o.z * H2_SCALE, o.w * H2_SCALE);
                }
            }
            __syncthreads();
            if (tid < 32) { float s_ = a.b_router[tid];
#pragma unroll
                for (int kp = 0; kp < 16; ++kp) s_ += red[kp * 32 + tid];
                cb[tid] = s_; }
            __syncthreads();
            int idx[4] = {0, 0, 0, 0}, rank[4] = {0, 0, 0, 0}; float gt[4] = {0.f, 0.f, 0.f, 0.f};
            const int tj = lane & 15, kq = lane >> 4;
            if (wave < 4) {
                const float* xp = a.out + (size_t)(row0 + 16 * wave + tj) * D + 256 * kq;
                f32x4v acc0 = {0.f, 0.f, 0.f, 0.f}, acc1 = {0.f, 0.f, 0.f, 0.f}; float ss = 0.f;
                const LAS float* wq = Wp + (256 * kq) * NE + tj;
                for (int s4 = 0; s4 < 64; ++s4) {
                    const f32x4v xv = *(const f32x4v*)(xp + 4 * s4);
                    ss += (xv.x * xv.x + xv.y * xv.y) + (xv.z * xv.z + xv.w * xv.w);
#pragma unroll
                    for (int u = 0; u < 4; ++u) { const float a0 = wq[(4 * s4 + u) * NE], a1 = wq[(4 * s4 + u) * NE + 16];
                        acc0 = __builtin_amdgcn_mfma_f32_16x16x4f32(a0, xv[u], acc0, 0, 0, 0); acc1 = __builtin_amdgcn_mfma_f32_16x16x4f32(a1, xv[u], acc1, 0, 0, 0); }
                }
                ss += __shfl_xor(ss, 16); ss += __shfl_xor(ss, 32);
                const float rstd = rsqrtf(ss * (1.f / D) + RMS_EPS);
                LAS float* lw = lgs + (wave * 16 + tj) * 32;
#pragma unroll
                for (int r = 0; r < 4; ++r) { lw[4 * kq + r] = acc0[r] * rstd + cb[4 * kq + r]; lw[16 + 4 * kq + r] = acc1[r] * rstd + cb[16 + 4 * kq + r]; }
                LDS_WAIT();
                if (lane < 16) {
                    float lg[NE];
#pragma unroll
                    for (int e = 0; e < NE; ++e) lg[e] = lgs[(wave * 16 + lane) * 32 + e];
                    float val[4];
#pragma unroll
                    for (int k = 0; k < 4; ++k) {
                        float best = -INFINITY; int bi = 0;
#pragma unroll
                        for (int e = 0; e < NE; ++e) { bool taken = false;
#pragma unroll
                            for (int kk = 0; kk < k; ++kk) taken |= (idx[kk] == e);
                            if (!taken && lg[e] > best) { best = lg[e]; bi = e; } }
                        idx[k] = bi; val[k] = best;
                    }
                    float den = 0.f;
#pragma unroll
                    for (int k = 0; k < 4; ++k) { gt[k] = __expf(val[k] - val[0]); den += gt[k]; }
                    const float rden = 1.f / den;
#pragma unroll
                    for (int k = 0; k < 4; ++k) { gt[k] *= rden; rank[k] = __hip_atomic_fetch_add(lcnt + idx[k], 1, __ATOMIC_RELAXED, __HIP_MEMORY_SCOPE_WORKGROUP); }
                }
            }
            __syncthreads();
            if (tid < 32 && rep_ == 0) lbase[tid] = atomicAdd(&w_counts[tid], lcnt[tid]);
            __syncthreads();
            if (wave < 4 && lane < 16 && rep_ == 0) {
                const int row = row0 + 16 * wave + lane;
#pragma unroll
                for (int k = 0; k < 4; ++k) { const int slot = lbase[idx[k]] + rank[k];
                    w_tope[row * 4 + k] = idx[k]; w_tops[row * 4 + k] = slot; w_topg[row * 4 + k] = gt[k]; w_list[idx[k] * M + slot] = row; }
            }
        }
        if (rep_ + 1 < NREP(6)) xcd_barrier(bar, wave);
    }
    SEAM(6);
    if (IN(7)) for (int rep_ = 0; rep_ < NREP(7); ++rep_) {
        PHASE_IDS();
        LOAD_PT();
        PGateUp p; p.init(PT, CN, (LAS int*)(lds + LDSCTL_OFF + 1024), 8, G, bx); p.build(wave, lane); __syncthreads(); p.H2 = w_H2; p.Wt = w_Wgu_t; p.bgu = a.b_gu; p.list = w_list; p.ACT = w_ACT;
        pg8::gemm_phase<PGateUp>(lds, p, wave);
        if (rep_ + 1 < NREP(7)) xcd_barrier(bar, wave);
    }
    SEAM(7);
    if (IN(8)) for (int rep_ = 0; rep_ < NREP(8); ++rep_) {
        PHASE_IDS();
        LOAD_PT();
        PDown p; p.init(PT, CN, (LAS int*)(lds + LDSCTL_OFF + 1024), 4, G, bx); p.build(wave, lane); __syncthreads(); p.ACT = w_ACT; p.Wt = w_Wd_t; p.bd = a.b_d; p.Y = w_Y;
        pg8::gemm_phase<PDown>(lds, p, wave);
        if (rep_ + 1 < NREP(8)) xcd_barrier(bar, wave);
    }
    SEAM(8);
    if (IN(9)) for (int rep_ = 0; rep_ < NREP(9); ++rep_) {
        PHASE_IDS();
        LOAD_PT();
        for (int row = gw; row < M; row += NGW) {
            const int b = row / S;
            const float* gate2 = w_mod + b * 6144 + 5120;
            const bf16_t* yr[4]; float gk[4];
#pragma unroll
            for (int k = 0; k < 4; ++k) { yr[k] = w_Y + (size_t)(PT[w_tope[row * 4 + k]] * 256 + w_tops[row * 4 + k]) * D; gk[k] = w_topg[row * 4 + k]; }
#pragma unroll
            for (int j = 0; j < 4; ++j) {
                const int c0 = 4 * lane + 256 * j;
                f32x4 acc = (f32x4){0.f, 0.f, 0.f, 0.f};
#pragma unroll
                for (int k = 0; k < 4; ++k) { const u32x2 w = *(const u32x2*)(yr[k] + c0);
                    acc.x += gk[k] * __uint_as_float(w.x << 16); acc.y += gk[k] * __uint_as_float(w.x & 0xffff0000u);
                    acc.z += gk[k] * __uint_as_float(w.y << 16); acc.w += gk[k] * __uint_as_float(w.y & 0xffff0000u); }
                const f32x4 g = *(const f32x4*)(gate2 + c0);
                f32x4* op = (f32x4*)(a.out + (size_t)row * D + c0);
                *op = *op + g * acc;
            }
        }
    }
#undef IN
#undef PHASE_IDS
#undef SEAM
#undef LOAD_PT
#undef w_counts
#undef w_mod
#undef w_Win_t
#undef w_Wout_t
#undef w_Wgu_t
#undef w_Wd_t
#undef w_XN
#undef w_QKV
#undef w_AO
#undef w_H2
#undef w_tope
#undef w_tops
#undef w_topg
#undef w_list
#undef w_ACT
#undef w_Y
#undef w_OBN
}

#ifndef RUN_MODE
#define RUN_MODE 1
#endif
#ifndef PH_MASK
#define PH_MASK 0x3ff
#endif
extern "C" void kernel_launch(void* const* d_in, const int* in_sizes, int n_in, void* d_out, int out_size, void* d_ws, size_t ws_size, hipStream_t stream) {
    static int grid = 0;
    if (grid == 0) {
        if (n_in != 23 || out_size != M * D || ws_size < WS_END) { fprintf(stderr, "kernel_launch: unexpected problem (n_in %d out %d ws %zu)\n", n_in, out_size, ws_size); grid = -1; return; }
        int dev = 0, cus = 0;
        if (hipGetDevice(&dev) != hipSuccess || hipDeviceGetAttribute(&cus, hipDeviceAttributeMultiprocessorCount, dev) != hipSuccess) { grid = -1; return; }
        if (hipFuncSetAttribute((const void*)mega, hipFuncAttributeMaxDynamicSharedMemorySize, LDS_BYTES) != hipSuccess) { fprintf(stderr, "kernel_launch: hipFuncSetAttribute failed\n"); grid = -1; return; }
        int per_cu = 0;
        if (hipOccupancyMaxActiveBlocksPerMultiprocessor(&per_cu, (const void*)mega, NTHREADS, LDS_BYTES) != hipSuccess || per_cu < 1) fprintf(stderr, "kernel_launch: occupancy query says %d blocks/CU\n", per_cu);
        (void)hipGetLastError();
        grid = cus;
    }
    if (grid < 0) return;
    const float* x = (const float*)d_in[0]; const float* c = (const float*)d_in[1]; const float* w_ada = (const float*)d_in[2]; const float* b_ada = (const float*)d_in[3];
    const float* g1 = (const float*)d_in[4]; const float* w_in = (const float*)d_in[5];
    const float* gaq = (const float*)d_in[6]; const float* gak = (const float*)d_in[7]; const float* gbq = (const float*)d_in[8]; const float* gbk = (const float*)d_in[9];
    const float* lq1 = (const float*)d_in[10]; const float* lk1 = (const float*)d_in[11]; const float* lq2 = (const float*)d_in[12]; const float* lk2 = (const float*)d_in[13];
    const float* gd = (const float*)d_in[14]; const float* w_out = (const float*)d_in[15]; const float* g2 = (const float*)d_in[16];
    const float* w_router = (const float*)d_in[17]; const float* b_router = (const float*)d_in[18];
    const float* w_gu = (const float*)d_in[19]; const float* b_gu = (const float*)d_in[20]; const float* w_d = (const float*)d_in[21]; const float* b_d = (const float*)d_in[22];
    unsigned char* ws = (unsigned char*)d_ws; float* out = (float*)d_out;
    int* counts = (int*)(ws + WS_CTL + CTL_COUNTS); int* padstart = (int*)(ws + WS_CTL + CTL_PADSTART); float* mod = (float*)(ws + WS_CTL + CTL_MOD);
    bf16_t* Win_t = (bf16_t*)(ws + WS_WIN); bf16_t* Wout_t = (bf16_t*)(ws + WS_WOUT); bf16_t* Wgu_t = (bf16_t*)(ws + WS_WGU); bf16_t* Wd_t = (bf16_t*)(ws + WS_WD);
    bf16_t* XN = (bf16_t*)(ws + WS_XN); bf16_t* QKV = (bf16_t*)(ws + WS_QKV); bf16_t* AO = (bf16_t*)(ws + WS_AO); bf16_t* H2 = (bf16_t*)(ws + WS_H2);
    int* tope = (int*)(ws + WS_TOPE); int* tops = (int*)(ws + WS_TOPS); float* topg = (float*)(ws + WS_TOPG); int* list = (int*)(ws + WS_LIST);
    bf16_t* ACT = (bf16_t*)(ws + WS_ACT); bf16_t* Y = (bf16_t*)(ws + WS_Y); float* OBN = (float*)(ws + WS_OBN);

    (void)hipMemsetAsync(ws + WS_CTL, 0, CTL_BYTES, stream);
    MArgs a{};
    a.x = x; a.c = c; a.w_ada = w_ada; a.b_ada = b_ada; a.g1 = g1; a.w_in = w_in; a.gaq = gaq; a.gak = gak; a.gbq = gbq; a.gbk = gbk; a.lq1 = lq1; a.lk1 = lk1; a.lq2 = lq2; a.lk2 = lk2;
    a.gd = gd; a.w_out = w_out; a.g2 = g2; a.w_router = w_router; a.b_router = b_router; a.w_gu = w_gu; a.b_gu = b_gu; a.w_d = w_d; a.b_d = b_d; a.out = out; a.ws = ws;
    a.ph_lo = 0; a.ph_hi = NPHASE; hipLaunchKernelGGL(mega, dim3(grid), dim3(NTHREADS), LDS_BYTES, stream, a);
}
```

```cpp
#include <hip/hip_runtime.h>
#include <cstdio>
#include <cstdint>

typedef unsigned short bf16_t;
typedef short bf16x8 __attribute__((ext_vector_type(8)));
typedef float f32x4 __attribute__((ext_vector_type(4)));
typedef unsigned u32x4 __attribute__((ext_vector_type(4)));
typedef unsigned u32x2 __attribute__((ext_vector_type(2)));

constexpr int D = 1024, NB = 8, S = 2048, M = NB * S;
constexpr int NIN = 3072, NE = 32, TOPK = 4, DFF = 1024;
constexpr int NASSIGN = M * TOPK;
constexpr int PADROWS = NASSIGN + NE * 256;
constexpr float RMS_EPS = 1e-6f;
constexpr float LOG2E = 1.4426950408889634f;
constexpr float QSCALE = 0.125f * LOG2E;
constexpr float LAMBDA_INIT = 0.2f;

constexpr size_t MiB = 1u << 20;
constexpr size_t WS_CTL = 0;
constexpr size_t CTL_BYTES = 1 * MiB;
constexpr size_t CTL_COUNTS = 0;
constexpr size_t CTL_PADSTART = 256;
constexpr size_t CTL_ADACNT = 1024;
constexpr size_t CTL_MOD = 64 * 1024;
constexpr size_t WS_WIN = 2 * MiB;
constexpr size_t WS_WOUT = 8 * MiB;
constexpr size_t WS_WGU = 10 * MiB;
constexpr size_t WS_WD = 138 * MiB;
constexpr size_t WS_XN = 202 * MiB;
constexpr size_t WS_QKV = 234 * MiB;
constexpr size_t WS_AO = 330 * MiB;
constexpr size_t WS_H2 = 362 * MiB;
constexpr size_t WS_TOPE = 394 * MiB;
constexpr size_t WS_TOPS = 395 * MiB;
constexpr size_t WS_TOPG = 396 * MiB;
constexpr size_t WS_LIST = 397 * MiB;
constexpr size_t WS_ACT = 400 * MiB;
constexpr size_t WS_Y = 544 * MiB;
constexpr size_t WS_OBN = 688 * MiB;
constexpr size_t WS_X1 = 752 * MiB;
constexpr size_t WS_MODP = 816 * MiB;
constexpr size_t WS_END = 824 * MiB;

__device__ __forceinline__ bf16_t f2bf(float f) { unsigned u = __float_as_uint(f); return (bf16_t)((u + 0x7fffu + ((u >> 16) & 1u)) >> 16); }
__device__ __forceinline__ float bf2f(bf16_t h) { return __uint_as_float(((unsigned)h) << 16); }
__device__ __forceinline__ unsigned pk2(float lo, float hi) { return (unsigned)f2bf(lo) | ((unsigned)f2bf(hi) << 16); }
__device__ __forceinline__ float wave_sum(float v) {
#pragma unroll
    for (int o = 1; o < 64; o <<= 1) v += __shfl_xor(v, o);
    return v;
}


#define LAS __attribute__((address_space(3)))
#define GAS __attribute__((address_space(1)))
#define RLX_AGENT __ATOMIC_RELAXED, __HIP_MEMORY_SCOPE_AGENT
#define LDS_WAIT() asm volatile("s_waitcnt lgkmcnt(0)" ::: "memory")
#define VM_WAIT() asm volatile("s_waitcnt vmcnt(0)" ::: "memory")

constexpr int NWAVES = 8, NTHREADS = 512;
constexpr int RING_BYTES = 131072, LDSCTL_OFF = RING_BYTES, MISC_OFF = LDSCTL_OFF + 320, PT_OFF = LDSCTL_OFF + 512, CNT_OFF = LDSCTL_OFF + 768, LDS_BYTES = 147456;
constexpr size_t CTL_BAR = 16384;
constexpr int NPHASE = 10;
constexpr float W8_SCALE = 512.f, H2_SCALE = 16.f, ACT_SCALE = 8.f, Y_SCALE = 32.f;

#define XB_TMO      128
#define XB_XCNT(j)  (256  + 64 * (j))
#define XB_XSUB(j)  (1280 + 64 * (j))
#define XB_XGEN(j)  (2304 + 64 * (j))
#define XB_TOP      3328
#define XB_TOPGEN   3392
#define XCD_BAR_WORDS 3456
#define XB_SPIN_CAP (1u << 22)
__device__ __forceinline__ unsigned xb_ld(unsigned* p)              { return __hip_atomic_load(p, __ATOMIC_RELAXED, __HIP_MEMORY_SCOPE_AGENT); }
__device__ __forceinline__ unsigned xb_add(unsigned* p, unsigned v) { return __hip_atomic_fetch_add(p, v, __ATOMIC_RELAXED, __HIP_MEMORY_SCOPE_AGENT); }
__device__ __forceinline__ unsigned xb_xcc_id() { return (unsigned)__builtin_amdgcn_s_getreg((3 << 11) | 20) & 0xFu; }
#define XB_SPIN(cond, bar) do { unsigned _sp = 0; while (cond) { __builtin_amdgcn_s_sleep(1); \
    if ((++_sp & 255u) == 0u) { if (xb_ld(&(bar)[XB_TMO])) break; if (_sp > XB_SPIN_CAP) { atomicAdd(&(bar)[XB_TMO], 1u); break; } } } } while (0)
struct XcdBarrier { unsigned* bar; unsigned x; volatile LAS unsigned* st; };
__device__ __forceinline__ XcdBarrier xcd_barrier_post(unsigned* bar, volatile LAS unsigned* st) {
    XcdBarrier b; b.bar = bar; b.x = xb_xcc_id(); b.st = st;
    if (threadIdx.x == 0) (void)xb_add(&bar[XB_XCNT(b.x)], 1u);
    return b;
}
__device__ __forceinline__ void xcd_barrier_complete(unsigned* bar, unsigned x, unsigned& nloc, unsigned& nx) {
    const unsigned G = gridDim.x * gridDim.y * gridDim.z;
    unsigned sum, cnt, mine, sp = 0u;
    for (;;) {
        sum = 0u; cnt = 0u; mine = 0u;
#pragma unroll
        for (unsigned j = 0; j < 16; ++j) { const unsigned c = xb_ld(&bar[XB_XCNT(j)]); sum += c; cnt += (c > 0u) ? 1u : 0u; mine = (j == x) ? c : mine; }
        if (sum == G) break;
        __builtin_amdgcn_s_sleep(1);
        if ((++sp & 255u) == 0u) { if (xb_ld(&bar[XB_TMO])) break; if (sp > XB_SPIN_CAP) { atomicAdd(&bar[XB_TMO], 1u); break; } }
    }
    nloc = mine > 0u ? mine : 1u; nx = cnt > 0u ? cnt : 1u;
}
__device__ __forceinline__ void xcd_barrier(const XcdBarrier& b, int wave) {
    asm volatile("s_waitcnt vmcnt(0)" ::: "memory");
    __syncthreads();
    if (wave == 0 && __builtin_amdgcn_mbcnt_hi(~0u, __builtin_amdgcn_mbcnt_lo(~0u, 0u)) == 0u) {
        unsigned* bar = b.bar;
        __builtin_amdgcn_s_waitcnt(0);
        unsigned nloc = b.st[0], nx = b.st[1];
        if (nloc == 0u) { xcd_barrier_complete(bar, b.x, nloc, nx); b.st[0] = nloc; b.st[1] = nx; }
        const unsigned old = xb_add(&bar[XB_XSUB(b.x)], 1u);
        const unsigned gen = old / nloc;
        if (old + 1u == (gen + 1u) * nloc) {
            __builtin_amdgcn_fence(__ATOMIC_RELEASE, "agent");
            asm volatile("s_waitcnt vmcnt(0)" ::: "memory");
            const unsigned og = xb_add(&bar[XB_TOP], 1u);
            const unsigned tg = og / nx;
            if (og + 1u == (tg + 1u) * nx) xb_add(&bar[XB_TOPGEN], 1u);
            else XB_SPIN(xb_ld(&bar[XB_TOPGEN]) == tg, bar);
            __builtin_amdgcn_fence(__ATOMIC_ACQUIRE, "agent");
            xb_add(&bar[XB_XGEN(b.x)], 1u);
            asm volatile("s_waitcnt vmcnt(0)" ::: "memory");
        } else {
            XB_SPIN(xb_ld(&bar[XB_XGEN(b.x)]) == gen, bar);
            __builtin_amdgcn_fence(__ATOMIC_ACQUIRE, "agent");
            asm volatile("s_waitcnt vmcnt(0)" ::: "memory");
        }
    }
    __syncthreads();
}

namespace pg8 {
constexpr int BM = 256, BK = 64, HALF = 128, HTB = HALF * BK * 2, STAGE_BYTES = 8 * HTB, NXCD = 8, WGM = 8;
__host__ __device__ __forceinline__ int lds_byte(int r, int c) { const int st = (r >> 4) * 2 + (c >> 5), rr = r & 15, cc = c & 31, ob = rr * 64 + cc * 2; return st * 1024 + (ob ^ (((ob >> 9) & 1) << 5)); }
__host__ __device__ __forceinline__ void stage_rc(int b, int& R, int& C) { const int st = b / 1024, sb = b % 1024, swz = sb ^ (((sb >> 9) & 1) << 5); R = (st >> 1) * 16 + swz / 64; C = (st & 1) * 32 + (swz % 64) / 2; }
constexpr __host__ __device__ __forceinline__ int perm32(int rho) { const int n = rho >> 4, i = rho & 15; return 8 * (i >> 2) + 4 * n + (i & 3); }
__device__ __forceinline__ unsigned cvt_pk_bf16(float lo, float hi) { unsigned r; asm volatile("v_cvt_pk_bf16_f32 %0, %1, %2" : "=v"(r) : "v"(lo), "v"(hi)); return r; }

typedef int v4i_t __attribute__((ext_vector_type(4))); typedef int v8i_t __attribute__((ext_vector_type(8)));
__device__ __forceinline__ v8i_t cat8(bf16x8 lo, bf16x8 hi) { const v4i_t a = __builtin_bit_cast(v4i_t, lo), b = __builtin_bit_cast(v4i_t, hi); return __builtin_shufflevector(a, b, 0, 1, 2, 3, 4, 5, 6, 7); }
__device__ __forceinline__ unsigned pk4_fp8(float a, float b, float c, float d) { int w = 0; w = __builtin_amdgcn_cvt_pk_fp8_f32(a, b, w, false); w = __builtin_amdgcn_cvt_pk_fp8_f32(c, d, w, true); return (unsigned)w; }
struct Unit { int pm, pn, e, cnt; };

template <class P>
__device__ __forceinline__ void gemm_phase(LAS unsigned char* lds, const P& p, int wid) {
    int lane = (int)__builtin_amdgcn_mbcnt_hi(~0u, __builtin_amdgcn_mbcnt_lo(~0u, 0u)); asm volatile("" : "+v"(lane));
    const int tid = wid * 64 + lane, wr = wid >> 2, wc = wid & 3, fr = lane & 15, fq = lane >> 4;
    constexpr int K = P::K, nt = K / BK;
    int Rr[2], Cc[2];
#pragma unroll
    for (int i = 0; i < 2; ++i) stage_rc(tid * 16 + i * 8192, Rr[i], Cc[i]);
    unsigned voffB[2], voffA[2][2];
#pragma unroll
    for (int i = 0; i < 2; ++i) { voffB[i] = (unsigned)(P::brow(0, Rr[i]) * K + Cc[i]) * 2u; voffA[0][i] = (unsigned)(Rr[i] * K + Cc[i]) * 2u; voffA[1][i] = voffA[0][i]; }
    constexpr size_t hB = (size_t)(P::brow(1, 0) - P::brow(0, 0)) * K * 2, hA = P::GATHER ? 0 : (size_t)HALF * K * 2;
    LAS unsigned* vpark = (LAS unsigned*)(lds + STAGE_BYTES + 4096) + tid * 4;
    const size_t kstep = (size_t)(BK * 2);
    const unsigned ldsw = (unsigned)wid * 1024u;
    const int aoff = lds_byte(wr * 64 + fr, fq * 8), boff = lds_byte(wc * 32 + fr, fq * 8);
#define PG8_SA(b, h) (((b) * 2 + (h)) * HTB)
#define PG8_SB(b, h) ((4 + (b) * 2 + (h)) * HTB)
#define PG8_STAGE(bufoff, gbase, voff) do { _Pragma("unroll") for (int _i = 0; _i < 2; ++_i) { unsigned _v = (voff)[_i]; asm volatile("" : "+v"(_v));     \
        __builtin_amdgcn_global_load_lds((const unsigned*)((const char*)(gbase) + _v), (LAS unsigned*)(lds + (bufoff) + ldsw + _i * 8192), 16, 0, 0); } } while (0)
#define PG8_STAGE_A(b, h, gbase) PG8_STAGE(PG8_SA(b, h), (gbase) + (h) * hA, voffA[P::GATHER ? (h) : 0])
#define PG8_STAGE_B(b, h, gbase) PG8_STAGE(PG8_SB(b, h), (gbase) + (h) * hB, voffB)
#define PG8_LDA(dst, b, h) do { _Pragma("unroll") for (int m = 0; m < 4; ++m) _Pragma("unroll") for (int k = 0; k < 2; ++k) dst[m][k] = *(const LAS bf16x8*)(lds + PG8_SA(b, h) + aoff + m * 2048 + k * 1024); } while (0)
#define PG8_LDB(dst, b, h) do { _Pragma("unroll") for (int n = 0; n < 2; ++n) _Pragma("unroll") for (int k = 0; k < 2; ++k) dst[n][k] = *(const LAS bf16x8*)(lds + PG8_SB(b, h) + boff + n * 2048 + k * 1024); } while (0)
#define PG8_MMA(ai, bj, At, Bt) do { __builtin_amdgcn_s_setprio(1); if constexpr (P::FP8) { _Pragma("unroll") for (int m = 0; m < 4; ++m) _Pragma("unroll") for (int n = 0; n < 2; ++n) \
        { const v8i_t b8_ = cat8(Bt[n][0], Bt[n][1]), a8_ = cat8(At[m][0], At[m][1]); \
          asm volatile("v_mfma_scale_f32_16x16x128_f8f6f4 %0, %1, %2, %0, %3, %3 op_sel_hi:[0,0,0]" : "+v"(acc[ai][bj][m][n]) : "v"(b8_), "v"(a8_), "v"(sc1_)); } } else { \
        _Pragma("unroll") for (int m = 0; m < 4; ++m) _Pragma("unroll") for (int n = 0; n < 2; ++n) _Pragma("unroll") for (int k = 0; k < 2; ++k) \
        acc[ai][bj][m][n] = __builtin_amdgcn_mfma_f32_16x16x32_bf16(Bt[n][k], At[m][k], acc[ai][bj][m][n], 0, 0, 0); } __builtin_amdgcn_s_setprio(0); } while (0)
#define PG8_WAIT_V(n) asm volatile("s_waitcnt vmcnt(" #n ")" ::: "memory")
#define PG8_WAIT_L(n) asm volatile("s_waitcnt lgkmcnt(" #n ")" ::: "memory")
#define PG8_BAR __builtin_amdgcn_s_barrier()
#define PG8_SCHED __builtin_amdgcn_sched_barrier(0)
    const int sc1_ = 0x7f7f7f7f;
    Unit cur, nxt; int ui = 0;
    if (!p.next(0, cur)) return;
    f32x4 acc[2][2][4][2];
#pragma unroll
    for (int a = 0; a < 2; ++a)
#pragma unroll
        for (int b = 0; b < 2; ++b)
#pragma unroll
            for (int m = 0; m < 4; ++m)
#pragma unroll
                for (int n = 0; n < 2; ++n) acc[a][b][m][n] = (f32x4){0.f, 0.f, 0.f, 0.f};
    bf16x8 At[4][2], B0[2][2], B1[2][2];
    const char* cA = p.a_base(cur); const char* cB = p.b_base(cur);
    if constexpr (P::GATHER) p.a_offsets(cur, Rr, Cc, voffA);
    PG8_STAGE_B(0, 0, cB); PG8_STAGE_B(0, 1, cB); PG8_STAGE_A(0, 0, cA); PG8_STAGE_A(0, 1, cA);
    if (wr == 1) PG8_BAR;
    PG8_WAIT_V(2); PG8_BAR;
    PG8_STAGE_B(1, 0, cB + kstep); PG8_STAGE_A(1, 0, cA + kstep); PG8_STAGE_B(1, 1, cB + kstep);
    PG8_WAIT_V(6); PG8_BAR;
    for (;;) {
        const bool has_next = p.next(ui + 1, nxt);
        const char* nA = has_next ? p.a_base(nxt) : cA; const char* nB = has_next ? p.b_base(nxt) : cB;
        if constexpr (P::GATHER) {
            unsigned vn[2][2];
            if (has_next) p.a_offsets(nxt, Rr, Cc, vn); else {
#pragma unroll
                for (int h = 0; h < 2; ++h)
#pragma unroll
                    for (int i = 0; i < 2; ++i) vn[h][i] = voffA[h][i]; }
            vpark[0] = vn[0][0]; vpark[1] = vn[0][1]; vpark[2] = vn[1][0]; vpark[3] = vn[1][1];
        }
#pragma nounroll
        for (int t = 0; t < nt; t += 2) {
            const bool last = (t == nt - 2);
            const char* a1 = cA + (size_t)(t + 1) * kstep;
            const char* a2 = last ? nA : cA + (size_t)(t + 2) * kstep; const char* b2 = last ? nB : cB + (size_t)(t + 2) * kstep;
            const char* a3 = a2 + kstep; const char* b3 = b2 + kstep;
            PG8_LDB(B0, 0, 0); PG8_LDB(B1, 0, 1); PG8_SCHED; PG8_LDA(At, 0, 0); PG8_STAGE_A(1, 1, a1);
            if constexpr (P::GATHER) { if (last) { voffA[0][0] = vpark[0]; voffA[0][1] = vpark[1]; voffA[1][0] = vpark[2]; voffA[1][1] = vpark[3]; } }
            PG8_WAIT_V(8); PG8_WAIT_L(0); PG8_BAR; PG8_MMA(0, 0, At, B0); PG8_MMA(0, 1, At, B1); PG8_BAR; PG8_SCHED;
            PG8_LDA(At, 0, 1); PG8_STAGE_B(0, 0, b2); PG8_STAGE_B(0, 1, b2); PG8_STAGE_A(0, 0, a2);
            PG8_WAIT_V(8); PG8_WAIT_L(0); PG8_BAR; PG8_MMA(1, 0, At, B0); PG8_MMA(1, 1, At, B1); PG8_BAR; PG8_SCHED;
            PG8_LDB(B0, 1, 0); PG8_LDB(B1, 1, 1); PG8_SCHED; PG8_LDA(At, 1, 0); PG8_STAGE_A(0, 1, a2);
            PG8_WAIT_V(8); PG8_WAIT_L(0); PG8_BAR; PG8_MMA(0, 0, At, B0); PG8_MMA(0, 1, At, B1); PG8_BAR; PG8_SCHED;
            PG8_LDA(At, 1, 1); PG8_STAGE_B(1, 0, b3); PG8_STAGE_B(1, 1, b3); PG8_STAGE_A(1, 0, a3);
            PG8_WAIT_V(8); PG8_WAIT_L(0); PG8_BAR; PG8_MMA(1, 0, At, B0); PG8_MMA(1, 1, At, B1); PG8_BAR; PG8_SCHED;
        }
        if (wr == 0) PG8_BAR;
        if constexpr (P::FP8) asm volatile("s_nop 15\n\ts_nop 15" ::: "memory");
        p.epi(acc, cur, wr, wc, fr, fq);
        if (!has_next) break;
#pragma unroll
        for (int a = 0; a < 2; ++a)
#pragma unroll
            for (int b = 0; b < 2; ++b)
#pragma unroll
                for (int m = 0; m < 4; ++m)
#pragma unroll
                    for (int n = 0; n < 2; ++n) acc[a][b][m][n] = (f32x4){0.f, 0.f, 0.f, 0.f};
        cur = nxt; cA = nA; cB = nB; ++ui;
        if (wr == 1) PG8_BAR;
    }
    PG8_WAIT_V(0);
    PG8_BAR;
#undef PG8_SA
#undef PG8_SB
#undef PG8_STAGE
#undef PG8_STAGE_A
#undef PG8_STAGE_B
#undef PG8_LDA
#undef PG8_LDB
#undef PG8_MMA
#undef PG8_WAIT_V
#undef PG8_WAIT_L
#undef PG8_BAR
#undef PG8_SCHED
}

struct DenseOrder {
    int nM, nN, nwg, G, c;
    __device__ void init(int M_, int N_, int G_, int c_) { nM = M_ / BM; nN = N_ / BM; nwg = nM * nN; G = G_; c = c_; }
    __device__ bool next(int i, Unit& u) const {
        const long L = (long)i * G + c; if (L >= nwg) return false;
        int wgid = (int)L; { const int q = nwg / NXCD, r = nwg % NXCD, xcd = wgid % NXCD, off = wgid / NXCD; wgid = (xcd < r ? xcd * (q + 1) : r * (q + 1) + (xcd - r) * q) + off; }
        const int nig = WGM * nN, gid = wgid / nig, fm = gid * WGM, gsz = (nM - fm) < WGM ? (nM - fm) : WGM;
        u.pm = fm + ((wgid % nig) % gsz); u.pn = (wgid % nig) / gsz; u.e = 0; u.cnt = 0; return true;
    }
};
struct GroupOrder {
    const LAS int* pt; const LAS int* cn; LAS int* ul; int npn, total, G, c;
    __device__ void init(const LAS int* pt_, const LAS int* cn_, LAS int* ul_, int npn_, int G_, int c_) { pt = pt_; cn = cn_; ul = ul_; npn = npn_; total = __builtin_amdgcn_readfirstlane(pt_[NE] * npn_); G = G_; c = c_; }
    __device__ void build(int wave, int lane) const {
        if (wave == 0 && lane < 16) {
            const long L = (long)lane * G + c; int pm = -1, pn = 0, e = 0, cnt = 0;
            if (L < total) {
                int wgid = (int)L; { const int q = total / NXCD, r = total % NXCD, xcd = wgid % NXCD, off = wgid / NXCD; wgid = (xcd < r ? xcd * (q + 1) : r * (q + 1) + (xcd - r) * q) + off; }
                for (int j = 1; j < NE; ++j) e += (pt[j] * npn <= wgid) ? 1 : 0;
                const int t0 = pt[e], te = pt[e + 1] - t0, local = wgid - t0 * npn, mt = local % te;
                pn = local / te; pm = t0 + mt; cnt = cn[e] - mt * 256;
            }
            ul[lane * 4 + 0] = pm; ul[lane * 4 + 1] = pn; ul[lane * 4 + 2] = e; ul[lane * 4 + 3] = cnt;
        }
    }
    __device__ bool next(int i, Unit& u) const {
        if (i >= 16) return false;
        u.pm = __builtin_amdgcn_readfirstlane(ul[i * 4 + 0]); u.pn = __builtin_amdgcn_readfirstlane(ul[i * 4 + 1]);
        u.e = __builtin_amdgcn_readfirstlane(ul[i * 4 + 2]); u.cnt = __builtin_amdgcn_readfirstlane(ul[i * 4 + 3]);
        return u.pm >= 0;
    }
};
}

struct PInProj : pg8::DenseOrder {
    static constexpr int K = 1024; static constexpr bool GATHER = false, FP8 = false;
    const bf16_t* XN; const bf16_t* Wt; bf16_t* QKV; const float *gaq, *gak, *gbq, *gbk;
    static constexpr __host__ __device__ __forceinline__ int brow(int bj, int R) { return 64 * (R >> 5) + 32 * bj + pg8::perm32(R & 31); }
    __device__ __forceinline__ const char* a_base(const pg8::Unit& u) const { return (const char*)(XN + (size_t)u.pm * 256 * K); }
    __device__ __forceinline__ const char* b_base(const pg8::Unit& u) const { return (const char*)(Wt + (size_t)u.pn * 256 * K); }
    __device__ __forceinline__ void epi(const f32x4 (&acc)[2][2][4][2], const pg8::Unit& u, int wr, int wc, int fr, int fq) const {
        constexpr float ISC = 1.f;
        const int ty = u.pn >> 1;
        const float* g = (ty == 0) ? gaq : (ty == 1) ? gak : (ty == 3) ? gbq : (ty == 4) ? gbk : nullptr;
        const float post = (ty == 0 || ty == 3) ? QSCALE : 1.f;
        const int row0 = u.pm * 256 + wr * 64 + fr, col0 = u.pn * 256 + wc * 64 + 8 * fq;
        f32x4 gv[2][2];
#pragma unroll
        for (int bj = 0; bj < 2; ++bj)
#pragma unroll
            for (int n = 0; n < 2; ++n) gv[bj][n] = g ? *(const f32x4*)(g + 32 * bj + 8 * fq + 4 * n) : (f32x4){1.f, 1.f, 1.f, 1.f};
#pragma unroll
        for (int ai = 0; ai < 2; ++ai)
#pragma unroll
            for (int m = 0; m < 4; ++m) {
                float rs = 1.f;
                if (g) {
                    float ss = 0.f;
#pragma unroll
                    for (int bj = 0; bj < 2; ++bj)
#pragma unroll
                        for (int n = 0; n < 2; ++n) { const f32x4 v = acc[ai][bj][m][n] * ISC; ss += (v[0] * v[0] + v[1] * v[1]) + (v[2] * v[2] + v[3] * v[3]); }
                    ss += __shfl_xor(ss, 16); ss += __shfl_xor(ss, 32);
                    rs = rsqrtf(ss * (1.f / 64.f) + RMS_EPS) * post;
                }
                bf16_t* rowp = QKV + (size_t)(row0 + ai * 128 + m * 16) * NIN + col0;
#pragma unroll
                for (int bj = 0; bj < 2; ++bj) {
                    const f32x4 v0 = acc[ai][bj][m][0] * gv[bj][0] * (rs * ISC), v1 = acc[ai][bj][m][1] * gv[bj][1] * (rs * ISC);
                    u32x4 w; w.x = pg8::cvt_pk_bf16(v0[0], v0[1]); w.y = pg8::cvt_pk_bf16(v0[2], v0[3]); w.z = pg8::cvt_pk_bf16(v1[0], v1[1]); w.w = pg8::cvt_pk_bf16(v1[2], v1[3]);
                    *(u32x4*)(rowp + 32 * bj) = w;
                }
            }
    }
};
struct POutProj : pg8::DenseOrder {
    static constexpr int K = 1024; static constexpr bool GATHER = false, FP8 = false;
    const bf16_t* AO; const bf16_t* Wt; const float* x; const float* mod; float* x1;
    static constexpr __host__ __device__ __forceinline__ int brow(int bj, int R) { return 128 * bj + R; }
    __device__ __forceinline__ const char* a_base(const pg8::Unit& u) const { return (const char*)(AO + (size_t)u.pm * 256 * K); }
    __device__ __forceinline__ const char* b_base(const pg8::Unit& u) const { return (const char*)(Wt + (size_t)u.pn * 256 * K); }
    __device__ __forceinline__ void epi(const f32x4 (&acc)[2][2][4][2], const pg8::Unit& u, int wr, int wc, int fr, int fq) const {
        const int row0 = u.pm * 256 + wr * 64 + fr, col0 = u.pn * 256 + wc * 32 + 4 * fq;
        const float* gate1 = mod + ((u.pm * 256) / S) * 6144 + 2048;
        f32x4 gv[2][2];
#pragma unroll
        for (int bj = 0; bj < 2; ++bj)
#pragma unroll
            for (int n = 0; n < 2; ++n) gv[bj][n] = *(const f32x4*)(gate1 + col0 + bj * 128 + n * 16);
#pragma unroll
        for (int ai = 0; ai < 2; ++ai)
#pragma unroll
            for (int m = 0; m < 4; ++m) { const size_t off = (size_t)(row0 + ai * 128 + m * 16) * D + col0;
#pragma unroll
                for (int bj = 0; bj < 2; ++bj)
#pragma unroll
                    for (int n = 0; n < 2; ++n) { const f32x4 xv = *(const f32x4*)(x + off + bj * 128 + n * 16); *(f32x4*)(x1 + off + bj * 128 + n * 16) = xv + gv[bj][n] * acc[ai][bj][m][n]; }
                if (m & 1) asm volatile("" ::: "memory"); }
    }
};
struct PGateUp : pg8::GroupOrder {
    static constexpr int K = 512; static constexpr bool GATHER = true, FP8 = true;
    const bf16_t* H2; const bf16_t* Wt; const float* bgu; const int* list; bf16_t* ACT;
    static constexpr __host__ __device__ __forceinline__ int brow(int bj, int R) { return 1024 * bj + (R & ~31) + pg8::perm32(R & 31); }
    __device__ __forceinline__ const char* a_base(const pg8::Unit&) const { return (const char*)H2; }
    __device__ __forceinline__ const char* b_base(const pg8::Unit& u) const { return (const char*)(Wt + ((size_t)u.e * 2048 + u.pn * 128) * K); }
    __device__ __forceinline__ void a_offsets(const pg8::Unit& u, const int (&R)[2], const int (&C)[2], unsigned (&voff)[2][2]) const {
        const int* lp = list + (size_t)u.e * M + (size_t)(u.pm - pt[u.e]) * 256;
#pragma unroll
        for (int h = 0; h < 2; ++h)
#pragma unroll
            for (int i = 0; i < 2; ++i) { int r = h * 128 + R[i]; r = r < u.cnt ? r : 0; const int tok = lp[r]; voff[h][i] = (unsigned)(tok * K + C[i]) * 2u; }
    }
    __device__ __forceinline__ void epi(const f32x4 (&acc)[2][2][4][2], const pg8::Unit& u, int wr, int wc, int fr, int fq) const {
        const int row0 = u.pm * 256 + wr * 64 + fr, col0 = u.pn * 128 + wc * 32 + 8 * fq;
        const float* bias = bgu + u.e * 2048 + col0;
        f32x4 bg[2], bu[2];
#pragma unroll
        for (int n = 0; n < 2; ++n) { bg[n] = *(const f32x4*)(bias + 4 * n); bu[n] = *(const f32x4*)(bias + 1024 + 4 * n); }
#pragma unroll
        for (int ai = 0; ai < 2; ++ai)
#pragma unroll
            for (int m = 0; m < 4; ++m) {
                float a[2][4];
#pragma unroll
                for (int n = 0; n < 2; ++n)
#pragma unroll
                    for (int r = 0; r < 4; ++r) {
                        float g = acc[ai][0][m][n][r] * (1.f / (H2_SCALE * W8_SCALE)) + bg[n][r], uu = acc[ai][1][m][n][r] * (1.f / (H2_SCALE * W8_SCALE)) + bu[n][r];
                        g = fminf(g, 7.f); uu = fminf(fmaxf(uu, -7.f), 7.f);
                        a[n][r] = fminf(fmaxf((uu + 1.f) * g * __builtin_amdgcn_rcpf(1.f + __builtin_amdgcn_exp2f(-1.702f * LOG2E * g)) * ACT_SCALE, -448.f), 448.f);
                    }
                u32x2 w; w.x = pg8::pk4_fp8(a[0][0], a[0][1], a[0][2], a[0][3]); w.y = pg8::pk4_fp8(a[1][0], a[1][1], a[1][2], a[1][3]);
                *(u32x2*)((unsigned char*)ACT + (size_t)(row0 + ai * 128 + m * 16) * DFF + col0) = w;
            }
    }
};
struct PDown : pg8::GroupOrder {
    static constexpr int K = 512; static constexpr bool GATHER = false, FP8 = true;
    const bf16_t* ACT; const bf16_t* Wt; const float* bd; bf16_t* Y;
    static constexpr __host__ __device__ __forceinline__ int brow(int bj, int R) { return 128 * bj + (R & ~31) + pg8::perm32(R & 31); }
    __device__ __forceinline__ const char* a_base(const pg8::Unit& u) const { return (const char*)(ACT + (size_t)u.pm * 256 * K); }
    __device__ __forceinline__ const char* b_base(const pg8::Unit& u) const { return (const char*)(Wt + ((size_t)u.e * 1024 + u.pn * 256) * K); }
    __device__ __forceinline__ void epi(const f32x4 (&acc)[2][2][4][2], const pg8::Unit& u, int wr, int wc, int fr, int fq) const {
        const int row0 = u.pm * 256 + wr * 64 + fr, col0 = u.pn * 256 + wc * 32 + 8 * fq;
        const float* bias = bd + u.e * 1024 + col0;
        f32x4 bv[2][2];
#pragma unroll
        for (int bj = 0; bj < 2; ++bj)
#pragma unroll
            for (int n = 0; n < 2; ++n) bv[bj][n] = *(const f32x4*)(bias + bj * 128 + 4 * n);
#pragma unroll
        for (int ai = 0; ai < 2; ++ai)
#pragma unroll
            for (int m = 0; m < 4; ++m) { unsigned char* rowp = (unsigned char*)Y + (size_t)(row0 + ai * 128 + m * 16) * D + col0;
#pragma unroll
                for (int bj = 0; bj < 2; ++bj) { f32x4 v0 = (acc[ai][bj][m][0] * (1.f / (ACT_SCALE * W8_SCALE)) + bv[bj][0]) * Y_SCALE, v1 = (acc[ai][bj][m][1] * (1.f / (ACT_SCALE * W8_SCALE)) + bv[bj][1]) * Y_SCALE;
#pragma unroll
                    for (int q_ = 0; q_ < 4; ++q_) { v0[q_] = fminf(fmaxf(v0[q_], -448.f), 448.f); v1[q_] = fminf(fmaxf(v1[q_], -448.f), 448.f); }
                    u32x2 w; w.x = pg8::pk4_fp8(v0[0], v0[1], v0[2], v0[3]); w.y = pg8::pk4_fp8(v1[0], v1[1], v1[2], v1[3]);
                    *(u32x2*)(rowp + bj * 128) = w; } }
    }
};


namespace att {
typedef float f32x16 __attribute__((ext_vector_type(16)));
typedef short s16x4 __attribute__((ext_vector_type(4)));
typedef short v4i16_t __attribute__((ext_vector_type(4)));
typedef float f32x2_t __attribute__((ext_vector_type(2))); typedef __bf16 bf16x2_t __attribute__((ext_vector_type(2)));
__device__ __forceinline__ unsigned cvtpk(float lo, float hi) { f32x2_t v = {lo, hi}; bf16x2_t b = __builtin_convertvector(v, bf16x2_t); return __builtin_bit_cast(unsigned, b); }
__device__ __forceinline__ s16x4 vtr(const LAS unsigned char* p) { return __builtin_bit_cast(s16x4, __builtin_amdgcn_ds_read_tr16_b64_v4i16((LAS v4i16_t*)p)); }
__device__ __forceinline__ void glds16(const void* gsrc, LAS unsigned char* dst) { __builtin_amdgcn_global_load_lds((const unsigned*)gsrc, (LAS unsigned*)dst, 16, 0, 0); }
#define ATT_CR(r) (((r) & 3) + 8 * ((r) >> 2))
#define ATT_WAIT_V(n) asm volatile("s_waitcnt vmcnt(" #n ")" ::: "memory")
#define ATT_WAIT_L0() asm volatile("s_waitcnt lgkmcnt(0)" ::: "memory")

template <int MODE> __device__ __forceinline__ float soft_tile(f32x16& p0, f32x16& p1, float sl, int dqh) {
    float sum = 0.f;
#pragma unroll
    for (int r = 0; r < 16; ++r) {
        float x0 = __builtin_fmaf(sl, (float)ATT_CR(r), p0[r]), x1 = __builtin_fmaf(sl, (float)(ATT_CR(r) + 32), p1[r]);
        if (MODE == 1) { x0 = (ATT_CR(r) <= dqh) ? x0 : -INFINITY; x1 = (ATT_CR(r) + 32 <= dqh) ? x1 : -INFINITY; }
        if (MODE == 2) { x0 = ((unsigned)(dqh - ATT_CR(r)) <= 128u) ? x0 : -INFINITY; x1 = ((unsigned)(dqh - ATT_CR(r) - 32) <= 128u) ? x1 : -INFINITY; }
        p0[r] = __builtin_amdgcn_exp2f(x0); p1[r] = __builtin_amdgcn_exp2f(x1);
        sum += p0[r] + p1[r];
    }
    return sum;
}
__device__ __forceinline__ void pack_p(const f32x16& p0, const f32x16& p1, bf16x8 (&pa)[4]) {
    u32x4 w0 = {cvtpk(p0[0], p0[1]), cvtpk(p0[2], p0[3]), cvtpk(p0[4], p0[5]), cvtpk(p0[6], p0[7])};
    u32x4 w1 = {cvtpk(p0[8], p0[9]), cvtpk(p0[10], p0[11]), cvtpk(p0[12], p0[13]), cvtpk(p0[14], p0[15])};
    u32x4 w2 = {cvtpk(p1[0], p1[1]), cvtpk(p1[2], p1[3]), cvtpk(p1[4], p1[5]), cvtpk(p1[6], p1[7])};
    u32x4 w3 = {cvtpk(p1[8], p1[9]), cvtpk(p1[10], p1[11]), cvtpk(p1[12], p1[13]), cvtpk(p1[14], p1[15])};
    pa[0] = __builtin_bit_cast(bf16x8, w0); pa[1] = __builtin_bit_cast(bf16x8, w1); pa[2] = __builtin_bit_cast(bf16x8, w2); pa[3] = __builtin_bit_cast(bf16x8, w3);
}
template <int NDB> __device__ __forceinline__ void pv_tile(f32x16 (&o)[NDB], const LAS unsigned char* vrd, const bf16x8 (&pa)[4]) {
#pragma unroll
    for (int db = 0; db < NDB; ++db) {
        s16x4 lo[4], hh[4];
#pragma unroll
        for (int g = 0; g < 4; ++g) { lo[g] = vtr(vrd + db * 4096 + g * 1024); hh[g] = vtr(vrd + db * 4096 + g * 1024 + 512); }
#pragma unroll
        for (int g = 0; g < 4; ++g) { const bf16x8 vf = {lo[g][0], lo[g][1], lo[g][2], lo[g][3], hh[g][0], hh[g][1], hh[g][2], hh[g][3]};
            o[db] = __builtin_amdgcn_mfma_f32_32x32x16_bf16(pa[g], vf, o[db], 0, 0, 0); }
    }
}
__device__ __forceinline__ float gain_bound(const float* ga, const float* gb, int lane) {
    float a = fabsf(ga[lane & 63]), b = fabsf(gb[lane & 63]);
#pragma unroll
    for (int o = 1; o < 64; o <<= 1) { a = fmaxf(a, __shfl_xor(a, o)); b = fmaxf(b, __shfl_xor(b, o)); }
    return QSCALE * 64.f * a * b * 1.02f + 0.25f;
}

constexpr int B2_SLOT = 32768;
__device__ __forceinline__ void attn_b2_unit(LAS unsigned char* lds, LAS float* wsf, const bf16_t* QKV, bf16_t* AO, const float* gd, int b, int h, int qb, float Mb, float lam, int wave, int lane) {
    const int r32 = lane & 31, hi = lane >> 5;
    const int c = wave >> 2, wq = wave & 3;
    const int q0 = qb * 128, tq = q0 + wq * 32 + r32;
    const size_t rowbase = (size_t)b * S;
    const bf16_t* Qp = QKV + (rowbase + tq) * NIN + 1536 + h * 128 + c * 64;
    const bf16_t* Kh = QKV + rowbase * NIN + 2048 + h * 128;
    const bf16_t* Vh = QKV + rowbase * NIN + 2560 + h * 128;
    const float sl = exp2f(-2.f * (float)(h + 1)) * LOG2E;
    bf16x8 qr[4];
#pragma unroll
    for (int d0 = 0; d0 < 4; ++d0) qr[d0] = *(const bf16x8*)(Qp + d0 * 16 + hi * 8);
    const int NT = (q0 + 128) / 64;
    const bf16_t* ksrc = Kh + (size_t)lane * NIN + wave * 8;
    const int i0 = wave, i1 = wave + 8;
    const bf16_t* vsrc0 = Vh + (size_t)(16 * (i0 & 3) + (lane >> 2)) * NIN + (i0 >> 2) * 32 + (lane & 3) * 8;
    const bf16_t* vsrc1 = Vh + (size_t)(16 * (i1 & 3) + (lane >> 2)) * NIN + (i1 >> 2) * 32 + (lane & 3) * 8;
#define ATT_DMA(t, s) do { const size_t to_ = (size_t)(t) * 64 * NIN; LAS unsigned char* sb_ = lds + (s) * B2_SLOT; \
        glds16(ksrc + to_, sb_ + wave * 1024); glds16(ksrc + 64 + to_, sb_ + 8192 + wave * 1024); glds16(vsrc0 + to_, sb_ + 16384 + i0 * 1024); glds16(vsrc1 + to_, sb_ + 16384 + i1 * 1024); } while (0)
    const int kfo = c * 8192 + hi * 1024 + r32 * 16;
    const int vro = 16384 + ((lane >> 4) & 1) * 32 + (lane & 3) * 8 + (4 * hi + ((lane & 15) >> 2)) * 64;
    f32x16 o[4]; float lsum = 0.f;
#pragma unroll
    for (int d = 0; d < 4; ++d) o[d] = f32x16{};
    ATT_WAIT_L0(); __builtin_amdgcn_s_barrier();
    ATT_DMA(0, 0); ATT_DMA(1, 1);
    const int qmax_w = q0 + wq * 32 + 31, qmin_w = q0 + wq * 32;
    int slot = 0;
    for (int t = 0; t < NT; ++t) {
        if (t + 1 < NT) ATT_WAIT_V(4); else ATT_WAIT_V(0);
        ATT_WAIT_L0(); __builtin_amdgcn_s_barrier();
        if (t + 2 < NT) { const int s2 = (slot >= 1) ? slot - 1 : 2; ATT_DMA(t + 2, s2); }
        const int k0 = 64 * t;
        if (k0 <= qmax_w) {
            const LAS unsigned char* sb = lds + slot * B2_SLOT;
            bf16x8 kf[8];
#pragma unroll
            for (int d0 = 0; d0 < 4; ++d0) { kf[2 * d0] = *(const LAS bf16x8*)(sb + kfo + d0 * 2048); kf[2 * d0 + 1] = *(const LAS bf16x8*)(sb + kfo + d0 * 2048 + 512); }
            const int dqh = tq - k0 - 4 * hi;
            const float ci = -sl * (float)dqh - Mb;
            f32x16 p0, p1;
#pragma unroll
            for (int r = 0; r < 16; ++r) { p0[r] = ci; p1[r] = ci; }
#pragma unroll
            for (int d0 = 0; d0 < 4; ++d0) { p0 = __builtin_amdgcn_mfma_f32_32x32x16_bf16(kf[2 * d0], qr[d0], p0, 0, 0, 0); p1 = __builtin_amdgcn_mfma_f32_32x32x16_bf16(kf[2 * d0 + 1], qr[d0], p1, 0, 0, 0); }
            if (k0 + 63 <= qmin_w) lsum += soft_tile<0>(p0, p1, sl, dqh); else lsum += soft_tile<1>(p0, p1, sl, dqh);
            bf16x8 pa[4]; pack_p(p0, p1, pa);
            pv_tile<4>(o, sb + vro, pa);
        }
        slot = (slot == 2) ? 0 : slot + 1;
    }
#undef ATT_DMA
    { auto rr = __builtin_amdgcn_permlane32_swap(__float_as_uint(lsum), __float_as_uint(lsum), false, false); lsum = __uint_as_float(rr[0]) + __uint_as_float(rr[1]); }
    if (hi == 0) wsf[r32] = lsum;
    ATT_WAIT_L0(); __builtin_amdgcn_s_barrier();
    LAS float* X = (LAS float*)lds + (size_t)(wq * 32) * 128 + r32;
    if (c == 1) {
#pragma unroll
        for (int r = 0; r < 16; ++r) { const int q = ATT_CR(r) + 4 * hi; const float f = lam * __builtin_amdgcn_rcpf(wsf[q]);
#pragma unroll
            for (int db = 0; db < 4; ++db) X[q * 128 + db * 32] = o[db][r] * f; }
    }
    ATT_WAIT_L0(); __builtin_amdgcn_s_barrier();
    if (c == 0) {
        float gdv[4];
#pragma unroll
        for (int db = 0; db < 4; ++db) gdv[db] = gd[db * 32 + r32] * (1.f - LAMBDA_INIT);
        LAS bf16_t* stg = (LAS bf16_t*)(lds + 65536 + wq * 8192);
#pragma unroll
        for (int r = 0; r < 16; ++r) { const int q = ATT_CR(r) + 4 * hi; const float rl = __builtin_amdgcn_rcpf(wsf[q]);
            float v[4], ss = 0.f;
#pragma unroll
            for (int db = 0; db < 4; ++db) { v[db] = o[db][r] * rl - X[q * 128 + db * 32]; ss += v[db] * v[db]; }
            ss += __shfl_xor(ss, 1); ss += __shfl_xor(ss, 2); ss += __shfl_xor(ss, 4); ss += __shfl_xor(ss, 8); ss += __shfl_xor(ss, 16);
            const float rs = rsqrtf(ss * (1.f / 128.f) + RMS_EPS);
#pragma unroll
            for (int db = 0; db < 4; ++db) stg[q * 128 + db * 32 + r32] = f2bf(v[db] * rs * gdv[db]); }
        ATT_WAIT_L0();
        bf16_t* ao = AO + (rowbase + q0 + wq * 32) * D + 512 + h * 128;
#pragma unroll
        for (int i = 0; i < 8; ++i) { const int p = i * 64 + lane, row = p >> 4, ch = p & 15; const u32x4 v = *(const LAS u32x4*)(stg + row * 128 + ch * 8); *(u32x4*)(ao + (size_t)row * D + ch * 8) = v; }
    }
    ATT_WAIT_L0();
}
__device__ __forceinline__ void attn_b_phase(LAS unsigned char* lds, LAS float* wsf, const bf16_t* QKV, bf16_t* AO, const float* gbq, const float* gbk, const float* gd,
                                             const float* lq1, const float* lk1, const float* lq2, const float* lk2, int vcu, int wave, int lane) {
    const float Mb = gain_bound(gbq, gbk, lane);
    float s1 = lq1[lane] * lk1[lane], s2 = lq2[lane] * lk2[lane];
#pragma unroll
    for (int o = 1; o < 64; o <<= 1) { s1 += __shfl_xor(s1, o); s2 += __shfl_xor(s2, o); }
    const float lam = __expf(s1) - __expf(s2) + LAMBDA_INIT;
    const int bh = vcu >> 3, s = vcu & 7, b = bh >> 2, h = bh & 3;
    attn_b2_unit(lds, wsf, QKV, AO, gd, b, h, 15 - s, Mb, lam, wave, lane);
    attn_b2_unit(lds, wsf, QKV, AO, gd, b, h, s, Mb, lam, wave, lane);
    ATT_WAIT_L0(); __builtin_amdgcn_s_barrier();
}

__device__ __forceinline__ void attn_a2_unit(LAS unsigned char* lds, LAS float* wsf, const bf16_t* QKV, bf16_t* AO, int b, int h, int r, int jb, float Mb, int wave, int lane) {
    const int r32 = lane & 31, hi = lane >> 5;
    const int j = 32 * jb + r32, tq = r + 16 * j;
    const size_t rowbase = (size_t)b * S;
    const bf16_t* Qp = QKV + (rowbase + tq) * NIN + h * 64;
    const bf16_t* Kh = QKV + rowbase * NIN + 512 + h * 64;
    const float sl1 = exp2f(-(float)(h + 1)) * LOG2E;
    bf16x8 qr[4];
#pragma unroll
    for (int d0 = 0; d0 < 4; ++d0) qr[d0] = *(const bf16x8*)(Qp + d0 * 16 + hi * 8);
    const int n3 = (jb >= 2) ? 2 : 1, n2 = (jb == 0) ? 2 : 4, n1 = (jb == 0) ? 8 : 10, npriv = n3 + n2;
    auto tile_step = [&](int idx) -> int { return idx < n3 ? 16 : 4; };
    auto tile_k0 = [&](int idx) -> int { return idx < n3 ? 64 * idx : 64 * ((jb == 0 ? 0 : 2 * jb - 2) + idx - n3); };
    auto tile_uq = [&](int step) -> int { return step == 16 ? j : (r >> 2) + 4 * j; };
    auto tile_pos0 = [&](int step, int k0) -> int { return (r & (step - 1)) + step * k0; };
    LAS unsigned char* vbuf = lds + wave * 16384;
    const int vr16 = lane >> 2;
    bf16x8 kfn[8];
#define ATT_PREF(idx, buf) do { const int st_ = tile_step(idx), k0_ = tile_k0(idx); const bf16_t* kb_ = Kh + (size_t)tile_pos0(st_, k0_) * NIN; const size_t rs_ = (size_t)st_ * NIN; \
        _Pragma("unroll") for (int d0 = 0; d0 < 4; ++d0) { kfn[2 * d0] = *(const bf16x8*)(kb_ + (size_t)r32 * rs_ + d0 * 16 + hi * 8); kfn[2 * d0 + 1] = *(const bf16x8*)(kb_ + (size_t)(r32 + 32) * rs_ + d0 * 16 + hi * 8); } \
        _Pragma("unroll") for (int i = 0; i < 8; ++i) glds16(kb_ + 512 + (size_t)(16 * (i & 3) + vr16) * rs_ + (i >> 2) * 32 + (lane & 3) * 8, vbuf + (buf) * 8192 + i * 1024); } while (0)
    const int vro = ((lane >> 4) & 1) * 32 + (lane & 3) * 8 + (4 * hi + ((lane & 15) >> 2)) * 64;
    f32x16 o[2]; o[0] = f32x16{}; o[1] = f32x16{}; float lsum = 0.f;
    ATT_WAIT_L0(); __builtin_amdgcn_s_barrier();
    ATT_PREF(0, 0);
    for (int idx = 0; idx < npriv; ++idx) {
        ATT_WAIT_V(0);
        bf16x8 kf[8];
#pragma unroll
        for (int i = 0; i < 8; ++i) kf[i] = kfn[i];
        ATT_WAIT_L0();
        if (idx + 1 < npriv) ATT_PREF(idx + 1, (idx + 1) & 1);
        const int st = tile_step(idx), k0 = tile_k0(idx);
        const int dqh = tile_uq(st) - k0 - 4 * hi;
        const float sl = sl1 * (float)st;
        const float ci = -sl * (float)dqh - Mb;
        f32x16 p0, p1;
#pragma unroll
        for (int rr = 0; rr < 16; ++rr) { p0[rr] = ci; p1[rr] = ci; }
#pragma unroll
        for (int d0 = 0; d0 < 4; ++d0) { p0 = __builtin_amdgcn_mfma_f32_32x32x16_bf16(kf[2 * d0], qr[d0], p0, 0, 0, 0); p1 = __builtin_amdgcn_mfma_f32_32x32x16_bf16(kf[2 * d0 + 1], qr[d0], p1, 0, 0, 0); }
        lsum += soft_tile<2>(p0, p1, sl, dqh);
        bf16x8 pa[4]; pack_p(p0, p1, pa);
        pv_tile<2>(o, vbuf + (idx & 1) * 8192 + vro, pa);
    }
#undef ATT_PREF
    ATT_WAIT_L0(); __builtin_amdgcn_s_barrier();
    const int T0 = (jb == 0) ? 0 : 8 * jb - 2;
    const bf16_t* ksrc = Kh + (size_t)(64 * T0 + lane) * NIN + wave * 8;
    const bf16_t* vsrc = Kh + 512 + (size_t)(64 * T0 + 16 * (wave & 3) + (lane >> 2)) * NIN + (wave >> 2) * 32 + (lane & 3) * 8;
#define ATT_DMA(t, s) do { const size_t to_ = (size_t)(t) * 64 * NIN; LAS unsigned char* sb_ = lds + (s) * 16384; glds16(ksrc + to_, sb_ + wave * 1024); glds16(vsrc + to_, sb_ + 8192 + wave * 1024); } while (0)
    const int kfo = hi * 1024 + r32 * 16;
    ATT_DMA(0, 0); ATT_DMA(1, 1);
    int slot = 0;
    for (int t = 0; t < n1; ++t) {
        if (t + 1 < n1) ATT_WAIT_V(2); else ATT_WAIT_V(0);
        ATT_WAIT_L0(); __builtin_amdgcn_s_barrier();
        if (t + 2 < n1) { const int s2 = (slot >= 1) ? slot - 1 : 2; ATT_DMA(t + 2, s2); }
        const LAS unsigned char* sb = lds + slot * 16384;
        bf16x8 kf[8];
#pragma unroll
        for (int d0 = 0; d0 < 4; ++d0) { kf[2 * d0] = *(const LAS bf16x8*)(sb + kfo + d0 * 2048); kf[2 * d0 + 1] = *(const LAS bf16x8*)(sb + kfo + d0 * 2048 + 512); }
        const int dqh = tq - 64 * (T0 + t) - 4 * hi;
        const float ci = -sl1 * (float)dqh - Mb;
        f32x16 p0, p1;
#pragma unroll
        for (int rr = 0; rr < 16; ++rr) { p0[rr] = ci; p1[rr] = ci; }
#pragma unroll
        for (int d0 = 0; d0 < 4; ++d0) { p0 = __builtin_amdgcn_mfma_f32_32x32x16_bf16(kf[2 * d0], qr[d0], p0, 0, 0, 0); p1 = __builtin_amdgcn_mfma_f32_32x32x16_bf16(kf[2 * d0 + 1], qr[d0], p1, 0, 0, 0); }
        lsum += soft_tile<2>(p0, p1, sl1, dqh);
        bf16x8 pa[4]; pack_p(p0, p1, pa);
        pv_tile<2>(o, sb + 8192 + vro, pa);
        slot = (slot == 2) ? 0 : slot + 1;
    }
#undef ATT_DMA
    { auto rr = __builtin_amdgcn_permlane32_swap(__float_as_uint(lsum), __float_as_uint(lsum), false, false); lsum = __uint_as_float(rr[0]) + __uint_as_float(rr[1]); }
    if (hi == 0) wsf[r32] = lsum;
    ATT_WAIT_L0(); __builtin_amdgcn_s_barrier();
    LAS bf16_t* stg = (LAS bf16_t*)(lds + wave * 4096);
#pragma unroll
    for (int rr = 0; rr < 16; ++rr) { const int q = ATT_CR(rr) + 4 * hi; const float rl = __builtin_amdgcn_rcpf(wsf[q]);
#pragma unroll
        for (int db = 0; db < 2; ++db) stg[q * 64 + db * 32 + r32] = f2bf(o[db][rr] * rl); }
    ATT_WAIT_L0();
#pragma unroll
    for (int i = 0; i < 4; ++i) { const int row = i * 8 + (lane >> 3), ch = lane & 7; const u32x4 v = *(const LAS u32x4*)(stg + row * 64 + ch * 8);
        *(u32x4*)(AO + (rowbase + r + 16 * (32 * jb + row)) * D + h * 64 + ch * 8) = v; }
    ATT_WAIT_L0();
}
__device__ __forceinline__ void attn_a_phase(LAS unsigned char* lds, LAS float* wsf, const bf16_t* QKV, bf16_t* AO, const float* gaq, const float* gak, int vcu, int wave, int lane) {
    const float Mb = gain_bound(gaq, gak, lane);
    const int bh = vcu >> 2, b = bh >> 3, h = bh & 7, r = 8 * (vcu & 1) + wave, jp = (vcu >> 1) & 1;
    attn_a2_unit(lds, wsf, QKV, AO, b, h, r, jp ? 2 : 3, Mb, wave, lane);
    attn_a2_unit(lds, wsf, QKV, AO, b, h, r, jp ? 1 : 0, Mb, wave, lane);
    ATT_WAIT_L0(); __builtin_amdgcn_s_barrier();
}
#undef ATT_CR
#undef ATT_WAIT_V
#undef ATT_WAIT_L0
}

struct MArgs {
    const float *x, *c, *w_ada, *b_ada, *g1, *w_in, *gaq, *gak, *gbq, *gbk, *lq1, *lk1, *lq2, *lk2, *gd, *w_out, *g2, *w_router, *b_router, *w_gu, *b_gu, *w_d, *b_d;
    float* out; unsigned char* ws; int ph_lo, ph_hi;
};

__device__ __forceinline__ void p0_transpose_item(const float* W, int K, int N, bf16_t* WT, LAS float* scr, int item, int lane) {
    const int nblk = N / 32, kb = item / nblk, nb = item % nblk, k0 = 64 * kb, n0 = 32 * nb;
    { f32x4 v[8];
#pragma unroll
      for (int i = 0; i < 8; ++i) v[i] = *(const f32x4*)(W + (size_t)(k0 + 8 * i + (lane >> 3)) * N + n0 + 4 * (lane & 7));
#pragma unroll
      for (int i = 0; i < 8; ++i) { LAS float* d = scr + (8 * i + (lane >> 3)) * 33 + 4 * (lane & 7); d[0] = v[i].x; d[1] = v[i].y; d[2] = v[i].z; d[3] = v[i].w; } }
    LDS_WAIT(); asm volatile("" ::: "memory");
    const int c = lane & 7;
#pragma unroll
    for (int j = 0; j < 4; ++j) { const int n = (lane >> 3) + 8 * j; const LAS float* s = scr + (8 * c) * 33 + n;
        u32x4 o; o.x = pk2(s[0 * 33], s[1 * 33]); o.y = pk2(s[2 * 33], s[3 * 33]); o.z = pk2(s[4 * 33], s[5 * 33]); o.w = pk2(s[6 * 33], s[7 * 33]);
        *(u32x4*)(WT + (size_t)(n0 + n) * K + k0 + 8 * c) = o; }
    LDS_WAIT(); asm volatile("" ::: "memory");
}

__device__ __forceinline__ void p0_transpose8_item(const float* W, int K, int N, unsigned char* WT, LAS float* scr, int item, int lane) {
    const int nblk = N / 32, kb = item / nblk, nb = item % nblk, k0 = 64 * kb, n0 = 32 * nb;
    { f32x4 v[8];
#pragma unroll
      for (int i = 0; i < 8; ++i) v[i] = *(const f32x4*)(W + (size_t)(k0 + 8 * i + (lane >> 3)) * N + n0 + 4 * (lane & 7));
#pragma unroll
      for (int i = 0; i < 8; ++i) { LAS float* d = scr + (8 * i + (lane >> 3)) * 33 + 4 * (lane & 7); d[0] = v[i].x; d[1] = v[i].y; d[2] = v[i].z; d[3] = v[i].w; } }
    LDS_WAIT(); asm volatile("" ::: "memory");
#pragma unroll
    for (int j = 0; j < 2; ++j) { const int n = (lane >> 2) + 16 * j, c = lane & 3; const LAS float* s = scr + (16 * c) * 33 + n;
        u32x4 o;
        o.x = pg8::pk4_fp8(s[0 * 33] * W8_SCALE, s[1 * 33] * W8_SCALE, s[2 * 33] * W8_SCALE, s[3 * 33] * W8_SCALE);
        o.y = pg8::pk4_fp8(s[4 * 33] * W8_SCALE, s[5 * 33] * W8_SCALE, s[6 * 33] * W8_SCALE, s[7 * 33] * W8_SCALE);
        o.z = pg8::pk4_fp8(s[8 * 33] * W8_SCALE, s[9 * 33] * W8_SCALE, s[10 * 33] * W8_SCALE, s[11 * 33] * W8_SCALE);
        o.w = pg8::pk4_fp8(s[12 * 33] * W8_SCALE, s[13 * 33] * W8_SCALE, s[14 * 33] * W8_SCALE, s[15 * 33] * W8_SCALE);
        *(u32x4*)(WT + (size_t)(n0 + n) * K + k0 + 16 * c) = o; }
    LDS_WAIT(); asm volatile("" ::: "memory");
}

constexpr int CV_I_GU = 16 * 64, CV_I_D = 16 * 32, CV_NIT = NE * (CV_I_GU + CV_I_D);
#ifndef CV_STATIC
#define CV_STATIC 16384
#endif
__device__ __forceinline__ void cv_item(const float* w_gu, const float* w_d, unsigned char* gu8, unsigned char* d8, LAS float* scr, int it, int lane) {
    if (it < NE * CV_I_GU) { const int e = it / CV_I_GU; p0_transpose8_item(w_gu + (size_t)e * 1024 * 2048, 1024, 2048, gu8 + (size_t)e * 1024 * 2048, scr, it % CV_I_GU, lane); }
    else { const int r_ = it - NE * CV_I_GU, e = r_ / CV_I_D; p0_transpose8_item(w_d + (size_t)e * 1024 * 1024, 1024, 1024, d8 + (size_t)e * 1024 * 1024, scr, r_ % CV_I_D, lane); }
}

__global__ void __launch_bounds__(NTHREADS, 2) mega(MArgs a) {
    extern __shared__ __attribute__((aligned(16))) unsigned char lds_raw[];
    LAS unsigned char* lds = (LAS unsigned char*)lds_raw;
    const int G = gridDim.x, bx = blockIdx.x, vcu = (G % 8 == 0) ? (bx % 8) * (G / 8) + bx / 8 : bx, NGW = G * NWAVES;
    const int wave = __builtin_amdgcn_readfirstlane((int)threadIdx.x >> 6);
#define PHASE_IDS() int lane = (int)__builtin_amdgcn_mbcnt_hi(~0u, __builtin_amdgcn_mbcnt_lo(~0u, 0u)); asm volatile("" : "+v"(lane)); const int tid = wave * 64 + lane, gw = vcu * NWAVES + wave; (void)tid; (void)gw
    volatile LAS unsigned* MISC = (volatile LAS unsigned*)(lds + MISC_OFF);
    LAS int* PT = (LAS int*)(lds + PT_OFF); LAS int* CN = (LAS int*)(lds + CNT_OFF);
#define w_counts ((int*)(a.ws + WS_CTL + CTL_COUNTS))
#define w_mod ((float*)(a.ws + WS_CTL + CTL_MOD))
#define w_modp ((float*)(a.ws + WS_MODP))
#define w_adacnt ((unsigned*)(a.ws + WS_CTL + CTL_ADACNT))
#define w_cvq ((unsigned*)(a.ws + WS_CTL + CTL_ADACNT + 256))
#define w_Win_t ((bf16_t*)(a.ws + WS_WIN))
#define w_Wout_t ((bf16_t*)(a.ws + WS_WOUT))
#define w_Wgu_t ((bf16_t*)(a.ws + WS_WGU))
#define w_Wd_t ((bf16_t*)(a.ws + WS_WD))
#define w_XN ((bf16_t*)(a.ws + WS_XN))
#define w_QKV ((bf16_t*)(a.ws + WS_QKV))
#define w_AO ((bf16_t*)(a.ws + WS_AO))
#define w_H2 ((bf16_t*)(a.ws + WS_H2))
#define w_tope ((int*)(a.ws + WS_TOPE))
#define w_tops ((int*)(a.ws + WS_TOPS))
#define w_topg ((float*)(a.ws + WS_TOPG))
#define w_list ((int*)(a.ws + WS_LIST))
#define w_ACT ((bf16_t*)(a.ws + WS_ACT))
#define w_Y ((bf16_t*)(a.ws + WS_Y))
#define w_OBN ((float*)(a.ws + WS_OBN))
#define w_X1 ((float*)(a.ws + WS_X1))
    for (int u = threadIdx.x; u < (LDS_BYTES - LDSCTL_OFF) / 4; u += NTHREADS) ((LAS unsigned*)(lds + LDSCTL_OFF))[u] = 0u;
    __syncthreads();
    const int lo = a.ph_lo, hi = a.ph_hi;
    XcdBarrier bar; bar.bar = (unsigned*)(a.ws + WS_CTL + CTL_BAR); bar.x = 0; bar.st = nullptr;
    if (hi - lo > 1) bar = xcd_barrier_post((unsigned*)(a.ws + WS_CTL + CTL_BAR), MISC + 8);
#define IN(k) (lo <= (k) && (k) < hi)
#ifndef REP_PH
#define REP_PH -1
#define REP_N 1
#endif
#define NREP(k) (((k) == REP_PH || REP_PH == 100) ? REP_N : 1)
#ifndef SPAN_PH
#define SPAN_PH -1
#endif
    LAS unsigned long long* tstamp = (LAS unsigned long long*)(lds + LDSCTL_OFF + 1536);
#define STAMP(i) do { if (SPAN_PH >= 0 && bx == 0 && threadIdx.x == 0) tstamp[i] = __builtin_amdgcn_s_memrealtime(); } while (0)
    STAMP(0);
#define SEAM(k) do { if (IN(k) && IN((k) + 1)) xcd_barrier(bar, wave); STAMP((k) + 1); } while (0)
#define LOAD_PT() do { if (wave == 0) { int cv = (lane < NE) ? w_counts[lane] : 0; int tl = (cv + 255) >> 8; int sc = tl; \
        _Pragma("unroll") for (int o = 1; o < 32; o <<= 1) { const int t_ = __shfl_up(sc, o); if ((lane & 31) >= o) sc += t_; } \
        if (lane < NE) { PT[lane + 1] = sc; CN[lane] = cv; } if (lane == 0) PT[0] = 0; } __syncthreads(); } while (0)

    if (IN(0)) for (int rep_ = 0; rep_ < NREP(0); ++rep_) {
        PHASE_IDS();
        LAS float* silu = (LAS float*)(lds + 98304);
        for (int i = tid; i < NB * D; i += NTHREADS) { const float cv = a.c[i]; silu[i] = cv / (1.f + __expf(-cv)); }
        __syncthreads();
        if (gw < 24 * 32 && rep_ == 0) {
            const int cc = gw % 24, ks = gw / 24, col = cc * 256 + 4 * lane;
            f32x4 acc[NB];
#pragma unroll
            for (int b = 0; b < NB; ++b) acc[b] = (ks == 0) ? *(const f32x4*)(a.b_ada + col) : (f32x4){0.f, 0.f, 0.f, 0.f};
#pragma unroll 1
            for (int k8 = ks * 32; k8 < ks * 32 + 32; k8 += 8) {
                f32x4 w[8];
#pragma unroll
                for (int i = 0; i < 8; ++i) w[i] = *(const f32x4*)(a.w_ada + (size_t)(k8 + i) * 6144 + col);
#pragma unroll
                for (int i = 0; i < 8; ++i)
#pragma unroll
                    for (int b = 0; b < NB; ++b) acc[b] += w[i] * silu[b * D + k8 + i];
            }
#pragma unroll
            for (int b = 0; b < NB; ++b) *(f32x4*)(w_modp + ((size_t)ks * NB + b) * 6144 + col) = acc[b];
        }
        if (rep_ == 0) {
            VM_WAIT(); __syncthreads();
            if (tid == 0) { __builtin_amdgcn_fence(__ATOMIC_RELEASE, "agent"); VM_WAIT(); __hip_atomic_fetch_add(w_adacnt, 1u, RLX_AGENT); }
        }
        LAS float* scr = (LAS float*)(lds + wave * 10240);
        constexpr int I_IN = 16 * 96, I_OUT = 16 * 32;
        for (int it = gw; it < I_IN + I_OUT; it += NGW) {
            if (it < I_IN) p0_transpose_item(a.w_in, 1024, 3072, w_Win_t, scr, it, lane);
            else p0_transpose_item(a.w_out, 1024, 1024, w_Wout_t, scr, it - I_IN, lane);
        }
        if (rep_ == 0) {
            if (tid == 0) { unsigned sp = 0; while (__hip_atomic_load(w_adacnt, RLX_AGENT) < (unsigned)G && ++sp < (1u << 24)) __builtin_amdgcn_s_sleep(2);
                            __builtin_amdgcn_fence(__ATOMIC_ACQUIRE, "agent"); VM_WAIT(); }
            __syncthreads();
            for (int idx = bx * NTHREADS + tid; idx < NB * 6144; idx += G * NTHREADS) { float sm = 0.f;
#pragma unroll 8
                for (int ks = 0; ks < 32; ++ks) sm += w_modp[(size_t)ks * NB * 6144 + idx];
                w_mod[idx] = sm; }
        }
        if (rep_ + 1 < NREP(0)) xcd_barrier(bar, wave);
    }
    SEAM(0);
    if (IN(1)) for (int rep_ = 0; rep_ < NREP(1); ++rep_) {
        PHASE_IDS();
        for (int r0 = gw * 4; r0 < M; r0 += NGW * 4) {
            const int b = r0 / S;
            f32x4 v[4][4]; float rs[4];
#pragma unroll
            for (int rr = 0; rr < 4; ++rr) { const f32x4* xr = (const f32x4*)(a.x + (size_t)(r0 + rr) * D) + lane;
#pragma unroll
                for (int j = 0; j < 4; ++j) v[rr][j] = xr[64 * j]; }
#pragma unroll
            for (int rr = 0; rr < 4; ++rr) { float ss = 0.f;
#pragma unroll
                for (int j = 0; j < 4; ++j) ss += (v[rr][j].x * v[rr][j].x + v[rr][j].y * v[rr][j].y) + (v[rr][j].z * v[rr][j].z + v[rr][j].w * v[rr][j].w);
                rs[rr] = rsqrtf(wave_sum(ss) * (1.f / D) + RMS_EPS); }
            const float* shift = w_mod + b * 6144, *scale = w_mod + b * 6144 + 1024;
#pragma unroll
            for (int j = 0; j < 4; ++j) {
                const int c0 = 4 * lane + 256 * j;
                const f32x4 g = *(const f32x4*)(a.g1 + c0), sc = *(const f32x4*)(scale + c0), sh = *(const f32x4*)(shift + c0);
                const f32x4 gs = g * (sc + 1.f);
#pragma unroll
                for (int rr = 0; rr < 4; ++rr) { const f32x4 o = v[rr][j] * rs[rr] * gs + sh;
                    u32x2 w; w.x = pk2(o.x, o.y); w.y = pk2(o.z, o.w);
                    *(u32x2*)(w_XN + (size_t)(r0 + rr) * D + c0) = w; }
            }
        }
        if (rep_ + 1 < NREP(1)) xcd_barrier(bar, wave);
    }
    SEAM(1);
    if (IN(2)) for (int rep_ = 0; rep_ < NREP(2); ++rep_) {
        PHASE_IDS();
#define P2_CONVERT() do { LAS float* scr = (LAS float*)(lds + wave * 10240); \
            for (int it = gw; it < CV_STATIC; it += NGW) cv_item(a.w_gu, a.w_d, (unsigned char*)w_Wgu_t, (unsigned char*)w_Wd_t, scr, it, lane); } while (0)
        PInProj p; p.init(M, NIN, G, bx); p.XN = w_XN; p.Wt = w_Win_t; p.QKV = w_QKV; p.gaq = a.gaq; p.gak = a.gak; p.gbq = a.gbq; p.gbk = a.gbk;
        if (bx & 1) { pg8::gemm_phase<PInProj>(lds, p, wave); __syncthreads(); P2_CONVERT(); }
        else { P2_CONVERT(); __syncthreads(); pg8::gemm_phase<PInProj>(lds, p, wave); }
#undef P2_CONVERT
        if (rep_ + 1 < NREP(2)) xcd_barrier(bar, wave);
    }
    SEAM(2);
    if (IN(3)) for (int rep_ = 0; rep_ < NREP(3); ++rep_) {
        PHASE_IDS();
        LAS float* wsf = (LAS float*)(lds + LDSCTL_OFF + 2048) + wave * 64;
#ifndef ATT_REP_A
#define ATT_REP_A 1
#define ATT_REP_B 1
#endif
        att::attn_a_phase(lds, wsf, w_QKV, w_AO, a.gaq, a.gak, vcu, wave, lane);
        STAMP(11);
        att::attn_b_phase(lds, wsf, w_QKV, w_AO, a.gbq, a.gbk, a.gd, a.lq1, a.lk1, a.lq2, a.lk2, vcu, wave, lane);
        if (rep_ == 0) {
            LAS float* scr = (LAS float*)(lds + wave * 10240);
            LAS int* qb_ = (LAS int*)(lds + LDSCTL_OFF + 1280);
            for (;;) {
                if (tid == 0) *qb_ = CV_STATIC + 16 * (int)__hip_atomic_fetch_add(w_cvq, 1u, RLX_AGENT);
                __syncthreads();
                const int base_ = *qb_;
                __syncthreads();
                if (base_ >= CV_NIT) break;
                for (int it = base_ + wave; it < base_ + 16 && it < CV_NIT; it += NWAVES)
                cv_item(a.w_gu, a.w_d, (unsigned char*)w_Wgu_t, (unsigned char*)w_Wd_t, scr, it, lane); }
        }
        if (rep_ + 1 < NREP(3)) xcd_barrier(bar, wave);
    }
    SEAM(3);
    if (IN(5)) for (int rep_ = 0; rep_ < NREP(5); ++rep_) {
        PHASE_IDS();
        POutProj p; p.init(M, D, G, bx); p.AO = w_AO; p.Wt = w_Wout_t; p.x = a.x; p.mod = w_mod; p.x1 = w_X1;
        pg8::gemm_phase<POutProj>(lds, p, wave);
        if (rep_ + 1 < NREP(5)) xcd_barrier(bar, wave);
    }
    SEAM(5);
    if (IN(6)) for (int rep_ = 0; rep_ < NREP(6); ++rep_) {
        PHASE_IDS();
        typedef float f32x4v __attribute__((ext_vector_type(4)));
        LAS float* Wp = (LAS float*)lds;
        LAS float* lgs = (LAS float*)(lds + LDSCTL_OFF + 4096);
        LAS float* red = (LAS float*)(lds + LDSCTL_OFF + 12288);
        LAS float* cb = (LAS float*)(lds + LDSCTL_OFF + 14336);
        LAS int* lcnt = (LAS int*)(lds + LDSCTL_OFF + 14464);
        LAS int* lbase = (LAS int*)(lds + LDSCTL_OFF + 14592);
        LAS float* ssl = (LAS float*)(lds + LDSCTL_OFF + 14720);
        for (int chunk = bx; chunk < M / 64; chunk += G) {
            const int row0 = chunk * 64, b = row0 / S;
            const float* shift = w_mod + b * 6144 + 3072, *scale = w_mod + b * 6144 + 4096;
            __syncthreads();
#pragma unroll 1
            for (int i0 = tid; i0 < 1024 * 8; i0 += NTHREADS * 8) {
                f32x4v w[8]; float gg[8], sc_[8];
#pragma unroll
                for (int u = 0; u < 8; ++u) { const int i = i0 + u * NTHREADS, k = i >> 3; w[u] = *(const f32x4v*)(a.w_router + (size_t)k * NE + (i & 7) * 4); gg[u] = a.g2[k]; sc_[u] = scale[k]; }
#pragma unroll
                for (int u = 0; u < 8; ++u) { const int i = i0 + u * NTHREADS, k = i >> 3; *(LAS f32x4v*)(Wp + k * NE + (i & 7) * 4) = w[u] * (gg[u] * (1.f + sc_[u])); }
            }
            { const int e = tid & 31, kp = tid >> 5; float acc = 0.f;
#pragma unroll 8
              for (int k = kp * 64; k < kp * 64 + 64; ++k) acc += shift[k] * a.w_router[(size_t)k * NE + e];
              red[kp * 32 + e] = acc; }
            if (tid < 32) lcnt[tid] = 0;
            if (tid < 64) ssl[tid] = 0.f;
            *(LAS f32x4v*)(lgs + tid * 4) = (f32x4v){0.f, 0.f, 0.f, 0.f};
#pragma unroll 1
            for (int rb = 0; rb < 2; ++rb) {
                f32x4 v[4][4]; float rs[4];
#pragma unroll
                for (int rr = 0; rr < 4; ++rr) { const f32x4* xr = (const f32x4*)(w_X1 + (size_t)(row0 + wave * 8 + rb * 4 + rr) * D) + lane;
#pragma unroll
                    for (int jj = 0; jj < 4; ++jj) v[rr][jj] = xr[64 * jj]; }
#pragma unroll
                for (int rr = 0; rr < 4; ++rr) { float s_ = 0.f;
#pragma unroll
                    for (int jj = 0; jj < 4; ++jj) s_ += (v[rr][jj].x * v[rr][jj].x + v[rr][jj].y * v[rr][jj].y) + (v[rr][jj].z * v[rr][jj].z + v[rr][jj].w * v[rr][jj].w);
                    rs[rr] = rsqrtf(wave_sum(s_) * (1.f / D) + RMS_EPS); }
#pragma unroll
                for (int jj = 0; jj < 4; ++jj) {
                    const int c0 = 4 * lane + 256 * jj;
                    const f32x4 g = *(const f32x4*)(a.g2 + c0), sc = *(const f32x4*)(scale + c0), sh = *(const f32x4*)(shift + c0);
#pragma unroll
                    for (int rr = 0; rr < 4; ++rr) { const f32x4 o = v[rr][jj] * rs[rr] * g * (sc + 1.f) + sh;
                        const f32x4 oc = __builtin_elementwise_min(__builtin_elementwise_max(o * H2_SCALE, (f32x4){-448.f, -448.f, -448.f, -448.f}), (f32x4){448.f, 448.f, 448.f, 448.f});
                        *(unsigned*)((unsigned char*)w_H2 + (size_t)(row0 + wave * 8 + rb * 4 + rr) * D + c0) = pg8::pk4_fp8(oc.x, oc.y, oc.z, oc.w); }
                }
            }
            __syncthreads();
            if (tid < 32) { float s_ = a.b_router[tid];
#pragma unroll
                for (int kp = 0; kp < 16; ++kp) s_ += red[kp * 32 + tid];
                cb[tid] = s_; }
            const int tj = lane & 15, kq = lane >> 4;
            {
                const int kb = 512 * (wave >> 2) + 128 * kq;
                const float* xp = w_X1 + (size_t)(row0 + 16 * (wave & 3) + tj) * D + kb;
                const LAS float* wq = Wp + kb * NE + tj;
                f32x4v acc0 = {0.f, 0.f, 0.f, 0.f}, acc1 = {0.f, 0.f, 0.f, 0.f}; float ssq = 0.f;
                f32x4v xa[8], xb[8];
#pragma unroll
                for (int i = 0; i < 8; ++i) xa[i] = *(const f32x4v*)(xp + 4 * i);
#pragma unroll
                for (int bt = 0; bt < 4; bt += 2) {
#pragma unroll
                    for (int i = 0; i < 8; ++i) xb[i] = *(const f32x4v*)(xp + 32 * (bt + 1) + 4 * i);
#pragma unroll
                    for (int i = 0; i < 8; ++i) { const f32x4v xv = xa[i]; ssq += (xv.x * xv.x + xv.y * xv.y) + (xv.z * xv.z + xv.w * xv.w);
#pragma unroll
                        for (int u = 0; u < 4; ++u) { const int kk = 32 * bt + 4 * i + u; const float a0 = wq[kk * NE], a1 = wq[kk * NE + 16];
                            acc0 = __builtin_amdgcn_mfma_f32_16x16x4f32(a0, xv[u], acc0, 0, 0, 0); acc1 = __builtin_amdgcn_mfma_f32_16x16x4f32(a1, xv[u], acc1, 0, 0, 0); } }
                    if (bt + 2 < 4) {
#pragma unroll
                        for (int i = 0; i < 8; ++i) xa[i] = *(const f32x4v*)(xp + 32 * (bt + 2) + 4 * i); }
#pragma unroll
                    for (int i = 0; i < 8; ++i) { const f32x4v xv = xb[i]; ssq += (xv.x * xv.x + xv.y * xv.y) + (xv.z * xv.z + xv.w * xv.w);
#pragma unroll
                        for (int u = 0; u < 4; ++u) { const int kk = 32 * (bt + 1) + 4 * i + u; const float a0 = wq[kk * NE], a1 = wq[kk * NE + 16];
                            acc0 = __builtin_amdgcn_mfma_f32_16x16x4f32(a0, xv[u], acc0, 0, 0, 0); acc1 = __builtin_amdgcn_mfma_f32_16x16x4f32(a1, xv[u], acc1, 0, 0, 0); } }
                }
                ssq += __shfl_xor(ssq, 16); ssq += __shfl_xor(ssq, 32);
                LAS float* lw = lgs + ((wave & 3) * 16 + tj) * 32;
#pragma unroll
                for (int r = 0; r < 4; ++r) { (void)__hip_atomic_fetch_add(lw + 4 * kq + r, acc0[r], __ATOMIC_RELAXED, __HIP_MEMORY_SCOPE_WORKGROUP); (void)__hip_atomic_fetch_add(lw + 16 + 4 * kq + r, acc1[r], __ATOMIC_RELAXED, __HIP_MEMORY_SCOPE_WORKGROUP); }
                if (kq == 0) (void)__hip_atomic_fetch_add(ssl + (wave & 3) * 16 + tj, ssq, __ATOMIC_RELAXED, __HIP_MEMORY_SCOPE_WORKGROUP);
            }
            __syncthreads();
            int idx[4] = {0, 0, 0, 0}, rank[4] = {0, 0, 0, 0}; float gt[4] = {0.f, 0.f, 0.f, 0.f};
            if (wave < 4 && lane < 16) {
                const float rstd = rsqrtf(ssl[wave * 16 + lane] * (1.f / D) + RMS_EPS);
                float lg[NE];
#pragma unroll
                for (int e = 0; e < NE; ++e) lg[e] = lgs[(wave * 16 + lane) * 32 + e] * rstd + cb[e];
                float val[4];
#pragma unroll
                for (int k = 0; k < 4; ++k) {
                    float best = -INFINITY; int bi = 0;
#pragma unroll
                    for (int e = 0; e < NE; ++e) { bool taken = false;
#pragma unroll
                        for (int kk = 0; kk < k; ++kk) taken |= (idx[kk] == e);
                        if (!taken && lg[e] > best) { best = lg[e]; bi = e; } }
                    idx[k] = bi; val[k] = best;
                }
                float den = 0.f;
#pragma unroll
                for (int k = 0; k < 4; ++k) { gt[k] = __expf(val[k] - val[0]); den += gt[k]; }
                const float rden = 1.f / den;
#pragma unroll
                for (int k = 0; k < 4; ++k) { gt[k] *= rden; rank[k] = __hip_atomic_fetch_add(lcnt + idx[k], 1, __ATOMIC_RELAXED, __HIP_MEMORY_SCOPE_WORKGROUP); }
            }
            __syncthreads();
            if (tid < 32 && rep_ == 0) lbase[tid] = atomicAdd(&w_counts[tid], lcnt[tid]);
            __syncthreads();
            if (wave < 4 && lane < 16 && rep_ == 0) {
                const int row = row0 + 16 * wave + lane;
#pragma unroll
                for (int k = 0; k < 4; ++k) { const int slot = lbase[idx[k]] + rank[k];
                    w_tope[row * 4 + k] = idx[k]; w_tops[row * 4 + k] = slot; w_topg[row * 4 + k] = gt[k]; w_list[idx[k] * M + slot] = row; }
            }
        }
        if (rep_ + 1 < NREP(6)) xcd_barrier(bar, wave);
    }
    SEAM(6);
    if (IN(7)) for (int rep_ = 0; rep_ < NREP(7); ++rep_) {
        PHASE_IDS();
        LOAD_PT();
        PGateUp p; p.init(PT, CN, (LAS int*)(lds + LDSCTL_OFF + 1024), 8, G, bx); p.build(wave, lane); __syncthreads(); p.H2 = w_H2; p.Wt = w_Wgu_t; p.bgu = a.b_gu; p.list = w_list; p.ACT = w_ACT;
        pg8::gemm_phase<PGateUp>(lds, p, wave);
        if (rep_ + 1 < NREP(7)) xcd_barrier(bar, wave);
    }
    SEAM(7);
    if (IN(8)) for (int rep_ = 0; rep_ < NREP(8); ++rep_) {
        PHASE_IDS();
        LOAD_PT();
        PDown p; p.init(PT, CN, (LAS int*)(lds + LDSCTL_OFF + 1024), 4, G, bx); p.build(wave, lane); __syncthreads(); p.ACT = w_ACT; p.Wt = w_Wd_t; p.bd = a.b_d; p.Y = w_Y;
        pg8::gemm_phase<PDown>(lds, p, wave);
        if (rep_ + 1 < NREP(8)) xcd_barrier(bar, wave);
    }
    SEAM(8);
    for (int rep_ = 0; rep_ + 1 < NREP(10); ++rep_) xcd_barrier(bar, wave);
    if (IN(9)) for (int rep_ = 0; rep_ < NREP(9); ++rep_) {
        PHASE_IDS();
        LOAD_PT();
        for (int r0 = gw * 2; r0 < M; r0 += NGW * 2) {
            const int b = r0 / S;
            const float* gate2 = w_mod + b * 6144 + 5120;
            const unsigned char* yr[2][4]; float gk[2][4];
#pragma unroll
            for (int rr = 0; rr < 2; ++rr)
#pragma unroll
                for (int k = 0; k < 4; ++k) { const int row = r0 + rr; yr[rr][k] = (const unsigned char*)w_Y + (size_t)(PT[w_tope[row * 4 + k]] * 256 + w_tops[row * 4 + k]) * D; gk[rr][k] = w_topg[row * 4 + k] * (1.f / Y_SCALE); }
#pragma unroll
            for (int j = 0; j < 4; ++j) {
                const int c0 = 4 * lane + 256 * j;
                int wv[2][4]; f32x4 xv[2];
#pragma unroll
                for (int rr = 0; rr < 2; ++rr) { xv[rr] = *(const f32x4*)(w_X1 + (size_t)(r0 + rr) * D + c0);
#pragma unroll
                    for (int k = 0; k < 4; ++k) wv[rr][k] = *(const int*)(yr[rr][k] + c0); }
                const f32x4 g = *(const f32x4*)(gate2 + c0);
#pragma unroll
                for (int rr = 0; rr < 2; ++rr) { f32x4 acc = (f32x4){0.f, 0.f, 0.f, 0.f};
#pragma unroll
                    for (int k = 0; k < 4; ++k) { const int w = wv[rr][k];
                        acc.x += gk[rr][k] * __builtin_amdgcn_cvt_f32_fp8(w, 0); acc.y += gk[rr][k] * __builtin_amdgcn_cvt_f32_fp8(w, 1);
                        acc.z += gk[rr][k] * __builtin_amdgcn_cvt_f32_fp8(w, 2); acc.w += gk[rr][k] * __builtin_amdgcn_cvt_f32_fp8(w, 3); }
                    *(f32x4*)(a.out + (size_t)(r0 + rr) * D + c0) = xv[rr] + g * acc; }
            }
        }
    }
    STAMP(10);
    if (SPAN_PH >= 0 && bx == 0 && threadIdx.x == 0) {
        const unsigned long long dur = (SPAN_PH == 20) ? tstamp[11] - tstamp[3] : (SPAN_PH == 21) ? tstamp[4] - tstamp[11] : tstamp[SPAN_PH + 1] - tstamp[SPAN_PH], t0 = __builtin_amdgcn_s_memrealtime();
        while (__builtin_amdgcn_s_memrealtime() - t0 < dur) __builtin_amdgcn_s_sleep(4);
    }
#undef IN
#undef PHASE_IDS
#undef SEAM
#undef LOAD_PT
#undef w_counts
#undef w_mod
#undef w_modp
#undef w_adacnt
#undef w_cvq
#undef w_Win_t
#undef w_Wout_t
#undef w_Wgu_t
#undef w_Wd_t
#undef w_XN
#undef w_QKV
#undef w_AO
#undef w_H2
#undef w_tope
#undef w_tops
#undef w_topg
#undef w_list
#undef w_ACT
#undef w_Y
#undef w_OBN
#undef w_X1
}

#ifndef RUN_MODE
#define RUN_MODE 1
#endif
#ifndef PH_MASK
#define PH_MASK 0x3ff
#endif
extern "C" void kernel_launch(void* const* d_in, const int* in_sizes, int n_in, void* d_out, int out_size, void* d_ws, size_t ws_size, hipStream_t stream) {
    static int grid = 0;
    if (grid == 0) {
        if (n_in != 23 || out_size != M * D || ws_size < WS_END) { fprintf(stderr, "kernel_launch: unexpected problem (n_in %d out %d ws %zu)\n", n_in, out_size, ws_size); grid = -1; return; }
        int dev = 0, cus = 0;
        if (hipGetDevice(&dev) != hipSuccess || hipDeviceGetAttribute(&cus, hipDeviceAttributeMultiprocessorCount, dev) != hipSuccess) { grid = -1; return; }
        if (hipFuncSetAttribute((const void*)mega, hipFuncAttributeMaxDynamicSharedMemorySize, LDS_BYTES) != hipSuccess) { fprintf(stderr, "kernel_launch: hipFuncSetAttribute failed\n"); grid = -1; return; }
        int per_cu = 0;
        if (hipOccupancyMaxActiveBlocksPerMultiprocessor(&per_cu, (const void*)mega, NTHREADS, LDS_BYTES) != hipSuccess || per_cu < 1) fprintf(stderr, "kernel_launch: occupancy query says %d blocks/CU\n", per_cu);
        (void)hipGetLastError();
        grid = cus;
    }
    if (grid < 0) return;
    const float* x = (const float*)d_in[0]; const float* c = (const float*)d_in[1]; const float* w_ada = (const float*)d_in[2]; const float* b_ada = (const float*)d_in[3];
    const float* g1 = (const float*)d_in[4]; const float* w_in = (const float*)d_in[5];
    const float* gaq = (const float*)d_in[6]; const float* gak = (const float*)d_in[7]; const float* gbq = (const float*)d_in[8]; const float* gbk = (const float*)d_in[9];
    const float* lq1 = (const float*)d_in[10]; const float* lk1 = (const float*)d_in[11]; const float* lq2 = (const float*)d_in[12]; const float* lk2 = (const float*)d_in[13];
    const float* gd = (const float*)d_in[14]; const float* w_out = (const float*)d_in[15]; const float* g2 = (const float*)d_in[16];
    const float* w_router = (const float*)d_in[17]; const float* b_router = (const float*)d_in[18];
    const float* w_gu = (const float*)d_in[19]; const float* b_gu = (const float*)d_in[20]; const float* w_d = (const float*)d_in[21]; const float* b_d = (const float*)d_in[22];
    unsigned char* ws = (unsigned char*)d_ws; float* out = (float*)d_out;
    int* counts = (int*)(ws + WS_CTL + CTL_COUNTS); int* padstart = (int*)(ws + WS_CTL + CTL_PADSTART); float* mod = (float*)(ws + WS_CTL + CTL_MOD);
    bf16_t* Win_t = (bf16_t*)(ws + WS_WIN); bf16_t* Wout_t = (bf16_t*)(ws + WS_WOUT); bf16_t* Wgu_t = (bf16_t*)(ws + WS_WGU); bf16_t* Wd_t = (bf16_t*)(ws + WS_WD);
    bf16_t* XN = (bf16_t*)(ws + WS_XN); bf16_t* QKV = (bf16_t*)(ws + WS_QKV); bf16_t* AO = (bf16_t*)(ws + WS_AO); bf16_t* H2 = (bf16_t*)(ws + WS_H2);
    int* tope = (int*)(ws + WS_TOPE); int* tops = (int*)(ws + WS_TOPS); float* topg = (float*)(ws + WS_TOPG); int* list = (int*)(ws + WS_LIST);
    bf16_t* ACT = (bf16_t*)(ws + WS_ACT); bf16_t* Y = (bf16_t*)(ws + WS_Y); float* OBN = (float*)(ws + WS_OBN);

    (void)hipMemsetAsync(ws + WS_CTL, 0, 32768, stream);
    MArgs a{};
    a.x = x; a.c = c; a.w_ada = w_ada; a.b_ada = b_ada; a.g1 = g1; a.w_in = w_in; a.gaq = gaq; a.gak = gak; a.gbq = gbq; a.gbk = gbk; a.lq1 = lq1; a.lk1 = lk1; a.lq2 = lq2; a.lk2 = lk2;
    a.gd = gd; a.w_out = w_out; a.g2 = g2; a.w_router = w_router; a.b_router = b_router; a.w_gu = w_gu; a.b_gu = b_gu; a.w_d = w_d; a.b_d = b_d; a.out = out; a.ws = ws;
    a.ph_lo = 0; a.ph_hi = NPHASE; hipLaunchKernelGGL(mega, dim3(grid), dim3(NTHREADS), LDS_BYTES, stream, a);
}
```

```cpp
#include <hip/hip_runtime.h>
#include <cstdio>
#include <cstdint>

typedef unsigned short bf16_t;
typedef short bf16x8 __attribute__((ext_vector_type(8)));
typedef float f32x4 __attribute__((ext_vector_type(4)));
typedef unsigned u32x4 __attribute__((ext_vector_type(4)));
typedef unsigned u32x2 __attribute__((ext_vector_type(2)));

constexpr int D = 1024, NB = 8, S = 2048, M = NB * S;
constexpr int NIN = 3072, NE = 32, TOPK = 4, DFF = 1024;
constexpr int NASSIGN = M * TOPK;
constexpr int PADROWS = NASSIGN + NE * 256;
constexpr float RMS_EPS = 1e-6f;
constexpr float LOG2E = 1.4426950408889634f;
constexpr float QSCALE = 0.125f * LOG2E;
constexpr float LAMBDA_INIT = 0.2f;

constexpr size_t MiB = 1u << 20;
constexpr size_t WS_CTL = 0;
constexpr size_t CTL_BYTES = 1 * MiB;
constexpr size_t CTL_COUNTS = 0;
constexpr size_t CTL_PADSTART = 256;
constexpr size_t CTL_ADACNT = 1024;
constexpr size_t CTL_MOD = 64 * 1024;
constexpr size_t WS_WIN = 2 * MiB;
constexpr size_t WS_WOUT = 8 * MiB;
constexpr size_t WS_WGU = 10 * MiB;
constexpr size_t WS_WD = 138 * MiB;
constexpr size_t WS_XN = 202 * MiB;
constexpr size_t WS_QKV = 234 * MiB;
constexpr size_t WS_AO = 330 * MiB;
constexpr size_t WS_H2 = 362 * MiB;
constexpr size_t WS_TOPE = 394 * MiB;
constexpr size_t WS_TOPS = 395 * MiB;
constexpr size_t WS_TOPG = 396 * MiB;
constexpr size_t WS_LIST = 397 * MiB;
constexpr size_t WS_ACT = 400 * MiB;
constexpr size_t WS_Y = 544 * MiB;
constexpr size_t WS_OBN = 688 * MiB;
constexpr size_t WS_X1 = 752 * MiB;
constexpr size_t WS_MODP = 816 * MiB;
constexpr size_t WS_END = 824 * MiB;

__device__ __forceinline__ bf16_t f2bf(float f) { unsigned u = __float_as_uint(f); return (bf16_t)((u + 0x7fffu + ((u >> 16) & 1u)) >> 16); }
__device__ __forceinline__ float bf2f(bf16_t h) { return __uint_as_float(((unsigned)h) << 16); }
__device__ __forceinline__ unsigned pk2(float lo, float hi) { return (unsigned)f2bf(lo) | ((unsigned)f2bf(hi) << 16); }
__device__ __forceinline__ float wave_sum(float v) {
#pragma unroll
    for (int o = 1; o < 64; o <<= 1) v += __shfl_xor(v, o);
    return v;
}


#define LAS __attribute__((address_space(3)))
#define GAS __attribute__((address_space(1)))
#define RLX_AGENT __ATOMIC_RELAXED, __HIP_MEMORY_SCOPE_AGENT
#define LDS_WAIT() asm volatile("s_waitcnt lgkmcnt(0)" ::: "memory")
#define VM_WAIT() asm volatile("s_waitcnt vmcnt(0)" ::: "memory")

constexpr int NWAVES = 8, NTHREADS = 512;
constexpr int RING_BYTES = 131072, LDSCTL_OFF = RING_BYTES, MISC_OFF = LDSCTL_OFF + 320, PT_OFF = LDSCTL_OFF + 512, CNT_OFF = LDSCTL_OFF + 768, LDS_BYTES = 147456;
constexpr size_t CTL_BAR = 16384;
constexpr int NPHASE = 10;
constexpr float W8_SCALE = 512.f, H2_SCALE = 16.f, ACT_SCALE = 8.f, Y_SCALE = 32.f;

#define XB_TMO      128
#define XB_XCNT(j)  (256  + 64 * (j))
#define XB_XSUB(j)  (1280 + 64 * (j))
#define XB_XGEN(j)  (2304 + 64 * (j))
#define XB_TOP      3328
#define XB_TOPGEN   3392
#define XCD_BAR_WORDS 3456
#define XB_SPIN_CAP (1u << 22)
__device__ __forceinline__ unsigned xb_ld(unsigned* p)              { return __hip_atomic_load(p, __ATOMIC_RELAXED, __HIP_MEMORY_SCOPE_AGENT); }
__device__ __forceinline__ unsigned xb_add(unsigned* p, unsigned v) { return __hip_atomic_fetch_add(p, v, __ATOMIC_RELAXED, __HIP_MEMORY_SCOPE_AGENT); }
__device__ __forceinline__ unsigned xb_xcc_id() { return (unsigned)__builtin_amdgcn_s_getreg((3 << 11) | 20) & 0xFu; }
#define XB_SPIN(cond, bar) do { unsigned _sp = 0; while (cond) { __builtin_amdgcn_s_sleep(1); \
    if ((++_sp & 255u) == 0u) { if (xb_ld(&(bar)[XB_TMO])) break; if (_sp > XB_SPIN_CAP) { atomicAdd(&(bar)[XB_TMO], 1u); break; } } } } while (0)
struct XcdBarrier { unsigned* bar; unsigned x; volatile LAS unsigned* st; };
__device__ __forceinline__ XcdBarrier xcd_barrier_post(unsigned* bar, volatile LAS unsigned* st) {
    XcdBarrier b; b.bar = bar; b.x = xb_xcc_id(); b.st = st;
    if (threadIdx.x == 0) (void)xb_add(&bar[XB_XCNT(b.x)], 1u);
    return b;
}
__device__ __forceinline__ void xcd_barrier_complete(unsigned* bar, unsigned x, unsigned& nloc, unsigned& nx) {
    const unsigned G = gridDim.x * gridDim.y * gridDim.z;
    unsigned sum, cnt, mine, sp = 0u;
    for (;;) {
        sum = 0u; cnt = 0u; mine = 0u;
#pragma unroll
        for (unsigned j = 0; j < 16; ++j) { const unsigned c = xb_ld(&bar[XB_XCNT(j)]); sum += c; cnt += (c > 0u) ? 1u : 0u; mine = (j == x) ? c : mine; }
        if (sum == G) break;
        __builtin_amdgcn_s_sleep(1);
        if ((++sp & 255u) == 0u) { if (xb_ld(&bar[XB_TMO])) break; if (sp > XB_SPIN_CAP) { atomicAdd(&bar[XB_TMO], 1u); break; } }
    }
    nloc = mine > 0u ? mine : 1u; nx = cnt > 0u ? cnt : 1u;
}
__device__ __forceinline__ void xcd_barrier(const XcdBarrier& b, int wave) {
    asm volatile("s_waitcnt vmcnt(0)" ::: "memory");
    __syncthreads();
    if (wave == 0 && __builtin_amdgcn_mbcnt_hi(~0u, __builtin_amdgcn_mbcnt_lo(~0u, 0u)) == 0u) {
        unsigned* bar = b.bar;
        __builtin_amdgcn_s_waitcnt(0);
        unsigned nloc = b.st[0], nx = b.st[1];
        if (nloc == 0u) { xcd_barrier_complete(bar, b.x, nloc, nx); b.st[0] = nloc; b.st[1] = nx; }
        const unsigned old = xb_add(&bar[XB_XSUB(b.x)], 1u);
        const unsigned gen = old / nloc;
        if (old + 1u == (gen + 1u) * nloc) {
            __builtin_amdgcn_fence(__ATOMIC_RELEASE, "agent");
            asm volatile("s_waitcnt vmcnt(0)" ::: "memory");
            const unsigned og = xb_add(&bar[XB_TOP], 1u);
            const unsigned tg = og / nx;
            if (og + 1u == (tg + 1u) * nx) xb_add(&bar[XB_TOPGEN], 1u);
            else XB_SPIN(xb_ld(&bar[XB_TOPGEN]) == tg, bar);
            __builtin_amdgcn_fence(__ATOMIC_ACQUIRE, "agent");
            xb_add(&bar[XB_XGEN(b.x)], 1u);
            asm volatile("s_waitcnt vmcnt(0)" ::: "memory");
        } else {
            XB_SPIN(xb_ld(&bar[XB_XGEN(b.x)]) == gen, bar);
            __builtin_amdgcn_fence(__ATOMIC_ACQUIRE, "agent");
            asm volatile("s_waitcnt vmcnt(0)" ::: "memory");
        }
    }
    __syncthreads();
}

namespace pg8 {
constexpr int BM = 256, BK = 64, HALF = 128, HTB = HALF * BK * 2, STAGE_BYTES = 8 * HTB, NXCD = 8, WGM = 8;
__host__ __device__ __forceinline__ int lds_byte(int r, int c) { const int st = (r >> 4) * 2 + (c >> 5), rr = r & 15, cc = c & 31, ob = rr * 64 + cc * 2; return st * 1024 + (ob ^ (((ob >> 9) & 1) << 5)); }
__host__ __device__ __forceinline__ void stage_rc(int b, int& R, int& C) { const int st = b / 1024, sb = b % 1024, swz = sb ^ (((sb >> 9) & 1) << 5); R = (st >> 1) * 16 + swz / 64; C = (st & 1) * 32 + (swz % 64) / 2; }
constexpr __host__ __device__ __forceinline__ int perm32(int rho) { const int n = rho >> 4, i = rho & 15; return 8 * (i >> 2) + 4 * n + (i & 3); }
__device__ __forceinline__ unsigned cvt_pk_bf16(float lo, float hi) { unsigned r; asm volatile("v_cvt_pk_bf16_f32 %0, %1, %2" : "=v"(r) : "v"(lo), "v"(hi)); return r; }

typedef int v4i_t __attribute__((ext_vector_type(4))); typedef int v8i_t __attribute__((ext_vector_type(8)));
__device__ __forceinline__ v8i_t cat8(bf16x8 lo, bf16x8 hi) { const v4i_t a = __builtin_bit_cast(v4i_t, lo), b = __builtin_bit_cast(v4i_t, hi); return __builtin_shufflevector(a, b, 0, 1, 2, 3, 4, 5, 6, 7); }
__device__ __forceinline__ unsigned pk4_fp8(float a, float b, float c, float d) { int w = 0; w = __builtin_amdgcn_cvt_pk_fp8_f32(a, b, w, false); w = __builtin_amdgcn_cvt_pk_fp8_f32(c, d, w, true); return (unsigned)w; }
struct Unit { int pm, pn, e, cnt; };

template <class P>
__device__ __forceinline__ void gemm_phase(LAS unsigned char* lds, const P& p, int wid) {
    int lane = (int)__builtin_amdgcn_mbcnt_hi(~0u, __builtin_amdgcn_mbcnt_lo(~0u, 0u)); asm volatile("" : "+v"(lane));
    const int tid = wid * 64 + lane, wr = wid >> 2, wc = wid & 3, fr = lane & 15, fq = lane >> 4;
    constexpr int K = P::K, nt = K / BK;
    int Rr[2], Cc[2];
#pragma unroll
    for (int i = 0; i < 2; ++i) stage_rc(tid * 16 + i * 8192, Rr[i], Cc[i]);
    unsigned voffB[2], voffA[2][2];
#pragma unroll
    for (int i = 0; i < 2; ++i) { voffB[i] = (unsigned)(P::brow(0, Rr[i]) * K + Cc[i]) * 2u; voffA[0][i] = (unsigned)(Rr[i] * K + Cc[i]) * 2u; voffA[1][i] = voffA[0][i]; }
    constexpr size_t hB = (size_t)(P::brow(1, 0) - P::brow(0, 0)) * K * 2, hA = P::GATHER ? 0 : (size_t)HALF * K * 2;
    LAS unsigned* vpark = (LAS unsigned*)(lds + STAGE_BYTES + 4096) + tid * 4;
    const size_t kstep = (size_t)(BK * 2);
    const unsigned ldsw = (unsigned)wid * 1024u;
    const int aoff = lds_byte(wr * 64 + fr, fq * 8), boff = lds_byte(wc * 32 + fr, fq * 8);
#define PG8_SA(b, h) (((b) * 2 + (h)) * HTB)
#define PG8_SB(b, h) ((4 + (b) * 2 + (h)) * HTB)
#define PG8_STAGE(bufoff, gbase, voff) do { _Pragma("unroll") for (int _i = 0; _i < 2; ++_i) { unsigned _v = (voff)[_i]; asm volatile("" : "+v"(_v));     \
        __builtin_amdgcn_global_load_lds((const unsigned*)((const char*)(gbase) + _v), (LAS unsigned*)(lds + (bufoff) + ldsw + _i * 8192), 16, 0, 0); } } while (0)
#define PG8_STAGE_A(b, h, gbase) PG8_STAGE(PG8_SA(b, h), (gbase) + (h) * hA, voffA[P::GATHER ? (h) : 0])
#define PG8_STAGE_B(b, h, gbase) PG8_STAGE(PG8_SB(b, h), (gbase) + (h) * hB, voffB)
#define PG8_LDA(dst, b, h) do { _Pragma("unroll") for (int m = 0; m < 4; ++m) _Pragma("unroll") for (int k = 0; k < 2; ++k) dst[m][k] = *(const LAS bf16x8*)(lds + PG8_SA(b, h) + aoff + m * 2048 + k * 1024); } while (0)
#define PG8_LDB(dst, b, h) do { _Pragma("unroll") for (int n = 0; n < 2; ++n) _Pragma("unroll") for (int k = 0; k < 2; ++k) dst[n][k] = *(const LAS bf16x8*)(lds + PG8_SB(b, h) + boff + n * 2048 + k * 1024); } while (0)
#define PG8_MMA(ai, bj, At, Bt) do { __builtin_amdgcn_s_setprio(1); if constexpr (P::FP8) { _Pragma("unroll") for (int m = 0; m < 4; ++m) _Pragma("unroll") for (int n = 0; n < 2; ++n) \
        { const v8i_t b8_ = cat8(Bt[n][0], Bt[n][1]), a8_ = cat8(At[m][0], At[m][1]); \
          asm volatile("v_mfma_scale_f32_16x16x128_f8f6f4 %0, %1, %2, %0, %3, %3 op_sel_hi:[0,0,0]" : "+v"(acc[ai][bj][m][n]) : "v"(b8_), "v"(a8_), "v"(sc1_)); } } else { \
        _Pragma("unroll") for (int m = 0; m < 4; ++m) _Pragma("unroll") for (int n = 0; n < 2; ++n) _Pragma("unroll") for (int k = 0; k < 2; ++k) \
        acc[ai][bj][m][n] = __builtin_amdgcn_mfma_f32_16x16x32_bf16(Bt[n][k], At[m][k], acc[ai][bj][m][n], 0, 0, 0); } __builtin_amdgcn_s_setprio(0); } while (0)
#define PG8_WAIT_V(n) asm volatile("s_waitcnt vmcnt(" #n ")" ::: "memory")
#define PG8_WAIT_L(n) asm volatile("s_waitcnt lgkmcnt(" #n ")" ::: "memory")
#define PG8_BAR __builtin_amdgcn_s_barrier()
#define PG8_SCHED __builtin_amdgcn_sched_barrier(0)
    const int sc1_ = 0x7f7f7f7f;
    Unit cur, nxt; int ui = 0;
    if (!p.next(0, cur)) return;
    f32x4 acc[2][2][4][2];
#pragma unroll
    for (int a = 0; a < 2; ++a)
#pragma unroll
        for (int b = 0; b < 2; ++b)
#pragma unroll
            for (int m = 0; m < 4; ++m)
#pragma unroll
                for (int n = 0; n < 2; ++n) acc[a][b][m][n] = (f32x4){0.f, 0.f, 0.f, 0.f};
    bf16x8 At[4][2], B0[2][2], B1[2][2];
    const char* cA = p.a_base(cur); const char* cB = p.b_base(cur);
    if constexpr (P::GATHER) p.a_offsets(cur, Rr, Cc, voffA);
    PG8_STAGE_B(0, 0, cB); PG8_STAGE_B(0, 1, cB); PG8_STAGE_A(0, 0, cA); PG8_STAGE_A(0, 1, cA);
    if (wr == 1) PG8_BAR;
    PG8_WAIT_V(2); PG8_BAR;
    PG8_STAGE_B(1, 0, cB + kstep); PG8_STAGE_A(1, 0, cA + kstep); PG8_STAGE_B(1, 1, cB + kstep);
    PG8_WAIT_V(6); PG8_BAR;
    for (;;) {
        const bool has_next = p.next(ui + 1, nxt);
        const char* nA = has_next ? p.a_base(nxt) : cA; const char* nB = has_next ? p.b_base(nxt) : cB;
        if constexpr (P::GATHER) {
            unsigned vn[2][2];
            if (has_next) p.a_offsets(nxt, Rr, Cc, vn); else {
#pragma unroll
                for (int h = 0; h < 2; ++h)
#pragma unroll
                    for (int i = 0; i < 2; ++i) vn[h][i] = voffA[h][i]; }
            vpark[0] = vn[0][0]; vpark[1] = vn[0][1]; vpark[2] = vn[1][0]; vpark[3] = vn[1][1];
        }
#pragma nounroll
        for (int t = 0; t < nt; t += 2) {
            const bool last = (t == nt - 2);
            const char* a1 = cA + (size_t)(t + 1) * kstep;
            const char* a2 = last ? nA : cA + (size_t)(t + 2) * kstep; const char* b2 = last ? nB : cB + (size_t)(t + 2) * kstep;
            const char* a3 = a2 + kstep; const char* b3 = b2 + kstep;
            PG8_LDB(B0, 0, 0); PG8_LDB(B1, 0, 1); PG8_SCHED; PG8_LDA(At, 0, 0); PG8_STAGE_A(1, 1, a1);
            if constexpr (P::GATHER) { if (last) { voffA[0][0] = vpark[0]; voffA[0][1] = vpark[1]; voffA[1][0] = vpark[2]; voffA[1][1] = vpark[3]; } }
            PG8_WAIT_V(8); PG8_WAIT_L(0); PG8_BAR; PG8_MMA(0, 0, At, B0); PG8_MMA(0, 1, At, B1); PG8_BAR; PG8_SCHED;
            PG8_LDA(At, 0, 1); PG8_STAGE_B(0, 0, b2); PG8_STAGE_B(0, 1, b2); PG8_STAGE_A(0, 0, a2);
            PG8_WAIT_V(8); PG8_WAIT_L(0); PG8_BAR; PG8_MMA(1, 0, At, B0); PG8_MMA(1, 1, At, B1); PG8_BAR; PG8_SCHED;
            PG8_LDB(B0, 1, 0); PG8_LDB(B1, 1, 1); PG8_SCHED; PG8_LDA(At, 1, 0); PG8_STAGE_A(0, 1, a2);
            PG8_WAIT_V(8); PG8_WAIT_L(0); PG8_BAR; PG8_MMA(0, 0, At, B0); PG8_MMA(0, 1, At, B1); PG8_BAR; PG8_SCHED;
            PG8_LDA(At, 1, 1); PG8_STAGE_B(1, 0, b3); PG8_STAGE_B(1, 1, b3); PG8_STAGE_A(1, 0, a3);
            PG8_WAIT_V(8); PG8_WAIT_L(0); PG8_BAR; PG8_MMA(1, 0, At, B0); PG8_MMA(1, 1, At, B1); PG8_BAR; PG8_SCHED;
        }
        if (wr == 0) PG8_BAR;
        if constexpr (P::FP8) asm volatile("s_nop 15\n\ts_nop 15" ::: "memory");
        p.epi(acc, cur, wr, wc, fr, fq);
        if (!has_next) break;
#pragma unroll
        for (int a = 0; a < 2; ++a)
#pragma unroll
            for (int b = 0; b < 2; ++b)
#pragma unroll
                for (int m = 0; m < 4; ++m)
#pragma unroll
                    for (int n = 0; n < 2; ++n) acc[a][b][m][n] = (f32x4){0.f, 0.f, 0.f, 0.f};
        cur = nxt; cA = nA; cB = nB; ++ui;
        if (wr == 1) PG8_BAR;
    }
    PG8_WAIT_V(0);
    PG8_BAR;
#undef PG8_SA
#undef PG8_SB
#undef PG8_STAGE
#undef PG8_STAGE_A
#undef PG8_STAGE_B
#undef PG8_LDA
#undef PG8_LDB
#undef PG8_MMA
#undef PG8_WAIT_V
#undef PG8_WAIT_L
#undef PG8_BAR
#undef PG8_SCHED
}

struct DenseOrder {
    int nM, nN, nwg, G, c;
    __device__ void init(int M_, int N_, int G_, int c_) { nM = M_ / BM; nN = N_ / BM; nwg = nM * nN; G = G_; c = c_; }
    __device__ bool next(int i, Unit& u) const {
        const long L = (long)i * G + c; if (L >= nwg) return false;
        int wgid = (int)L; { const int q = nwg / NXCD, r = nwg % NXCD, xcd = wgid % NXCD, off = wgid / NXCD; wgid = (xcd < r ? xcd * (q + 1) : r * (q + 1) + (xcd - r) * q) + off; }
        const int nig = WGM * nN, gid = wgid / nig, fm = gid * WGM, gsz = (nM - fm) < WGM ? (nM - fm) : WGM;
        u.pm = fm + ((wgid % nig) % gsz); u.pn = (wgid % nig) / gsz; u.e = 0; u.cnt = 0; return true;
    }
};
struct GroupOrder {
    const LAS int* pt; const LAS int* cn; LAS int* ul; int npn, total, G, c;
    __device__ void init(const LAS int* pt_, const LAS int* cn_, LAS int* ul_, int npn_, int G_, int c_) { pt = pt_; cn = cn_; ul = ul_; npn = npn_; total = __builtin_amdgcn_readfirstlane(pt_[NE] * npn_); G = G_; c = c_; }
    __device__ void build(int wave, int lane) const {
        if (wave == 0 && lane < 16) {
            const long L = (long)lane * G + c; int pm = -1, pn = 0, e = 0, cnt = 0;
            if (L < total) {
                int wgid = (int)L; { const int q = total / NXCD, r = total % NXCD, xcd = wgid % NXCD, off = wgid / NXCD; wgid = (xcd < r ? xcd * (q + 1) : r * (q + 1) + (xcd - r) * q) + off; }
                for (int j = 1; j < NE; ++j) e += (pt[j] * npn <= wgid) ? 1 : 0;
                const int t0 = pt[e], te = pt[e + 1] - t0, local = wgid - t0 * npn, mt = local % te;
                pn = local / te; pm = t0 + mt; cnt = cn[e] - mt * 256;
            }
            ul[lane * 4 + 0] = pm; ul[lane * 4 + 1] = pn; ul[lane * 4 + 2] = e; ul[lane * 4 + 3] = cnt;
        }
    }
    __device__ bool next(int i, Unit& u) const {
        if (i >= 16) return false;
        u.pm = __builtin_amdgcn_readfirstlane(ul[i * 4 + 0]); u.pn = __builtin_amdgcn_readfirstlane(ul[i * 4 + 1]);
        u.e = __builtin_amdgcn_readfirstlane(ul[i * 4 + 2]); u.cnt = __builtin_amdgcn_readfirstlane(ul[i * 4 + 3]);
        return u.pm >= 0;
    }
};
}

struct PInProj : pg8::DenseOrder {
    static constexpr int K = 1024; static constexpr bool GATHER = false, FP8 = false;
    const bf16_t* XN; const bf16_t* Wt; bf16_t* QKV; const float *gaq, *gak, *gbq, *gbk;
    static constexpr __host__ __device__ __forceinline__ int brow(int bj, int R) { return 64 * (R >> 5) + 32 * bj + pg8::perm32(R & 31); }
    __device__ __forceinline__ const char* a_base(const pg8::Unit& u) const { return (const char*)(XN + (size_t)u.pm * 256 * K); }
    __device__ __forceinline__ const char* b_base(const pg8::Unit& u) const { return (const char*)(Wt + (size_t)u.pn * 256 * K); }
    __device__ __forceinline__ void epi(const f32x4 (&acc)[2][2][4][2], const pg8::Unit& u, int wr, int wc, int fr, int fq) const {
        constexpr float ISC = 1.f;
        const int ty = u.pn >> 1;
        const float* g = (ty == 0) ? gaq : (ty == 1) ? gak : (ty == 3) ? gbq : (ty == 4) ? gbk : nullptr;
        const float post = (ty == 0 || ty == 3) ? QSCALE : 1.f;
        const int row0 = u.pm * 256 + wr * 64 + fr, col0 = u.pn * 256 + wc * 64 + 8 * fq;
        f32x4 gv[2][2];
#pragma unroll
        for (int bj = 0; bj < 2; ++bj)
#pragma unroll
            for (int n = 0; n < 2; ++n) gv[bj][n] = g ? *(const f32x4*)(g + 32 * bj + 8 * fq + 4 * n) : (f32x4){1.f, 1.f, 1.f, 1.f};
#pragma unroll
        for (int ai = 0; ai < 2; ++ai)
#pragma unroll
            for (int m = 0; m < 4; ++m) {
                float rs = 1.f;
                if (g) {
                    float ss = 0.f;
#pragma unroll
                    for (int bj = 0; bj < 2; ++bj)
#pragma unroll
                        for (int n = 0; n < 2; ++n) { const f32x4 v = acc[ai][bj][m][n] * ISC; ss += (v[0] * v[0] + v[1] * v[1]) + (v[2] * v[2] + v[3] * v[3]); }
                    ss += __shfl_xor(ss, 16); ss += __shfl_xor(ss, 32);
                    rs = rsqrtf(ss * (1.f / 64.f) + RMS_EPS) * post;
                }
                bf16_t* rowp = QKV + (size_t)(row0 + ai * 128 + m * 16) * NIN + col0;
#pragma unroll
                for (int bj = 0; bj < 2; ++bj) {
                    const f32x4 v0 = acc[ai][bj][m][0] * gv[bj][0] * (rs * ISC), v1 = acc[ai][bj][m][1] * gv[bj][1] * (rs * ISC);
                    u32x4 w; w.x = pg8::cvt_pk_bf16(v0[0], v0[1]); w.y = pg8::cvt_pk_bf16(v0[2], v0[3]); w.z = pg8::cvt_pk_bf16(v1[0], v1[1]); w.w = pg8::cvt_pk_bf16(v1[2], v1[3]);
                    *(u32x4*)(rowp + 32 * bj) = w;
                }
            }
    }
};
struct POutProj : pg8::DenseOrder {
    static constexpr int K = 1024; static constexpr bool GATHER = false, FP8 = false;
    const bf16_t* AO; const bf16_t* Wt; const float* x; const float* mod; float* x1;
    static constexpr __host__ __device__ __forceinline__ int brow(int bj, int R) { return 128 * bj + R; }
    __device__ __forceinline__ const char* a_base(const pg8::Unit& u) const { return (const char*)(AO + (size_t)u.pm * 256 * K); }
    __device__ __forceinline__ const char* b_base(const pg8::Unit& u) const { return (const char*)(Wt + (size_t)u.pn * 256 * K); }
    __device__ __forceinline__ void epi(const f32x4 (&acc)[2][2][4][2], const pg8::Unit& u, int wr, int wc, int fr, int fq) const {
        const int row0 = u.pm * 256 + wr * 64 + fr, col0 = u.pn * 256 + wc * 32 + 4 * fq;
        const float* gate1 = mod + ((u.pm * 256) / S) * 6144 + 2048;
        f32x4 gv[2][2];
#pragma unroll
        for (int bj = 0; bj < 2; ++bj)
#pragma unroll
            for (int n = 0; n < 2; ++n) gv[bj][n] = *(const f32x4*)(gate1 + col0 + bj * 128 + n * 16);
#pragma unroll
        for (int ai = 0; ai < 2; ++ai)
#pragma unroll
            for (int m = 0; m < 4; ++m) { const size_t off = (size_t)(row0 + ai * 128 + m * 16) * D + col0;
#pragma unroll
                for (int bj = 0; bj < 2; ++bj)
#pragma unroll
                    for (int n = 0; n < 2; ++n) { const f32x4 xv = *(const f32x4*)(x + off + bj * 128 + n * 16); *(f32x4*)(x1 + off + bj * 128 + n * 16) = xv + gv[bj][n] * acc[ai][bj][m][n]; }
                if (m & 1) asm volatile("" ::: "memory"); }
    }
};
struct PGateUp : pg8::GroupOrder {
    static constexpr int K = 512; static constexpr bool GATHER = true, FP8 = true;
    const bf16_t* H2; const bf16_t* Wt; const float* bgu; const int* list; bf16_t* ACT;
    static constexpr __host__ __device__ __forceinline__ int brow(int bj, int R) { return 1024 * bj + (R & ~31) + pg8::perm32(R & 31); }
    __device__ __forceinline__ const char* a_base(const pg8::Unit&) const { return (const char*)H2; }
    __device__ __forceinline__ const char* b_base(const pg8::Unit& u) const { return (const char*)(Wt + ((size_t)u.e * 2048 + u.pn * 128) * K); }
    __device__ __forceinline__ void a_offsets(const pg8::Unit& u, const int (&R)[2], const int (&C)[2], unsigned (&voff)[2][2]) const {
        const int* lp = list + (size_t)u.e * M + (size_t)(u.pm - pt[u.e]) * 256;
#pragma unroll
        for (int h = 0; h < 2; ++h)
#pragma unroll
            for (int i = 0; i < 2; ++i) { int r = h * 128 + R[i]; r = r < u.cnt ? r : 0; const int tok = lp[r]; voff[h][i] = (unsigned)(tok * K + C[i]) * 2u; }
    }
    __device__ __forceinline__ void epi(const f32x4 (&acc)[2][2][4][2], const pg8::Unit& u, int wr, int wc, int fr, int fq) const {
        const int row0 = u.pm * 256 + wr * 64 + fr, col0 = u.pn * 128 + wc * 32 + 8 * fq;
        const float* bias = bgu + u.e * 2048 + col0;
        f32x4 bg[2], bu[2];
#pragma unroll
        for (int n = 0; n < 2; ++n) { bg[n] = *(const f32x4*)(bias + 4 * n); bu[n] = (*(const f32x4*)(bias + 1024 + 4 * n) + 1.f) * ACT_SCALE; }
#pragma unroll
        for (int ai = 0; ai < 2; ++ai)
#pragma unroll
            for (int m = 0; m < 4; ++m) {
                float a[2][4];
#pragma unroll
                for (int n = 0; n < 2; ++n)
#pragma unroll
                    for (int r = 0; r < 4; ++r) {
                        const float g = fminf(__builtin_fmaf(acc[ai][0][m][n][r], 1.f / (H2_SCALE * W8_SCALE), bg[n][r]), 7.f);
                        const float u8 = __builtin_amdgcn_fmed3f(__builtin_fmaf(acc[ai][1][m][n][r], ACT_SCALE / (H2_SCALE * W8_SCALE), bu[n][r]), -6.f * ACT_SCALE, 8.f * ACT_SCALE);
                        a[n][r] = u8 * (g * __builtin_amdgcn_rcpf(1.f + __builtin_amdgcn_exp2f(-1.702f * LOG2E * g)));
                    }
                u32x2 w; w.x = pg8::pk4_fp8(a[0][0], a[0][1], a[0][2], a[0][3]); w.y = pg8::pk4_fp8(a[1][0], a[1][1], a[1][2], a[1][3]);
                *(u32x2*)((unsigned char*)ACT + (size_t)(row0 + ai * 128 + m * 16) * DFF + col0) = w;
            }
    }
};
struct PDown : pg8::GroupOrder {
    static constexpr int K = 512; static constexpr bool GATHER = false, FP8 = true;
    const bf16_t* ACT; const bf16_t* Wt; const float* bd; bf16_t* Y;
    static constexpr __host__ __device__ __forceinline__ int brow(int bj, int R) { return 128 * bj + (R & ~31) + pg8::perm32(R & 31); }
    __device__ __forceinline__ const char* a_base(const pg8::Unit& u) const { return (const char*)(ACT + (size_t)u.pm * 256 * K); }
    __device__ __forceinline__ const char* b_base(const pg8::Unit& u) const { return (const char*)(Wt + ((size_t)u.e * 1024 + u.pn * 256) * K); }
    __device__ __forceinline__ void epi(const f32x4 (&acc)[2][2][4][2], const pg8::Unit& u, int wr, int wc, int fr, int fq) const {
        const int row0 = u.pm * 256 + wr * 64 + fr, col0 = u.pn * 256 + wc * 32 + 8 * fq;
        const float* bias = bd + u.e * 1024 + col0;
        f32x4 bv[2][2];
#pragma unroll
        for (int bj = 0; bj < 2; ++bj)
#pragma unroll
            for (int n = 0; n < 2; ++n) bv[bj][n] = *(const f32x4*)(bias + bj * 128 + 4 * n) * Y_SCALE;
#pragma unroll
        for (int ai = 0; ai < 2; ++ai)
#pragma unroll
            for (int m = 0; m < 4; ++m) { unsigned char* rowp = (unsigned char*)Y + (size_t)(row0 + ai * 128 + m * 16) * D + col0;
#pragma unroll
                for (int bj = 0; bj < 2; ++bj) { f32x4 v0, v1;
#pragma unroll
                    for (int q_ = 0; q_ < 4; ++q_) { v0[q_] = __builtin_amdgcn_fmed3f(__builtin_fmaf(acc[ai][bj][m][0][q_], Y_SCALE / (ACT_SCALE * W8_SCALE), bv[bj][0][q_]), -448.f, 448.f);
                                                     v1[q_] = __builtin_amdgcn_fmed3f(__builtin_fmaf(acc[ai][bj][m][1][q_], Y_SCALE / (ACT_SCALE * W8_SCALE), bv[bj][1][q_]), -448.f, 448.f); }
                    u32x2 w; w.x = pg8::pk4_fp8(v0[0], v0[1], v0[2], v0[3]); w.y = pg8::pk4_fp8(v1[0], v1[1], v1[2], v1[3]);
                    *(u32x2*)(rowp + bj * 128) = w; } }
    }
};


namespace att {
typedef float f32x16 __attribute__((ext_vector_type(16)));
typedef short s16x4 __attribute__((ext_vector_type(4)));
typedef short v4i16_t __attribute__((ext_vector_type(4)));
typedef float f32x2_t __attribute__((ext_vector_type(2))); typedef __bf16 bf16x2_t __attribute__((ext_vector_type(2)));
__device__ __forceinline__ unsigned cvtpk(float lo, float hi) { f32x2_t v = {lo, hi}; bf16x2_t b = __builtin_convertvector(v, bf16x2_t); return __builtin_bit_cast(unsigned, b); }
__device__ __forceinline__ s16x4 vtr(const LAS unsigned char* p) { return __builtin_bit_cast(s16x4, __builtin_amdgcn_ds_read_tr16_b64_v4i16((LAS v4i16_t*)p)); }
__device__ __forceinline__ void glds16(const void* gsrc, LAS unsigned char* dst) { __builtin_amdgcn_global_load_lds((const unsigned*)gsrc, (LAS unsigned*)dst, 16, 0, 0); }
#define ATT_CR(r) (((r) & 3) + 8 * ((r) >> 2))
#define ATT_WAIT_V(n) asm volatile("s_waitcnt vmcnt(" #n ")" ::: "memory")
#define ATT_WAIT_L0() asm volatile("s_waitcnt lgkmcnt(0)" ::: "memory")

template <int MODE> __device__ __forceinline__ float soft_tile(f32x16& p0, f32x16& p1, float sl, int dqh) {
    float sum = 0.f;
#pragma unroll
    for (int r = 0; r < 16; ++r) {
        float x0 = __builtin_fmaf(sl, (float)ATT_CR(r), p0[r]), x1 = __builtin_fmaf(sl, (float)(ATT_CR(r) + 32), p1[r]);
        if (MODE == 1) { x0 = (ATT_CR(r) <= dqh) ? x0 : -INFINITY; x1 = (ATT_CR(r) + 32 <= dqh) ? x1 : -INFINITY; }
        if (MODE == 2) { x0 = ((unsigned)(dqh - ATT_CR(r)) <= 128u) ? x0 : -INFINITY; x1 = ((unsigned)(dqh - ATT_CR(r) - 32) <= 128u) ? x1 : -INFINITY; }
        p0[r] = __builtin_amdgcn_exp2f(x0); p1[r] = __builtin_amdgcn_exp2f(x1);
        sum += p0[r] + p1[r];
    }
    return sum;
}
__device__ __forceinline__ void pack_p(const f32x16& p0, const f32x16& p1, bf16x8 (&pa)[4]) {
    u32x4 w0 = {cvtpk(p0[0], p0[1]), cvtpk(p0[2], p0[3]), cvtpk(p0[4], p0[5]), cvtpk(p0[6], p0[7])};
    u32x4 w1 = {cvtpk(p0[8], p0[9]), cvtpk(p0[10], p0[11]), cvtpk(p0[12], p0[13]), cvtpk(p0[14], p0[15])};
    u32x4 w2 = {cvtpk(p1[0], p1[1]), cvtpk(p1[2], p1[3]), cvtpk(p1[4], p1[5]), cvtpk(p1[6], p1[7])};
    u32x4 w3 = {cvtpk(p1[8], p1[9]), cvtpk(p1[10], p1[11]), cvtpk(p1[12], p1[13]), cvtpk(p1[14], p1[15])};
    pa[0] = __builtin_bit_cast(bf16x8, w0); pa[1] = __builtin_bit_cast(bf16x8, w1); pa[2] = __builtin_bit_cast(bf16x8, w2); pa[3] = __builtin_bit_cast(bf16x8, w3);
}
template <int NDB> __device__ __forceinline__ void pv_tile(f32x16 (&o)[NDB], const LAS unsigned char* vrd, const bf16x8 (&pa)[4]) {
#pragma unroll
    for (int db = 0; db < NDB; ++db) {
        s16x4 lo[4], hh[4];
#pragma unroll
        for (int g = 0; g < 4; ++g) { lo[g] = vtr(vrd + db * 4096 + g * 1024); hh[g] = vtr(vrd + db * 4096 + g * 1024 + 512); }
#pragma unroll
        for (int g = 0; g < 4; ++g) { const bf16x8 vf = {lo[g][0], lo[g][1], lo[g][2], lo[g][3], hh[g][0], hh[g][1], hh[g][2], hh[g][3]};
            o[db] = __builtin_amdgcn_mfma_f32_32x32x16_bf16(pa[g], vf, o[db], 0, 0, 0); }
    }
}
__device__ __forceinline__ float gain_bound(const float* ga, const float* gb, int lane) {
    float a = fabsf(ga[lane & 63]), b = fabsf(gb[lane & 63]);
#pragma unroll
    for (int o = 1; o < 64; o <<= 1) { a = fmaxf(a, __shfl_xor(a, o)); b = fmaxf(b, __shfl_xor(b, o)); }
    return QSCALE * 64.f * a * b * 1.02f + 0.25f;
}

constexpr int B2_SLOT = 32768;
__device__ __forceinline__ void attn_b2_unit(LAS unsigned char* lds, LAS float* wsf, const bf16_t* QKV, bf16_t* AO, const float* gd, int b, int h, int qb, float Mb, float lam, int wave, int lane) {
    const int r32 = lane & 31, hi = lane >> 5;
    const int c = wave >> 2, wq = wave & 3;
    const int q0 = qb * 128, tq = q0 + wq * 32 + r32;
    const size_t rowbase = (size_t)b * S;
    const bf16_t* Qp = QKV + (rowbase + tq) * NIN + 1536 + h * 128 + c * 64;
    const bf16_t* Kh = QKV + rowbase * NIN + 2048 + h * 128;
    const bf16_t* Vh = QKV + rowbase * NIN + 2560 + h * 128;
    const float sl = exp2f(-2.f * (float)(h + 1)) * LOG2E;
    bf16x8 qr[4];
#pragma unroll
    for (int d0 = 0; d0 < 4; ++d0) qr[d0] = *(const bf16x8*)(Qp + d0 * 16 + hi * 8);
    const int NT = (q0 + 128) / 64;
    const bf16_t* ksrc = Kh + (size_t)lane * NIN + wave * 8;
    const int i0 = wave, i1 = wave + 8;
    const bf16_t* vsrc0 = Vh + (size_t)(16 * (i0 & 3) + (lane >> 2)) * NIN + (i0 >> 2) * 32 + (lane & 3) * 8;
    const bf16_t* vsrc1 = Vh + (size_t)(16 * (i1 & 3) + (lane >> 2)) * NIN + (i1 >> 2) * 32 + (lane & 3) * 8;
#define ATT_DMA(t, s) do { const size_t to_ = (size_t)(t) * 64 * NIN; LAS unsigned char* sb_ = lds + (s) * B2_SLOT; \
        glds16(ksrc + to_, sb_ + wave * 1024); glds16(ksrc + 64 + to_, sb_ + 8192 + wave * 1024); glds16(vsrc0 + to_, sb_ + 16384 + i0 * 1024); glds16(vsrc1 + to_, sb_ + 16384 + i1 * 1024); } while (0)
    const int kfo = c * 8192 + hi * 1024 + r32 * 16;
    const int vro = 16384 + ((lane >> 4) & 1) * 32 + (lane & 3) * 8 + (4 * hi + ((lane & 15) >> 2)) * 64;
    f32x16 o[4]; float lsum = 0.f;
#pragma unroll
    for (int d = 0; d < 4; ++d) o[d] = f32x16{};
    ATT_WAIT_L0(); __builtin_amdgcn_s_barrier();
    ATT_DMA(0, 0); ATT_DMA(1, 1);
    const int qmax_w = q0 + wq * 32 + 31, qmin_w = q0 + wq * 32;
    int slot = 0;
    for (int t = 0; t < NT; ++t) {
        if (t + 1 < NT) ATT_WAIT_V(4); else ATT_WAIT_V(0);
        ATT_WAIT_L0(); __builtin_amdgcn_s_barrier();
        if (t + 2 < NT) { const int s2 = (slot >= 1) ? slot - 1 : 2; ATT_DMA(t + 2, s2); }
        const int k0 = 64 * t;
        if (k0 <= qmax_w) {
            const LAS unsigned char* sb = lds + slot * B2_SLOT;
            bf16x8 kf[8];
#pragma unroll
            for (int d0 = 0; d0 < 4; ++d0) { kf[2 * d0] = *(const LAS bf16x8*)(sb + kfo + d0 * 2048); kf[2 * d0 + 1] = *(const LAS bf16x8*)(sb + kfo + d0 * 2048 + 512); }
            const int dqh = tq - k0 - 4 * hi;
            const float ci = -sl * (float)dqh - Mb;
            f32x16 p0, p1;
#pragma unroll
            for (int r = 0; r < 16; ++r) { p0[r] = ci; p1[r] = ci; }
#pragma unroll
            for (int d0 = 0; d0 < 4; ++d0) { p0 = __builtin_amdgcn_mfma_f32_32x32x16_bf16(kf[2 * d0], qr[d0], p0, 0, 0, 0); p1 = __builtin_amdgcn_mfma_f32_32x32x16_bf16(kf[2 * d0 + 1], qr[d0], p1, 0, 0, 0); }
            if (k0 + 63 <= qmin_w) lsum += soft_tile<0>(p0, p1, sl, dqh); else lsum += soft_tile<1>(p0, p1, sl, dqh);
            bf16x8 pa[4]; pack_p(p0, p1, pa);
            pv_tile<4>(o, sb + vro, pa);
        }
        slot = (slot == 2) ? 0 : slot + 1;
    }
#undef ATT_DMA
    { auto rr = __builtin_amdgcn_permlane32_swap(__float_as_uint(lsum), __float_as_uint(lsum), false, false); lsum = __uint_as_float(rr[0]) + __uint_as_float(rr[1]); }
    if (hi == 0) wsf[r32] = lsum;
    ATT_WAIT_L0(); __builtin_amdgcn_s_barrier();
    LAS float* X = (LAS float*)lds + (size_t)(wq * 32) * 128 + r32;
    if (c == 1) {
#pragma unroll
        for (int r = 0; r < 16; ++r) { const int q = ATT_CR(r) + 4 * hi; const float f = lam * __builtin_amdgcn_rcpf(wsf[q]);
#pragma unroll
            for (int db = 0; db < 4; ++db) X[q * 128 + db * 32] = o[db][r] * f; }
    }
    ATT_WAIT_L0(); __builtin_amdgcn_s_barrier();
    if (c == 0) {
        float gdv[4];
#pragma unroll
        for (int db = 0; db < 4; ++db) gdv[db] = gd[db * 32 + r32] * (1.f - LAMBDA_INIT);
        LAS bf16_t* stg = (LAS bf16_t*)(lds + 65536 + wq * 8192);
#pragma unroll
        for (int r = 0; r < 16; ++r) { const int q = ATT_CR(r) + 4 * hi; const float rl = __builtin_amdgcn_rcpf(wsf[q]);
            float v[4], ss = 0.f;
#pragma unroll
            for (int db = 0; db < 4; ++db) { v[db] = o[db][r] * rl - X[q * 128 + db * 32]; ss += v[db] * v[db]; }
            ss += __shfl_xor(ss, 1); ss += __shfl_xor(ss, 2); ss += __shfl_xor(ss, 4); ss += __shfl_xor(ss, 8); ss += __shfl_xor(ss, 16);
            const float rs = rsqrtf(ss * (1.f / 128.f) + RMS_EPS);
#pragma unroll
            for (int db = 0; db < 4; ++db) stg[q * 128 + db * 32 + r32] = f2bf(v[db] * rs * gdv[db]); }
        ATT_WAIT_L0();
        bf16_t* ao = AO + (rowbase + q0 + wq * 32) * D + 512 + h * 128;
#pragma unroll
        for (int i = 0; i < 8; ++i) { const int p = i * 64 + lane, row = p >> 4, ch = p & 15; const u32x4 v = *(const LAS u32x4*)(stg + row * 128 + ch * 8); *(u32x4*)(ao + (size_t)row * D + ch * 8) = v; }
    }
    ATT_WAIT_L0();
}
__device__ __forceinline__ void attn_b_phase(LAS unsigned char* lds, LAS float* wsf, const bf16_t* QKV, bf16_t* AO, const float* gbq, const float* gbk, const float* gd,
                                             const float* lq1, const float* lk1, const float* lq2, const float* lk2, int vcu, int wave, int lane) {
    const float Mb = gain_bound(gbq, gbk, lane);
    float s1 = lq1[lane] * lk1[lane], s2 = lq2[lane] * lk2[lane];
#pragma unroll
    for (int o = 1; o < 64; o <<= 1) { s1 += __shfl_xor(s1, o); s2 += __shfl_xor(s2, o); }
    const float lam = __expf(s1) - __expf(s2) + LAMBDA_INIT;
    const int bh = vcu >> 3, s = vcu & 7, b = bh >> 2, h = bh & 3;
    attn_b2_unit(lds, wsf, QKV, AO, gd, b, h, 15 - s, Mb, lam, wave, lane);
    attn_b2_unit(lds, wsf, QKV, AO, gd, b, h, s, Mb, lam, wave, lane);
    ATT_WAIT_L0(); __builtin_amdgcn_s_barrier();
}

__device__ __forceinline__ void attn_a2_unit(LAS unsigned char* lds, LAS float* wsf, const bf16_t* QKV, bf16_t* AO, int b, int h, int r, int jb, float Mb, int wave, int lane) {
    const int r32 = lane & 31, hi = lane >> 5;
    const int j = 32 * jb + r32, tq = r + 16 * j;
    const size_t rowbase = (size_t)b * S;
    const bf16_t* Qp = QKV + (rowbase + tq) * NIN + h * 64;
    const bf16_t* Kh = QKV + rowbase * NIN + 512 + h * 64;
    const float sl1 = exp2f(-(float)(h + 1)) * LOG2E;
    bf16x8 qr[4];
#pragma unroll
    for (int d0 = 0; d0 < 4; ++d0) qr[d0] = *(const bf16x8*)(Qp + d0 * 16 + hi * 8);
    const int n3 = (jb >= 2) ? 2 : 1, n2 = (jb == 0) ? 2 : 4, n1 = (jb == 0) ? 8 : 10, npriv = n3 + n2;
    auto tile_step = [&](int idx) -> int { return idx < n3 ? 16 : 4; };
    auto tile_k0 = [&](int idx) -> int { return idx < n3 ? 64 * idx : 64 * ((jb == 0 ? 0 : 2 * jb - 2) + idx - n3); };
    auto tile_uq = [&](int step) -> int { return step == 16 ? j : (r >> 2) + 4 * j; };
    auto tile_pos0 = [&](int step, int k0) -> int { return (r & (step - 1)) + step * k0; };
    LAS unsigned char* vbuf = lds + wave * 16384;
    const int vr16 = lane >> 2;
    bf16x8 kfn[8];
#define ATT_PREF(idx, buf) do { const int st_ = tile_step(idx), k0_ = tile_k0(idx); const bf16_t* kb_ = Kh + (size_t)tile_pos0(st_, k0_) * NIN; const size_t rs_ = (size_t)st_ * NIN; \
        _Pragma("unroll") for (int d0 = 0; d0 < 4; ++d0) { kfn[2 * d0] = *(const bf16x8*)(kb_ + (size_t)r32 * rs_ + d0 * 16 + hi * 8); kfn[2 * d0 + 1] = *(const bf16x8*)(kb_ + (size_t)(r32 + 32) * rs_ + d0 * 16 + hi * 8); } \
        _Pragma("unroll") for (int i = 0; i < 8; ++i) glds16(kb_ + 512 + (size_t)(16 * (i & 3) + vr16) * rs_ + (i >> 2) * 32 + (lane & 3) * 8, vbuf + (buf) * 8192 + i * 1024); } while (0)
    const int vro = ((lane >> 4) & 1) * 32 + (lane & 3) * 8 + (4 * hi + ((lane & 15) >> 2)) * 64;
    f32x16 o[2]; o[0] = f32x16{}; o[1] = f32x16{}; float lsum = 0.f;
    ATT_WAIT_L0(); __builtin_amdgcn_s_barrier();
    ATT_PREF(0, 0);
    for (int idx = 0; idx < npriv; ++idx) {
        ATT_WAIT_V(0);
        bf16x8 kf[8];
#pragma unroll
        for (int i = 0; i < 8; ++i) kf[i] = kfn[i];
        ATT_WAIT_L0();
        if (idx + 1 < npriv) ATT_PREF(idx + 1, (idx + 1) & 1);
        const int st = tile_step(idx), k0 = tile_k0(idx);
        const int dqh = tile_uq(st) - k0 - 4 * hi;
        const float sl = sl1 * (float)st;
        const float ci = -sl * (float)dqh - Mb;
        f32x16 p0, p1;
#pragma unroll
        for (int rr = 0; rr < 16; ++rr) { p0[rr] = ci; p1[rr] = ci; }
#pragma unroll
        for (int d0 = 0; d0 < 4; ++d0) { p0 = __builtin_amdgcn_mfma_f32_32x32x16_bf16(kf[2 * d0], qr[d0], p0, 0, 0, 0); p1 = __builtin_amdgcn_mfma_f32_32x32x16_bf16(kf[2 * d0 + 1], qr[d0], p1, 0, 0, 0); }
        lsum += soft_tile<2>(p0, p1, sl, dqh);
        bf16x8 pa[4]; pack_p(p0, p1, pa);
        pv_tile<2>(o, vbuf + (idx & 1) * 8192 + vro, pa);
    }
#undef ATT_PREF
    ATT_WAIT_L0(); __builtin_amdgcn_s_barrier();
    const int T0 = (jb == 0) ? 0 : 8 * jb - 2;
    const bf16_t* ksrc = Kh + (size_t)(64 * T0 + lane) * NIN + wave * 8;
    const bf16_t* vsrc = Kh + 512 + (size_t)(64 * T0 + 16 * (wave & 3) + (lane >> 2)) * NIN + (wave >> 2) * 32 + (lane & 3) * 8;
#define ATT_DMA(t, s) do { const size_t to_ = (size_t)(t) * 64 * NIN; LAS unsigned char* sb_ = lds + (s) * 16384; glds16(ksrc + to_, sb_ + wave * 1024); glds16(vsrc + to_, sb_ + 8192 + wave * 1024); } while (0)
    const int kfo = hi * 1024 + r32 * 16;
    ATT_DMA(0, 0); ATT_DMA(1, 1);
    int slot = 0;
    for (int t = 0; t < n1; ++t) {
        if (t + 1 < n1) ATT_WAIT_V(2); else ATT_WAIT_V(0);
        ATT_WAIT_L0(); __builtin_amdgcn_s_barrier();
        if (t + 2 < n1) { const int s2 = (slot >= 1) ? slot - 1 : 2; ATT_DMA(t + 2, s2); }
        const LAS unsigned char* sb = lds + slot * 16384;
        bf16x8 kf[8];
#pragma unroll
        for (int d0 = 0; d0 < 4; ++d0) { kf[2 * d0] = *(const LAS bf16x8*)(sb + kfo + d0 * 2048); kf[2 * d0 + 1] = *(const LAS bf16x8*)(sb + kfo + d0 * 2048 + 512); }
        const int dqh = tq - 64 * (T0 + t) - 4 * hi;
        const float ci = -sl1 * (float)dqh - Mb;
        f32x16 p0, p1;
#pragma unroll
        for (int rr = 0; rr < 16; ++rr) { p0[rr] = ci; p1[rr] = ci; }
#pragma unroll
        for (int d0 = 0; d0 < 4; ++d0) { p0 = __builtin_amdgcn_mfma_f32_32x32x16_bf16(kf[2 * d0], qr[d0], p0, 0, 0, 0); p1 = __builtin_amdgcn_mfma_f32_32x32x16_bf16(kf[2 * d0 + 1], qr[d0], p1, 0, 0, 0); }
        lsum += soft_tile<2>(p0, p1, sl1, dqh);
        bf16x8 pa[4]; pack_p(p0, p1, pa);
        pv_tile<2>(o, sb + 8192 + vro, pa);
        slot = (slot == 2) ? 0 : slot + 1;
    }
#undef ATT_DMA
    { auto rr = __builtin_amdgcn_permlane32_swap(__float_as_uint(lsum), __float_as_uint(lsum), false, false); lsum = __uint_as_float(rr[0]) + __uint_as_float(rr[1]); }
    if (hi == 0) wsf[r32] = lsum;
    ATT_WAIT_L0(); __builtin_amdgcn_s_barrier();
    LAS bf16_t* stg = (LAS bf16_t*)(lds + wave * 4096);
#pragma unroll
    for (int rr = 0; rr < 16; ++rr) { const int q = ATT_CR(rr) + 4 * hi; const float rl = __builtin_amdgcn_rcpf(wsf[q]);
#pragma unroll
        for (int db = 0; db < 2; ++db) stg[q * 64 + db * 32 + r32] = f2bf(o[db][rr] * rl); }
    ATT_WAIT_L0();
#pragma unroll
    for (int i = 0; i < 4; ++i) { const int row = i * 8 + (lane >> 3), ch = lane & 7; const u32x4 v = *(const LAS u32x4*)(stg + row * 64 + ch * 8);
        *(u32x4*)(AO + (rowbase + r + 16 * (32 * jb + row)) * D + h * 64 + ch * 8) = v; }
    ATT_WAIT_L0();
}
__device__ __forceinline__ void attn_a_phase(LAS unsigned char* lds, LAS float* wsf, const bf16_t* QKV, bf16_t* AO, const float* gaq, const float* gak, int vcu, int wave, int lane) {
    const float Mb = gain_bound(gaq, gak, lane);
    const int bh = vcu >> 2, b = bh >> 3, h = bh & 7, r = 8 * (vcu & 1) + wave, jp = (vcu >> 1) & 1;
    attn_a2_unit(lds, wsf, QKV, AO, b, h, r, jp ? 2 : 3, Mb, wave, lane);
    attn_a2_unit(lds, wsf, QKV, AO, b, h, r, jp ? 1 : 0, Mb, wave, lane);
    ATT_WAIT_L0(); __builtin_amdgcn_s_barrier();
}
#undef ATT_CR
#undef ATT_WAIT_V
#undef ATT_WAIT_L0
}

struct MArgs {
    const float *x, *c, *w_ada, *b_ada, *g1, *w_in, *gaq, *gak, *gbq, *gbk, *lq1, *lk1, *lq2, *lk2, *gd, *w_out, *g2, *w_router, *b_router, *w_gu, *b_gu, *w_d, *b_d;
    float* out; unsigned char* ws; int ph_lo, ph_hi;
};

__device__ __forceinline__ void p0_transpose_item(const float* W, int K, int N, bf16_t* WT, LAS float* scr, int item, int lane) {
    const int nblk = N / 32, kb = item / nblk, nb = item % nblk, k0 = 64 * kb, n0 = 32 * nb;
    { f32x4 v[8];
#pragma unroll
      for (int i = 0; i < 8; ++i) v[i] = *(const f32x4*)(W + (size_t)(k0 + 8 * i + (lane >> 3)) * N + n0 + 4 * (lane & 7));
#pragma unroll
      for (int i = 0; i < 8; ++i) { LAS float* d = scr + (8 * i + (lane >> 3)) * 33 + 4 * (lane & 7); d[0] = v[i].x; d[1] = v[i].y; d[2] = v[i].z; d[3] = v[i].w; } }
    LDS_WAIT(); asm volatile("" ::: "memory");
    const int c = lane & 7;
#pragma unroll
    for (int j = 0; j < 4; ++j) { const int n = (lane >> 3) + 8 * j; const LAS float* s = scr + (8 * c) * 33 + n;
        u32x4 o; o.x = pk2(s[0 * 33], s[1 * 33]); o.y = pk2(s[2 * 33], s[3 * 33]); o.z = pk2(s[4 * 33], s[5 * 33]); o.w = pk2(s[6 * 33], s[7 * 33]);
        *(u32x4*)(WT + (size_t)(n0 + n) * K + k0 + 8 * c) = o; }
    LDS_WAIT(); asm volatile("" ::: "memory");
}

__device__ __forceinline__ void p0_transpose8_item(const float* W, int K, int N, unsigned char* WT, LAS float* scr, int item, int lane) {
    const int nblk = N / 32, kb = item / nblk, nb = item % nblk, k0 = 64 * kb, n0 = 32 * nb;
    { f32x4 v[8];
#pragma unroll
      for (int i = 0; i < 8; ++i) v[i] = *(const f32x4*)(W + (size_t)(k0 + 8 * i + (lane >> 3)) * N + n0 + 4 * (lane & 7));
#pragma unroll
      for (int i = 0; i < 8; ++i) { LAS float* d = scr + (8 * i + (lane >> 3)) * 33 + 4 * (lane & 7); d[0] = v[i].x; d[1] = v[i].y; d[2] = v[i].z; d[3] = v[i].w; } }
    LDS_WAIT(); asm volatile("" ::: "memory");
#pragma unroll
    for (int j = 0; j < 2; ++j) { const int n = (lane >> 2) + 16 * j, c = lane & 3; const LAS float* s = scr + (16 * c) * 33 + n;
        u32x4 o;
        o.x = pg8::pk4_fp8(s[0 * 33] * W8_SCALE, s[1 * 33] * W8_SCALE, s[2 * 33] * W8_SCALE, s[3 * 33] * W8_SCALE);
        o.y = pg8::pk4_fp8(s[4 * 33] * W8_SCALE, s[5 * 33] * W8_SCALE, s[6 * 33] * W8_SCALE, s[7 * 33] * W8_SCALE);
        o.z = pg8::pk4_fp8(s[8 * 33] * W8_SCALE, s[9 * 33] * W8_SCALE, s[10 * 33] * W8_SCALE, s[11 * 33] * W8_SCALE);
        o.w = pg8::pk4_fp8(s[12 * 33] * W8_SCALE, s[13 * 33] * W8_SCALE, s[14 * 33] * W8_SCALE, s[15 * 33] * W8_SCALE);
        *(u32x4*)(WT + (size_t)(n0 + n) * K + k0 + 16 * c) = o; }
    LDS_WAIT(); asm volatile("" ::: "memory");
}

constexpr int CV_I_GU = 16 * 64, CV_I_D = 16 * 32, CV_NIT = NE * (CV_I_GU + CV_I_D);
#ifndef CV_STATIC
#define CV_STATIC 16384
#endif
__device__ __forceinline__ void cv_item(const float* w_gu, const float* w_d, unsigned char* gu8, unsigned char* d8, LAS float* scr, int it, int lane) {
    if (it < NE * CV_I_GU) { const int e = it / CV_I_GU; p0_transpose8_item(w_gu + (size_t)e * 1024 * 2048, 1024, 2048, gu8 + (size_t)e * 1024 * 2048, scr, it % CV_I_GU, lane); }
    else { const int r_ = it - NE * CV_I_GU, e = r_ / CV_I_D; p0_transpose8_item(w_d + (size_t)e * 1024 * 1024, 1024, 1024, d8 + (size_t)e * 1024 * 1024, scr, r_ % CV_I_D, lane); }
}

__global__ void __launch_bounds__(NTHREADS, 2) mega(MArgs a) {
    extern __shared__ __attribute__((aligned(16))) unsigned char lds_raw[];
    LAS unsigned char* lds = (LAS unsigned char*)lds_raw;
    const int G = gridDim.x, bx = blockIdx.x, vcu = (G % 8 == 0) ? (bx % 8) * (G / 8) + bx / 8 : bx, NGW = G * NWAVES;
    const int wave = __builtin_amdgcn_readfirstlane((int)threadIdx.x >> 6);
#define PHASE_IDS() int lane = (int)__builtin_amdgcn_mbcnt_hi(~0u, __builtin_amdgcn_mbcnt_lo(~0u, 0u)); asm volatile("" : "+v"(lane)); const int tid = wave * 64 + lane, gw = vcu * NWAVES + wave; (void)tid; (void)gw
    volatile LAS unsigned* MISC = (volatile LAS unsigned*)(lds + MISC_OFF);
    LAS int* PT = (LAS int*)(lds + PT_OFF); LAS int* CN = (LAS int*)(lds + CNT_OFF);
#define w_counts ((int*)(a.ws + WS_CTL + CTL_COUNTS))
#define w_mod ((float*)(a.ws + WS_CTL + CTL_MOD))
#define w_modp ((float*)(a.ws + WS_MODP))
#define w_adacnt ((unsigned*)(a.ws + WS_CTL + CTL_ADACNT))
#define w_cvq ((unsigned*)(a.ws + WS_CTL + CTL_ADACNT + 256))
#define w_Win_t ((bf16_t*)(a.ws + WS_WIN))
#define w_Wout_t ((bf16_t*)(a.ws + WS_WOUT))
#define w_Wgu_t ((bf16_t*)(a.ws + WS_WGU))
#define w_Wd_t ((bf16_t*)(a.ws + WS_WD))
#define w_XN ((bf16_t*)(a.ws + WS_XN))
#define w_QKV ((bf16_t*)(a.ws + WS_QKV))
#define w_AO ((bf16_t*)(a.ws + WS_AO))
#define w_H2 ((bf16_t*)(a.ws + WS_H2))
#define w_tope ((int*)(a.ws + WS_TOPE))
#define w_tops ((int*)(a.ws + WS_TOPS))
#define w_topg ((float*)(a.ws + WS_TOPG))
#define w_list ((int*)(a.ws + WS_LIST))
#define w_ACT ((bf16_t*)(a.ws + WS_ACT))
#define w_Y ((bf16_t*)(a.ws + WS_Y))
#define w_OBN ((float*)(a.ws + WS_OBN))
#define w_X1 ((float*)(a.ws + WS_X1))
    for (int u = threadIdx.x; u < (LDS_BYTES - LDSCTL_OFF) / 4; u += NTHREADS) ((LAS unsigned*)(lds + LDSCTL_OFF))[u] = 0u;
    __syncthreads();
    const int lo = a.ph_lo, hi = a.ph_hi;
    XcdBarrier bar; bar.bar = (unsigned*)(a.ws + WS_CTL + CTL_BAR); bar.x = 0; bar.st = nullptr;
    if (hi - lo > 1) bar = xcd_barrier_post((unsigned*)(a.ws + WS_CTL + CTL_BAR), MISC + 8);
#define IN(k) (lo <= (k) && (k) < hi)
#ifndef REP_PH
#define REP_PH -1
#define REP_N 1
#endif
#define NREP(k) (((k) == REP_PH || REP_PH == 100) ? REP_N : 1)
#ifndef SPAN_PH
#define SPAN_PH -1
#endif
    LAS unsigned long long* tstamp = (LAS unsigned long long*)(lds + LDSCTL_OFF + 1536);
#define STAMP(i) do { if (SPAN_PH >= 0 && bx == 0 && threadIdx.x == 0) tstamp[i] = __builtin_amdgcn_s_memrealtime(); } while (0)
    STAMP(0);
#define SEAM(k) do { if (IN(k) && IN((k) + 1)) xcd_barrier(bar, wave); STAMP((k) + 1); } while (0)
#define LOAD_PT() do { if (wave == 0) { int cv = (lane < NE) ? w_counts[lane] : 0; int tl = (cv + 255) >> 8; int sc = tl; \
        _Pragma("unroll") for (int o = 1; o < 32; o <<= 1) { const int t_ = __shfl_up(sc, o); if ((lane & 31) >= o) sc += t_; } \
        if (lane < NE) { PT[lane + 1] = sc; CN[lane] = cv; } if (lane == 0) PT[0] = 0; } __syncthreads(); } while (0)

    if (IN(0)) for (int rep_ = 0; rep_ < NREP(0); ++rep_) {
        PHASE_IDS();
        LAS float* silu = (LAS float*)(lds + 98304);
        for (int i = tid; i < NB * D; i += NTHREADS) { const float cv = a.c[i]; silu[i] = cv / (1.f + __expf(-cv)); }
        __syncthreads();
        if (gw < 24 * 32 && rep_ == 0) {
            const int cc = gw % 24, ks = gw / 24, col = cc * 256 + 4 * lane;
            f32x4 acc[NB];
#pragma unroll
            for (int b = 0; b < NB; ++b) acc[b] = (ks == 0) ? *(const f32x4*)(a.b_ada + col) : (f32x4){0.f, 0.f, 0.f, 0.f};
#pragma unroll 1
            for (int k8 = ks * 32; k8 < ks * 32 + 32; k8 += 8) {
                f32x4 w[8];
#pragma unroll
                for (int i = 0; i < 8; ++i) w[i] = *(const f32x4*)(a.w_ada + (size_t)(k8 + i) * 6144 + col);
#pragma unroll
                for (int i = 0; i < 8; ++i)
#pragma unroll
                    for (int b = 0; b < NB; ++b) acc[b] += w[i] * silu[b * D + k8 + i];
            }
#pragma unroll
            for (int b = 0; b < NB; ++b) *(f32x4*)(w_modp + ((size_t)ks * NB + b) * 6144 + col) = acc[b];
        }
        if (rep_ == 0) {
            VM_WAIT(); __syncthreads();
            if (tid == 0) { __builtin_amdgcn_fence(__ATOMIC_RELEASE, "agent"); VM_WAIT(); __hip_atomic_fetch_add(w_adacnt, 1u, RLX_AGENT); }
        }
        LAS float* scr = (LAS float*)(lds + wave * 10240);
        constexpr int I_IN = 16 * 96, I_OUT = 16 * 32;
        for (int it = gw; it < I_IN + I_OUT; it += NGW) {
            if (it < I_IN) p0_transpose_item(a.w_in, 1024, 3072, w_Win_t, scr, it, lane);
            else p0_transpose_item(a.w_out, 1024, 1024, w_Wout_t, scr, it - I_IN, lane);
        }
        if (rep_ == 0) {
            if (tid == 0) { unsigned sp = 0; while (__hip_atomic_load(w_adacnt, RLX_AGENT) < (unsigned)G && ++sp < (1u << 24)) __builtin_amdgcn_s_sleep(2);
                            __builtin_amdgcn_fence(__ATOMIC_ACQUIRE, "agent"); VM_WAIT(); }
            __syncthreads();
            for (int idx = bx * NTHREADS + tid; idx < NB * 6144; idx += G * NTHREADS) { float sm = 0.f;
#pragma unroll 8
                for (int ks = 0; ks < 32; ++ks) sm += w_modp[(size_t)ks * NB * 6144 + idx];
                w_mod[idx] = sm; }
        }
        if (rep_ + 1 < NREP(0)) xcd_barrier(bar, wave);
    }
    SEAM(0);
    if (IN(1)) for (int rep_ = 0; rep_ < NREP(1); ++rep_) {
        PHASE_IDS();
        for (int r0 = gw * 4; r0 < M; r0 += NGW * 4) {
            const int b = r0 / S;
            f32x4 v[4][4]; float rs[4];
#pragma unroll
            for (int rr = 0; rr < 4; ++rr) { const f32x4* xr = (const f32x4*)(a.x + (size_t)(r0 + rr) * D) + lane;
#pragma unroll
                for (int j = 0; j < 4; ++j) v[rr][j] = xr[64 * j]; }
#pragma unroll
            for (int rr = 0; rr < 4; ++rr) { float ss = 0.f;
#pragma unroll
                for (int j = 0; j < 4; ++j) ss += (v[rr][j].x * v[rr][j].x + v[rr][j].y * v[rr][j].y) + (v[rr][j].z * v[rr][j].z + v[rr][j].w * v[rr][j].w);
                rs[rr] = rsqrtf(wave_sum(ss) * (1.f / D) + RMS_EPS); }
            const float* shift = w_mod + b * 6144, *scale = w_mod + b * 6144 + 1024;
#pragma unroll
            for (int j = 0; j < 4; ++j) {
                const int c0 = 4 * lane + 256 * j;
                const f32x4 g = *(const f32x4*)(a.g1 + c0), sc = *(const f32x4*)(scale + c0), sh = *(const f32x4*)(shift + c0);
                const f32x4 gs = g * (sc + 1.f);
#pragma unroll
                for (int rr = 0; rr < 4; ++rr) { const f32x4 o = v[rr][j] * rs[rr] * gs + sh;
                    u32x2 w; w.x = pk2(o.x, o.y); w.y = pk2(o.z, o.w);
                    *(u32x2*)(w_XN + (size_t)(r0 + rr) * D + c0) = w; }
            }
        }
        if (rep_ + 1 < NREP(1)) xcd_barrier(bar, wave);
    }
    SEAM(1);
    if (IN(2)) for (int rep_ = 0; rep_ < NREP(2); ++rep_) {
        PHASE_IDS();
#define P2_CONVERT() do { LAS float* scr = (LAS float*)(lds + wave * 10240); \
            for (int it = gw; it < CV_STATIC; it += NGW) cv_item(a.w_gu, a.w_d, (unsigned char*)w_Wgu_t, (unsigned char*)w_Wd_t, scr, it, lane); } while (0)
        PInProj p; p.init(M, NIN, G, bx); p.XN = w_XN; p.Wt = w_Win_t; p.QKV = w_QKV; p.gaq = a.gaq; p.gak = a.gak; p.gbq = a.gbq; p.gbk = a.gbk;
        if (bx & 1) { pg8::gemm_phase<PInProj>(lds, p, wave); __syncthreads(); P2_CONVERT(); }
        else { P2_CONVERT(); __syncthreads(); pg8::gemm_phase<PInProj>(lds, p, wave); }
#undef P2_CONVERT
        if (rep_ + 1 < NREP(2)) xcd_barrier(bar, wave);
    }
    SEAM(2);
    if (IN(3)) for (int rep_ = 0; rep_ < NREP(3); ++rep_) {
        PHASE_IDS();
        LAS float* wsf = (LAS float*)(lds + LDSCTL_OFF + 2048) + wave * 64;
#ifndef ATT_REP_A
#define ATT_REP_A 1
#define ATT_REP_B 1
#endif
        att::attn_a_phase(lds, wsf, w_QKV, w_AO, a.gaq, a.gak, vcu, wave, lane);
        STAMP(11);
        att::attn_b_phase(lds, wsf, w_QKV, w_AO, a.gbq, a.gbk, a.gd, a.lq1, a.lk1, a.lq2, a.lk2, vcu, wave, lane);
        if (rep_ == 0) {
            LAS float* scr = (LAS float*)(lds + wave * 10240);
            LAS int* qb_ = (LAS int*)(lds + LDSCTL_OFF + 1280);
            for (;;) {
                if (tid == 0) *qb_ = CV_STATIC + 16 * (int)__hip_atomic_fetch_add(w_cvq, 1u, RLX_AGENT);
                __syncthreads();
                const int base_ = *qb_;
                __syncthreads();
                if (base_ >= CV_NIT) break;
                for (int it = base_ + wave; it < base_ + 16 && it < CV_NIT; it += NWAVES)
                cv_item(a.w_gu, a.w_d, (unsigned char*)w_Wgu_t, (unsigned char*)w_Wd_t, scr, it, lane); }
        }
        if (rep_ + 1 < NREP(3)) xcd_barrier(bar, wave);
    }
    SEAM(3);
    if (IN(5)) for (int rep_ = 0; rep_ < NREP(5); ++rep_) {
        PHASE_IDS();
        POutProj p; p.init(M, D, G, bx); p.AO = w_AO; p.Wt = w_Wout_t; p.x = a.x; p.mod = w_mod; p.x1 = w_X1;
        pg8::gemm_phase<POutProj>(lds, p, wave);
        if (rep_ + 1 < NREP(5)) xcd_barrier(bar, wave);
    }
    SEAM(5);
    if (IN(6)) for (int rep_ = 0; rep_ < NREP(6); ++rep_) {
        PHASE_IDS();
        typedef float f32x4v __attribute__((ext_vector_type(4)));
        LAS float* Wp = (LAS float*)lds;
        LAS float* lgs = (LAS float*)(lds + LDSCTL_OFF + 4096);
        LAS float* red = (LAS float*)(lds + LDSCTL_OFF + 12288);
        LAS float* cb = (LAS float*)(lds + LDSCTL_OFF + 14336);
        LAS int* lcnt = (LAS int*)(lds + LDSCTL_OFF + 14464);
        LAS int* lbase = (LAS int*)(lds + LDSCTL_OFF + 14592);
        LAS float* ssl = (LAS float*)(lds + LDSCTL_OFF + 14720);
        for (int chunk = bx; chunk < M / 64; chunk += G) {
            const int row0 = chunk * 64, b = row0 / S;
            const float* shift = w_mod + b * 6144 + 3072, *scale = w_mod + b * 6144 + 4096;
            __syncthreads();
#pragma unroll 1
            for (int i0 = tid; i0 < 1024 * 8; i0 += NTHREADS * 8) {
                f32x4v w[8]; float gg[8], sc_[8];
#pragma unroll
                for (int u = 0; u < 8; ++u) { const int i = i0 + u * NTHREADS, k = i >> 3; w[u] = *(const f32x4v*)(a.w_router + (size_t)k * NE + (i & 7) * 4); gg[u] = a.g2[k]; sc_[u] = scale[k]; }
#pragma unroll
                for (int u = 0; u < 8; ++u) { const int i = i0 + u * NTHREADS, k = i >> 3; *(LAS f32x4v*)(Wp + k * NE + (i & 7) * 4) = w[u] * (gg[u] * (1.f + sc_[u])); }
            }
            { const int e = tid & 31, kp = tid >> 5; float acc = 0.f;
#pragma unroll 8
              for (int k = kp * 64; k < kp * 64 + 64; ++k) acc += shift[k] * a.w_router[(size_t)k * NE + e];
              red[kp * 32 + e] = acc; }
            if (tid < 32) lcnt[tid] = 0;
            if (tid < 64) ssl[tid] = 0.f;
            *(LAS f32x4v*)(lgs + tid * 4) = (f32x4v){0.f, 0.f, 0.f, 0.f};
#pragma unroll 1
            for (int rb = 0; rb < 2; ++rb) {
                f32x4 v[4][4]; float rs[4];
#pragma unroll
                for (int rr = 0; rr < 4; ++rr) { const f32x4* xr = (const f32x4*)(w_X1 + (size_t)(row0 + wave * 8 + rb * 4 + rr) * D) + lane;
#pragma unroll
                    for (int jj = 0; jj < 4; ++jj) v[rr][jj] = xr[64 * jj]; }
#pragma unroll
                for (int rr = 0; rr < 4; ++rr) { float s_ = 0.f;
#pragma unroll
                    for (int jj = 0; jj < 4; ++jj) s_ += (v[rr][jj].x * v[rr][jj].x + v[rr][jj].y * v[rr][jj].y) + (v[rr][jj].z * v[rr][jj].z + v[rr][jj].w * v[rr][jj].w);
                    rs[rr] = rsqrtf(wave_sum(s_) * (1.f / D) + RMS_EPS); }
#pragma unroll
                for (int jj = 0; jj < 4; ++jj) {
                    const int c0 = 4 * lane + 256 * jj;
                    const f32x4 g = *(const f32x4*)(a.g2 + c0), sc = *(const f32x4*)(scale + c0), sh = *(const f32x4*)(shift + c0);
#pragma unroll
                    for (int rr = 0; rr < 4; ++rr) { const f32x4 o = v[rr][jj] * rs[rr] * g * (sc + 1.f) + sh;
                        const f32x4 oc = __builtin_elementwise_min(__builtin_elementwise_max(o * H2_SCALE, (f32x4){-448.f, -448.f, -448.f, -448.f}), (f32x4){448.f, 448.f, 448.f, 448.f});
                        *(unsigned*)((unsigned char*)w_H2 + (size_t)(row0 + wave * 8 + rb * 4 + rr) * D + c0) = pg8::pk4_fp8(oc.x, oc.y, oc.z, oc.w); }
                }
            }
            __syncthreads();
            if (tid < 32) { float s_ = a.b_router[tid];
#pragma unroll
                for (int kp = 0; kp < 16; ++kp) s_ += red[kp * 32 + tid];
                cb[tid] = s_; }
            const int tj = lane & 15, kq = lane >> 4;
            {
                const int kb = 512 * (wave >> 2) + 128 * kq;
                const float* xp = w_X1 + (size_t)(row0 + 16 * (wave & 3) + tj) * D + kb;
                const LAS float* wq = Wp + kb * NE + tj;
                f32x4v acc0 = {0.f, 0.f, 0.f, 0.f}, acc1 = {0.f, 0.f, 0.f, 0.f}; float ssq = 0.f;
                f32x4v xa[8], xb[8];
#pragma unroll
                for (int i = 0; i < 8; ++i) xa[i] = *(const f32x4v*)(xp + 4 * i);
#pragma unroll
                for (int bt = 0; bt < 4; bt += 2) {
#pragma unroll
                    for (int i = 0; i < 8; ++i) xb[i] = *(const f32x4v*)(xp + 32 * (bt + 1) + 4 * i);
#pragma unroll
                    for (int i = 0; i < 8; ++i) { const f32x4v xv = xa[i]; ssq += (xv.x * xv.x + xv.y * xv.y) + (xv.z * xv.z + xv.w * xv.w);
#pragma unroll
                        for (int u = 0; u < 4; ++u) { const int kk = 32 * bt + 4 * i + u; const float a0 = wq[kk * NE], a1 = wq[kk * NE + 16];
                            acc0 = __builtin_amdgcn_mfma_f32_16x16x4f32(a0, xv[u], acc0, 0, 0, 0); acc1 = __builtin_amdgcn_mfma_f32_16x16x4f32(a1, xv[u], acc1, 0, 0, 0); } }
                    if (bt + 2 < 4) {
#pragma unroll
                        for (int i = 0; i < 8; ++i) xa[i] = *(const f32x4v*)(xp + 32 * (bt + 2) + 4 * i); }
#pragma unroll
                    for (int i = 0; i < 8; ++i) { const f32x4v xv = xb[i]; ssq += (xv.x * xv.x + xv.y * xv.y) + (xv.z * xv.z + xv.w * xv.w);
#pragma unroll
                        for (int u = 0; u < 4; ++u) { const int kk = 32 * (bt + 1) + 4 * i + u; const float a0 = wq[kk * NE], a1 = wq[kk * NE + 16];
                            acc0 = __builtin_amdgcn_mfma_f32_16x16x4f32(a0, xv[u], acc0, 0, 0, 0); acc1 = __builtin_amdgcn_mfma_f32_16x16x4f32(a1, xv[u], acc1, 0, 0, 0); } }
                }
                ssq += __shfl_xor(ssq, 16); ssq += __shfl_xor(ssq, 32);
                LAS float* lw = lgs + ((wave & 3) * 16 + tj) * 32;
#pragma unroll
                for (int r = 0; r < 4; ++r) { (void)__hip_atomic_fetch_add(lw + 4 * kq + r, acc0[r], __ATOMIC_RELAXED, __HIP_MEMORY_SCOPE_WORKGROUP); (void)__hip_atomic_fetch_add(lw + 16 + 4 * kq + r, acc1[r], __ATOMIC_RELAXED, __HIP_MEMORY_SCOPE_WORKGROUP); }
                if (kq == 0) (void)__hip_atomic_fetch_add(ssl + (wave & 3) * 16 + tj, ssq, __ATOMIC_RELAXED, __HIP_MEMORY_SCOPE_WORKGROUP);
            }
            __syncthreads();
            int idx[4] = {0, 0, 0, 0}, rank[4] = {0, 0, 0, 0}; float gt[4] = {0.f, 0.f, 0.f, 0.f};
            if (wave < 4 && lane < 16) {
                const float rstd = rsqrtf(ssl[wave * 16 + lane] * (1.f / D) + RMS_EPS);
                float lg[NE];
#pragma unroll
                for (int e = 0; e < NE; ++e) lg[e] = lgs[(wave * 16 + lane) * 32 + e] * rstd + cb[e];
                float val[4];
#pragma unroll
                for (int k = 0; k < 4; ++k) {
                    float best = -INFINITY; int bi = 0;
#pragma unroll
                    for (int e = 0; e < NE; ++e) { bool taken = false;
#pragma unroll
                        for (int kk = 0; kk < k; ++kk) taken |= (idx[kk] == e);
                        if (!taken && lg[e] > best) { best = lg[e]; bi = e; } }
                    idx[k] = bi; val[k] = best;
                }
                float den = 0.f;
#pragma unroll
                for (int k = 0; k < 4; ++k) { gt[k] = __expf(val[k] - val[0]); den += gt[k]; }
                const float rden = 1.f / den;
#pragma unroll
                for (int k = 0; k < 4; ++k) { gt[k] *= rden; rank[k] = __hip_atomic_fetch_add(lcnt + idx[k], 1, __ATOMIC_RELAXED, __HIP_MEMORY_SCOPE_WORKGROUP); }
            }
            __syncthreads();
            if (tid < 32 && rep_ == 0) lbase[tid] = atomicAdd(&w_counts[tid], lcnt[tid]);
            __syncthreads();
            if (wave < 4 && lane < 16 && rep_ == 0) {
                const int row = row0 + 16 * wave + lane;
#pragma unroll
                for (int k = 0; k < 4; ++k) { const int slot = lbase[idx[k]] + rank[k];
                    w_tope[row * 4 + k] = idx[k]; w_tops[row * 4 + k] = slot; w_topg[row * 4 + k] = gt[k]; w_list[idx[k] * M + slot] = row; }
            }
        }
        if (rep_ + 1 < NREP(6)) xcd_barrier(bar, wave);
    }
    SEAM(6);
    if (IN(7)) for (int rep_ = 0; rep_ < NREP(7); ++rep_) {
        PHASE_IDS();
        LOAD_PT();
        PGateUp p; p.init(PT, CN, (LAS int*)(lds + LDSCTL_OFF + 1024), 8, G, bx); p.build(wave, lane); __syncthreads(); p.H2 = w_H2; p.Wt = w_Wgu_t; p.bgu = a.b_gu; p.list = w_list; p.ACT = w_ACT;
        pg8::gemm_phase<PGateUp>(lds, p, wave);
        if (rep_ + 1 < NREP(7)) xcd_barrier(bar, wave);
    }
    SEAM(7);
    if (IN(8)) for (int rep_ = 0; rep_ < NREP(8); ++rep_) {
        PHASE_IDS();
        LOAD_PT();
        PDown p; p.init(PT, CN, (LAS int*)(lds + LDSCTL_OFF + 1024), 4, G, bx); p.build(wave, lane); __syncthreads(); p.ACT = w_ACT; p.Wt = w_Wd_t; p.bd = a.b_d; p.Y = w_Y;
        pg8::gemm_phase<PDown>(lds, p, wave);
        if (rep_ + 1 < NREP(8)) xcd_barrier(bar, wave);
    }
    SEAM(8);
    for (int rep_ = 0; rep_ + 1 < NREP(10); ++rep_) xcd_barrier(bar, wave);
    if (IN(9)) for (int rep_ = 0; rep_ < NREP(9); ++rep_) {
        PHASE_IDS();
        LOAD_PT();
        for (int r0 = gw * 2; r0 < M; r0 += NGW * 2) {
            const int b = r0 / S;
            const float* gate2 = w_mod + b * 6144 + 5120;
            const unsigned char* yr[2][4]; float gk[2][4];
#pragma unroll
            for (int rr = 0; rr < 2; ++rr)
#pragma unroll
                for (int k = 0; k < 4; ++k) { const int row = r0 + rr; yr[rr][k] = (const unsigned char*)w_Y + (size_t)(PT[w_tope[row * 4 + k]] * 256 + w_tops[row * 4 + k]) * D; gk[rr][k] = w_topg[row * 4 + k] * (1.f / Y_SCALE); }
#pragma unroll
            for (int j = 0; j < 4; ++j) {
                const int c0 = 4 * lane + 256 * j;
                int wv[2][4]; f32x4 xv[2];
#pragma unroll
                for (int rr = 0; rr < 2; ++rr) { xv[rr] = *(const f32x4*)(w_X1 + (size_t)(r0 + rr) * D + c0);
#pragma unroll
                    for (int k = 0; k < 4; ++k) wv[rr][k] = *(const int*)(yr[rr][k] + c0); }
                const f32x4 g = *(const f32x4*)(gate2 + c0);
#pragma unroll
                for (int rr = 0; rr < 2; ++rr) { f32x4 acc = (f32x4){0.f, 0.f, 0.f, 0.f};
#pragma unroll
                    for (int k = 0; k < 4; ++k) { const int w = wv[rr][k];
                        acc.x += gk[rr][k] * __builtin_amdgcn_cvt_f32_fp8(w, 0); acc.y += gk[rr][k] * __builtin_amdgcn_cvt_f32_fp8(w, 1);
                        acc.z += gk[rr][k] * __builtin_amdgcn_cvt_f32_fp8(w, 2); acc.w += gk[rr][k] * __builtin_amdgcn_cvt_f32_fp8(w, 3); }
                    *(f32x4*)(a.out + (size_t)(r0 + rr) * D + c0) = xv[rr] + g * acc; }
            }
        }
    }
    STAMP(10);
    if (SPAN_PH >= 0 && bx == 0 && threadIdx.x == 0) {
        const unsigned long long dur = (SPAN_PH == 20) ? tstamp[11] - tstamp[3] : (SPAN_PH == 21) ? tstamp[4] - tstamp[11] : tstamp[SPAN_PH + 1] - tstamp[SPAN_PH], t0 = __builtin_amdgcn_s_memrealtime();
        while (__builtin_amdgcn_s_memrealtime() - t0 < dur) __builtin_amdgcn_s_sleep(4);
    }
#undef IN
#undef PHASE_IDS
#undef SEAM
#undef LOAD_PT
#undef w_counts
#undef w_mod
#undef w_modp
#undef w_adacnt
#undef w_cvq
#undef w_Win_t
#undef w_Wout_t
#undef w_Wgu_t
#undef w_Wd_t
#undef w_XN
#undef w_QKV
#undef w_AO
#undef w_H2
#undef w_tope
#undef w_tops
#undef w_topg
#undef w_list
#undef w_ACT
#undef w_Y
#undef w_OBN
#undef w_X1
}

#ifndef RUN_MODE
#define RUN_MODE 1
#endif
#ifndef PH_MASK
#define PH_MASK 0x3ff
#endif
extern "C" void kernel_launch(void* const* d_in, const int* in_sizes, int n_in, void* d_out, int out_size, void* d_ws, size_t ws_size, hipStream_t stream) {
    static int grid = 0;
    if (grid == 0) {
        if (n_in != 23 || out_size != M * D || ws_size < WS_END) { fprintf(stderr, "kernel_launch: unexpected problem (n_in %d out %d ws %zu)\n", n_in, out_size, ws_size); grid = -1; return; }
        int dev = 0, cus = 0;
        if (hipGetDevice(&dev) != hipSuccess || hipDeviceGetAttribute(&cus, hipDeviceAttributeMultiprocessorCount, dev) != hipSuccess) { grid = -1; return; }
        if (hipFuncSetAttribute((const void*)mega, hipFuncAttributeMaxDynamicSharedMemorySize, LDS_BYTES) != hipSuccess) { fprintf(stderr, "kernel_launch: hipFuncSetAttribute failed\n"); grid = -1; return; }
        int per_cu = 0;
        if (hipOccupancyMaxActiveBlocksPerMultiprocessor(&per_cu, (const void*)mega, NTHREADS, LDS_BYTES) != hipSuccess || per_cu < 1) fprintf(stderr, "kernel_launch: occupancy query says %d blocks/CU\n", per_cu);
        (void)hipGetLastError();
        grid = cus;
    }
    if (grid < 0) return;
    const float* x = (const float*)d_in[0]; const float* c = (const float*)d_in[1]; const float* w_ada = (const float*)d_in[2]; const float* b_ada = (const float*)d_in[3];
    const float* g1 = (const float*)d_in[4]; const float* w_in = (const float*)d_in[5];
    const float* gaq = (const float*)d_in[6]; const float* gak = (const float*)d_in[7]; const float* gbq = (const float*)d_in[8]; const float* gbk = (const float*)d_in[9];
    const float* lq1 = (const float*)d_in[10]; const float* lk1 = (const float*)d_in[11]; const float* lq2 = (const float*)d_in[12]; const float* lk2 = (const float*)d_in[13];
    const float* gd = (const float*)d_in[14]; const float* w_out = (const float*)d_in[15]; const float* g2 = (const float*)d_in[16];
    const float* w_router = (const float*)d_in[17]; const float* b_router = (const float*)d_in[18];
    const float* w_gu = (const float*)d_in[19]; const float* b_gu = (const float*)d_in[20]; const float* w_d = (const float*)d_in[21]; const float* b_d = (const float*)d_in[22];
    unsigned char* ws = (unsigned char*)d_ws; float* out = (float*)d_out;
    int* counts = (int*)(ws + WS_CTL + CTL_COUNTS); int* padstart = (int*)(ws + WS_CTL + CTL_PADSTART); float* mod = (float*)(ws + WS_CTL + CTL_MOD);
    bf16_t* Win_t = (bf16_t*)(ws + WS_WIN); bf16_t* Wout_t = (bf16_t*)(ws + WS_WOUT); bf16_t* Wgu_t = (bf16_t*)(ws + WS_WGU); bf16_t* Wd_t = (bf16_t*)(ws + WS_WD);
    bf16_t* XN = (bf16_t*)(ws + WS_XN); bf16_t* QKV = (bf16_t*)(ws + WS_QKV); bf16_t* AO = (bf16_t*)(ws + WS_AO); bf16_t* H2 = (bf16_t*)(ws + WS_H2);
    int* tope = (int*)(ws + WS_TOPE); int* tops = (int*)(ws + WS_TOPS); float* topg = (float*)(ws + WS_TOPG); int* list = (int*)(ws + WS_LIST);
    bf16_t* ACT = (bf16_t*)(ws + WS_ACT); bf16_t* Y = (bf16_t*)(ws + WS_Y); float* OBN = (float*)(ws + WS_OBN);

    (void)hipMemsetAsync(ws + WS_CTL, 0, 32768, stream);
    MArgs a{};
    a.x = x; a.c = c; a.w_ada = w_ada; a.b_ada = b_ada; a.g1 = g1; a.w_in = w_in; a.gaq = gaq; a.gak = gak; a.gbq = gbq; a.gbk = gbk; a.lq1 = lq1; a.lk1 = lk1; a.lq2 = lq2; a.lk2 = lk2;
    a.gd = gd; a.w_out = w_out; a.g2 = g2; a.w_router = w_router; a.b_router = b_router; a.w_gu = w_gu; a.b_gu = b_gu; a.w_d = w_d; a.b_d = b_d; a.out = out; a.ws = ws;
    a.ph_lo = 0; a.ph_hi = NPHASE; hipLaunchKernelGGL(mega, dim3(grid), dim3(NTHREADS), LDS_BYTES, stream, a);
}
```

```cpp
#include <hip/hip_runtime.h>
#include <cstdio>
#include <cstdint>

typedef unsigned short bf16_t;
typedef short bf16x8 __attribute__((ext_vector_type(8)));
typedef float f32x4 __attribute__((ext_vector_type(4)));
typedef unsigned u32x4 __attribute__((ext_vector_type(4)));
typedef unsigned u32x2 __attribute__((ext_vector_type(2)));

constexpr int D = 1024, NB = 8, S = 2048, M = NB * S;
constexpr int NIN = 3072, NE = 32, TOPK = 4, DFF = 1024;
constexpr int NASSIGN = M * TOPK;
constexpr int PADROWS = NASSIGN + NE * 256;
constexpr float RMS_EPS = 1e-6f;
constexpr float LOG2E = 1.4426950408889634f;
constexpr float QSCALE = 0.125f * LOG2E;
constexpr float LAMBDA_INIT = 0.2f;

constexpr size_t MiB = 1u << 20;
constexpr size_t WS_CTL = 0;
constexpr size_t CTL_BYTES = 1 * MiB;
constexpr size_t CTL_COUNTS = 0;
constexpr size_t CTL_PADSTART = 256;
constexpr size_t CTL_ADACNT = 1024;
constexpr size_t CTL_MOD = 64 * 1024;
constexpr size_t WS_WIN = 2 * MiB;
constexpr size_t WS_WOUT = 8 * MiB;
constexpr size_t WS_WGU = 10 * MiB;
constexpr size_t WS_WD = 138 * MiB;
constexpr size_t WS_XN = 202 * MiB;
constexpr size_t WS_QKV = 234 * MiB;
constexpr size_t WS_AO = 330 * MiB;
constexpr size_t WS_H2 = 362 * MiB;
constexpr size_t WS_TOPE = 394 * MiB;
constexpr size_t WS_TOPS = 395 * MiB;
constexpr size_t WS_TOPG = 396 * MiB;
constexpr size_t WS_LIST = 397 * MiB;
constexpr size_t WS_ACT = 400 * MiB;
constexpr size_t WS_Y = 544 * MiB;
constexpr size_t WS_OBN = 688 * MiB;
constexpr size_t WS_X1 = 752 * MiB;
constexpr size_t WS_MODP = 816 * MiB;
constexpr size_t WS_END = 824 * MiB;

__device__ __forceinline__ bf16_t f2bf(float f) { unsigned u = __float_as_uint(f); return (bf16_t)((u + 0x7fffu + ((u >> 16) & 1u)) >> 16); }
__device__ __forceinline__ float bf2f(bf16_t h) { return __uint_as_float(((unsigned)h) << 16); }
__device__ __forceinline__ unsigned pk2(float lo, float hi) { return (unsigned)f2bf(lo) | ((unsigned)f2bf(hi) << 16); }
__device__ __forceinline__ float wave_sum(float v) {
#pragma unroll
    for (int o = 1; o < 64; o <<= 1) v += __shfl_xor(v, o);
    return v;
}


#define LAS __attribute__((address_space(3)))
#define GAS __attribute__((address_space(1)))
#define RLX_AGENT __ATOMIC_RELAXED, __HIP_MEMORY_SCOPE_AGENT
#define LDS_WAIT() asm volatile("s_waitcnt lgkmcnt(0)" ::: "memory")
#define VM_WAIT() asm volatile("s_waitcnt vmcnt(0)" ::: "memory")

constexpr int NWAVES = 8, NTHREADS = 512;
constexpr int RING_BYTES = 131072, LDSCTL_OFF = RING_BYTES, MISC_OFF = LDSCTL_OFF + 320, PT_OFF = LDSCTL_OFF + 512, CNT_OFF = LDSCTL_OFF + 768, LDS_BYTES = 147456;
constexpr size_t CTL_BAR = 16384;
constexpr int NPHASE = 10;
constexpr float W8_SCALE = 512.f, H2_SCALE = 16.f, ACT_SCALE = 8.f, Y_SCALE = 32.f;

#define XB_TMO      128
#define XB_XCNT(j)  (256  + 64 * (j))
#define XB_XSUB(j)  (1280 + 64 * (j))
#define XB_XGEN(j)  (2304 + 64 * (j))
#define XB_TOP      3328
#define XB_TOPGEN   3392
#define XCD_BAR_WORDS 3456
#define XB_SPIN_CAP (1u << 22)
__device__ __forceinline__ unsigned xb_ld(unsigned* p)              { return __hip_atomic_load(p, __ATOMIC_RELAXED, __HIP_MEMORY_SCOPE_AGENT); }
__device__ __forceinline__ unsigned xb_add(unsigned* p, unsigned v) { return __hip_atomic_fetch_add(p, v, __ATOMIC_RELAXED, __HIP_MEMORY_SCOPE_AGENT); }
__device__ __forceinline__ unsigned xb_xcc_id() { return (unsigned)__builtin_amdgcn_s_getreg((3 << 11) | 20) & 0xFu; }
#define XB_SPIN(cond, bar) do { unsigned _sp = 0; while (cond) { __builtin_amdgcn_s_sleep(1); \
    if ((++_sp & 255u) == 0u) { if (xb_ld(&(bar)[XB_TMO])) break; if (_sp > XB_SPIN_CAP) { atomicAdd(&(bar)[XB_TMO], 1u); break; } } } } while (0)
struct XcdBarrier { unsigned* bar; unsigned x; volatile LAS unsigned* st; };
__device__ __forceinline__ XcdBarrier xcd_barrier_post(unsigned* bar, volatile LAS unsigned* st) {
    XcdBarrier b; b.bar = bar; b.x = xb_xcc_id(); b.st = st;
    if (threadIdx.x == 0) (void)xb_add(&bar[XB_XCNT(b.x)], 1u);
    return b;
}
__device__ __forceinline__ void xcd_barrier_complete(unsigned* bar, unsigned x, unsigned& nloc, unsigned& nx) {
    const unsigned G = gridDim.x * gridDim.y * gridDim.z;
    unsigned sum, cnt, mine, sp = 0u;
    for (;;) {
        sum = 0u; cnt = 0u; mine = 0u;
#pragma unroll
        for (unsigned j = 0; j < 16; ++j) { const unsigned c = xb_ld(&bar[XB_XCNT(j)]); sum += c; cnt += (c > 0u) ? 1u : 0u; mine = (j == x) ? c : mine; }
        if (sum == G) break;
        __builtin_amdgcn_s_sleep(1);
        if ((++sp & 255u) == 0u) { if (xb_ld(&bar[XB_TMO])) break; if (sp > XB_SPIN_CAP) { atomicAdd(&bar[XB_TMO], 1u); break; } }
    }
    nloc = mine > 0u ? mine : 1u; nx = cnt > 0u ? cnt : 1u;
}
__device__ __forceinline__ void xcd_barrier(const XcdBarrier& b, int wave) {
    asm volatile("s_waitcnt vmcnt(0)" ::: "memory");
    __syncthreads();
    if (wave == 0 && __builtin_amdgcn_mbcnt_hi(~0u, __builtin_amdgcn_mbcnt_lo(~0u, 0u)) == 0u) {
        unsigned* bar = b.bar;
        __builtin_amdgcn_s_waitcnt(0);
        unsigned nloc = b.st[0], nx = b.st[1];
        if (nloc == 0u) { xcd_barrier_complete(bar, b.x, nloc, nx); b.st[0] = nloc; b.st[1] = nx; }
        const unsigned old = xb_add(&bar[XB_XSUB(b.x)], 1u);
        const unsigned gen = old / nloc;
        if (old + 1u == (gen + 1u) * nloc) {
            __builtin_amdgcn_fence(__ATOMIC_RELEASE, "agent");
            asm volatile("s_waitcnt vmcnt(0)" ::: "memory");
            const unsigned og = xb_add(&bar[XB_TOP], 1u);
            const unsigned tg = og / nx;
            if (og + 1u == (tg + 1u) * nx) xb_add(&bar[XB_TOPGEN], 1u);
            else XB_SPIN(xb_ld(&bar[XB_TOPGEN]) == tg, bar);
            __builtin_amdgcn_fence(__ATOMIC_ACQUIRE, "agent");
            xb_add(&bar[XB_XGEN(b.x)], 1u);
            asm volatile("s_waitcnt vmcnt(0)" ::: "memory");
        } else {
            XB_SPIN(xb_ld(&bar[XB_XGEN(b.x)]) == gen, bar);
            __builtin_amdgcn_fence(__ATOMIC_ACQUIRE, "agent");
            asm volatile("s_waitcnt vmcnt(0)" ::: "memory");
        }
    }
    __syncthreads();
}

namespace pg8 {
constexpr int BM = 256, BK = 64, HALF = 128, HTB = HALF * BK * 2, STAGE_BYTES = 8 * HTB, NXCD = 8, WGM = 8;
__host__ __device__ __forceinline__ int lds_byte(int r, int c) { const int st = (r >> 4) * 2 + (c >> 5), rr = r & 15, cc = c & 31, ob = rr * 64 + cc * 2; return st * 1024 + (ob ^ (((ob >> 9) & 1) << 5)); }
__host__ __device__ __forceinline__ void stage_rc(int b, int& R, int& C) { const int st = b / 1024, sb = b % 1024, swz = sb ^ (((sb >> 9) & 1) << 5); R = (st >> 1) * 16 + swz / 64; C = (st & 1) * 32 + (swz % 64) / 2; }
constexpr __host__ __device__ __forceinline__ int perm32(int rho) { const int n = rho >> 4, i = rho & 15; return 8 * (i >> 2) + 4 * n + (i & 3); }
__device__ __forceinline__ unsigned cvt_pk_bf16(float lo, float hi) { unsigned r; asm volatile("v_cvt_pk_bf16_f32 %0, %1, %2" : "=v"(r) : "v"(lo), "v"(hi)); return r; }

typedef int v4i_t __attribute__((ext_vector_type(4))); typedef int v8i_t __attribute__((ext_vector_type(8)));
__device__ __forceinline__ v8i_t cat8(bf16x8 lo, bf16x8 hi) { const v4i_t a = __builtin_bit_cast(v4i_t, lo), b = __builtin_bit_cast(v4i_t, hi); return __builtin_shufflevector(a, b, 0, 1, 2, 3, 4, 5, 6, 7); }
__device__ __forceinline__ unsigned pk4_fp8(float a, float b, float c, float d) { int w = 0; w = __builtin_amdgcn_cvt_pk_fp8_f32(a, b, w, false); w = __builtin_amdgcn_cvt_pk_fp8_f32(c, d, w, true); return (unsigned)w; }
struct Unit { int pm, pn, e, cnt; };

template <class P>
__device__ __forceinline__ void gemm_phase(LAS unsigned char* lds, const P& p, int wid) {
    int lane = (int)__builtin_amdgcn_mbcnt_hi(~0u, __builtin_amdgcn_mbcnt_lo(~0u, 0u)); asm volatile("" : "+v"(lane));
    const int tid = wid * 64 + lane, wr = wid >> 2, wc = wid & 3, fr = lane & 15, fq = lane >> 4;
    constexpr int K = P::K, nt = K / BK;
    int Rr[2], Cc[2];
#pragma unroll
    for (int i = 0; i < 2; ++i) stage_rc(tid * 16 + i * 8192, Rr[i], Cc[i]);
    unsigned voffB[2], voffA[2][2];
#pragma unroll
    for (int i = 0; i < 2; ++i) { voffB[i] = (unsigned)(P::brow(0, Rr[i]) * K + Cc[i]) * 2u; voffA[0][i] = (unsigned)(Rr[i] * K + Cc[i]) * 2u; voffA[1][i] = voffA[0][i]; }
    constexpr size_t hB = (size_t)(P::brow(1, 0) - P::brow(0, 0)) * K * 2, hA = P::GATHER ? 0 : (size_t)HALF * K * 2;
    LAS unsigned* vpark = (LAS unsigned*)(lds + STAGE_BYTES + 4096) + tid * 4;
    const size_t kstep = (size_t)(BK * 2);
    const unsigned ldsw = (unsigned)wid * 1024u;
    const int aoff = lds_byte(wr * 64 + fr, fq * 8), boff = lds_byte(wc * 32 + fr, fq * 8);
#define PG8_SA(b, h) (((b) * 2 + (h)) * HTB)
#define PG8_SB(b, h) ((4 + (b) * 2 + (h)) * HTB)
#define PG8_STAGE(bufoff, gbase, voff) do { _Pragma("unroll") for (int _i = 0; _i < 2; ++_i) { unsigned _v = (voff)[_i]; asm volatile("" : "+v"(_v));     \
        __builtin_amdgcn_global_load_lds((const unsigned*)((const char*)(gbase) + _v), (LAS unsigned*)(lds + (bufoff) + ldsw + _i * 8192), 16, 0, 0); } } while (0)
#define PG8_STAGE_A(b, h, gbase) PG8_STAGE(PG8_SA(b, h), (gbase) + (h) * hA, voffA[P::GATHER ? (h) : 0])
#define PG8_STAGE_B(b, h, gbase) PG8_STAGE(PG8_SB(b, h), (gbase) + (h) * hB, voffB)
#define PG8_LDA(dst, b, h) do { _Pragma("unroll") for (int m = 0; m < 4; ++m) _Pragma("unroll") for (int k = 0; k < 2; ++k) dst[m][k] = *(const LAS bf16x8*)(lds + PG8_SA(b, h) + aoff + m * 2048 + k * 1024); } while (0)
#define PG8_LDB(dst, b, h) do { _Pragma("unroll") for (int n = 0; n < 2; ++n) _Pragma("unroll") for (int k = 0; k < 2; ++k) dst[n][k] = *(const LAS bf16x8*)(lds + PG8_SB(b, h) + boff + n * 2048 + k * 1024); } while (0)
#define PG8_MMA(ai, bj, At, Bt) do { __builtin_amdgcn_s_setprio(1); if constexpr (P::FP8) { _Pragma("unroll") for (int m = 0; m < 4; ++m) _Pragma("unroll") for (int n = 0; n < 2; ++n) \
        { const v8i_t b8_ = cat8(Bt[n][0], Bt[n][1]), a8_ = cat8(At[m][0], At[m][1]); \
          asm volatile("v_mfma_scale_f32_16x16x128_f8f6f4 %0, %1, %2, %0, %3, %3 op_sel_hi:[0,0,0]" : "+v"(acc[ai][bj][m][n]) : "v"(b8_), "v"(a8_), "v"(sc1_)); } } else { \
        _Pragma("unroll") for (int m = 0; m < 4; ++m) _Pragma("unroll") for (int n = 0; n < 2; ++n) _Pragma("unroll") for (int k = 0; k < 2; ++k) \
        acc[ai][bj][m][n] = __builtin_amdgcn_mfma_f32_16x16x32_bf16(Bt[n][k], At[m][k], acc[ai][bj][m][n], 0, 0, 0); } __builtin_amdgcn_s_setprio(0); } while (0)
#define PG8_WAIT_V(n) asm volatile("s_waitcnt vmcnt(" #n ")" ::: "memory")
#define PG8_WAIT_L(n) asm volatile("s_waitcnt lgkmcnt(" #n ")" ::: "memory")
#define PG8_BAR __builtin_amdgcn_s_barrier()
#define PG8_SCHED __builtin_amdgcn_sched_barrier(0)
    const int sc1_ = 0x7f7f7f7f;
    Unit cur, nxt; int ui = 0;
    if (!p.next(0, cur)) return;
    f32x4 acc[2][2][4][2];
#pragma unroll
    for (int a = 0; a < 2; ++a)
#pragma unroll
        for (int b = 0; b < 2; ++b)
#pragma unroll
            for (int m = 0; m < 4; ++m)
#pragma unroll
                for (int n = 0; n < 2; ++n) acc[a][b][m][n] = (f32x4){0.f, 0.f, 0.f, 0.f};
    bf16x8 At[4][2], B0[2][2], B1[2][2];
    const char* cA = p.a_base(cur); const char* cB = p.b_base(cur);
    if constexpr (P::GATHER) p.a_offsets(cur, Rr, Cc, voffA);
    PG8_STAGE_B(0, 0, cB); PG8_STAGE_B(0, 1, cB); PG8_STAGE_A(0, 0, cA); PG8_STAGE_A(0, 1, cA);
    if (wr == 1) PG8_BAR;
    PG8_WAIT_V(2); PG8_BAR;
    PG8_STAGE_B(1, 0, cB + kstep); PG8_STAGE_A(1, 0, cA + kstep); PG8_STAGE_B(1, 1, cB + kstep);
    PG8_WAIT_V(6); PG8_BAR;
    for (;;) {
        const bool has_next = p.next(ui + 1, nxt);
        const char* nA = has_next ? p.a_base(nxt) : cA; const char* nB = has_next ? p.b_base(nxt) : cB;
        if constexpr (P::GATHER) {
            unsigned vn[2][2];
            if (has_next) p.a_offsets(nxt, Rr, Cc, vn); else {
#pragma unroll
                for (int h = 0; h < 2; ++h)
#pragma unroll
                    for (int i = 0; i < 2; ++i) vn[h][i] = voffA[h][i]; }
            vpark[0] = vn[0][0]; vpark[1] = vn[0][1]; vpark[2] = vn[1][0]; vpark[3] = vn[1][1];
        }
#pragma nounroll
        for (int t = 0; t < nt; t += 2) {
            const bool last = (t == nt - 2);
            const char* a1 = cA + (size_t)(t + 1) * kstep;
            const char* a2 = last ? nA : cA + (size_t)(t + 2) * kstep; const char* b2 = last ? nB : cB + (size_t)(t + 2) * kstep;
            const char* a3 = a2 + kstep; const char* b3 = b2 + kstep;
            PG8_LDB(B0, 0, 0); PG8_LDB(B1, 0, 1); PG8_SCHED; PG8_LDA(At, 0, 0); PG8_STAGE_A(1, 1, a1);
            if constexpr (P::GATHER) { if (last) { voffA[0][0] = vpark[0]; voffA[0][1] = vpark[1]; voffA[1][0] = vpark[2]; voffA[1][1] = vpark[3]; } }
            PG8_WAIT_V(8); PG8_WAIT_L(0); PG8_BAR; PG8_MMA(0, 0, At, B0); PG8_MMA(0, 1, At, B1); PG8_BAR; PG8_SCHED;
            PG8_LDA(At, 0, 1); PG8_STAGE_B(0, 0, b2); PG8_STAGE_B(0, 1, b2); PG8_STAGE_A(0, 0, a2);
            PG8_WAIT_V(8); PG8_WAIT_L(0); PG8_BAR; PG8_MMA(1, 0, At, B0); PG8_MMA(1, 1, At, B1); PG8_BAR; PG8_SCHED;
            PG8_LDB(B0, 1, 0); PG8_LDB(B1, 1, 1); PG8_SCHED; PG8_LDA(At, 1, 0); PG8_STAGE_A(0, 1, a2);
            PG8_WAIT_V(8); PG8_WAIT_L(0); PG8_BAR; PG8_MMA(0, 0, At, B0); PG8_MMA(0, 1, At, B1); PG8_BAR; PG8_SCHED;
            PG8_LDA(At, 1, 1); PG8_STAGE_B(1, 0, b3); PG8_STAGE_B(1, 1, b3); PG8_STAGE_A(1, 0, a3);
            PG8_WAIT_V(8); PG8_WAIT_L(0); PG8_BAR; PG8_MMA(1, 0, At, B0); PG8_MMA(1, 1, At, B1); PG8_BAR; PG8_SCHED;
        }
        if (wr == 0) PG8_BAR;
        if constexpr (P::FP8) asm volatile("s_nop 15\n\ts_nop 15" ::: "memory");
        p.epi(acc, cur, wr, wc, fr, fq);
        if (!has_next) break;
#pragma unroll
        for (int a = 0; a < 2; ++a)
#pragma unroll
            for (int b = 0; b < 2; ++b)
#pragma unroll
                for (int m = 0; m < 4; ++m)
#pragma unroll
                    for (int n = 0; n < 2; ++n) acc[a][b][m][n] = (f32x4){0.f, 0.f, 0.f, 0.f};
        cur = nxt; cA = nA; cB = nB; ++ui;
        if (wr == 1) PG8_BAR;
    }
    PG8_WAIT_V(0);
    PG8_BAR;
#undef PG8_SA
#undef PG8_SB
#undef PG8_STAGE
#undef PG8_STAGE_A
#undef PG8_STAGE_B
#undef PG8_LDA
#undef PG8_LDB
#undef PG8_MMA
#undef PG8_WAIT_V
#undef PG8_WAIT_L
#undef PG8_BAR
#undef PG8_SCHED
}

struct DenseOrder {
    int nM, nN, nwg, G, c;
    __device__ void init(int M_, int N_, int G_, int c_) { nM = M_ / BM; nN = N_ / BM; nwg = nM * nN; G = G_; c = c_; }
    __device__ bool next(int i, Unit& u) const {
        const long L = (long)i * G + c; if (L >= nwg) return false;
        int wgid = (int)L; { const int q = nwg / NXCD, r = nwg % NXCD, xcd = wgid % NXCD, off = wgid / NXCD; wgid = (xcd < r ? xcd * (q + 1) : r * (q + 1) + (xcd - r) * q) + off; }
        const int nig = WGM * nN, gid = wgid / nig, fm = gid * WGM, gsz = (nM - fm) < WGM ? (nM - fm) : WGM;
        u.pm = fm + ((wgid % nig) % gsz); u.pn = (wgid % nig) / gsz; u.e = 0; u.cnt = 0; return true;
    }
};
struct GroupOrder {
    const LAS int* pt; const LAS int* cn; LAS int* ul; int npn, total, G, c;
    __device__ void init(const LAS int* pt_, const LAS int* cn_, LAS int* ul_, int npn_, int G_, int c_) { pt = pt_; cn = cn_; ul = ul_; npn = npn_; total = __builtin_amdgcn_readfirstlane(pt_[NE] * npn_); G = G_; c = c_; }
    __device__ void build(int wave, int lane) const {
        if (wave == 0 && lane < 16) {
            const long L = (long)lane * G + c; int pm = -1, pn = 0, e = 0, cnt = 0;
            if (L < total) {
                int wgid = (int)L; { const int q = total / NXCD, r = total % NXCD, xcd = wgid % NXCD, off = wgid / NXCD; wgid = (xcd < r ? xcd * (q + 1) : r * (q + 1) + (xcd - r) * q) + off; }
                for (int j = 1; j < NE; ++j) e += (pt[j] * npn <= wgid) ? 1 : 0;
                const int t0 = pt[e], te = pt[e + 1] - t0, local = wgid - t0 * npn, mt = local % te;
                pn = local / te; pm = t0 + mt; cnt = cn[e] - mt * 256;
            }
            ul[lane * 4 + 0] = pm; ul[lane * 4 + 1] = pn; ul[lane * 4 + 2] = e; ul[lane * 4 + 3] = cnt;
        }
    }
    __device__ bool next(int i, Unit& u) const {
        if (i >= 16) return false;
        u.pm = __builtin_amdgcn_readfirstlane(ul[i * 4 + 0]); u.pn = __builtin_amdgcn_readfirstlane(ul[i * 4 + 1]);
        u.e = __builtin_amdgcn_readfirstlane(ul[i * 4 + 2]); u.cnt = __builtin_amdgcn_readfirstlane(ul[i * 4 + 3]);
        return u.pm >= 0;
    }
};
}

struct PInProj : pg8::DenseOrder {
    static constexpr int K = 1024; static constexpr bool GATHER = false, FP8 = false;
    const bf16_t* XN; const bf16_t* Wt; bf16_t* QKV; const float *gaq, *gak, *gbq, *gbk;
    static constexpr __host__ __device__ __forceinline__ int brow(int bj, int R) { return 64 * (R >> 5) + 32 * bj + pg8::perm32(R & 31); }
    __device__ __forceinline__ const char* a_base(const pg8::Unit& u) const { return (const char*)(XN + (size_t)u.pm * 256 * K); }
    __device__ __forceinline__ const char* b_base(const pg8::Unit& u) const { return (const char*)(Wt + (size_t)u.pn * 256 * K); }
    __device__ __forceinline__ void epi(const f32x4 (&acc)[2][2][4][2], const pg8::Unit& u, int wr, int wc, int fr, int fq) const {
        constexpr float ISC = 1.f;
        const int ty = u.pn >> 1;
        const float* g = (ty == 0) ? gaq : (ty == 1) ? gak : (ty == 3) ? gbq : (ty == 4) ? gbk : nullptr;
        const float post = (ty == 0 || ty == 3) ? QSCALE : 1.f;
        const int row0 = u.pm * 256 + wr * 64 + fr, col0 = u.pn * 256 + wc * 64 + 8 * fq;
        f32x4 gv[2][2];
#pragma unroll
        for (int bj = 0; bj < 2; ++bj)
#pragma unroll
            for (int n = 0; n < 2; ++n) gv[bj][n] = g ? *(const f32x4*)(g + 32 * bj + 8 * fq + 4 * n) : (f32x4){1.f, 1.f, 1.f, 1.f};
#pragma unroll
        for (int ai = 0; ai < 2; ++ai)
#pragma unroll
            for (int m = 0; m < 4; ++m) {
                float rs = 1.f;
                if (g) {
                    float ss = 0.f;
#pragma unroll
                    for (int bj = 0; bj < 2; ++bj)
#pragma unroll
                        for (int n = 0; n < 2; ++n) { const f32x4 v = acc[ai][bj][m][n] * ISC; ss += (v[0] * v[0] + v[1] * v[1]) + (v[2] * v[2] + v[3] * v[3]); }
                    ss += __shfl_xor(ss, 16); ss += __shfl_xor(ss, 32);
                    rs = rsqrtf(ss * (1.f / 64.f) + RMS_EPS) * post;
                }
                bf16_t* rowp = QKV + (size_t)(row0 + ai * 128 + m * 16) * NIN + col0;
#pragma unroll
                for (int bj = 0; bj < 2; ++bj) {
                    const f32x4 v0 = acc[ai][bj][m][0] * gv[bj][0] * (rs * ISC), v1 = acc[ai][bj][m][1] * gv[bj][1] * (rs * ISC);
                    u32x4 w; w.x = pg8::cvt_pk_bf16(v0[0], v0[1]); w.y = pg8::cvt_pk_bf16(v0[2], v0[3]); w.z = pg8::cvt_pk_bf16(v1[0], v1[1]); w.w = pg8::cvt_pk_bf16(v1[2], v1[3]);
                    *(u32x4*)(rowp + 32 * bj) = w;
                }
            }
    }
};
struct POutProj : pg8::DenseOrder {
    static constexpr int K = 1024; static constexpr bool GATHER = false, FP8 = false;
    const bf16_t* AO; const bf16_t* Wt; const float* x; const float* mod; float* x1;
    static constexpr __host__ __device__ __forceinline__ int brow(int bj, int R) { return 128 * bj + R; }
    __device__ __forceinline__ const char* a_base(const pg8::Unit& u) const { return (const char*)(AO + (size_t)u.pm * 256 * K); }
    __device__ __forceinline__ const char* b_base(const pg8::Unit& u) const { return (const char*)(Wt + (size_t)u.pn * 256 * K); }
    __device__ __forceinline__ void epi(const f32x4 (&acc)[2][2][4][2], const pg8::Unit& u, int wr, int wc, int fr, int fq) const {
        const int row0 = u.pm * 256 + wr * 64 + fr, col0 = u.pn * 256 + wc * 32 + 4 * fq;
        const float* gate1 = mod + ((u.pm * 256) / S) * 6144 + 2048;
        f32x4 gv[2][2];
#pragma unroll
        for (int bj = 0; bj < 2; ++bj)
#pragma unroll
            for (int n = 0; n < 2; ++n) gv[bj][n] = *(const f32x4*)(gate1 + col0 + bj * 128 + n * 16);
#pragma unroll
        for (int ai = 0; ai < 2; ++ai)
#pragma unroll
            for (int m = 0; m < 4; ++m) { const size_t off = (size_t)(row0 + ai * 128 + m * 16) * D + col0;
#pragma unroll
                for (int bj = 0; bj < 2; ++bj)
#pragma unroll
                    for (int n = 0; n < 2; ++n) { const f32x4 xv = *(const f32x4*)(x + off + bj * 128 + n * 16); *(f32x4*)(x1 + off + bj * 128 + n * 16) = xv + gv[bj][n] * acc[ai][bj][m][n]; }
                if (m & 1) asm volatile("" ::: "memory"); }
    }
};
struct PGateUp : pg8::GroupOrder {
    static constexpr int K = 512; static constexpr bool GATHER = true, FP8 = true;
    const bf16_t* H2; const bf16_t* Wt; const float* bgu; const int* list; bf16_t* ACT;
    static constexpr __host__ __device__ __forceinline__ int brow(int bj, int R) { return 1024 * bj + (R & ~31) + pg8::perm32(R & 31); }
    __device__ __forceinline__ const char* a_base(const pg8::Unit&) const { return (const char*)H2; }
    __device__ __forceinline__ const char* b_base(const pg8::Unit& u) const { return (const char*)(Wt + ((size_t)u.e * 2048 + u.pn * 128) * K); }
    __device__ __forceinline__ void a_offsets(const pg8::Unit& u, const int (&R)[2], const int (&C)[2], unsigned (&voff)[2][2]) const {
        const int* lp = list + (size_t)u.e * M + (size_t)(u.pm - pt[u.e]) * 256;
#pragma unroll
        for (int h = 0; h < 2; ++h)
#pragma unroll
            for (int i = 0; i < 2; ++i) { int r = h * 128 + R[i]; r = r < u.cnt ? r : 0; const int tok = lp[r]; voff[h][i] = (unsigned)(tok * K + C[i]) * 2u; }
    }
    __device__ __forceinline__ void epi(const f32x4 (&acc)[2][2][4][2], const pg8::Unit& u, int wr, int wc, int fr, int fq) const {
        const int row0 = u.pm * 256 + wr * 64 + fr, col0 = u.pn * 128 + wc * 32 + 8 * fq;
        const float* bias = bgu + u.e * 2048 + col0;
        f32x4 bg[2], bu[2];
#pragma unroll
        for (int n = 0; n < 2; ++n) { bg[n] = *(const f32x4*)(bias + 4 * n); bu[n] = (*(const f32x4*)(bias + 1024 + 4 * n) + 1.f) * ACT_SCALE; }
#pragma unroll
        for (int ai = 0; ai < 2; ++ai)
#pragma unroll
            for (int m = 0; m < 4; ++m) {
                float a[2][4];
#pragma unroll
                for (int n = 0; n < 2; ++n)
#pragma unroll
                    for (int r = 0; r < 4; ++r) {
                        const float g = fminf(__builtin_fmaf(acc[ai][0][m][n][r], 1.f / (H2_SCALE * W8_SCALE), bg[n][r]), 7.f);
                        const float u8 = __builtin_amdgcn_fmed3f(__builtin_fmaf(acc[ai][1][m][n][r], ACT_SCALE / (H2_SCALE * W8_SCALE), bu[n][r]), -6.f * ACT_SCALE, 8.f * ACT_SCALE);
                        a[n][r] = u8 * (g * __builtin_amdgcn_rcpf(1.f + __builtin_amdgcn_exp2f(-1.702f * LOG2E * g)));
                    }
                u32x2 w; w.x = pg8::pk4_fp8(a[0][0], a[0][1], a[0][2], a[0][3]); w.y = pg8::pk4_fp8(a[1][0], a[1][1], a[1][2], a[1][3]);
                *(u32x2*)((unsigned char*)ACT + (size_t)(row0 + ai * 128 + m * 16) * DFF + col0) = w;
            }
    }
};
struct PDown : pg8::GroupOrder {
    static constexpr int K = 512; static constexpr bool GATHER = false, FP8 = true;
    const bf16_t* ACT; const bf16_t* Wt; const float* bd; bf16_t* Y;
    static constexpr __host__ __device__ __forceinline__ int brow(int bj, int R) { return 128 * bj + (R & ~31) + pg8::perm32(R & 31); }
    __device__ __forceinline__ const char* a_base(const pg8::Unit& u) const { return (const char*)(ACT + (size_t)u.pm * 256 * K); }
    __device__ __forceinline__ const char* b_base(const pg8::Unit& u) const { return (const char*)(Wt + ((size_t)u.e * 1024 + u.pn * 256) * K); }
    __device__ __forceinline__ void epi(const f32x4 (&acc)[2][2][4][2], const pg8::Unit& u, int wr, int wc, int fr, int fq) const {
        const int row0 = u.pm * 256 + wr * 64 + fr, col0 = u.pn * 256 + wc * 32 + 8 * fq;
        const float* bias = bd + u.e * 1024 + col0;
        f32x4 bv[2][2];
#pragma unroll
        for (int bj = 0; bj < 2; ++bj)
#pragma unroll
            for (int n = 0; n < 2; ++n) bv[bj][n] = *(const f32x4*)(bias + bj * 128 + 4 * n) * Y_SCALE;
#pragma unroll
        for (int ai = 0; ai < 2; ++ai)
#pragma unroll
            for (int m = 0; m < 4; ++m) { unsigned char* rowp = (unsigned char*)Y + (size_t)(row0 + ai * 128 + m * 16) * D + col0;
#pragma unroll
                for (int bj = 0; bj < 2; ++bj) { f32x4 v0, v1;
#pragma unroll
                    for (int q_ = 0; q_ < 4; ++q_) { v0[q_] = __builtin_amdgcn_fmed3f(__builtin_fmaf(acc[ai][bj][m][0][q_], Y_SCALE / (ACT_SCALE * W8_SCALE), bv[bj][0][q_]), -448.f, 448.f);
                                                     v1[q_] = __builtin_amdgcn_fmed3f(__builtin_fmaf(acc[ai][bj][m][1][q_], Y_SCALE / (ACT_SCALE * W8_SCALE), bv[bj][1][q_]), -448.f, 448.f); }
                    u32x2 w; w.x = pg8::pk4_fp8(v0[0], v0[1], v0[2], v0[3]); w.y = pg8::pk4_fp8(v1[0], v1[1], v1[2], v1[3]);
                    *(u32x2*)(rowp + bj * 128) = w; } }
    }
};


namespace att {
typedef float f32x16 __attribute__((ext_vector_type(16)));
typedef short s16x4 __attribute__((ext_vector_type(4)));
typedef short v4i16_t __attribute__((ext_vector_type(4)));
typedef float f32x2_t __attribute__((ext_vector_type(2))); typedef __bf16 bf16x2_t __attribute__((ext_vector_type(2)));
__device__ __forceinline__ unsigned cvtpk(float lo, float hi) { f32x2_t v = {lo, hi}; bf16x2_t b = __builtin_convertvector(v, bf16x2_t); return __builtin_bit_cast(unsigned, b); }
__device__ __forceinline__ s16x4 vtr(const LAS unsigned char* p) { return __builtin_bit_cast(s16x4, __builtin_amdgcn_ds_read_tr16_b64_v4i16((LAS v4i16_t*)p)); }
__device__ __forceinline__ void glds16(const void* gsrc, LAS unsigned char* dst) { __builtin_amdgcn_global_load_lds((const unsigned*)gsrc, (LAS unsigned*)dst, 16, 0, 0); }
#define ATT_CR(r) (((r) & 3) + 8 * ((r) >> 2))
#define ATT_WAIT_V(n) asm volatile("s_waitcnt vmcnt(" #n ")" ::: "memory")
#define ATT_WAIT_L0() asm volatile("s_waitcnt lgkmcnt(0)" ::: "memory")

template <int MODE> __device__ __forceinline__ float soft_tile(f32x16& p0, f32x16& p1, float sl, int dqh) {
    float sum = 0.f;
#pragma unroll
    for (int r = 0; r < 16; ++r) {
        float x0 = __builtin_fmaf(sl, (float)ATT_CR(r), p0[r]), x1 = __builtin_fmaf(sl, (float)(ATT_CR(r) + 32), p1[r]);
        if (MODE == 1) { x0 = (ATT_CR(r) <= dqh) ? x0 : -INFINITY; x1 = (ATT_CR(r) + 32 <= dqh) ? x1 : -INFINITY; }
        if (MODE == 2) { x0 = ((unsigned)(dqh - ATT_CR(r)) <= 128u) ? x0 : -INFINITY; x1 = ((unsigned)(dqh - ATT_CR(r) - 32) <= 128u) ? x1 : -INFINITY; }
        p0[r] = __builtin_amdgcn_exp2f(x0); p1[r] = __builtin_amdgcn_exp2f(x1);
        sum += p0[r] + p1[r];
    }
    return sum;
}
__device__ __forceinline__ void pack_p(const f32x16& p0, const f32x16& p1, bf16x8 (&pa)[4]) {
    u32x4 w0 = {cvtpk(p0[0], p0[1]), cvtpk(p0[2], p0[3]), cvtpk(p0[4], p0[5]), cvtpk(p0[6], p0[7])};
    u32x4 w1 = {cvtpk(p0[8], p0[9]), cvtpk(p0[10], p0[11]), cvtpk(p0[12], p0[13]), cvtpk(p0[14], p0[15])};
    u32x4 w2 = {cvtpk(p1[0], p1[1]), cvtpk(p1[2], p1[3]), cvtpk(p1[4], p1[5]), cvtpk(p1[6], p1[7])};
    u32x4 w3 = {cvtpk(p1[8], p1[9]), cvtpk(p1[10], p1[11]), cvtpk(p1[12], p1[13]), cvtpk(p1[14], p1[15])};
    pa[0] = __builtin_bit_cast(bf16x8, w0); pa[1] = __builtin_bit_cast(bf16x8, w1); pa[2] = __builtin_bit_cast(bf16x8, w2); pa[3] = __builtin_bit_cast(bf16x8, w3);
}
template <int NDB> __device__ __forceinline__ void pv_tile(f32x16 (&o)[NDB], const LAS unsigned char* vrd, const bf16x8 (&pa)[4]) {
#pragma unroll
    for (int db = 0; db < NDB; ++db) {
        s16x4 lo[4], hh[4];
#pragma unroll
        for (int g = 0; g < 4; ++g) { lo[g] = vtr(vrd + db * 4096 + g * 1024); hh[g] = vtr(vrd + db * 4096 + g * 1024 + 512); }
#pragma unroll
        for (int g = 0; g < 4; ++g) { const bf16x8 vf = {lo[g][0], lo[g][1], lo[g][2], lo[g][3], hh[g][0], hh[g][1], hh[g][2], hh[g][3]};
            o[db] = __builtin_amdgcn_mfma_f32_32x32x16_bf16(pa[g], vf, o[db], 0, 0, 0); }
    }
}
__device__ __forceinline__ float gain_bound(const float* ga, const float* gb, int lane) {
    float a = fabsf(ga[lane & 63]), b = fabsf(gb[lane & 63]);
#pragma unroll
    for (int o = 1; o < 64; o <<= 1) { a = fmaxf(a, __shfl_xor(a, o)); b = fmaxf(b, __shfl_xor(b, o)); }
    return QSCALE * 64.f * a * b * 1.02f + 0.25f;
}

constexpr int B2_SLOT = 32768;
__device__ __forceinline__ void attn_b2_unit(LAS unsigned char* lds, LAS float* wsf, const bf16_t* QKV, bf16_t* AO, const float* gd, int b, int h, int qb, float Mb, float lam, int wave, int lane) {
    const int r32 = lane & 31, hi = lane >> 5;
    const int c = wave >> 2, wq = wave & 3;
    const int q0 = qb * 128, tq = q0 + wq * 32 + r32;
    const size_t rowbase = (size_t)b * S;
    const bf16_t* Qp = QKV + (rowbase + tq) * NIN + 1536 + h * 128 + c * 64;
    const bf16_t* Kh = QKV + rowbase * NIN + 2048 + h * 128;
    const bf16_t* Vh = QKV + rowbase * NIN + 2560 + h * 128;
    const float sl = exp2f(-2.f * (float)(h + 1)) * LOG2E;
    bf16x8 qr[4];
#pragma unroll
    for (int d0 = 0; d0 < 4; ++d0) qr[d0] = *(const bf16x8*)(Qp + d0 * 16 + hi * 8);
    const int NT = (q0 + 128) / 64;
    const bf16_t* ksrc = Kh + (size_t)lane * NIN + wave * 8;
    const int i0 = wave, i1 = wave + 8;
    const bf16_t* vsrc0 = Vh + (size_t)(16 * (i0 & 3) + (lane >> 2)) * NIN + (i0 >> 2) * 32 + (lane & 3) * 8;
    const bf16_t* vsrc1 = Vh + (size_t)(16 * (i1 & 3) + (lane >> 2)) * NIN + (i1 >> 2) * 32 + (lane & 3) * 8;
#define ATT_DMA(t, s) do { const size_t to_ = (size_t)(t) * 64 * NIN; LAS unsigned char* sb_ = lds + (s) * B2_SLOT; \
        glds16(ksrc + to_, sb_ + wave * 1024); glds16(ksrc + 64 + to_, sb_ + 8192 + wave * 1024); glds16(vsrc0 + to_, sb_ + 16384 + i0 * 1024); glds16(vsrc1 + to_, sb_ + 16384 + i1 * 1024); } while (0)
    const int kfo = c * 8192 + hi * 1024 + r32 * 16;
    const int vro = 16384 + ((lane >> 4) & 1) * 32 + (lane & 3) * 8 + (4 * hi + ((lane & 15) >> 2)) * 64;
    f32x16 o[4]; float lsum = 0.f;
#pragma unroll
    for (int d = 0; d < 4; ++d) o[d] = f32x16{};
    ATT_WAIT_L0(); __builtin_amdgcn_s_barrier();
    ATT_DMA(0, 0); ATT_DMA(1, 1);
    const int qmax_w = q0 + wq * 32 + 31, qmin_w = q0 + wq * 32;
    int slot = 0;
    for (int t = 0; t < NT; ++t) {
        if (t + 1 < NT) ATT_WAIT_V(4); else ATT_WAIT_V(0);
        ATT_WAIT_L0(); __builtin_amdgcn_s_barrier();
        if (t + 2 < NT) { const int s2 = (slot >= 1) ? slot - 1 : 2; ATT_DMA(t + 2, s2); }
        const int k0 = 64 * t;
        if (k0 <= qmax_w) {
            const LAS unsigned char* sb = lds + slot * B2_SLOT;
            bf16x8 kf[8];
#pragma unroll
            for (int d0 = 0; d0 < 4; ++d0) { kf[2 * d0] = *(const LAS bf16x8*)(sb + kfo + d0 * 2048); kf[2 * d0 + 1] = *(const LAS bf16x8*)(sb + kfo + d0 * 2048 + 512); }
            const int dqh = tq - k0 - 4 * hi;
            const float ci = -sl * (float)dqh - Mb;
            f32x16 p0, p1;
#pragma unroll
            for (int r = 0; r < 16; ++r) { p0[r] = ci; p1[r] = ci; }
#pragma unroll
            for (int d0 = 0; d0 < 4; ++d0) { p0 = __builtin_amdgcn_mfma_f32_32x32x16_bf16(kf[2 * d0], qr[d0], p0, 0, 0, 0); p1 = __builtin_amdgcn_mfma_f32_32x32x16_bf16(kf[2 * d0 + 1], qr[d0], p1, 0, 0, 0); }
            if (k0 + 63 <= qmin_w) lsum += soft_tile<0>(p0, p1, sl, dqh); else lsum += soft_tile<1>(p0, p1, sl, dqh);
            bf16x8 pa[4]; pack_p(p0, p1, pa);
            pv_tile<4>(o, sb + vro, pa);
        }
        slot = (slot == 2) ? 0 : slot + 1;
    }
#undef ATT_DMA
    { auto rr = __builtin_amdgcn_permlane32_swap(__float_as_uint(lsum), __float_as_uint(lsum), false, false); lsum = __uint_as_float(rr[0]) + __uint_as_float(rr[1]); }
    if (hi == 0) wsf[r32] = lsum;
    ATT_WAIT_L0(); __builtin_amdgcn_s_barrier();
    LAS float* X = (LAS float*)lds + (size_t)(wq * 32) * 128 + r32;
    if (c == 1) {
#pragma unroll
        for (int r = 0; r < 16; ++r) { const int q = ATT_CR(r) + 4 * hi; const float f = lam * __builtin_amdgcn_rcpf(wsf[q]);
#pragma unroll
            for (int db = 0; db < 4; ++db) X[q * 128 + db * 32] = o[db][r] * f; }
    }
    ATT_WAIT_L0(); __builtin_amdgcn_s_barrier();
    if (c == 0) {
        float gdv[4];
#pragma unroll
        for (int db = 0; db < 4; ++db) gdv[db] = gd[db * 32 + r32] * (1.f - LAMBDA_INIT);
        LAS bf16_t* stg = (LAS bf16_t*)(lds + 65536 + wq * 8192);
#pragma unroll
        for (int r = 0; r < 16; ++r) { const int q = ATT_CR(r) + 4 * hi; const float rl = __builtin_amdgcn_rcpf(wsf[q]);
            float v[4], ss = 0.f;
#pragma unroll
            for (int db = 0; db < 4; ++db) { v[db] = o[db][r] * rl - X[q * 128 + db * 32]; ss += v[db] * v[db]; }
            ss += __shfl_xor(ss, 1); ss += __shfl_xor(ss, 2); ss += __shfl_xor(ss, 4); ss += __shfl_xor(ss, 8); ss += __shfl_xor(ss, 16);
            const float rs = rsqrtf(ss * (1.f / 128.f) + RMS_EPS);
#pragma unroll
            for (int db = 0; db < 4; ++db) stg[q * 128 + db * 32 + r32] = f2bf(v[db] * rs * gdv[db]); }
        ATT_WAIT_L0();
        bf16_t* ao = AO + (rowbase + q0 + wq * 32) * D + 512 + h * 128;
#pragma unroll
        for (int i = 0; i < 8; ++i) { const int p = i * 64 + lane, row = p >> 4, ch = p & 15; const u32x4 v = *(const LAS u32x4*)(stg + row * 128 + ch * 8); *(u32x4*)(ao + (size_t)row * D + ch * 8) = v; }
    }
    ATT_WAIT_L0();
}
__device__ __forceinline__ void attn_b_phase(LAS unsigned char* lds, LAS float* wsf, const bf16_t* QKV, bf16_t* AO, const float* gbq, const float* gbk, const float* gd,
                                             const float* lq1, const float* lk1, const float* lq2, const float* lk2, int vcu, int wave, int lane) {
    const float Mb = gain_bound(gbq, gbk, lane);
    float s1 = lq1[lane] * lk1[lane], s2 = lq2[lane] * lk2[lane];
#pragma unroll
    for (int o = 1; o < 64; o <<= 1) { s1 += __shfl_xor(s1, o); s2 += __shfl_xor(s2, o); }
    const float lam = __expf(s1) - __expf(s2) + LAMBDA_INIT;
    const int bh = vcu >> 3, s = vcu & 7, b = bh >> 2, h = bh & 3;
    attn_b2_unit(lds, wsf, QKV, AO, gd, b, h, 15 - s, Mb, lam, wave, lane);
    attn_b2_unit(lds, wsf, QKV, AO, gd, b, h, s, Mb, lam, wave, lane);
    ATT_WAIT_L0(); __builtin_amdgcn_s_barrier();
}

__device__ __forceinline__ void attn_a2_unit(LAS unsigned char* lds, LAS float* wsf, const bf16_t* QKV, bf16_t* AO, int b, int h, int r, int jb, float Mb, int wave, int lane) {
    const int r32 = lane & 31, hi = lane >> 5;
    const int j = 32 * jb + r32, tq = r + 16 * j;
    const size_t rowbase = (size_t)b * S;
    const bf16_t* Qp = QKV + (rowbase + tq) * NIN + h * 64;
    const bf16_t* Kh = QKV + rowbase * NIN + 512 + h * 64;
    const float sl1 = exp2f(-(float)(h + 1)) * LOG2E;
    bf16x8 qr[4];
#pragma unroll
    for (int d0 = 0; d0 < 4; ++d0) qr[d0] = *(const bf16x8*)(Qp + d0 * 16 + hi * 8);
    const int n3 = (jb >= 2) ? 2 : 1, n2 = (jb == 0) ? 2 : 4, n1 = (jb == 0) ? 8 : 10, npriv = n3 + n2;
    auto tile_step = [&](int idx) -> int { return idx < n3 ? 16 : 4; };
    auto tile_k0 = [&](int idx) -> int { return idx < n3 ? 64 * idx : 64 * ((jb == 0 ? 0 : 2 * jb - 2) + idx - n3); };
    auto tile_uq = [&](int step) -> int { return step == 16 ? j : (r >> 2) + 4 * j; };
    auto tile_pos0 = [&](int step, int k0) -> int { return (r & (step - 1)) + step * k0; };
    LAS unsigned char* vbuf = lds + wave * 16384;
    const int vr16 = lane >> 2;
    bf16x8 kfn[8];
#define ATT_PREF(idx, buf) do { const int st_ = tile_step(idx), k0_ = tile_k0(idx); const bf16_t* kb_ = Kh + (size_t)tile_pos0(st_, k0_) * NIN; const size_t rs_ = (size_t)st_ * NIN; \
        _Pragma("unroll") for (int d0 = 0; d0 < 4; ++d0) { kfn[2 * d0] = *(const bf16x8*)(kb_ + (size_t)r32 * rs_ + d0 * 16 + hi * 8); kfn[2 * d0 + 1] = *(const bf16x8*)(kb_ + (size_t)(r32 + 32) * rs_ + d0 * 16 + hi * 8); } \
        _Pragma("unroll") for (int i = 0; i < 8; ++i) glds16(kb_ + 512 + (size_t)(16 * (i & 3) + vr16) * rs_ + (i >> 2) * 32 + (lane & 3) * 8, vbuf + (buf) * 8192 + i * 1024); } while (0)
    const int vro = ((lane >> 4) & 1) * 32 + (lane & 3) * 8 + (4 * hi + ((lane & 15) >> 2)) * 64;
    f32x16 o[2]; o[0] = f32x16{}; o[1] = f32x16{}; float lsum = 0.f;
    ATT_WAIT_L0(); __builtin_amdgcn_s_barrier();
    ATT_PREF(0, 0);
    for (int idx = 0; idx < npriv; ++idx) {
        ATT_WAIT_V(0);
        bf16x8 kf[8];
#pragma unroll
        for (int i = 0; i < 8; ++i) kf[i] = kfn[i];
        ATT_WAIT_L0();
        if (idx + 1 < npriv) ATT_PREF(idx + 1, (idx + 1) & 1);
        const int st = tile_step(idx), k0 = tile_k0(idx);
        const int dqh = tile_uq(st) - k0 - 4 * hi;
        const float sl = sl1 * (float)st;
        const float ci = -sl * (float)dqh - Mb;
        f32x16 p0, p1;
#pragma unroll
        for (int rr = 0; rr < 16; ++rr) { p0[rr] = ci; p1[rr] = ci; }
#pragma unroll
        for (int d0 = 0; d0 < 4; ++d0) { p0 = __builtin_amdgcn_mfma_f32_32x32x16_bf16(kf[2 * d0], qr[d0], p0, 0, 0, 0); p1 = __builtin_amdgcn_mfma_f32_32x32x16_bf16(kf[2 * d0 + 1], qr[d0], p1, 0, 0, 0); }
        lsum += soft_tile<2>(p0, p1, sl, dqh);
        bf16x8 pa[4]; pack_p(p0, p1, pa);
        pv_tile<2>(o, vbuf + (idx & 1) * 8192 + vro, pa);
    }
#undef ATT_PREF
    ATT_WAIT_L0(); __builtin_amdgcn_s_barrier();
    const int T0 = (jb == 0) ? 0 : 8 * jb - 2;
    const bf16_t* ksrc = Kh + (size_t)(64 * T0 + lane) * NIN + wave * 8;
    const bf16_t* vsrc = Kh + 512 + (size_t)(64 * T0 + 16 * (wave & 3) + (lane >> 2)) * NIN + (wave >> 2) * 32 + (lane & 3) * 8;
#define ATT_DMA(t, s) do { const size_t to_ = (size_t)(t) * 64 * NIN; LAS unsigned char* sb_ = lds + (s) * 16384; glds16(ksrc + to_, sb_ + wave * 1024); glds16(vsrc + to_, sb_ + 8192 + wave * 1024); } while (0)
    const int kfo = hi * 1024 + r32 * 16;
    ATT_DMA(0, 0); ATT_DMA(1, 1);
    int slot = 0;
    for (int t = 0; t < n1; ++t) {
        if (t + 1 < n1) ATT_WAIT_V(2); else ATT_WAIT_V(0);
        ATT_WAIT_L0(); __builtin_amdgcn_s_barrier();
        if (t + 2 < n1) { const int s2 = (slot >= 1) ? slot - 1 : 2; ATT_DMA(t + 2, s2); }
        const LAS unsigned char* sb = lds + slot * 16384;
        bf16x8 kf[8];
#pragma unroll
        for (int d0 = 0; d0 < 4; ++d0) { kf[2 * d0] = *(const LAS bf16x8*)(sb + kfo + d0 * 2048); kf[2 * d0 + 1] = *(const LAS bf16x8*)(sb + kfo + d0 * 2048 + 512); }
        const int dqh = tq - 64 * (T0 + t) - 4 * hi;
        const float ci = -sl1 * (float)dqh - Mb;
        f32x16 p0, p1;
#pragma unroll
        for (int rr = 0; rr < 16; ++rr) { p0[rr] = ci; p1[rr] = ci; }
#pragma unroll
        for (int d0 = 0; d0 < 4; ++d0) { p0 = __builtin_amdgcn_mfma_f32_32x32x16_bf16(kf[2 * d0], qr[d0], p0, 0, 0, 0); p1 = __builtin_amdgcn_mfma_f32_32x32x16_bf16(kf[2 * d0 + 1], qr[d0], p1, 0, 0, 0); }
        lsum += soft_tile<2>(p0, p1, sl1, dqh);
        bf16x8 pa[4]; pack_p(p0, p1, pa);
        pv_tile<2>(o, sb + 8192 + vro, pa);
        slot = (slot == 2) ? 0 : slot + 1;
    }
#undef ATT_DMA
    { auto rr = __builtin_amdgcn_permlane32_swap(__float_as_uint(lsum), __float_as_uint(lsum), false, false); lsum = __uint_as_float(rr[0]) + __uint_as_float(rr[1]); }
    if (hi == 0) wsf[r32] = lsum;
    ATT_WAIT_L0(); __builtin_amdgcn_s_barrier();
    LAS bf16_t* stg = (LAS bf16_t*)(lds + wave * 4096);
#pragma unroll
    for (int rr = 0; rr < 16; ++rr) { const int q = ATT_CR(rr) + 4 * hi; const float rl = __builtin_amdgcn_rcpf(wsf[q]);
#pragma unroll
        for (int db = 0; db < 2; ++db) stg[q * 64 + db * 32 + r32] = f2bf(o[db][rr] * rl); }
    ATT_WAIT_L0();
#pragma unroll
    for (int i = 0; i < 4; ++i) { const int row = i * 8 + (lane >> 3), ch = lane & 7; const u32x4 v = *(const LAS u32x4*)(stg + row * 64 + ch * 8);
        *(u32x4*)(AO + (rowbase + r + 16 * (32 * jb + row)) * D + h * 64 + ch * 8) = v; }
    ATT_WAIT_L0();
}
__device__ __forceinline__ void attn_a_phase(LAS unsigned char* lds, LAS float* wsf, const bf16_t* QKV, bf16_t* AO, const float* gaq, const float* gak, int vcu, int wave, int lane) {
    const float Mb = gain_bound(gaq, gak, lane);
    const int bh = vcu >> 2, b = bh >> 3, h = bh & 7, r = 8 * (vcu & 1) + wave, jp = (vcu >> 1) & 1;
    attn_a2_unit(lds, wsf, QKV, AO, b, h, r, jp ? 2 : 3, Mb, wave, lane);
    attn_a2_unit(lds, wsf, QKV, AO, b, h, r, jp ? 1 : 0, Mb, wave, lane);
    ATT_WAIT_L0(); __builtin_amdgcn_s_barrier();
}
#undef ATT_CR
#undef ATT_WAIT_V
#undef ATT_WAIT_L0
}

struct MArgs {
    const float *x, *c, *w_ada, *b_ada, *g1, *w_in, *gaq, *gak, *gbq, *gbk, *lq1, *lk1, *lq2, *lk2, *gd, *w_out, *g2, *w_router, *b_router, *w_gu, *b_gu, *w_d, *b_d;
    float* out; unsigned char* ws; int ph_lo, ph_hi;
};

__device__ __forceinline__ void p0_transpose_item(const float* W, int K, int N, bf16_t* WT, LAS float* scr, int item, int lane) {
    const int nblk = N / 32, kb = item / nblk, nb = item % nblk, k0 = 64 * kb, n0 = 32 * nb;
    { f32x4 v[8];
#pragma unroll
      for (int i = 0; i < 8; ++i) v[i] = __builtin_nontemporal_load((const f32x4*)(W + (size_t)(k0 + 8 * i + (lane >> 3)) * N + n0 + 4 * (lane & 7)));
#pragma unroll
      for (int i = 0; i < 8; ++i) { LAS float* d = scr + (8 * i + (lane >> 3)) * 33 + 4 * (lane & 7); d[0] = v[i].x; d[1] = v[i].y; d[2] = v[i].z; d[3] = v[i].w; } }
    LDS_WAIT(); asm volatile("" ::: "memory");
    const int c = lane & 7;
#pragma unroll
    for (int j = 0; j < 4; ++j) { const int n = (lane >> 3) + 8 * j; const LAS float* s = scr + (8 * c) * 33 + n;
        u32x4 o; o.x = pk2(s[0 * 33], s[1 * 33]); o.y = pk2(s[2 * 33], s[3 * 33]); o.z = pk2(s[4 * 33], s[5 * 33]); o.w = pk2(s[6 * 33], s[7 * 33]);
        *(u32x4*)(WT + (size_t)(n0 + n) * K + k0 + 8 * c) = o; }
    LDS_WAIT(); asm volatile("" ::: "memory");
}

__device__ __forceinline__ void p0_transpose8_item(const float* W, int K, int N, unsigned char* WT, LAS float* scr, int item, int lane) {
    const int nblk = N / 32, kb = item / nblk, nb = item % nblk, k0 = 64 * kb, n0 = 32 * nb;
    { f32x4 v[8];
#pragma unroll
      for (int i = 0; i < 8; ++i) v[i] = __builtin_nontemporal_load((const f32x4*)(W + (size_t)(k0 + 8 * i + (lane >> 3)) * N + n0 + 4 * (lane & 7)));
#pragma unroll
      for (int i = 0; i < 8; ++i) { LAS float* d = scr + (8 * i + (lane >> 3)) * 33 + 4 * (lane & 7); d[0] = v[i].x; d[1] = v[i].y; d[2] = v[i].z; d[3] = v[i].w; } }
    LDS_WAIT(); asm volatile("" ::: "memory");
#pragma unroll
    for (int j = 0; j < 2; ++j) { const int n = (lane >> 2) + 16 * j, c = lane & 3; const LAS float* s = scr + (16 * c) * 33 + n;
        u32x4 o;
        o.x = pg8::pk4_fp8(s[0 * 33] * W8_SCALE, s[1 * 33] * W8_SCALE, s[2 * 33] * W8_SCALE, s[3 * 33] * W8_SCALE);
        o.y = pg8::pk4_fp8(s[4 * 33] * W8_SCALE, s[5 * 33] * W8_SCALE, s[6 * 33] * W8_SCALE, s[7 * 33] * W8_SCALE);
        o.z = pg8::pk4_fp8(s[8 * 33] * W8_SCALE, s[9 * 33] * W8_SCALE, s[10 * 33] * W8_SCALE, s[11 * 33] * W8_SCALE);
        o.w = pg8::pk4_fp8(s[12 * 33] * W8_SCALE, s[13 * 33] * W8_SCALE, s[14 * 33] * W8_SCALE, s[15 * 33] * W8_SCALE);
        __builtin_nontemporal_store(o, (u32x4*)(WT + (size_t)(n0 + n) * K + k0 + 16 * c)); }
    LDS_WAIT(); asm volatile("" ::: "memory");
}

constexpr int CV_I_GU = 16 * 64, CV_I_D = 16 * 32, CV_NIT = NE * (CV_I_GU + CV_I_D);
#ifndef CV_STATIC
#define CV_STATIC 16384
#endif
__device__ __forceinline__ void cv_item(const float* w_gu, const float* w_d, unsigned char* gu8, unsigned char* d8, LAS float* scr, int it, int lane) {
    if (it < NE * CV_I_GU) { const int e = it / CV_I_GU; p0_transpose8_item(w_gu + (size_t)e * 1024 * 2048, 1024, 2048, gu8 + (size_t)e * 1024 * 2048, scr, it % CV_I_GU, lane); }
    else { const int r_ = it - NE * CV_I_GU, e = r_ / CV_I_D; p0_transpose8_item(w_d + (size_t)e * 1024 * 1024, 1024, 1024, d8 + (size_t)e * 1024 * 1024, scr, r_ % CV_I_D, lane); }
}

__global__ void __launch_bounds__(NTHREADS, 2) mega(MArgs a) {
    extern __shared__ __attribute__((aligned(16))) unsigned char lds_raw[];
    LAS unsigned char* lds = (LAS unsigned char*)lds_raw;
    const int G = gridDim.x, bx = blockIdx.x, vcu = (G % 8 == 0) ? (bx % 8) * (G / 8) + bx / 8 : bx, NGW = G * NWAVES;
    const int wave = __builtin_amdgcn_readfirstlane((int)threadIdx.x >> 6);
#define PHASE_IDS() int lane = (int)__builtin_amdgcn_mbcnt_hi(~0u, __builtin_amdgcn_mbcnt_lo(~0u, 0u)); asm volatile("" : "+v"(lane)); const int tid = wave * 64 + lane, gw = vcu * NWAVES + wave; (void)tid; (void)gw
    volatile LAS unsigned* MISC = (volatile LAS unsigned*)(lds + MISC_OFF);
    LAS int* PT = (LAS int*)(lds + PT_OFF); LAS int* CN = (LAS int*)(lds + CNT_OFF);
#define w_counts ((int*)(a.ws + WS_CTL + CTL_COUNTS))
#define w_mod ((float*)(a.ws + WS_CTL + CTL_MOD))
#define w_modp ((float*)(a.ws + WS_MODP))
#define w_adacnt ((unsigned*)(a.ws + WS_CTL + CTL_ADACNT))
#define w_cvq ((unsigned*)(a.ws + WS_CTL + CTL_ADACNT + 256))
#define w_Win_t ((bf16_t*)(a.ws + WS_WIN))
#define w_Wout_t ((bf16_t*)(a.ws + WS_WOUT))
#define w_Wgu_t ((bf16_t*)(a.ws + WS_WGU))
#define w_Wd_t ((bf16_t*)(a.ws + WS_WD))
#define w_XN ((bf16_t*)(a.ws + WS_XN))
#define w_QKV ((bf16_t*)(a.ws + WS_QKV))
#define w_AO ((bf16_t*)(a.ws + WS_AO))
#define w_H2 ((bf16_t*)(a.ws + WS_H2))
#define w_tope ((int*)(a.ws + WS_TOPE))
#define w_tops ((int*)(a.ws + WS_TOPS))
#define w_topg ((float*)(a.ws + WS_TOPG))
#define w_list ((int*)(a.ws + WS_LIST))
#define w_ACT ((bf16_t*)(a.ws + WS_ACT))
#define w_Y ((bf16_t*)(a.ws + WS_Y))
#define w_OBN ((float*)(a.ws + WS_OBN))
#define w_X1 ((float*)(a.ws + WS_X1))
    for (int u = threadIdx.x; u < (LDS_BYTES - LDSCTL_OFF) / 4; u += NTHREADS) ((LAS unsigned*)(lds + LDSCTL_OFF))[u] = 0u;
    __syncthreads();
    const int lo = a.ph_lo, hi = a.ph_hi;
    XcdBarrier bar; bar.bar = (unsigned*)(a.ws + WS_CTL + CTL_BAR); bar.x = 0; bar.st = nullptr;
    if (hi - lo > 1) bar = xcd_barrier_post((unsigned*)(a.ws + WS_CTL + CTL_BAR), MISC + 8);
#define IN(k) (lo <= (k) && (k) < hi)
#ifndef REP_PH
#define REP_PH -1
#define REP_N 1
#endif
#define NREP(k) (((k) == REP_PH || REP_PH == 100) ? REP_N : 1)
#ifndef SPAN_PH
#define SPAN_PH -1
#endif
    LAS unsigned long long* tstamp = (LAS unsigned long long*)(lds + LDSCTL_OFF + 1536);
#define STAMP(i) do { if (SPAN_PH >= 0 && bx == 0 && threadIdx.x == 0) tstamp[i] = __builtin_amdgcn_s_memrealtime(); } while (0)
    STAMP(0);
#define SEAM(k) do { if (IN(k) && IN((k) + 1)) xcd_barrier(bar, wave); STAMP((k) + 1); } while (0)
#define LOAD_PT() do { if (wave == 0) { int cv = (lane < NE) ? w_counts[lane] : 0; int tl = (cv + 255) >> 8; int sc = tl; \
        _Pragma("unroll") for (int o = 1; o < 32; o <<= 1) { const int t_ = __shfl_up(sc, o); if ((lane & 31) >= o) sc += t_; } \
        if (lane < NE) { PT[lane + 1] = sc; CN[lane] = cv; } if (lane == 0) PT[0] = 0; } __syncthreads(); } while (0)

    if (IN(0)) for (int rep_ = 0; rep_ < NREP(0); ++rep_) {
        PHASE_IDS();
        LAS float* silu = (LAS float*)(lds + 98304);
        for (int i = tid; i < NB * D; i += NTHREADS) { const float cv = a.c[i]; silu[i] = cv / (1.f + __expf(-cv)); }
        __syncthreads();
        if (gw < 24 * 32 && rep_ == 0) {
            const int cc = gw % 24, ks = gw / 24, col = cc * 256 + 4 * lane;
            f32x4 acc[NB];
#pragma unroll
            for (int b = 0; b < NB; ++b) acc[b] = (ks == 0) ? *(const f32x4*)(a.b_ada + col) : (f32x4){0.f, 0.f, 0.f, 0.f};
#pragma unroll 1
            for (int k8 = ks * 32; k8 < ks * 32 + 32; k8 += 8) {
                f32x4 w[8];
#pragma unroll
                for (int i = 0; i < 8; ++i) w[i] = __builtin_nontemporal_load((const f32x4*)(a.w_ada + (size_t)(k8 + i) * 6144 + col));
#pragma unroll
                for (int i = 0; i < 8; ++i)
#pragma unroll
                    for (int b = 0; b < NB; ++b) acc[b] += w[i] * silu[b * D + k8 + i];
            }
#pragma unroll
            for (int b = 0; b < NB; ++b) *(f32x4*)(w_modp + ((size_t)ks * NB + b) * 6144 + col) = acc[b];
        }
        if (rep_ == 0) {
            VM_WAIT(); __syncthreads();
            if (tid == 0) { __builtin_amdgcn_fence(__ATOMIC_RELEASE, "agent"); VM_WAIT(); __hip_atomic_fetch_add(w_adacnt, 1u, RLX_AGENT); }
        }
        LAS float* scr = (LAS float*)(lds + wave * 10240);
        constexpr int I_IN = 16 * 96, I_OUT = 16 * 32;
        for (int it = gw; it < I_IN + I_OUT; it += NGW) {
            if (it < I_IN) p0_transpose_item(a.w_in, 1024, 3072, w_Win_t, scr, it, lane);
            else p0_transpose_item(a.w_out, 1024, 1024, w_Wout_t, scr, it - I_IN, lane);
        }
        if (rep_ == 0) {
            if (tid == 0) { unsigned sp = 0; while (__hip_atomic_load(w_adacnt, RLX_AGENT) < (unsigned)G && ++sp < (1u << 24)) __builtin_amdgcn_s_sleep(2);
                            __builtin_amdgcn_fence(__ATOMIC_ACQUIRE, "agent"); VM_WAIT(); }
            __syncthreads();
            for (int idx = bx * NTHREADS + tid; idx < NB * 6144; idx += G * NTHREADS) { float sm = 0.f;
#pragma unroll 8
                for (int ks = 0; ks < 32; ++ks) sm += w_modp[(size_t)ks * NB * 6144 + idx];
                w_mod[idx] = sm; }
        }
        if (rep_ + 1 < NREP(0)) xcd_barrier(bar, wave);
    }
    SEAM(0);
    if (IN(1)) for (int rep_ = 0; rep_ < NREP(1); ++rep_) {
        PHASE_IDS();
        for (int r0 = gw * 4; r0 < M; r0 += NGW * 4) {
            const int b = r0 / S;
            f32x4 v[4][4]; float rs[4];
#pragma unroll
            for (int rr = 0; rr < 4; ++rr) { const f32x4* xr = (const f32x4*)(a.x + (size_t)(r0 + rr) * D) + lane;
#pragma unroll
                for (int j = 0; j < 4; ++j) v[rr][j] = __builtin_nontemporal_load(xr + 64 * j); }
#pragma unroll
            for (int rr = 0; rr < 4; ++rr) { float ss = 0.f;
#pragma unroll
                for (int j = 0; j < 4; ++j) ss += (v[rr][j].x * v[rr][j].x + v[rr][j].y * v[rr][j].y) + (v[rr][j].z * v[rr][j].z + v[rr][j].w * v[rr][j].w);
                rs[rr] = rsqrtf(wave_sum(ss) * (1.f / D) + RMS_EPS); }
            const float* shift = w_mod + b * 6144, *scale = w_mod + b * 6144 + 1024;
#pragma unroll
            for (int j = 0; j < 4; ++j) {
                const int c0 = 4 * lane + 256 * j;
                const f32x4 g = *(const f32x4*)(a.g1 + c0), sc = *(const f32x4*)(scale + c0), sh = *(const f32x4*)(shift + c0);
                const f32x4 gs = g * (sc + 1.f);
#pragma unroll
                for (int rr = 0; rr < 4; ++rr) { const f32x4 o = v[rr][j] * rs[rr] * gs + sh;
                    u32x2 w; w.x = pk2(o.x, o.y); w.y = pk2(o.z, o.w);
                    *(u32x2*)(w_XN + (size_t)(r0 + rr) * D + c0) = w; }
            }
        }
        if (rep_ + 1 < NREP(1)) xcd_barrier(bar, wave);
    }
    SEAM(1);
    if (IN(2)) for (int rep_ = 0; rep_ < NREP(2); ++rep_) {
        PHASE_IDS();
#define P2_CONVERT() do { LAS float* scr = (LAS float*)(lds + wave * 10240); \
            for (int it = gw; it < CV_STATIC; it += NGW) cv_item(a.w_gu, a.w_d, (unsigned char*)w_Wgu_t, (unsigned char*)w_Wd_t, scr, it, lane); } while (0)
        PInProj p; p.init(M, NIN, G, bx); p.XN = w_XN; p.Wt = w_Win_t; p.QKV = w_QKV; p.gaq = a.gaq; p.gak = a.gak; p.gbq = a.gbq; p.gbk = a.gbk;
        if (bx & 1) { pg8::gemm_phase<PInProj>(lds, p, wave); __syncthreads(); P2_CONVERT(); }
        else { P2_CONVERT(); __syncthreads(); pg8::gemm_phase<PInProj>(lds, p, wave); }
#undef P2_CONVERT
        if (rep_ + 1 < NREP(2)) xcd_barrier(bar, wave);
    }
    SEAM(2);
    if (IN(3)) for (int rep_ = 0; rep_ < NREP(3); ++rep_) {
        PHASE_IDS();
        LAS float* wsf = (LAS float*)(lds + LDSCTL_OFF + 2048) + wave * 64;
#ifndef ATT_REP_A
#define ATT_REP_A 1
#define ATT_REP_B 1
#endif
        att::attn_a_phase(lds, wsf, w_QKV, w_AO, a.gaq, a.gak, vcu, wave, lane);
        STAMP(11);
        att::attn_b_phase(lds, wsf, w_QKV, w_AO, a.gbq, a.gbk, a.gd, a.lq1, a.lk1, a.lq2, a.lk2, vcu, wave, lane);
        if (rep_ == 0) {
            LAS float* scr = (LAS float*)(lds + wave * 10240);
            LAS int* qb_ = (LAS int*)(lds + LDSCTL_OFF + 1280);
            for (;;) {
                if (tid == 0) *qb_ = CV_STATIC + 16 * (int)__hip_atomic_fetch_add(w_cvq, 1u, RLX_AGENT);
                __syncthreads();
                const int base_ = *qb_;
                __syncthreads();
                if (base_ >= CV_NIT) break;
                for (int it = base_ + wave; it < base_ + 16 && it < CV_NIT; it += NWAVES)
                cv_item(a.w_gu, a.w_d, (unsigned char*)w_Wgu_t, (unsigned char*)w_Wd_t, scr, it, lane); }
        }
        if (rep_ + 1 < NREP(3)) xcd_barrier(bar, wave);
    }
    SEAM(3);
    if (IN(5)) for (int rep_ = 0; rep_ < NREP(5); ++rep_) {
        PHASE_IDS();
        POutProj p; p.init(M, D, G, bx); p.AO = w_AO; p.Wt = w_Wout_t; p.x = a.x; p.mod = w_mod; p.x1 = w_X1;
        pg8::gemm_phase<POutProj>(lds, p, wave);
        if (rep_ + 1 < NREP(5)) xcd_barrier(bar, wave);
    }
    SEAM(5);
    if (IN(6)) for (int rep_ = 0; rep_ < NREP(6); ++rep_) {
        PHASE_IDS();
        typedef float f32x4v __attribute__((ext_vector_type(4)));
        LAS float* Wp = (LAS float*)lds;
        LAS float* lgs = (LAS float*)(lds + LDSCTL_OFF + 4096);
        LAS float* red = (LAS float*)(lds + LDSCTL_OFF + 12288);
        LAS float* cb = (LAS float*)(lds + LDSCTL_OFF + 14336);
        LAS int* lcnt = (LAS int*)(lds + LDSCTL_OFF + 14464);
        LAS int* lbase = (LAS int*)(lds + LDSCTL_OFF + 14592);
        LAS float* ssl = (LAS float*)(lds + LDSCTL_OFF + 14720);
        for (int chunk = bx; chunk < M / 64; chunk += G) {
            const int row0 = chunk * 64, b = row0 / S;
            const float* shift = w_mod + b * 6144 + 3072, *scale = w_mod + b * 6144 + 4096;
            __syncthreads();
#pragma unroll 1
            for (int i0 = tid; i0 < 1024 * 8; i0 += NTHREADS * 8) {
                f32x4v w[8]; float gg[8], sc_[8];
#pragma unroll
                for (int u = 0; u < 8; ++u) { const int i = i0 + u * NTHREADS, k = i >> 3; w[u] = *(const f32x4v*)(a.w_router + (size_t)k * NE + (i & 7) * 4); gg[u] = a.g2[k]; sc_[u] = scale[k]; }
#pragma unroll
                for (int u = 0; u < 8; ++u) { const int i = i0 + u * NTHREADS, k = i >> 3; *(LAS f32x4v*)(Wp + k * NE + (i & 7) * 4) = w[u] * (gg[u] * (1.f + sc_[u])); }
            }
            { const int e = tid & 31, kp = tid >> 5; float acc = 0.f;
#pragma unroll 8
              for (int k = kp * 64; k < kp * 64 + 64; ++k) acc += shift[k] * a.w_router[(size_t)k * NE + e];
              red[kp * 32 + e] = acc; }
            if (tid < 32) lcnt[tid] = 0;
            if (tid < 64) ssl[tid] = 0.f;
            *(LAS f32x4v*)(lgs + tid * 4) = (f32x4v){0.f, 0.f, 0.f, 0.f};
#pragma unroll 1
            for (int rb = 0; rb < 2; ++rb) {
                f32x4 v[4][4]; float rs[4];
#pragma unroll
                for (int rr = 0; rr < 4; ++rr) { const f32x4* xr = (const f32x4*)(w_X1 + (size_t)(row0 + wave * 8 + rb * 4 + rr) * D) + lane;
#pragma unroll
                    for (int jj = 0; jj < 4; ++jj) v[rr][jj] = xr[64 * jj]; }
#pragma unroll
                for (int rr = 0; rr < 4; ++rr) { float s_ = 0.f;
#pragma unroll
                    for (int jj = 0; jj < 4; ++jj) s_ += (v[rr][jj].x * v[rr][jj].x + v[rr][jj].y * v[rr][jj].y) + (v[rr][jj].z * v[rr][jj].z + v[rr][jj].w * v[rr][jj].w);
                    rs[rr] = rsqrtf(wave_sum(s_) * (1.f / D) + RMS_EPS); }
#pragma unroll
                for (int jj = 0; jj < 4; ++jj) {
                    const int c0 = 4 * lane + 256 * jj;
                    const f32x4 g = *(const f32x4*)(a.g2 + c0), sc = *(const f32x4*)(scale + c0), sh = *(const f32x4*)(shift + c0);
#pragma unroll
                    for (int rr = 0; rr < 4; ++rr) { const f32x4 o = v[rr][jj] * rs[rr] * g * (sc + 1.f) + sh;
                        const f32x4 oc = __builtin_elementwise_min(__builtin_elementwise_max(o * H2_SCALE, (f32x4){-448.f, -448.f, -448.f, -448.f}), (f32x4){448.f, 448.f, 448.f, 448.f});
                        *(unsigned*)((unsigned char*)w_H2 + (size_t)(row0 + wave * 8 + rb * 4 + rr) * D + c0) = pg8::pk4_fp8(oc.x, oc.y, oc.z, oc.w); }
                }
            }
            __syncthreads();
            if (tid < 32) { float s_ = a.b_router[tid];
#pragma unroll
                for (int kp = 0; kp < 16; ++kp) s_ += red[kp * 32 + tid];
                cb[tid] = s_; }
            const int tj = lane & 15, kq = lane >> 4;
            {
                const int kb = 512 * (wave >> 2) + 128 * kq;
                const float* xp = w_X1 + (size_t)(row0 + 16 * (wave & 3) + tj) * D + kb;
                const LAS float* wq = Wp + kb * NE + tj;
                f32x4v acc0 = {0.f, 0.f, 0.f, 0.f}, acc1 = {0.f, 0.f, 0.f, 0.f}; float ssq = 0.f;
                f32x4v xa[8], xb[8];
#pragma unroll
                for (int i = 0; i < 8; ++i) xa[i] = *(const f32x4v*)(xp + 4 * i);
#pragma unroll
                for (int bt = 0; bt < 4; bt += 2) {
#pragma unroll
                    for (int i = 0; i < 8; ++i) xb[i] = *(const f32x4v*)(xp + 32 * (bt + 1) + 4 * i);
#pragma unroll
                    for (int i = 0; i < 8; ++i) { const f32x4v xv = xa[i]; ssq += (xv.x * xv.x + xv.y * xv.y) + (xv.z * xv.z + xv.w * xv.w);
#pragma unroll
                        for (int u = 0; u < 4; ++u) { const int kk = 32 * bt + 4 * i + u; const float a0 = wq[kk * NE], a1 = wq[kk * NE + 16];
                            acc0 = __builtin_amdgcn_mfma_f32_16x16x4f32(a0, xv[u], acc0, 0, 0, 0); acc1 = __builtin_amdgcn_mfma_f32_16x16x4f32(a1, xv[u], acc1, 0, 0, 0); } }
                    if (bt + 2 < 4) {
#pragma unroll
                        for (int i = 0; i < 8; ++i) xa[i] = *(const f32x4v*)(xp + 32 * (bt + 2) + 4 * i); }
#pragma unroll
                    for (int i = 0; i < 8; ++i) { const f32x4v xv = xb[i]; ssq += (xv.x * xv.x + xv.y * xv.y) + (xv.z * xv.z + xv.w * xv.w);
#pragma unroll
                        for (int u = 0; u < 4; ++u) { const int kk = 32 * (bt + 1) + 4 * i + u; const float a0 = wq[kk * NE], a1 = wq[kk * NE + 16];
                            acc0 = __builtin_amdgcn_mfma_f32_16x16x4f32(a0, xv[u], acc0, 0, 0, 0); acc1 = __builtin_amdgcn_mfma_f32_16x16x4f32(a1, xv[u], acc1, 0, 0, 0); } }
                }
                ssq += __shfl_xor(ssq, 16); ssq += __shfl_xor(ssq, 32);
                LAS float* lw = lgs + ((wave & 3) * 16 + tj) * 32;
#pragma unroll
                for (int r = 0; r < 4; ++r) { (void)__hip_atomic_fetch_add(lw + 4 * kq + r, acc0[r], __ATOMIC_RELAXED, __HIP_MEMORY_SCOPE_WORKGROUP); (void)__hip_atomic_fetch_add(lw + 16 + 4 * kq + r, acc1[r], __ATOMIC_RELAXED, __HIP_MEMORY_SCOPE_WORKGROUP); }
                if (kq == 0) (void)__hip_atomic_fetch_add(ssl + (wave & 3) * 16 + tj, ssq, __ATOMIC_RELAXED, __HIP_MEMORY_SCOPE_WORKGROUP);
            }
            __syncthreads();
            int idx[4] = {0, 0, 0, 0}, rank[4] = {0, 0, 0, 0}; float gt[4] = {0.f, 0.f, 0.f, 0.f};
            if (wave < 4 && lane < 16) {
                const float rstd = rsqrtf(ssl[wave * 16 + lane] * (1.f / D) + RMS_EPS);
                float lg[NE];
#pragma unroll
                for (int e = 0; e < NE; ++e) lg[e] = lgs[(wave * 16 + lane) * 32 + e] * rstd + cb[e];
                float val[4];
#pragma unroll
                for (int k = 0; k < 4; ++k) {
                    float best = -INFINITY; int bi = 0;
#pragma unroll
                    for (int e = 0; e < NE; ++e) { bool taken = false;
#pragma unroll
                        for (int kk = 0; kk < k; ++kk) taken |= (idx[kk] == e);
                        if (!taken && lg[e] > best) { best = lg[e]; bi = e; } }
                    idx[k] = bi; val[k] = best;
                }
                float den = 0.f;
#pragma unroll
                for (int k = 0; k < 4; ++k) { gt[k] = __expf(val[k] - val[0]); den += gt[k]; }
                const float rden = 1.f / den;
#pragma unroll
                for (int k = 0; k < 4; ++k) { gt[k] *= rden; rank[k] = __hip_atomic_fetch_add(lcnt + idx[k], 1, __ATOMIC_RELAXED, __HIP_MEMORY_SCOPE_WORKGROUP); }
            }
            __syncthreads();
            if (tid < 32 && rep_ == 0) lbase[tid] = atomicAdd(&w_counts[tid], lcnt[tid]);
            __syncthreads();
            if (wave < 4 && lane < 16 && rep_ == 0) {
                const int row = row0 + 16 * wave + lane;
#pragma unroll
                for (int k = 0; k < 4; ++k) { const int slot = lbase[idx[k]] + rank[k];
                    w_tope[row * 4 + k] = idx[k]; w_tops[row * 4 + k] = slot; w_topg[row * 4 + k] = gt[k]; w_list[idx[k] * M + slot] = row; }
            }
        }
        if (rep_ + 1 < NREP(6)) xcd_barrier(bar, wave);
    }
    SEAM(6);
    if (IN(7)) for (int rep_ = 0; rep_ < NREP(7); ++rep_) {
        PHASE_IDS();
        LOAD_PT();
        PGateUp p; p.init(PT, CN, (LAS int*)(lds + LDSCTL_OFF + 1024), 8, G, bx); p.build(wave, lane); __syncthreads(); p.H2 = w_H2; p.Wt = w_Wgu_t; p.bgu = a.b_gu; p.list = w_list; p.ACT = w_ACT;
        pg8::gemm_phase<PGateUp>(lds, p, wave);
        if (rep_ + 1 < NREP(7)) xcd_barrier(bar, wave);
    }
    SEAM(7);
    if (IN(8)) for (int rep_ = 0; rep_ < NREP(8); ++rep_) {
        PHASE_IDS();
        LOAD_PT();
        PDown p; p.init(PT, CN, (LAS int*)(lds + LDSCTL_OFF + 1024), 4, G, bx); p.build(wave, lane); __syncthreads(); p.ACT = w_ACT; p.Wt = w_Wd_t; p.bd = a.b_d; p.Y = w_Y;
        pg8::gemm_phase<PDown>(lds, p, wave);
        if (rep_ + 1 < NREP(8)) xcd_barrier(bar, wave);
    }
    SEAM(8);
    for (int rep_ = 0; rep_ + 1 < NREP(10); ++rep_) xcd_barrier(bar, wave);
    if (IN(9)) for (int rep_ = 0; rep_ < NREP(9); ++rep_) {
        PHASE_IDS();
        LOAD_PT();
        for (int r0 = gw * 2; r0 < M; r0 += NGW * 2) {
            const int b = r0 / S;
            const float* gate2 = w_mod + b * 6144 + 5120;
            const unsigned char* yr[2][4]; float gk[2][4];
#pragma unroll
            for (int rr = 0; rr < 2; ++rr)
#pragma unroll
                for (int k = 0; k < 4; ++k) { const int row = r0 + rr; yr[rr][k] = (const unsigned char*)w_Y + (size_t)(PT[w_tope[row * 4 + k]] * 256 + w_tops[row * 4 + k]) * D; gk[rr][k] = w_topg[row * 4 + k] * (1.f / Y_SCALE); }
#pragma unroll
            for (int j = 0; j < 4; ++j) {
                const int c0 = 4 * lane + 256 * j;
                int wv[2][4]; f32x4 xv[2];
#pragma unroll
                for (int rr = 0; rr < 2; ++rr) { xv[rr] = *(const f32x4*)(w_X1 + (size_t)(r0 + rr) * D + c0);
#pragma unroll
                    for (int k = 0; k < 4; ++k) wv[rr][k] = *(const int*)(yr[rr][k] + c0); }
                const f32x4 g = *(const f32x4*)(gate2 + c0);
#pragma unroll
                for (int rr = 0; rr < 2; ++rr) { f32x4 acc = (f32x4){0.f, 0.f, 0.f, 0.f};
#pragma unroll
                    for (int k = 0; k < 4; ++k) { const int w = wv[rr][k];
                        acc.x += gk[rr][k] * __builtin_amdgcn_cvt_f32_fp8(w, 0); acc.y += gk[rr][k] * __builtin_amdgcn_cvt_f32_fp8(w, 1);
                        acc.z += gk[rr][k] * __builtin_amdgcn_cvt_f32_fp8(w, 2); acc.w += gk[rr][k] * __builtin_amdgcn_cvt_f32_fp8(w, 3); }
                    *(f32x4*)(a.out + (size_t)(r0 + rr) * D + c0) = xv[rr] + g * acc; }
            }
        }
    }
    STAMP(10);
    if (SPAN_PH >= 0 && bx == 0 && threadIdx.x == 0) {
        const unsigned long long dur = (SPAN_PH == 20) ? tstamp[11] - tstamp[3] : (SPAN_PH == 21) ? tstamp[4] - tstamp[11] : tstamp[SPAN_PH + 1] - tstamp[SPAN_PH], t0 = __builtin_amdgcn_s_memrealtime();
        while (__builtin_amdgcn_s_memrealtime() - t0 < dur) __builtin_amdgcn_s_sleep(4);
    }
#undef IN
#undef PHASE_IDS
#undef SEAM
#undef LOAD_PT
#undef w_counts
#undef w_mod
#undef w_modp
#undef w_adacnt
#undef w_cvq
#undef w_Win_t
#undef w_Wout_t
#undef w_Wgu_t
#undef w_Wd_t
#undef w_XN
#undef w_QKV
#undef w_AO
#undef w_H2
#undef w_tope
#undef w_tops
#undef w_topg
#undef w_list
#undef w_ACT
#undef w_Y
#undef w_OBN
#undef w_X1
}

#ifndef RUN_MODE
#define RUN_MODE 1
#endif
#ifndef PH_MASK
#define PH_MASK 0x3ff
#endif
extern "C" void kernel_launch(void* const* d_in, const int* in_sizes, int n_in, void* d_out, int out_size, void* d_ws, size_t ws_size, hipStream_t stream) {
    static int grid = 0;
    if (grid == 0) {
        if (n_in != 23 || out_size != M * D || ws_size < WS_END) { fprintf(stderr, "kernel_launch: unexpected problem (n_in %d out %d ws %zu)\n", n_in, out_size, ws_size); grid = -1; return; }
        int dev = 0, cus = 0;
        if (hipGetDevice(&dev) != hipSuccess || hipDeviceGetAttribute(&cus, hipDeviceAttributeMultiprocessorCount, dev) != hipSuccess) { grid = -1; return; }
        if (hipFuncSetAttribute((const void*)mega, hipFuncAttributeMaxDynamicSharedMemorySize, LDS_BYTES) != hipSuccess) { fprintf(stderr, "kernel_launch: hipFuncSetAttribute failed\n"); grid = -1; return; }
        int per_cu = 0;
        if (hipOccupancyMaxActiveBlocksPerMultiprocessor(&per_cu, (const void*)mega, NTHREADS, LDS_BYTES) != hipSuccess || per_cu < 1) fprintf(stderr, "kernel_launch: occupancy query says %d blocks/CU\n", per_cu);
        (void)hipGetLastError();
        grid = cus;
    }
    if (grid < 0) return;
    const float* x = (const float*)d_in[0]; const float* c = (const float*)d_in[1]; const float* w_ada = (const float*)d_in[2]; const float* b_ada = (const float*)d_in[3];
    const float* g1 = (const float*)d_in[4]; const float* w_in = (const float*)d_in[5];
    const float* gaq = (const float*)d_in[6]; const float* gak = (const float*)d_in[7]; const float* gbq = (const float*)d_in[8]; const float* gbk = (const float*)d_in[9];
    const float* lq1 = (const float*)d_in[10]; const float* lk1 = (const float*)d_in[11]; const float* lq2 = (const float*)d_in[12]; const float* lk2 = (const float*)d_in[13];
    const float* gd = (const float*)d_in[14]; const float* w_out = (const float*)d_in[15]; const float* g2 = (const float*)d_in[16];
    const float* w_router = (const float*)d_in[17]; const float* b_router = (const float*)d_in[18];
    const float* w_gu = (const float*)d_in[19]; const float* b_gu = (const float*)d_in[20]; const float* w_d = (const float*)d_in[21]; const float* b_d = (const float*)d_in[22];
    unsigned char* ws = (unsigned char*)d_ws; float* out = (float*)d_out;
    int* counts = (int*)(ws + WS_CTL + CTL_COUNTS); int* padstart = (int*)(ws + WS_CTL + CTL_PADSTART); float* mod = (float*)(ws + WS_CTL + CTL_MOD);
    bf16_t* Win_t = (bf16_t*)(ws + WS_WIN); bf16_t* Wout_t = (bf16_t*)(ws + WS_WOUT); bf16_t* Wgu_t = (bf16_t*)(ws + WS_WGU); bf16_t* Wd_t = (bf16_t*)(ws + WS_WD);
    bf16_t* XN = (bf16_t*)(ws + WS_XN); bf16_t* QKV = (bf16_t*)(ws + WS_QKV); bf16_t* AO = (bf16_t*)(ws + WS_AO); bf16_t* H2 = (bf16_t*)(ws + WS_H2);
    int* tope = (int*)(ws + WS_TOPE); int* tops = (int*)(ws + WS_TOPS); float* topg = (float*)(ws + WS_TOPG); int* list = (int*)(ws + WS_LIST);
    bf16_t* ACT = (bf16_t*)(ws + WS_ACT); bf16_t* Y = (bf16_t*)(ws + WS_Y); float* OBN = (float*)(ws + WS_OBN);

    (void)hipMemsetAsync(ws + WS_CTL, 0, 32768, stream);
    MArgs a{};
    a.x = x; a.c = c; a.w_ada = w_ada; a.b_ada = b_ada; a.g1 = g1; a.w_in = w_in; a.gaq = gaq; a.gak = gak; a.gbq = gbq; a.gbk = gbk; a.lq1 = lq1; a.lk1 = lk1; a.lq2 = lq2; a.lk2 = lk2;
    a.gd = gd; a.w_out = w_out; a.g2 = g2; a.w_router = w_router; a.b_router = b_router; a.w_gu = w_gu; a.b_gu = b_gu; a.w_d = w_d; a.b_d = b_d; a.out = out; a.ws = ws;
    a.ph_lo = 0; a.ph_hi = NPHASE; hipLaunchKernelGGL(mega, dim3(grid), dim3(NTHREADS), LDS_BYTES, stream, a);
}
```

```cpp
#include <hip/hip_runtime.h>
#include <cstdio>
#include <cstdint>

typedef unsigned short bf16_t;
typedef short bf16x8 __attribute__((ext_vector_type(8)));
typedef float f32x4 __attribute__((ext_vector_type(4)));
typedef unsigned u32x4 __attribute__((ext_vector_type(4)));
typedef unsigned u32x2 __attribute__((ext_vector_type(2)));

constexpr int D = 1024, NB = 8, S = 2048, M = NB * S;
constexpr int NIN = 3072, NE = 32, TOPK = 4, DFF = 1024;
constexpr int NASSIGN = M * TOPK;
constexpr int PADROWS = NASSIGN + NE * 256;
constexpr float RMS_EPS = 1e-6f;
constexpr float LOG2E = 1.4426950408889634f;
constexpr float QSCALE = 0.125f * LOG2E;
constexpr float LAMBDA_INIT = 0.2f;

constexpr size_t MiB = 1u << 20;
constexpr size_t WS_CTL = 0;
constexpr size_t CTL_BYTES = 1 * MiB;
constexpr size_t CTL_COUNTS = 0;
constexpr size_t CTL_PADSTART = 256;
constexpr size_t CTL_ADACNT = 1024;
constexpr size_t CTL_MOD = 64 * 1024;
constexpr size_t WS_WIN = 2 * MiB;
constexpr size_t WS_WOUT = 8 * MiB;
constexpr size_t WS_WGU = 10 * MiB;
constexpr size_t WS_WD = 138 * MiB;
constexpr size_t WS_XN = 202 * MiB;
constexpr size_t WS_QKV = 234 * MiB;
constexpr size_t WS_AO = 330 * MiB;
constexpr size_t WS_H2 = 362 * MiB;
constexpr size_t WS_TOPE = 394 * MiB;
constexpr size_t WS_TOPS = 395 * MiB;
constexpr size_t WS_TOPG = 396 * MiB;
constexpr size_t WS_LIST = 397 * MiB;
constexpr size_t WS_ACT = 400 * MiB;
constexpr size_t WS_Y = 544 * MiB;
constexpr size_t WS_OBN = 688 * MiB;
constexpr size_t WS_X1 = 752 * MiB;
constexpr size_t WS_MODP = 816 * MiB;
constexpr size_t WS_END = 824 * MiB;

__device__ __forceinline__ bf16_t f2bf(float f) { unsigned u = __float_as_uint(f); return (bf16_t)((u + 0x7fffu + ((u >> 16) & 1u)) >> 16); }
__device__ __forceinline__ float bf2f(bf16_t h) { return __uint_as_float(((unsigned)h) << 16); }
__device__ __forceinline__ unsigned pk2(float lo, float hi) { return (unsigned)f2bf(lo) | ((unsigned)f2bf(hi) << 16); }
__device__ __forceinline__ float wave_sum(float v) {
#pragma unroll
    for (int o = 1; o < 64; o <<= 1) v += __shfl_xor(v, o);
    return v;
}


#define LAS __attribute__((address_space(3)))
#define GAS __attribute__((address_space(1)))
#define RLX_AGENT __ATOMIC_RELAXED, __HIP_MEMORY_SCOPE_AGENT
#define LDS_WAIT() asm volatile("s_waitcnt lgkmcnt(0)" ::: "memory")
#define VM_WAIT() asm volatile("s_waitcnt vmcnt(0)" ::: "memory")

constexpr int NWAVES = 8, NTHREADS = 512;
constexpr int RING_BYTES = 131072, LDSCTL_OFF = RING_BYTES, MISC_OFF = LDSCTL_OFF + 320, PT_OFF = LDSCTL_OFF + 512, CNT_OFF = LDSCTL_OFF + 768, LDS_BYTES = 147456;
constexpr size_t CTL_BAR = 16384;
constexpr int NPHASE = 10;
constexpr float W8_SCALE = 512.f, H2_SCALE = 16.f, ACT_SCALE = 8.f, Y_SCALE = 32.f;

#define XB_TMO      128
#define XB_XCNT(j)  (256  + 64 * (j))
#define XB_XSUB(j)  (1280 + 64 * (j))
#define XB_XGEN(j)  (2304 + 64 * (j))
#define XB_TOP      3328
#define XB_TOPGEN   3392
#define XCD_BAR_WORDS 3456
#define XB_SPIN_CAP (1u << 22)
__device__ __forceinline__ unsigned xb_ld(unsigned* p)              { return __hip_atomic_load(p, __ATOMIC_RELAXED, __HIP_MEMORY_SCOPE_AGENT); }
__device__ __forceinline__ unsigned xb_add(unsigned* p, unsigned v) { return __hip_atomic_fetch_add(p, v, __ATOMIC_RELAXED, __HIP_MEMORY_SCOPE_AGENT); }
__device__ __forceinline__ unsigned xb_xcc_id() { return (unsigned)__builtin_amdgcn_s_getreg((3 << 11) | 20) & 0xFu; }
#define XB_SPIN(cond, bar) do { unsigned _sp = 0; while (cond) { __builtin_amdgcn_s_sleep(1); \
    if ((++_sp & 255u) == 0u) { if (xb_ld(&(bar)[XB_TMO])) break; if (_sp > XB_SPIN_CAP) { atomicAdd(&(bar)[XB_TMO], 1u); break; } } } } while (0)
struct XcdBarrier { unsigned* bar; unsigned x; volatile LAS unsigned* st; };
__device__ __forceinline__ XcdBarrier xcd_barrier_post(unsigned* bar, volatile LAS unsigned* st) {
    XcdBarrier b; b.bar = bar; b.x = xb_xcc_id(); b.st = st;
    if (threadIdx.x == 0) (void)xb_add(&bar[XB_XCNT(b.x)], 1u);
    return b;
}
__device__ __forceinline__ void xcd_barrier_complete(unsigned* bar, unsigned x, unsigned& nloc, unsigned& nx) {
    const unsigned G = gridDim.x * gridDim.y * gridDim.z;
    unsigned sum, cnt, mine, sp = 0u;
    for (;;) {
        sum = 0u; cnt = 0u; mine = 0u;
#pragma unroll
        for (unsigned j = 0; j < 16; ++j) { const unsigned c = xb_ld(&bar[XB_XCNT(j)]); sum += c; cnt += (c > 0u) ? 1u : 0u; mine = (j == x) ? c : mine; }
        if (sum == G) break;
        __builtin_amdgcn_s_sleep(1);
        if ((++sp & 255u) == 0u) { if (xb_ld(&bar[XB_TMO])) break; if (sp > XB_SPIN_CAP) { atomicAdd(&bar[XB_TMO], 1u); break; } }
    }
    nloc = mine > 0u ? mine : 1u; nx = cnt > 0u ? cnt : 1u;
}
__device__ __forceinline__ void xcd_barrier(const XcdBarrier& b, int wave) {
    asm volatile("s_waitcnt vmcnt(0)" ::: "memory");
    __syncthreads();
    if (wave == 0 && __builtin_amdgcn_mbcnt_hi(~0u, __builtin_amdgcn_mbcnt_lo(~0u, 0u)) == 0u) {
        unsigned* bar = b.bar;
        __builtin_amdgcn_s_waitcnt(0);
        unsigned nloc = b.st[0], nx = b.st[1];
        if (nloc == 0u) { xcd_barrier_complete(bar, b.x, nloc, nx); b.st[0] = nloc; b.st[1] = nx; }
        const unsigned old = xb_add(&bar[XB_XSUB(b.x)], 1u);
        const unsigned gen = old / nloc;
        if (old + 1u == (gen + 1u) * nloc) {
            __builtin_amdgcn_fence(__ATOMIC_RELEASE, "agent");
            asm volatile("s_waitcnt vmcnt(0)" ::: "memory");
            const unsigned og = xb_add(&bar[XB_TOP], 1u);
            const unsigned tg = og / nx;
            if (og + 1u == (tg + 1u) * nx) xb_add(&bar[XB_TOPGEN], 1u);
            else XB_SPIN(xb_ld(&bar[XB_TOPGEN]) == tg, bar);
            __builtin_amdgcn_fence(__ATOMIC_ACQUIRE, "agent");
            xb_add(&bar[XB_XGEN(b.x)], 1u);
            asm volatile("s_waitcnt vmcnt(0)" ::: "memory");
        } else {
            XB_SPIN(xb_ld(&bar[XB_XGEN(b.x)]) == gen, bar);
            __builtin_amdgcn_fence(__ATOMIC_ACQUIRE, "agent");
            asm volatile("s_waitcnt vmcnt(0)" ::: "memory");
        }
    }
    __syncthreads();
}

namespace pg8 {
constexpr int BM = 256, BK = 64, HALF = 128, HTB = HALF * BK * 2, STAGE_BYTES = 8 * HTB, NXCD = 8, WGM = 8;
__host__ __device__ __forceinline__ int lds_byte(int r, int c) { const int st = (r >> 4) * 2 + (c >> 5), rr = r & 15, cc = c & 31, ob = rr * 64 + cc * 2; return st * 1024 + (ob ^ (((ob >> 9) & 1) << 5)); }
__host__ __device__ __forceinline__ void stage_rc(int b, int& R, int& C) { const int st = b / 1024, sb = b % 1024, swz = sb ^ (((sb >> 9) & 1) << 5); R = (st >> 1) * 16 + swz / 64; C = (st & 1) * 32 + (swz % 64) / 2; }
constexpr __host__ __device__ __forceinline__ int perm32(int rho) { const int n = rho >> 4, i = rho & 15; return 8 * (i >> 2) + 4 * n + (i & 3); }
__device__ __forceinline__ unsigned cvt_pk_bf16(float lo, float hi) { unsigned r; asm volatile("v_cvt_pk_bf16_f32 %0, %1, %2" : "=v"(r) : "v"(lo), "v"(hi)); return r; }

typedef int v4i_t __attribute__((ext_vector_type(4))); typedef int v8i_t __attribute__((ext_vector_type(8)));
__device__ __forceinline__ v8i_t cat8(bf16x8 lo, bf16x8 hi) { const v4i_t a = __builtin_bit_cast(v4i_t, lo), b = __builtin_bit_cast(v4i_t, hi); return __builtin_shufflevector(a, b, 0, 1, 2, 3, 4, 5, 6, 7); }
__device__ __forceinline__ unsigned pk4_fp8(float a, float b, float c, float d) { int w = 0; w = __builtin_amdgcn_cvt_pk_fp8_f32(a, b, w, false); w = __builtin_amdgcn_cvt_pk_fp8_f32(c, d, w, true); return (unsigned)w; }
struct Unit { int pm, pn, e, cnt; };

template <class P>
__device__ __forceinline__ void gemm_phase(LAS unsigned char* lds, const P& p, int wid) {
    int lane = (int)__builtin_amdgcn_mbcnt_hi(~0u, __builtin_amdgcn_mbcnt_lo(~0u, 0u)); asm volatile("" : "+v"(lane));
    const int tid = wid * 64 + lane, wr = wid >> 2, wc = wid & 3, fr = lane & 15, fq = lane >> 4;
    constexpr int K = P::K, nt = K / BK;
    int Rr[2], Cc[2];
#pragma unroll
    for (int i = 0; i < 2; ++i) stage_rc(tid * 16 + i * 8192, Rr[i], Cc[i]);
    unsigned voffB[2], voffA[2][2];
#pragma unroll
    for (int i = 0; i < 2; ++i) { voffB[i] = (unsigned)(P::brow(0, Rr[i]) * K + Cc[i]) * 2u; voffA[0][i] = (unsigned)(Rr[i] * K + Cc[i]) * 2u; voffA[1][i] = voffA[0][i]; }
    constexpr size_t hB = (size_t)(P::brow(1, 0) - P::brow(0, 0)) * K * 2, hA = P::GATHER ? 0 : (size_t)HALF * K * 2;
    LAS unsigned* vpark = (LAS unsigned*)(lds + STAGE_BYTES + 4096) + tid * 4;
    const size_t kstep = (size_t)(BK * 2);
    const unsigned ldsw = (unsigned)wid * 1024u;
    const int aoff = lds_byte(wr * 64 + fr, fq * 8), boff = lds_byte(wc * 32 + fr, fq * 8);
#define PG8_SA(b, h) (((b) * 2 + (h)) * HTB)
#define PG8_SB(b, h) ((4 + (b) * 2 + (h)) * HTB)
#define PG8_STAGE(bufoff, gbase, voff) do { _Pragma("unroll") for (int _i = 0; _i < 2; ++_i) { unsigned _v = (voff)[_i]; asm volatile("" : "+v"(_v));     \
        __builtin_amdgcn_global_load_lds((const unsigned*)((const char*)(gbase) + _v), (LAS unsigned*)(lds + (bufoff) + ldsw + _i * 8192), 16, 0, 0); } } while (0)
#define PG8_STAGE_A(b, h, gbase) PG8_STAGE(PG8_SA(b, h), (gbase) + (h) * hA, voffA[P::GATHER ? (h) : 0])
#define PG8_STAGE_B(b, h, gbase) PG8_STAGE(PG8_SB(b, h), (gbase) + (h) * hB, voffB)
#define PG8_LDA(dst, b, h) do { _Pragma("unroll") for (int m = 0; m < 4; ++m) _Pragma("unroll") for (int k = 0; k < 2; ++k) dst[m][k] = *(const LAS bf16x8*)(lds + PG8_SA(b, h) + aoff + m * 2048 + k * 1024); } while (0)
#define PG8_LDB(dst, b, h) do { _Pragma("unroll") for (int n = 0; n < 2; ++n) _Pragma("unroll") for (int k = 0; k < 2; ++k) dst[n][k] = *(const LAS bf16x8*)(lds + PG8_SB(b, h) + boff + n * 2048 + k * 1024); } while (0)
#define PG8_MMA(ai, bj, At, Bt) do { __builtin_amdgcn_s_setprio(1); if constexpr (P::FP8) { _Pragma("unroll") for (int m = 0; m < 4; ++m) _Pragma("unroll") for (int n = 0; n < 2; ++n) \
        { const v8i_t b8_ = cat8(Bt[n][0], Bt[n][1]), a8_ = cat8(At[m][0], At[m][1]); \
          asm volatile("v_mfma_scale_f32_16x16x128_f8f6f4 %0, %1, %2, %0, %3, %3 op_sel_hi:[0,0,0]" : "+v"(acc[ai][bj][m][n]) : "v"(b8_), "v"(a8_), "v"(sc1_)); } } else { \
        _Pragma("unroll") for (int m = 0; m < 4; ++m) _Pragma("unroll") for (int n = 0; n < 2; ++n) _Pragma("unroll") for (int k = 0; k < 2; ++k) \
        acc[ai][bj][m][n] = __builtin_amdgcn_mfma_f32_16x16x32_bf16(Bt[n][k], At[m][k], acc[ai][bj][m][n], 0, 0, 0); } __builtin_amdgcn_s_setprio(0); } while (0)
#define PG8_WAIT_V(n) asm volatile("s_waitcnt vmcnt(" #n ")" ::: "memory")
#define PG8_WAIT_L(n) asm volatile("s_waitcnt lgkmcnt(" #n ")" ::: "memory")
#define PG8_BAR __builtin_amdgcn_s_barrier()
#define PG8_SCHED __builtin_amdgcn_sched_barrier(0)
    const int sc1_ = 0x7f7f7f7f;
    Unit cur, nxt; int ui = 0;
    if (!p.next(0, cur)) return;
    f32x4 acc[2][2][4][2];
#pragma unroll
    for (int a = 0; a < 2; ++a)
#pragma unroll
        for (int b = 0; b < 2; ++b)
#pragma unroll
            for (int m = 0; m < 4; ++m)
#pragma unroll
                for (int n = 0; n < 2; ++n) acc[a][b][m][n] = (f32x4){0.f, 0.f, 0.f, 0.f};
    bf16x8 At[4][2], B0[2][2], B1[2][2];
    const char* cA = p.a_base(cur); const char* cB = p.b_base(cur);
    if constexpr (P::GATHER) p.a_offsets(cur, Rr, Cc, voffA);
    PG8_STAGE_B(0, 0, cB); PG8_STAGE_B(0, 1, cB); PG8_STAGE_A(0, 0, cA); PG8_STAGE_A(0, 1, cA);
    if (wr == 1) PG8_BAR;
    PG8_WAIT_V(2); PG8_BAR;
    PG8_STAGE_B(1, 0, cB + kstep); PG8_STAGE_A(1, 0, cA + kstep); PG8_STAGE_B(1, 1, cB + kstep);
    PG8_WAIT_V(6); PG8_BAR;
    for (;;) {
        const bool has_next = p.next(ui + 1, nxt);
        const char* nA = has_next ? p.a_base(nxt) : cA; const char* nB = has_next ? p.b_base(nxt) : cB;
        if constexpr (P::GATHER) {
            unsigned vn[2][2];
            if (has_next) p.a_offsets(nxt, Rr, Cc, vn); else {
#pragma unroll
                for (int h = 0; h < 2; ++h)
#pragma unroll
                    for (int i = 0; i < 2; ++i) vn[h][i] = voffA[h][i]; }
            vpark[0] = vn[0][0]; vpark[1] = vn[0][1]; vpark[2] = vn[1][0]; vpark[3] = vn[1][1];
        }
#pragma nounroll
        for (int t = 0; t < nt; t += 2) {
            const bool last = (t == nt - 2);
            const char* a1 = cA + (size_t)(t + 1) * kstep;
            const char* a2 = last ? nA : cA + (size_t)(t + 2) * kstep; const char* b2 = last ? nB : cB + (size_t)(t + 2) * kstep;
            const char* a3 = a2 + kstep; const char* b3 = b2 + kstep;
            PG8_LDB(B0, 0, 0); PG8_LDB(B1, 0, 1); PG8_SCHED; PG8_LDA(At, 0, 0); PG8_STAGE_A(1, 1, a1);
            if constexpr (P::GATHER) { if (last) { voffA[0][0] = vpark[0]; voffA[0][1] = vpark[1]; voffA[1][0] = vpark[2]; voffA[1][1] = vpark[3]; } }
            PG8_WAIT_V(8); PG8_WAIT_L(0); PG8_BAR; PG8_MMA(0, 0, At, B0); PG8_MMA(0, 1, At, B1); PG8_BAR; PG8_SCHED;
            PG8_LDA(At, 0, 1); PG8_STAGE_B(0, 0, b2); PG8_STAGE_B(0, 1, b2); PG8_STAGE_A(0, 0, a2);
            PG8_WAIT_V(8); PG8_WAIT_L(0); PG8_BAR; PG8_MMA(1, 0, At, B0); PG8_MMA(1, 1, At, B1); PG8_BAR; PG8_SCHED;
            PG8_LDB(B0, 1, 0); PG8_LDB(B1, 1, 1); PG8_SCHED; PG8_LDA(At, 1, 0); PG8_STAGE_A(0, 1, a2);
            PG8_WAIT_V(8); PG8_WAIT_L(0); PG8_BAR; PG8_MMA(0, 0, At, B0); PG8_MMA(0, 1, At, B1); PG8_BAR; PG8_SCHED;
            PG8_LDA(At, 1, 1); PG8_STAGE_B(1, 0, b3); PG8_STAGE_B(1, 1, b3); PG8_STAGE_A(1, 0, a3);
            PG8_WAIT_V(8); PG8_WAIT_L(0); PG8_BAR; PG8_MMA(1, 0, At, B0); PG8_MMA(1, 1, At, B1); PG8_BAR; PG8_SCHED;
        }
        if (wr == 0) PG8_BAR;
        if constexpr (P::FP8) asm volatile("s_nop 15\n\ts_nop 15" ::: "memory");
        p.epi(acc, cur, wr, wc, fr, fq);
        if (!has_next) break;
#pragma unroll
        for (int a = 0; a < 2; ++a)
#pragma unroll
            for (int b = 0; b < 2; ++b)
#pragma unroll
                for (int m = 0; m < 4; ++m)
#pragma unroll
                    for (int n = 0; n < 2; ++n) acc[a][b][m][n] = (f32x4){0.f, 0.f, 0.f, 0.f};
        cur = nxt; cA = nA; cB = nB; ++ui;
        if (wr == 1) PG8_BAR;
    }
    PG8_WAIT_V(0);
    PG8_BAR;
#undef PG8_SA
#undef PG8_SB
#undef PG8_STAGE
#undef PG8_STAGE_A
#undef PG8_STAGE_B
#undef PG8_LDA
#undef PG8_LDB
#undef PG8_MMA
#undef PG8_WAIT_V
#undef PG8_WAIT_L
#undef PG8_BAR
#undef PG8_SCHED
}

struct DenseOrder {
    int nM, nN, nwg, G, c;
    __device__ void init(int M_, int N_, int G_, int c_) { nM = M_ / BM; nN = N_ / BM; nwg = nM * nN; G = G_; c = c_; }
    __device__ bool next(int i, Unit& u) const {
        const long L = (long)i * G + c; if (L >= nwg) return false;
        int wgid = (int)L; { const int q = nwg / NXCD, r = nwg % NXCD, xcd = wgid % NXCD, off = wgid / NXCD; wgid = (xcd < r ? xcd * (q + 1) : r * (q + 1) + (xcd - r) * q) + off; }
        const int nig = WGM * nN, gid = wgid / nig, fm = gid * WGM, gsz = (nM - fm) < WGM ? (nM - fm) : WGM;
        u.pm = fm + ((wgid % nig) % gsz); u.pn = (wgid % nig) / gsz; u.e = 0; u.cnt = 0; return true;
    }
};
struct GroupOrder {
    const LAS int* pt; const LAS int* cn; LAS int* ul; int npn, total, G, c;
    __device__ void init(const LAS int* pt_, const LAS int* cn_, LAS int* ul_, int npn_, int G_, int c_) { pt = pt_; cn = cn_; ul = ul_; npn = npn_; total = __builtin_amdgcn_readfirstlane(pt_[NE] * npn_); G = G_; c = c_; }
    __device__ void build(int wave, int lane) const {
        if (wave == 0 && lane < 16) {
            const long L = (long)lane * G + c; int pm = -1, pn = 0, e = 0, cnt = 0;
            if (L < total) {
                int wgid = (int)L; { const int q = total / NXCD, r = total % NXCD, xcd = wgid % NXCD, off = wgid / NXCD; wgid = (xcd < r ? xcd * (q + 1) : r * (q + 1) + (xcd - r) * q) + off; }
                for (int j = 1; j < NE; ++j) e += (pt[j] * npn <= wgid) ? 1 : 0;
                const int t0 = pt[e], te = pt[e + 1] - t0, local = wgid - t0 * npn, mt = local % te;
                pn = local / te; pm = t0 + mt; cnt = cn[e] - mt * 256;
            }
            ul[lane * 4 + 0] = pm; ul[lane * 4 + 1] = pn; ul[lane * 4 + 2] = e; ul[lane * 4 + 3] = cnt;
        }
    }
    __device__ bool next(int i, Unit& u) const {
        if (i >= 16) return false;
        u.pm = __builtin_amdgcn_readfirstlane(ul[i * 4 + 0]); u.pn = __builtin_amdgcn_readfirstlane(ul[i * 4 + 1]);
        u.e = __builtin_amdgcn_readfirstlane(ul[i * 4 + 2]); u.cnt = __builtin_amdgcn_readfirstlane(ul[i * 4 + 3]);
        return u.pm >= 0;
    }
};
}

struct PInProj : pg8::DenseOrder {
    static constexpr int K = 1024; static constexpr bool GATHER = false, FP8 = false;
    const bf16_t* XN; const bf16_t* Wt; bf16_t* QKV; const float *gaq, *gak, *gbq, *gbk;
    static constexpr __host__ __device__ __forceinline__ int brow(int bj, int R) { return 64 * (R >> 5) + 32 * bj + pg8::perm32(R & 31); }
    __device__ __forceinline__ const char* a_base(const pg8::Unit& u) const { return (const char*)(XN + (size_t)u.pm * 256 * K); }
    __device__ __forceinline__ const char* b_base(const pg8::Unit& u) const { return (const char*)(Wt + (size_t)u.pn * 256 * K); }
    __device__ __forceinline__ void epi(const f32x4 (&acc)[2][2][4][2], const pg8::Unit& u, int wr, int wc, int fr, int fq) const {
        constexpr float ISC = 1.f;
        const int ty = u.pn >> 1;
        const float* g = (ty == 0) ? gaq : (ty == 1) ? gak : (ty == 3) ? gbq : (ty == 4) ? gbk : nullptr;
        const float post = (ty == 0 || ty == 3) ? QSCALE : 1.f;
        const int row0 = u.pm * 256 + wr * 64 + fr, col0 = u.pn * 256 + wc * 64 + 8 * fq;
        f32x4 gv[2][2];
#pragma unroll
        for (int bj = 0; bj < 2; ++bj)
#pragma unroll
            for (int n = 0; n < 2; ++n) gv[bj][n] = g ? *(const f32x4*)(g + 32 * bj + 8 * fq + 4 * n) : (f32x4){1.f, 1.f, 1.f, 1.f};
#pragma unroll
        for (int ai = 0; ai < 2; ++ai)
#pragma unroll
            for (int m = 0; m < 4; ++m) {
                float rs = 1.f;
                if (g) {
                    float ss = 0.f;
#pragma unroll
                    for (int bj = 0; bj < 2; ++bj)
#pragma unroll
                        for (int n = 0; n < 2; ++n) { const f32x4 v = acc[ai][bj][m][n] * ISC; ss += (v[0] * v[0] + v[1] * v[1]) + (v[2] * v[2] + v[3] * v[3]); }
                    ss += __shfl_xor(ss, 16); ss += __shfl_xor(ss, 32);
                    rs = rsqrtf(ss * (1.f / 64.f) + RMS_EPS) * post;
                }
                bf16_t* rowp = QKV + (size_t)(row0 + ai * 128 + m * 16) * NIN + col0;
#pragma unroll
                for (int bj = 0; bj < 2; ++bj) {
                    const f32x4 v0 = acc[ai][bj][m][0] * gv[bj][0] * (rs * ISC), v1 = acc[ai][bj][m][1] * gv[bj][1] * (rs * ISC);
                    u32x4 w; w.x = pg8::cvt_pk_bf16(v0[0], v0[1]); w.y = pg8::cvt_pk_bf16(v0[2], v0[3]); w.z = pg8::cvt_pk_bf16(v1[0], v1[1]); w.w = pg8::cvt_pk_bf16(v1[2], v1[3]);
                    *(u32x4*)(rowp + 32 * bj) = w;
                }
            }
    }
};
struct POutProj : pg8::DenseOrder {
    static constexpr int K = 1024; static constexpr bool GATHER = false, FP8 = false;
    const bf16_t* AO; const bf16_t* Wt; const float* x; const float* mod; bf16_t* x1;
    static constexpr __host__ __device__ __forceinline__ int brow(int bj, int R) { return 128 * bj + (R & ~31) + pg8::perm32(R & 31); }
    __device__ __forceinline__ const char* a_base(const pg8::Unit& u) const { return (const char*)(AO + (size_t)u.pm * 256 * K); }
    __device__ __forceinline__ const char* b_base(const pg8::Unit& u) const { return (const char*)(Wt + (size_t)u.pn * 256 * K); }
    __device__ __forceinline__ void epi(const f32x4 (&acc)[2][2][4][2], const pg8::Unit& u, int wr, int wc, int fr, int fq) const {
        const int row0 = u.pm * 256 + wr * 64 + fr, col0 = u.pn * 256 + wc * 32 + 8 * fq;
        const float* gate1 = mod + ((u.pm * 256) / S) * 6144 + 2048 + col0;
        f32x4 gv[2][2];
#pragma unroll
        for (int bj = 0; bj < 2; ++bj)
#pragma unroll
            for (int n = 0; n < 2; ++n) gv[bj][n] = *(const f32x4*)(gate1 + bj * 128 + 4 * n);
#pragma unroll
        for (int ai = 0; ai < 2; ++ai)
#pragma unroll
            for (int m = 0; m < 4; ++m) { const size_t off = (size_t)(row0 + ai * 128 + m * 16) * D + col0;
#pragma unroll
                for (int bj = 0; bj < 2; ++bj) {
                    const f32x4 xa = __builtin_nontemporal_load((const f32x4*)(x + off + bj * 128)), xb = __builtin_nontemporal_load((const f32x4*)(x + off + bj * 128 + 4));
                    const f32x4 v0 = xa + gv[bj][0] * acc[ai][bj][m][0], v1 = xb + gv[bj][1] * acc[ai][bj][m][1];
                    u32x4 w; w.x = pg8::cvt_pk_bf16(v0[0], v0[1]); w.y = pg8::cvt_pk_bf16(v0[2], v0[3]); w.z = pg8::cvt_pk_bf16(v1[0], v1[1]); w.w = pg8::cvt_pk_bf16(v1[2], v1[3]);
                    *(u32x4*)(x1 + off + bj * 128) = w; }
                if (m & 1) asm volatile("" ::: "memory"); }
    }
};
struct PGateUp : pg8::GroupOrder {
    static constexpr int K = 512; static constexpr bool GATHER = true, FP8 = true;
    const bf16_t* H2; const bf16_t* Wt; const float* bgu; const int* list; bf16_t* ACT;
    static constexpr __host__ __device__ __forceinline__ int brow(int bj, int R) { return 1024 * bj + (R & ~31) + pg8::perm32(R & 31); }
    __device__ __forceinline__ const char* a_base(const pg8::Unit&) const { return (const char*)H2; }
    __device__ __forceinline__ const char* b_base(const pg8::Unit& u) const { return (const char*)(Wt + ((size_t)u.e * 2048 + u.pn * 128) * K); }
    __device__ __forceinline__ void a_offsets(const pg8::Unit& u, const int (&R)[2], const int (&C)[2], unsigned (&voff)[2][2]) const {
        const int* lp = list + (size_t)u.e * M + (size_t)(u.pm - pt[u.e]) * 256;
#pragma unroll
        for (int h = 0; h < 2; ++h)
#pragma unroll
            for (int i = 0; i < 2; ++i) { int r = h * 128 + R[i]; r = r < u.cnt ? r : 0; const int tok = lp[r]; voff[h][i] = (unsigned)(tok * K + C[i]) * 2u; }
    }
    __device__ __forceinline__ void epi(const f32x4 (&acc)[2][2][4][2], const pg8::Unit& u, int wr, int wc, int fr, int fq) const {
        const int row0 = u.pm * 256 + wr * 64 + fr, col0 = u.pn * 128 + wc * 32 + 8 * fq;
        const float* bias = bgu + u.e * 2048 + col0;
        f32x4 bg[2], bu[2];
#pragma unroll
        for (int n = 0; n < 2; ++n) { bg[n] = *(const f32x4*)(bias + 4 * n); bu[n] = (*(const f32x4*)(bias + 1024 + 4 * n) + 1.f) * ACT_SCALE; }
#pragma unroll
        for (int ai = 0; ai < 2; ++ai)
#pragma unroll
            for (int m = 0; m < 4; ++m) {
                float a[2][4];
#pragma unroll
                for (int n = 0; n < 2; ++n)
#pragma unroll
                    for (int r = 0; r < 4; ++r) {
                        const float g = fminf(__builtin_fmaf(acc[ai][0][m][n][r], 1.f / (H2_SCALE * W8_SCALE), bg[n][r]), 7.f);
                        const float u8 = __builtin_amdgcn_fmed3f(__builtin_fmaf(acc[ai][1][m][n][r], ACT_SCALE / (H2_SCALE * W8_SCALE), bu[n][r]), -6.f * ACT_SCALE, 8.f * ACT_SCALE);
                        a[n][r] = u8 * (g * __builtin_amdgcn_rcpf(1.f + __builtin_amdgcn_exp2f(-1.702f * LOG2E * g)));
                    }
                u32x2 w; w.x = pg8::pk4_fp8(a[0][0], a[0][1], a[0][2], a[0][3]); w.y = pg8::pk4_fp8(a[1][0], a[1][1], a[1][2], a[1][3]);
                *(u32x2*)((unsigned char*)ACT + (size_t)(row0 + ai * 128 + m * 16) * DFF + col0) = w;
            }
    }
};
struct PDown : pg8::GroupOrder {
    static constexpr int K = 512; static constexpr bool GATHER = false, FP8 = true;
    const bf16_t* ACT; const bf16_t* Wt; const float* bd; bf16_t* Y;
    static constexpr __host__ __device__ __forceinline__ int brow(int bj, int R) { return 128 * bj + (R & ~31) + pg8::perm32(R & 31); }
    __device__ __forceinline__ const char* a_base(const pg8::Unit& u) const { return (const char*)(ACT + (size_t)u.pm * 256 * K); }
    __device__ __forceinline__ const char* b_base(const pg8::Unit& u) const { return (const char*)(Wt + ((size_t)u.e * 1024 + u.pn * 256) * K); }
    __device__ __forceinline__ void epi(const f32x4 (&acc)[2][2][4][2], const pg8::Unit& u, int wr, int wc, int fr, int fq) const {
        const int row0 = u.pm * 256 + wr * 64 + fr, col0 = u.pn * 256 + wc * 32 + 8 * fq;
        const float* bias = bd + u.e * 1024 + col0;
        f32x4 bv[2][2];
#pragma unroll
        for (int bj = 0; bj < 2; ++bj)
#pragma unroll
            for (int n = 0; n < 2; ++n) bv[bj][n] = *(const f32x4*)(bias + bj * 128 + 4 * n) * Y_SCALE;
#pragma unroll
        for (int ai = 0; ai < 2; ++ai)
#pragma unroll
            for (int m = 0; m < 4; ++m) { unsigned char* rowp = (unsigned char*)Y + (size_t)(row0 + ai * 128 + m * 16) * D + col0;
#pragma unroll
                for (int bj = 0; bj < 2; ++bj) { f32x4 v0, v1;
#pragma unroll
                    for (int q_ = 0; q_ < 4; ++q_) { v0[q_] = __builtin_amdgcn_fmed3f(__builtin_fmaf(acc[ai][bj][m][0][q_], Y_SCALE / (ACT_SCALE * W8_SCALE), bv[bj][0][q_]), -448.f, 448.f);
                                                     v1[q_] = __builtin_amdgcn_fmed3f(__builtin_fmaf(acc[ai][bj][m][1][q_], Y_SCALE / (ACT_SCALE * W8_SCALE), bv[bj][1][q_]), -448.f, 448.f); }
                    u32x2 w; w.x = pg8::pk4_fp8(v0[0], v0[1], v0[2], v0[3]); w.y = pg8::pk4_fp8(v1[0], v1[1], v1[2], v1[3]);
                    *(u32x2*)(rowp + bj * 128) = w; } }
    }
};


namespace att {
typedef float f32x16 __attribute__((ext_vector_type(16)));
typedef short s16x4 __attribute__((ext_vector_type(4)));
typedef short v4i16_t __attribute__((ext_vector_type(4)));
typedef float f32x2_t __attribute__((ext_vector_type(2))); typedef __bf16 bf16x2_t __attribute__((ext_vector_type(2)));
__device__ __forceinline__ unsigned cvtpk(float lo, float hi) { f32x2_t v = {lo, hi}; bf16x2_t b = __builtin_convertvector(v, bf16x2_t); return __builtin_bit_cast(unsigned, b); }
__device__ __forceinline__ s16x4 vtr(const LAS unsigned char* p) { return __builtin_bit_cast(s16x4, __builtin_amdgcn_ds_read_tr16_b64_v4i16((LAS v4i16_t*)p)); }
__device__ __forceinline__ void glds16(const void* gsrc, LAS unsigned char* dst) { __builtin_amdgcn_global_load_lds((const unsigned*)gsrc, (LAS unsigned*)dst, 16, 0, 0); }
#define ATT_CR(r) (((r) & 3) + 8 * ((r) >> 2))
#define ATT_WAIT_V(n) asm volatile("s_waitcnt vmcnt(" #n ")" ::: "memory")
#define ATT_WAIT_L0() asm volatile("s_waitcnt lgkmcnt(0)" ::: "memory")

template <int MODE> __device__ __forceinline__ float soft_tile(f32x16& p0, f32x16& p1, float sl, int dqh) {
    float sum = 0.f;
#pragma unroll
    for (int r = 0; r < 16; ++r) {
        float x0 = __builtin_fmaf(sl, (float)ATT_CR(r), p0[r]), x1 = __builtin_fmaf(sl, (float)(ATT_CR(r) + 32), p1[r]);
        if (MODE == 1) { x0 = (ATT_CR(r) <= dqh) ? x0 : -INFINITY; x1 = (ATT_CR(r) + 32 <= dqh) ? x1 : -INFINITY; }
        if (MODE == 2) { x0 = ((unsigned)(dqh - ATT_CR(r)) <= 128u) ? x0 : -INFINITY; x1 = ((unsigned)(dqh - ATT_CR(r) - 32) <= 128u) ? x1 : -INFINITY; }
        p0[r] = __builtin_amdgcn_exp2f(x0); p1[r] = __builtin_amdgcn_exp2f(x1);
        sum += p0[r] + p1[r];
    }
    return sum;
}
__device__ __forceinline__ void pack_p(const f32x16& p0, const f32x16& p1, bf16x8 (&pa)[4]) {
    u32x4 w0 = {cvtpk(p0[0], p0[1]), cvtpk(p0[2], p0[3]), cvtpk(p0[4], p0[5]), cvtpk(p0[6], p0[7])};
    u32x4 w1 = {cvtpk(p0[8], p0[9]), cvtpk(p0[10], p0[11]), cvtpk(p0[12], p0[13]), cvtpk(p0[14], p0[15])};
    u32x4 w2 = {cvtpk(p1[0], p1[1]), cvtpk(p1[2], p1[3]), cvtpk(p1[4], p1[5]), cvtpk(p1[6], p1[7])};
    u32x4 w3 = {cvtpk(p1[8], p1[9]), cvtpk(p1[10], p1[11]), cvtpk(p1[12], p1[13]), cvtpk(p1[14], p1[15])};
    pa[0] = __builtin_bit_cast(bf16x8, w0); pa[1] = __builtin_bit_cast(bf16x8, w1); pa[2] = __builtin_bit_cast(bf16x8, w2); pa[3] = __builtin_bit_cast(bf16x8, w3);
}
template <int NDB> __device__ __forceinline__ void pv_tile(f32x16 (&o)[NDB], const LAS unsigned char* vrd, const bf16x8 (&pa)[4]) {
#pragma unroll
    for (int db = 0; db < NDB; ++db) {
        s16x4 lo[4], hh[4];
#pragma unroll
        for (int g = 0; g < 4; ++g) { lo[g] = vtr(vrd + db * 4096 + g * 1024); hh[g] = vtr(vrd + db * 4096 + g * 1024 + 512); }
#pragma unroll
        for (int g = 0; g < 4; ++g) { const bf16x8 vf = {lo[g][0], lo[g][1], lo[g][2], lo[g][3], hh[g][0], hh[g][1], hh[g][2], hh[g][3]};
            o[db] = __builtin_amdgcn_mfma_f32_32x32x16_bf16(pa[g], vf, o[db], 0, 0, 0); }
    }
}
__device__ __forceinline__ float gain_bound(const float* ga, const float* gb, int lane) {
    float a = fabsf(ga[lane & 63]), b = fabsf(gb[lane & 63]);
#pragma unroll
    for (int o = 1; o < 64; o <<= 1) { a = fmaxf(a, __shfl_xor(a, o)); b = fmaxf(b, __shfl_xor(b, o)); }
    return QSCALE * 64.f * a * b * 1.02f + 0.25f;
}

constexpr int B2_SLOT = 32768;
__device__ __forceinline__ void attn_b2_unit(LAS unsigned char* lds, LAS float* wsf, const bf16_t* QKV, bf16_t* AO, const float* gd, int b, int h, int qb, float Mb, float lam, int wave, int lane) {
    const int r32 = lane & 31, hi = lane >> 5;
    const int c = wave >> 2, wq = wave & 3;
    const int q0 = qb * 128, tq = q0 + wq * 32 + r32;
    const size_t rowbase = (size_t)b * S;
    const bf16_t* Qp = QKV + (rowbase + tq) * NIN + 1536 + h * 128 + c * 64;
    const bf16_t* Kh = QKV + rowbase * NIN + 2048 + h * 128;
    const bf16_t* Vh = QKV + rowbase * NIN + 2560 + h * 128;
    const float sl = exp2f(-2.f * (float)(h + 1)) * LOG2E;
    bf16x8 qr[4];
#pragma unroll
    for (int d0 = 0; d0 < 4; ++d0) qr[d0] = *(const bf16x8*)(Qp + d0 * 16 + hi * 8);
    const int NT = (q0 + 128) / 64;
    const bf16_t* ksrc = Kh + (size_t)lane * NIN + wave * 8;
    const int i0 = wave, i1 = wave + 8;
    const bf16_t* vsrc0 = Vh + (size_t)(16 * (i0 & 3) + (lane >> 2)) * NIN + (i0 >> 2) * 32 + (lane & 3) * 8;
    const bf16_t* vsrc1 = Vh + (size_t)(16 * (i1 & 3) + (lane >> 2)) * NIN + (i1 >> 2) * 32 + (lane & 3) * 8;
#define ATT_DMA(t, s) do { const size_t to_ = (size_t)(t) * 64 * NIN; LAS unsigned char* sb_ = lds + (s) * B2_SLOT; \
        glds16(ksrc + to_, sb_ + wave * 1024); glds16(ksrc + 64 + to_, sb_ + 8192 + wave * 1024); glds16(vsrc0 + to_, sb_ + 16384 + i0 * 1024); glds16(vsrc1 + to_, sb_ + 16384 + i1 * 1024); } while (0)
    const int kfo = c * 8192 + hi * 1024 + r32 * 16;
    const int vro = 16384 + ((lane >> 4) & 1) * 32 + (lane & 3) * 8 + (4 * hi + ((lane & 15) >> 2)) * 64;
    f32x16 o[4]; float lsum = 0.f;
#pragma unroll
    for (int d = 0; d < 4; ++d) o[d] = f32x16{};
    ATT_WAIT_L0(); __builtin_amdgcn_s_barrier();
    ATT_DMA(0, 0); ATT_DMA(1, 1);
    const int qmax_w = q0 + wq * 32 + 31, qmin_w = q0 + wq * 32;
    int slot = 0;
    for (int t = 0; t < NT; ++t) {
        if (t + 1 < NT) ATT_WAIT_V(4); else ATT_WAIT_V(0);
        ATT_WAIT_L0(); __builtin_amdgcn_s_barrier();
        if (t + 2 < NT) { const int s2 = (slot >= 1) ? slot - 1 : 2; ATT_DMA(t + 2, s2); }
        const int k0 = 64 * t;
        if (k0 <= qmax_w) {
            const LAS unsigned char* sb = lds + slot * B2_SLOT;
            bf16x8 kf[8];
#pragma unroll
            for (int d0 = 0; d0 < 4; ++d0) { kf[2 * d0] = *(const LAS bf16x8*)(sb + kfo + d0 * 2048); kf[2 * d0 + 1] = *(const LAS bf16x8*)(sb + kfo + d0 * 2048 + 512); }
            const int dqh = tq - k0 - 4 * hi;
            const float ci = -sl * (float)dqh - Mb;
            f32x16 p0, p1;
#pragma unroll
            for (int r = 0; r < 16; ++r) { p0[r] = ci; p1[r] = ci; }
#pragma unroll
            for (int d0 = 0; d0 < 4; ++d0) { p0 = __builtin_amdgcn_mfma_f32_32x32x16_bf16(kf[2 * d0], qr[d0], p0, 0, 0, 0); p1 = __builtin_amdgcn_mfma_f32_32x32x16_bf16(kf[2 * d0 + 1], qr[d0], p1, 0, 0, 0); }
            if (k0 + 63 <= qmin_w) lsum += soft_tile<0>(p0, p1, sl, dqh); else lsum += soft_tile<1>(p0, p1, sl, dqh);
            bf16x8 pa[4]; pack_p(p0, p1, pa);
            pv_tile<4>(o, sb + vro, pa);
        }
        slot = (slot == 2) ? 0 : slot + 1;
    }
#undef ATT_DMA
    { auto rr = __builtin_amdgcn_permlane32_swap(__float_as_uint(lsum), __float_as_uint(lsum), false, false); lsum = __uint_as_float(rr[0]) + __uint_as_float(rr[1]); }
    if (hi == 0) wsf[r32] = lsum;
    ATT_WAIT_L0(); __builtin_amdgcn_s_barrier();
    LAS float* X = (LAS float*)lds + (size_t)(wq * 32) * 128 + r32;
    if (c == 1) {
#pragma unroll
        for (int r = 0; r < 16; ++r) { const int q = ATT_CR(r) + 4 * hi; const float f = lam * __builtin_amdgcn_rcpf(wsf[q]);
#pragma unroll
            for (int db = 0; db < 4; ++db) X[q * 128 + db * 32] = o[db][r] * f; }
    }
    ATT_WAIT_L0(); __builtin_amdgcn_s_barrier();
    if (c == 0) {
        float gdv[4];
#pragma unroll
        for (int db = 0; db < 4; ++db) gdv[db] = gd[db * 32 + r32] * (1.f - LAMBDA_INIT);
        LAS bf16_t* stg = (LAS bf16_t*)(lds + 65536 + wq * 8192);
#pragma unroll
        for (int r = 0; r < 16; ++r) { const int q = ATT_CR(r) + 4 * hi; const float rl = __builtin_amdgcn_rcpf(wsf[q]);
            float v[4], ss = 0.f;
#pragma unroll
            for (int db = 0; db < 4; ++db) { v[db] = o[db][r] * rl - X[q * 128 + db * 32]; ss += v[db] * v[db]; }
            ss += __shfl_xor(ss, 1); ss += __shfl_xor(ss, 2); ss += __shfl_xor(ss, 4); ss += __shfl_xor(ss, 8); ss += __shfl_xor(ss, 16);
            const float rs = rsqrtf(ss * (1.f / 128.f) + RMS_EPS);
#pragma unroll
            for (int db = 0; db < 4; ++db) stg[q * 128 + db * 32 + r32] = f2bf(v[db] * rs * gdv[db]); }
        ATT_WAIT_L0();
        bf16_t* ao = AO + (rowbase + q0 + wq * 32) * D + 512 + h * 128;
#pragma unroll
        for (int i = 0; i < 8; ++i) { const int p = i * 64 + lane, row = p >> 4, ch = p & 15; const u32x4 v = *(const LAS u32x4*)(stg + row * 128 + ch * 8); *(u32x4*)(ao + (size_t)row * D + ch * 8) = v; }
    }
    ATT_WAIT_L0();
}
__device__ __forceinline__ void attn_b_phase(LAS unsigned char* lds, LAS float* wsf, const bf16_t* QKV, bf16_t* AO, const float* gbq, const float* gbk, const float* gd,
                                             const float* lq1, const float* lk1, const float* lq2, const float* lk2, int vcu, int wave, int lane) {
    const float Mb = gain_bound(gbq, gbk, lane);
    float s1 = lq1[lane] * lk1[lane], s2 = lq2[lane] * lk2[lane];
#pragma unroll
    for (int o = 1; o < 64; o <<= 1) { s1 += __shfl_xor(s1, o); s2 += __shfl_xor(s2, o); }
    const float lam = __expf(s1) - __expf(s2) + LAMBDA_INIT;
    const int bh = vcu >> 3, s = vcu & 7, b = bh >> 2, h = bh & 3;
    attn_b2_unit(lds, wsf, QKV, AO, gd, b, h, 15 - s, Mb, lam, wave, lane);
    attn_b2_unit(lds, wsf, QKV, AO, gd, b, h, s, Mb, lam, wave, lane);
    ATT_WAIT_L0(); __builtin_amdgcn_s_barrier();
}

__device__ __forceinline__ void attn_a2_unit(LAS unsigned char* lds, LAS float* wsf, const bf16_t* QKV, bf16_t* AO, int b, int h, int r, int jb, float Mb, int wave, int lane) {
    const int r32 = lane & 31, hi = lane >> 5;
    const int j = 32 * jb + r32, tq = r + 16 * j;
    const size_t rowbase = (size_t)b * S;
    const bf16_t* Qp = QKV + (rowbase + tq) * NIN + h * 64;
    const bf16_t* Kh = QKV + rowbase * NIN + 512 + h * 64;
    const float sl1 = exp2f(-(float)(h + 1)) * LOG2E;
    bf16x8 qr[4];
#pragma unroll
    for (int d0 = 0; d0 < 4; ++d0) qr[d0] = *(const bf16x8*)(Qp + d0 * 16 + hi * 8);
    const int n3 = (jb >= 2) ? 2 : 1, n2 = (jb == 0) ? 2 : 4, n1 = (jb == 0) ? 8 : 10, npriv = n3 + n2;
    auto tile_step = [&](int idx) -> int { return idx < n3 ? 16 : 4; };
    auto tile_k0 = [&](int idx) -> int { return idx < n3 ? 64 * idx : 64 * ((jb == 0 ? 0 : 2 * jb - 2) + idx - n3); };
    auto tile_uq = [&](int step) -> int { return step == 16 ? j : (r >> 2) + 4 * j; };
    auto tile_pos0 = [&](int step, int k0) -> int { return (r & (step - 1)) + step * k0; };
    LAS unsigned char* vbuf = lds + wave * 16384;
    const int vr16 = lane >> 2;
    bf16x8 kfn[8];
#define ATT_PREF(idx, buf) do { const int st_ = tile_step(idx), k0_ = tile_k0(idx); const bf16_t* kb_ = Kh + (size_t)tile_pos0(st_, k0_) * NIN; const size_t rs_ = (size_t)st_ * NIN; \
        _Pragma("unroll") for (int d0 = 0; d0 < 4; ++d0) { kfn[2 * d0] = *(const bf16x8*)(kb_ + (size_t)r32 * rs_ + d0 * 16 + hi * 8); kfn[2 * d0 + 1] = *(const bf16x8*)(kb_ + (size_t)(r32 + 32) * rs_ + d0 * 16 + hi * 8); } \
        _Pragma("unroll") for (int i = 0; i < 8; ++i) glds16(kb_ + 512 + (size_t)(16 * (i & 3) + vr16) * rs_ + (i >> 2) * 32 + (lane & 3) * 8, vbuf + (buf) * 8192 + i * 1024); } while (0)
    const int vro = ((lane >> 4) & 1) * 32 + (lane & 3) * 8 + (4 * hi + ((lane & 15) >> 2)) * 64;
    f32x16 o[2]; o[0] = f32x16{}; o[1] = f32x16{}; float lsum = 0.f;
    ATT_WAIT_L0(); __builtin_amdgcn_s_barrier();
    ATT_PREF(0, 0);
    for (int idx = 0; idx < npriv; ++idx) {
        ATT_WAIT_V(0);
        bf16x8 kf[8];
#pragma unroll
        for (int i = 0; i < 8; ++i) kf[i] = kfn[i];
        ATT_WAIT_L0();
        if (idx + 1 < npriv) ATT_PREF(idx + 1, (idx + 1) & 1);
        const int st = tile_step(idx), k0 = tile_k0(idx);
        const int dqh = tile_uq(st) - k0 - 4 * hi;
        const float sl = sl1 * (float)st;
        const float ci = -sl * (float)dqh - Mb;
        f32x16 p0, p1;
#pragma unroll
        for (int rr = 0; rr < 16; ++rr) { p0[rr] = ci; p1[rr] = ci; }
#pragma unroll
        for (int d0 = 0; d0 < 4; ++d0) { p0 = __builtin_amdgcn_mfma_f32_32x32x16_bf16(kf[2 * d0], qr[d0], p0, 0, 0, 0); p1 = __builtin_amdgcn_mfma_f32_32x32x16_bf16(kf[2 * d0 + 1], qr[d0], p1, 0, 0, 0); }
        lsum += soft_tile<2>(p0, p1, sl, dqh);
        bf16x8 pa[4]; pack_p(p0, p1, pa);
        pv_tile<2>(o, vbuf + (idx & 1) * 8192 + vro, pa);
    }
#undef ATT_PREF
    ATT_WAIT_L0(); __builtin_amdgcn_s_barrier();
    const int T0 = (jb == 0) ? 0 : 8 * jb - 2;
    const bf16_t* ksrc = Kh + (size_t)(64 * T0 + lane) * NIN + wave * 8;
    const bf16_t* vsrc = Kh + 512 + (size_t)(64 * T0 + 16 * (wave & 3) + (lane >> 2)) * NIN + (wave >> 2) * 32 + (lane & 3) * 8;
#define ATT_DMA(t, s) do { const size_t to_ = (size_t)(t) * 64 * NIN; LAS unsigned char* sb_ = lds + (s) * 16384; glds16(ksrc + to_, sb_ + wave * 1024); glds16(vsrc + to_, sb_ + 8192 + wave * 1024); } while (0)
    const int kfo = hi * 1024 + r32 * 16;
    ATT_DMA(0, 0); ATT_DMA(1, 1);
    int slot = 0;
    for (int t = 0; t < n1; ++t) {
        if (t + 1 < n1) ATT_WAIT_V(2); else ATT_WAIT_V(0);
        ATT_WAIT_L0(); __builtin_amdgcn_s_barrier();
        if (t + 2 < n1) { const int s2 = (slot >= 1) ? slot - 1 : 2; ATT_DMA(t + 2, s2); }
        const LAS unsigned char* sb = lds + slot * 16384;
        bf16x8 kf[8];
#pragma unroll
        for (int d0 = 0; d0 < 4; ++d0) { kf[2 * d0] = *(const LAS bf16x8*)(sb + kfo + d0 * 2048); kf[2 * d0 + 1] = *(const LAS bf16x8*)(sb + kfo + d0 * 2048 + 512); }
        const int dqh = tq - 64 * (T0 + t) - 4 * hi;
        const float ci = -sl1 * (float)dqh - Mb;
        f32x16 p0, p1;
#pragma unroll
        for (int rr = 0; rr < 16; ++rr) { p0[rr] = ci; p1[rr] = ci; }
#pragma unroll
        for (int d0 = 0; d0 < 4; ++d0) { p0 = __builtin_amdgcn_mfma_f32_32x32x16_bf16(kf[2 * d0], qr[d0], p0, 0, 0, 0); p1 = __builtin_amdgcn_mfma_f32_32x32x16_bf16(kf[2 * d0 + 1], qr[d0], p1, 0, 0, 0); }
        lsum += soft_tile<2>(p0, p1, sl1, dqh);
        bf16x8 pa[4]; pack_p(p0, p1, pa);
        pv_tile<2>(o, sb + 8192 + vro, pa);
        slot = (slot == 2) ? 0 : slot + 1;
    }
#undef ATT_DMA
    { auto rr = __builtin_amdgcn_permlane32_swap(__float_as_uint(lsum), __float_as_uint(lsum), false, false); lsum = __uint_as_float(rr[0]) + __uint_as_float(rr[1]); }
    if (hi == 0) wsf[r32] = lsum;
    ATT_WAIT_L0(); __builtin_amdgcn_s_barrier();
    LAS bf16_t* stg = (LAS bf16_t*)(lds + wave * 4096);
#pragma unroll
    for (int rr = 0; rr < 16; ++rr) { const int q = ATT_CR(rr) + 4 * hi; const float rl = __builtin_amdgcn_rcpf(wsf[q]);
#pragma unroll
        for (int db = 0; db < 2; ++db) stg[q * 64 + db * 32 + r32] = f2bf(o[db][rr] * rl); }
    ATT_WAIT_L0();
#pragma unroll
    for (int i = 0; i < 4; ++i) { const int row = i * 8 + (lane >> 3), ch = lane & 7; const u32x4 v = *(const LAS u32x4*)(stg + row * 64 + ch * 8);
        *(u32x4*)(AO + (rowbase + r + 16 * (32 * jb + row)) * D + h * 64 + ch * 8) = v; }
    ATT_WAIT_L0();
}
__device__ __forceinline__ void attn_a_phase(LAS unsigned char* lds, LAS float* wsf, const bf16_t* QKV, bf16_t* AO, const float* gaq, const float* gak, int vcu, int wave, int lane) {
    const float Mb = gain_bound(gaq, gak, lane);
    const int bh = vcu >> 2, b = bh >> 3, h = bh & 7, r = 8 * (vcu & 1) + wave, jp = (vcu >> 1) & 1;
    attn_a2_unit(lds, wsf, QKV, AO, b, h, r, jp ? 2 : 3, Mb, wave, lane);
    attn_a2_unit(lds, wsf, QKV, AO, b, h, r, jp ? 1 : 0, Mb, wave, lane);
    ATT_WAIT_L0(); __builtin_amdgcn_s_barrier();
}
#undef ATT_CR
#undef ATT_WAIT_V
#undef ATT_WAIT_L0
}

struct MArgs {
    const float *x, *c, *w_ada, *b_ada, *g1, *w_in, *gaq, *gak, *gbq, *gbk, *lq1, *lk1, *lq2, *lk2, *gd, *w_out, *g2, *w_router, *b_router, *w_gu, *b_gu, *w_d, *b_d;
    float* out; unsigned char* ws; int ph_lo, ph_hi;
};

__device__ __forceinline__ void p0_transpose_item(const float* W, int K, int N, bf16_t* WT, LAS float* scr, int item, int lane) {
    const int nblk = N / 32, kb = item / nblk, nb = item % nblk, k0 = 64 * kb, n0 = 32 * nb;
    { f32x4 v[8];
#pragma unroll
      for (int i = 0; i < 8; ++i) v[i] = __builtin_nontemporal_load((const f32x4*)(W + (size_t)(k0 + 8 * i + (lane >> 3)) * N + n0 + 4 * (lane & 7)));
#pragma unroll
      for (int i = 0; i < 8; ++i) { LAS float* d = scr + (8 * i + (lane >> 3)) * 33 + 4 * (lane & 7); d[0] = v[i].x; d[1] = v[i].y; d[2] = v[i].z; d[3] = v[i].w; } }
    LDS_WAIT(); asm volatile("" ::: "memory");
    const int c = lane & 7;
#pragma unroll
    for (int j = 0; j < 4; ++j) { const int n = (lane >> 3) + 8 * j; const LAS float* s = scr + (8 * c) * 33 + n;
        u32x4 o; o.x = pk2(s[0 * 33], s[1 * 33]); o.y = pk2(s[2 * 33], s[3 * 33]); o.z = pk2(s[4 * 33], s[5 * 33]); o.w = pk2(s[6 * 33], s[7 * 33]);
        *(u32x4*)(WT + (size_t)(n0 + n) * K + k0 + 8 * c) = o; }
    LDS_WAIT(); asm volatile("" ::: "memory");
}

__device__ __forceinline__ void p0_transpose8_item(const float* W, int K, int N, unsigned char* WT, LAS float* scr, int item, int lane) {
    const int nblk = N / 32, kb = item / nblk, nb = item % nblk, k0 = 64 * kb, n0 = 32 * nb;
    { f32x4 v[8];
#pragma unroll
      for (int i = 0; i < 8; ++i) v[i] = __builtin_nontemporal_load((const f32x4*)(W + (size_t)(k0 + 8 * i + (lane >> 3)) * N + n0 + 4 * (lane & 7)));
#pragma unroll
      for (int i = 0; i < 8; ++i) { LAS float* d = scr + (8 * i + (lane >> 3)) * 33 + 4 * (lane & 7); d[0] = v[i].x; d[1] = v[i].y; d[2] = v[i].z; d[3] = v[i].w; } }
    LDS_WAIT(); asm volatile("" ::: "memory");
#pragma unroll
    for (int j = 0; j < 2; ++j) { const int n = (lane >> 2) + 16 * j, c = lane & 3; const LAS float* s = scr + (16 * c) * 33 + n;
        u32x4 o;
        o.x = pg8::pk4_fp8(s[0 * 33] * W8_SCALE, s[1 * 33] * W8_SCALE, s[2 * 33] * W8_SCALE, s[3 * 33] * W8_SCALE);
        o.y = pg8::pk4_fp8(s[4 * 33] * W8_SCALE, s[5 * 33] * W8_SCALE, s[6 * 33] * W8_SCALE, s[7 * 33] * W8_SCALE);
        o.z = pg8::pk4_fp8(s[8 * 33] * W8_SCALE, s[9 * 33] * W8_SCALE, s[10 * 33] * W8_SCALE, s[11 * 33] * W8_SCALE);
        o.w = pg8::pk4_fp8(s[12 * 33] * W8_SCALE, s[13 * 33] * W8_SCALE, s[14 * 33] * W8_SCALE, s[15 * 33] * W8_SCALE);
        __builtin_nontemporal_store(o, (u32x4*)(WT + (size_t)(n0 + n) * K + k0 + 16 * c)); }
    LDS_WAIT(); asm volatile("" ::: "memory");
}

constexpr int CV_I_GU = 16 * 64, CV_I_D = 16 * 32, CV_NIT = NE * (CV_I_GU + CV_I_D);
#ifndef CV_STATIC
#define CV_STATIC 16384
#endif
__device__ __forceinline__ void cv_item(const float* w_gu, const float* w_d, unsigned char* gu8, unsigned char* d8, LAS float* scr, int it, int lane) {
    if (it < NE * CV_I_GU) { const int e = it / CV_I_GU; p0_transpose8_item(w_gu + (size_t)e * 1024 * 2048, 1024, 2048, gu8 + (size_t)e * 1024 * 2048, scr, it % CV_I_GU, lane); }
    else { const int r_ = it - NE * CV_I_GU, e = r_ / CV_I_D; p0_transpose8_item(w_d + (size_t)e * 1024 * 1024, 1024, 1024, d8 + (size_t)e * 1024 * 1024, scr, r_ % CV_I_D, lane); }
}

__global__ void __launch_bounds__(NTHREADS, 2) mega(MArgs a) {
    extern __shared__ __attribute__((aligned(16))) unsigned char lds_raw[];
    LAS unsigned char* lds = (LAS unsigned char*)lds_raw;
    const int G = gridDim.x, bx = blockIdx.x, vcu = (G % 8 == 0) ? (bx % 8) * (G / 8) + bx / 8 : bx, NGW = G * NWAVES;
    const int wave = __builtin_amdgcn_readfirstlane((int)threadIdx.x >> 6);
#define PHASE_IDS() int lane = (int)__builtin_amdgcn_mbcnt_hi(~0u, __builtin_amdgcn_mbcnt_lo(~0u, 0u)); asm volatile("" : "+v"(lane)); const int tid = wave * 64 + lane, gw = vcu * NWAVES + wave; (void)tid; (void)gw
    volatile LAS unsigned* MISC = (volatile LAS unsigned*)(lds + MISC_OFF);
    LAS int* PT = (LAS int*)(lds + PT_OFF); LAS int* CN = (LAS int*)(lds + CNT_OFF);
#define w_counts ((int*)(a.ws + WS_CTL + CTL_COUNTS))
#define w_mod ((float*)(a.ws + WS_CTL + CTL_MOD))
#define w_modp ((float*)(a.ws + WS_MODP))
#define w_adacnt ((unsigned*)(a.ws + WS_CTL + CTL_ADACNT))
#define w_cvq ((unsigned*)(a.ws + WS_CTL + CTL_ADACNT + 256))
#define w_Win_t ((bf16_t*)(a.ws + WS_WIN))
#define w_Wout_t ((bf16_t*)(a.ws + WS_WOUT))
#define w_Wgu_t ((bf16_t*)(a.ws + WS_WGU))
#define w_Wd_t ((bf16_t*)(a.ws + WS_WD))
#define w_XN ((bf16_t*)(a.ws + WS_XN))
#define w_QKV ((bf16_t*)(a.ws + WS_QKV))
#define w_AO ((bf16_t*)(a.ws + WS_AO))
#define w_H2 ((bf16_t*)(a.ws + WS_H2))
#define w_tope ((int*)(a.ws + WS_TOPE))
#define w_tops ((int*)(a.ws + WS_TOPS))
#define w_topg ((float*)(a.ws + WS_TOPG))
#define w_list ((int*)(a.ws + WS_LIST))
#define w_ACT ((bf16_t*)(a.ws + WS_ACT))
#define w_Y ((bf16_t*)(a.ws + WS_Y))
#define w_OBN ((float*)(a.ws + WS_OBN))
#define w_X1 ((bf16_t*)(a.ws + WS_X1))
    for (int u = threadIdx.x; u < (LDS_BYTES - LDSCTL_OFF) / 4; u += NTHREADS) ((LAS unsigned*)(lds + LDSCTL_OFF))[u] = 0u;
    __syncthreads();
    const int lo = a.ph_lo, hi = a.ph_hi;
    XcdBarrier bar; bar.bar = (unsigned*)(a.ws + WS_CTL + CTL_BAR); bar.x = 0; bar.st = nullptr;
    if (hi - lo > 1) bar = xcd_barrier_post((unsigned*)(a.ws + WS_CTL + CTL_BAR), MISC + 8);
#define IN(k) (lo <= (k) && (k) < hi)
#ifndef REP_PH
#define REP_PH -1
#define REP_N 1
#endif
#define NREP(k) (((k) == REP_PH || REP_PH == 100) ? REP_N : 1)
#ifndef SPAN_PH
#define SPAN_PH -1
#endif
    LAS unsigned long long* tstamp = (LAS unsigned long long*)(lds + LDSCTL_OFF + 1536);
#define STAMP(i) do { if (SPAN_PH >= 0 && bx == 0 && threadIdx.x == 0) tstamp[i] = __builtin_amdgcn_s_memrealtime(); } while (0)
    STAMP(0);
#define SEAM(k) do { if (IN(k) && IN((k) + 1)) xcd_barrier(bar, wave); STAMP((k) + 1); } while (0)
#define LOAD_PT() do { if (wave == 0) { int cv = (lane < NE) ? w_counts[lane] : 0; int tl = (cv + 255) >> 8; int sc = tl; \
        _Pragma("unroll") for (int o = 1; o < 32; o <<= 1) { const int t_ = __shfl_up(sc, o); if ((lane & 31) >= o) sc += t_; } \
        if (lane < NE) { PT[lane + 1] = sc; CN[lane] = cv; } if (lane == 0) PT[0] = 0; } __syncthreads(); } while (0)

    if (IN(0)) for (int rep_ = 0; rep_ < NREP(0); ++rep_) {
        PHASE_IDS();
        LAS float* silu = (LAS float*)(lds + 98304);
        for (int i = tid; i < NB * D; i += NTHREADS) { const float cv = a.c[i]; silu[i] = cv / (1.f + __expf(-cv)); }
        __syncthreads();
        if (gw < 24 * 32 && rep_ == 0) {
            const int cc = gw % 24, ks = gw / 24, col = cc * 256 + 4 * lane;
            f32x4 acc[NB];
#pragma unroll
            for (int b = 0; b < NB; ++b) acc[b] = (ks == 0) ? *(const f32x4*)(a.b_ada + col) : (f32x4){0.f, 0.f, 0.f, 0.f};
#pragma unroll 1
            for (int k8 = ks * 32; k8 < ks * 32 + 32; k8 += 8) {
                f32x4 w[8];
#pragma unroll
                for (int i = 0; i < 8; ++i) w[i] = __builtin_nontemporal_load((const f32x4*)(a.w_ada + (size_t)(k8 + i) * 6144 + col));
#pragma unroll
                for (int i = 0; i < 8; ++i)
#pragma unroll
                    for (int b = 0; b < NB; ++b) acc[b] += w[i] * silu[b * D + k8 + i];
            }
#pragma unroll
            for (int b = 0; b < NB; ++b) *(f32x4*)(w_modp + ((size_t)ks * NB + b) * 6144 + col) = acc[b];
        }
        if (rep_ == 0) {
            VM_WAIT(); __syncthreads();
            if (tid == 0) { __builtin_amdgcn_fence(__ATOMIC_RELEASE, "agent"); VM_WAIT(); __hip_atomic_fetch_add(w_adacnt, 1u, RLX_AGENT); }
        }
        LAS float* scr = (LAS float*)(lds + wave * 10240);
        constexpr int I_IN = 16 * 96, I_OUT = 16 * 32;
        for (int it = gw; it < I_IN + I_OUT; it += NGW) {
            if (it < I_IN) p0_transpose_item(a.w_in, 1024, 3072, w_Win_t, scr, it, lane);
            else p0_transpose_item(a.w_out, 1024, 1024, w_Wout_t, scr, it - I_IN, lane);
        }
        if (rep_ == 0) {
            if (tid == 0) { unsigned sp = 0; while (__hip_atomic_load(w_adacnt, RLX_AGENT) < (unsigned)G && ++sp < (1u << 24)) __builtin_amdgcn_s_sleep(2);
                            __builtin_amdgcn_fence(__ATOMIC_ACQUIRE, "agent"); VM_WAIT(); }
            __syncthreads();
            for (int idx = bx * NTHREADS + tid; idx < NB * 6144; idx += G * NTHREADS) { float sm = 0.f;
#pragma unroll 8
                for (int ks = 0; ks < 32; ++ks) sm += w_modp[(size_t)ks * NB * 6144 + idx];
                w_mod[idx] = sm; }
        }
        if (rep_ + 1 < NREP(0)) xcd_barrier(bar, wave);
    }
    SEAM(0);
    if (IN(1)) for (int rep_ = 0; rep_ < NREP(1); ++rep_) {
        PHASE_IDS();
        for (int r0 = gw * 4; r0 < M; r0 += NGW * 4) {
            const int b = r0 / S;
            f32x4 v[4][4]; float rs[4];
#pragma unroll
            for (int rr = 0; rr < 4; ++rr) { const f32x4* xr = (const f32x4*)(a.x + (size_t)(r0 + rr) * D) + lane;
#pragma unroll
                for (int j = 0; j < 4; ++j) v[rr][j] = __builtin_nontemporal_load(xr + 64 * j); }
#pragma unroll
            for (int rr = 0; rr < 4; ++rr) { float ss = 0.f;
#pragma unroll
                for (int j = 0; j < 4; ++j) ss += (v[rr][j].x * v[rr][j].x + v[rr][j].y * v[rr][j].y) + (v[rr][j].z * v[rr][j].z + v[rr][j].w * v[rr][j].w);
                rs[rr] = rsqrtf(wave_sum(ss) * (1.f / D) + RMS_EPS); }
            const float* shift = w_mod + b * 6144, *scale = w_mod + b * 6144 + 1024;
#pragma unroll
            for (int j = 0; j < 4; ++j) {
                const int c0 = 4 * lane + 256 * j;
                const f32x4 g = *(const f32x4*)(a.g1 + c0), sc = *(const f32x4*)(scale + c0), sh = *(const f32x4*)(shift + c0);
                const f32x4 gs = g * (sc + 1.f);
#pragma unroll
                for (int rr = 0; rr < 4; ++rr) { const f32x4 o = v[rr][j] * rs[rr] * gs + sh;
                    u32x2 w; w.x = pk2(o.x, o.y); w.y = pk2(o.z, o.w);
                    *(u32x2*)(w_XN + (size_t)(r0 + rr) * D + c0) = w; }
            }
        }
        if (rep_ + 1 < NREP(1)) xcd_barrier(bar, wave);
    }
    SEAM(1);
    if (IN(2)) for (int rep_ = 0; rep_ < NREP(2); ++rep_) {
        PHASE_IDS();
#define P2_CONVERT() do { LAS float* scr = (LAS float*)(lds + wave * 10240); \
            for (int it = gw; it < CV_STATIC; it += NGW) cv_item(a.w_gu, a.w_d, (unsigned char*)w_Wgu_t, (unsigned char*)w_Wd_t, scr, it, lane); } while (0)
        PInProj p; p.init(M, NIN, G, bx); p.XN = w_XN; p.Wt = w_Win_t; p.QKV = w_QKV; p.gaq = a.gaq; p.gak = a.gak; p.gbq = a.gbq; p.gbk = a.gbk;
        if (bx & 1) { pg8::gemm_phase<PInProj>(lds, p, wave); __syncthreads(); P2_CONVERT(); }
        else { P2_CONVERT(); __syncthreads(); pg8::gemm_phase<PInProj>(lds, p, wave); }
#undef P2_CONVERT
        if (rep_ + 1 < NREP(2)) xcd_barrier(bar, wave);
    }
    SEAM(2);
    if (IN(3)) for (int rep_ = 0; rep_ < NREP(3); ++rep_) {
        PHASE_IDS();
        LAS float* wsf = (LAS float*)(lds + LDSCTL_OFF + 2048) + wave * 64;
#ifndef ATT_REP_A
#define ATT_REP_A 1
#define ATT_REP_B 1
#endif
        att::attn_a_phase(lds, wsf, w_QKV, w_AO, a.gaq, a.gak, vcu, wave, lane);
        STAMP(11);
        att::attn_b_phase(lds, wsf, w_QKV, w_AO, a.gbq, a.gbk, a.gd, a.lq1, a.lk1, a.lq2, a.lk2, vcu, wave, lane);
        if (rep_ == 0) {
            LAS float* scr = (LAS float*)(lds + wave * 10240);
            LAS int* qb_ = (LAS int*)(lds + LDSCTL_OFF + 1280);
            for (;;) {
                if (tid == 0) *qb_ = CV_STATIC + 16 * (int)__hip_atomic_fetch_add(w_cvq, 1u, RLX_AGENT);
                __syncthreads();
                const int base_ = *qb_;
                __syncthreads();
                if (base_ >= CV_NIT) break;
                for (int it = base_ + wave; it < base_ + 16 && it < CV_NIT; it += NWAVES)
                cv_item(a.w_gu, a.w_d, (unsigned char*)w_Wgu_t, (unsigned char*)w_Wd_t, scr, it, lane); }
        }
        if (rep_ + 1 < NREP(3)) xcd_barrier(bar, wave);
    }
    SEAM(3);
    if (IN(5)) for (int rep_ = 0; rep_ < NREP(5); ++rep_) {
        PHASE_IDS();
        POutProj p; p.init(M, D, G, bx); p.AO = w_AO; p.Wt = w_Wout_t; p.x = a.x; p.mod = w_mod; p.x1 = w_X1;
        pg8::gemm_phase<POutProj>(lds, p, wave);
        if (rep_ + 1 < NREP(5)) xcd_barrier(bar, wave);
    }
    SEAM(5);
    if (IN(6)) for (int rep_ = 0; rep_ < NREP(6); ++rep_) {
        PHASE_IDS();
        typedef float f32x4v __attribute__((ext_vector_type(4)));
        LAS float* Wp = (LAS float*)lds;
        LAS float* lgs = (LAS float*)(lds + LDSCTL_OFF + 4096);
        LAS float* red = (LAS float*)(lds + LDSCTL_OFF + 12288);
        LAS float* cb = (LAS float*)(lds + LDSCTL_OFF + 14336);
        LAS int* lcnt = (LAS int*)(lds + LDSCTL_OFF + 14464);
        LAS int* lbase = (LAS int*)(lds + LDSCTL_OFF + 14592);
        LAS float* ssl = (LAS float*)(lds + LDSCTL_OFF + 14720);
        for (int chunk = bx; chunk < M / 64; chunk += G) {
            const int row0 = chunk * 64, b = row0 / S;
            const float* shift = w_mod + b * 6144 + 3072, *scale = w_mod + b * 6144 + 4096;
            __syncthreads();
#pragma unroll 1
            for (int i0 = tid; i0 < 1024 * 8; i0 += NTHREADS * 8) {
                f32x4v w[8]; float gg[8], sc_[8];
#pragma unroll
                for (int u = 0; u < 8; ++u) { const int i = i0 + u * NTHREADS, k = i >> 3; w[u] = *(const f32x4v*)(a.w_router + (size_t)k * NE + (i & 7) * 4); gg[u] = a.g2[k]; sc_[u] = scale[k]; }
#pragma unroll
                for (int u = 0; u < 8; ++u) { const int i = i0 + u * NTHREADS, k = i >> 3; *(LAS f32x4v*)(Wp + k * NE + (i & 7) * 4) = w[u] * (gg[u] * (1.f + sc_[u])); }
            }
            { const int e = tid & 31, kp = tid >> 5; float acc = 0.f;
#pragma unroll 8
              for (int k = kp * 64; k < kp * 64 + 64; ++k) acc += shift[k] * a.w_router[(size_t)k * NE + e];
              red[kp * 32 + e] = acc; }
            if (tid < 32) lcnt[tid] = 0;
            if (tid < 64) ssl[tid] = 0.f;
            *(LAS f32x4v*)(lgs + tid * 4) = (f32x4v){0.f, 0.f, 0.f, 0.f};
#pragma unroll 1
            for (int rb = 0; rb < 2; ++rb) {
                f32x4 v[4][4]; float rs[4];
#pragma unroll
                for (int rr = 0; rr < 4; ++rr) { const u32x2* xr = (const u32x2*)(w_X1 + (size_t)(row0 + wave * 8 + rb * 4 + rr) * D) + lane;
#pragma unroll
                    for (int jj = 0; jj < 4; ++jj) { const u32x2 w = xr[64 * jj]; v[rr][jj] = (f32x4){__uint_as_float(w.x << 16), __uint_as_float(w.x & 0xffff0000u), __uint_as_float(w.y << 16), __uint_as_float(w.y & 0xffff0000u)}; } }
#pragma unroll
                for (int rr = 0; rr < 4; ++rr) { float s_ = 0.f;
#pragma unroll
                    for (int jj = 0; jj < 4; ++jj) s_ += (v[rr][jj].x * v[rr][jj].x + v[rr][jj].y * v[rr][jj].y) + (v[rr][jj].z * v[rr][jj].z + v[rr][jj].w * v[rr][jj].w);
                    rs[rr] = rsqrtf(wave_sum(s_) * (1.f / D) + RMS_EPS); }
#pragma unroll
                for (int jj = 0; jj < 4; ++jj) {
                    const int c0 = 4 * lane + 256 * jj;
                    const f32x4 g = *(const f32x4*)(a.g2 + c0), sc = *(const f32x4*)(scale + c0), sh = *(const f32x4*)(shift + c0);
#pragma unroll
                    for (int rr = 0; rr < 4; ++rr) { const f32x4 o = v[rr][jj] * rs[rr] * g * (sc + 1.f) + sh;
                        const f32x4 oc = __builtin_elementwise_min(__builtin_elementwise_max(o * H2_SCALE, (f32x4){-448.f, -448.f, -448.f, -448.f}), (f32x4){448.f, 448.f, 448.f, 448.f});
                        *(unsigned*)((unsigned char*)w_H2 + (size_t)(row0 + wave * 8 + rb * 4 + rr) * D + c0) = pg8::pk4_fp8(oc.x, oc.y, oc.z, oc.w); }
                }
            }
            __syncthreads();
            if (tid < 32) { float s_ = a.b_router[tid];
#pragma unroll
                for (int kp = 0; kp < 16; ++kp) s_ += red[kp * 32 + tid];
                cb[tid] = s_; }
            const int tj = lane & 15, kq = lane >> 4;
            {
                const int kb = 512 * (wave >> 2) + 128 * kq;
                const bf16_t* xp = w_X1 + (size_t)(row0 + 16 * (wave & 3) + tj) * D + kb;
                const LAS float* wq = Wp + kb * NE + tj;
                f32x4v acc0 = {0.f, 0.f, 0.f, 0.f}, acc1 = {0.f, 0.f, 0.f, 0.f}; float ssq = 0.f;
                u32x4 xw[16];
#pragma unroll
                for (int i = 0; i < 16; ++i) xw[i] = *(const u32x4*)(xp + 8 * i);
#pragma unroll
                for (int i = 0; i < 16; ++i) {
#pragma unroll
                    for (int h2_ = 0; h2_ < 4; ++h2_) { const unsigned wv = (h2_ == 0) ? xw[i].x : (h2_ == 1) ? xw[i].y : (h2_ == 2) ? xw[i].z : xw[i].w;
                        const float x0 = __uint_as_float(wv << 16), x1_ = __uint_as_float(wv & 0xffff0000u); ssq += x0 * x0 + x1_ * x1_;
                        const int kk = 8 * i + 2 * h2_;
                        acc0 = __builtin_amdgcn_mfma_f32_16x16x4f32(wq[kk * NE], x0, acc0, 0, 0, 0); acc1 = __builtin_amdgcn_mfma_f32_16x16x4f32(wq[kk * NE + 16], x0, acc1, 0, 0, 0);
                        acc0 = __builtin_amdgcn_mfma_f32_16x16x4f32(wq[(kk + 1) * NE], x1_, acc0, 0, 0, 0); acc1 = __builtin_amdgcn_mfma_f32_16x16x4f32(wq[(kk + 1) * NE + 16], x1_, acc1, 0, 0, 0); }
                }
                ssq += __shfl_xor(ssq, 16); ssq += __shfl_xor(ssq, 32);
                LAS float* lw = lgs + ((wave & 3) * 16 + tj) * 32;
#pragma unroll
                for (int r = 0; r < 4; ++r) { (void)__hip_atomic_fetch_add(lw + 4 * kq + r, acc0[r], __ATOMIC_RELAXED, __HIP_MEMORY_SCOPE_WORKGROUP); (void)__hip_atomic_fetch_add(lw + 16 + 4 * kq + r, acc1[r], __ATOMIC_RELAXED, __HIP_MEMORY_SCOPE_WORKGROUP); }
                if (kq == 0) (void)__hip_atomic_fetch_add(ssl + (wave & 3) * 16 + tj, ssq, __ATOMIC_RELAXED, __HIP_MEMORY_SCOPE_WORKGROUP);
            }
            __syncthreads();
            int idx[4] = {0, 0, 0, 0}, rank[4] = {0, 0, 0, 0}; float gt[4] = {0.f, 0.f, 0.f, 0.f};
            if (wave < 4 && lane < 16) {
                const float rstd = rsqrtf(ssl[wave * 16 + lane] * (1.f / D) + RMS_EPS);
                float lg[NE];
#pragma unroll
                for (int e = 0; e < NE; ++e) lg[e] = lgs[(wave * 16 + lane) * 32 + e] * rstd + cb[e];
                float val[4];
#pragma unroll
                for (int k = 0; k < 4; ++k) {
                    float best = -INFINITY; int bi = 0;
#pragma unroll
                    for (int e = 0; e < NE; ++e) { bool taken = false;
#pragma unroll
                        for (int kk = 0; kk < k; ++kk) taken |= (idx[kk] == e);
                        if (!taken && lg[e] > best) { best = lg[e]; bi = e; } }
                    idx[k] = bi; val[k] = best;
                }
                float den = 0.f;
#pragma unroll
                for (int k = 0; k < 4; ++k) { gt[k] = __expf(val[k] - val[0]); den += gt[k]; }
                const float rden = 1.f / den;
#pragma unroll
                for (int k = 0; k < 4; ++k) { gt[k] *= rden; rank[k] = __hip_atomic_fetch_add(lcnt + idx[k], 1, __ATOMIC_RELAXED, __HIP_MEMORY_SCOPE_WORKGROUP); }
            }
            __syncthreads();
            if (tid < 32 && rep_ == 0) lbase[tid] = atomicAdd(&w_counts[tid], lcnt[tid]);
            __syncthreads();
            if (wave < 4 && lane < 16 && rep_ == 0) {
                const int row = row0 + 16 * wave + lane;
#pragma unroll
                for (int k = 0; k < 4; ++k) { const int slot = lbase[idx[k]] + rank[k];
                    w_tope[row * 4 + k] = idx[k]; w_tops[row * 4 + k] = slot; w_topg[row * 4 + k] = gt[k]; w_list[idx[k] * M + slot] = row; }
            }
        }
        if (rep_ + 1 < NREP(6)) xcd_barrier(bar, wave);
    }
    SEAM(6);
    if (IN(7)) for (int rep_ = 0; rep_ < NREP(7); ++rep_) {
        PHASE_IDS();
        LOAD_PT();
        PGateUp p; p.init(PT, CN, (LAS int*)(lds + LDSCTL_OFF + 1024), 8, G, bx); p.build(wave, lane); __syncthreads(); p.H2 = w_H2; p.Wt = w_Wgu_t; p.bgu = a.b_gu; p.list = w_list; p.ACT = w_ACT;
        pg8::gemm_phase<PGateUp>(lds, p, wave);
        if (rep_ + 1 < NREP(7)) xcd_barrier(bar, wave);
    }
    SEAM(7);
    if (IN(8)) for (int rep_ = 0; rep_ < NREP(8); ++rep_) {
        PHASE_IDS();
        LOAD_PT();
        PDown p; p.init(PT, CN, (LAS int*)(lds + LDSCTL_OFF + 1024), 4, G, bx); p.build(wave, lane); __syncthreads(); p.ACT = w_ACT; p.Wt = w_Wd_t; p.bd = a.b_d; p.Y = w_Y;
        pg8::gemm_phase<PDown>(lds, p, wave);
        if (rep_ + 1 < NREP(8)) xcd_barrier(bar, wave);
    }
    SEAM(8);
    for (int rep_ = 0; rep_ + 1 < NREP(10); ++rep_) xcd_barrier(bar, wave);
    if (IN(9)) for (int rep_ = 0; rep_ < NREP(9); ++rep_) {
        PHASE_IDS();
        LOAD_PT();
        for (int r0 = gw * 2; r0 < M; r0 += NGW * 2) {
            const int b = r0 / S;
            const float* gate2 = w_mod + b * 6144 + 5120;
            const unsigned char* yr[2][4]; float gk[2][4];
#pragma unroll
            for (int rr = 0; rr < 2; ++rr)
#pragma unroll
                for (int k = 0; k < 4; ++k) { const int row = r0 + rr; yr[rr][k] = (const unsigned char*)w_Y + (size_t)(PT[w_tope[row * 4 + k]] * 256 + w_tops[row * 4 + k]) * D; gk[rr][k] = w_topg[row * 4 + k] * (1.f / Y_SCALE); }
#pragma unroll
            for (int j = 0; j < 4; ++j) {
                const int c0 = 4 * lane + 256 * j;
                int wv[2][4]; u32x2 xw[2];
#pragma unroll
                for (int rr = 0; rr < 2; ++rr) { xw[rr] = *(const u32x2*)(w_X1 + (size_t)(r0 + rr) * D + c0);
#pragma unroll
                    for (int k = 0; k < 4; ++k) wv[rr][k] = *(const int*)(yr[rr][k] + c0); }
                const f32x4 g = *(const f32x4*)(gate2 + c0);
#pragma unroll
                for (int rr = 0; rr < 2; ++rr) { f32x4 acc = (f32x4){0.f, 0.f, 0.f, 0.f};
#pragma unroll
                    for (int k = 0; k < 4; ++k) { const int w = wv[rr][k];
                        acc.x += gk[rr][k] * __builtin_amdgcn_cvt_f32_fp8(w, 0); acc.y += gk[rr][k] * __builtin_amdgcn_cvt_f32_fp8(w, 1);
                        acc.z += gk[rr][k] * __builtin_amdgcn_cvt_f32_fp8(w, 2); acc.w += gk[rr][k] * __builtin_amdgcn_cvt_f32_fp8(w, 3); }
                    const f32x4 xv = {__uint_as_float(xw[rr].x << 16), __uint_as_float(xw[rr].x & 0xffff0000u), __uint_as_float(xw[rr].y << 16), __uint_as_float(xw[rr].y & 0xffff0000u)};
                    *(f32x4*)(a.out + (size_t)(r0 + rr) * D + c0) = xv + g * acc; }
            }
        }
    }
    STAMP(10);
    if (SPAN_PH >= 0 && bx == 0 && threadIdx.x == 0) {
        const unsigned long long dur = (SPAN_PH == 20) ? tstamp[11] - tstamp[3] : (SPAN_PH == 21) ? tstamp[4] - tstamp[11] : tstamp[SPAN_PH + 1] - tstamp[SPAN_PH], t0 = __builtin_amdgcn_s_memrealtime();
        while (__builtin_amdgcn_s_memrealtime() - t0 < dur) __builtin_amdgcn_s_sleep(4);
    }
#undef IN
#undef PHASE_IDS
#undef SEAM
#undef LOAD_PT
#undef w_counts
#undef w_mod
#undef w_modp
#undef w_adacnt
#undef w_cvq
#undef w_Win_t
#undef w_Wout_t
#undef w_Wgu_t
#undef w_Wd_t
#undef w_XN
#undef w_QKV
#undef w_AO
#undef w_H2
#undef w_tope
#undef w_tops
#undef w_topg
#undef w_list
#undef w_ACT
#undef w_Y
#undef w_OBN
#undef w_X1
}

#ifndef RUN_MODE
#define RUN_MODE 1
#endif
#ifndef PH_MASK
#define PH_MASK 0x3ff
#endif
extern "C" void kernel_launch(void* const* d_in, const int* in_sizes, int n_in, void* d_out, int out_size, void* d_ws, size_t ws_size, hipStream_t stream) {
    static int grid = 0;
    if (grid == 0) {
        if (n_in != 23 || out_size != M * D || ws_size < WS_END) { fprintf(stderr, "kernel_launch: unexpected problem (n_in %d out %d ws %zu)\n", n_in, out_size, ws_size); grid = -1; return; }
        int dev = 0, cus = 0;
        if (hipGetDevice(&dev) != hipSuccess || hipDeviceGetAttribute(&cus, hipDeviceAttributeMultiprocessorCount, dev) != hipSuccess) { grid = -1; return; }
        if (hipFuncSetAttribute((const void*)mega, hipFuncAttributeMaxDynamicSharedMemorySize, LDS_BYTES) != hipSuccess) { fprintf(stderr, "kernel_launch: hipFuncSetAttribute failed\n"); grid = -1; return; }
        int per_cu = 0;
        if (hipOccupancyMaxActiveBlocksPerMultiprocessor(&per_cu, (const void*)mega, NTHREADS, LDS_BYTES) != hipSuccess || per_cu < 1) fprintf(stderr, "kernel_launch: occupancy query says %d blocks/CU\n", per_cu);
        (void)hipGetLastError();
        grid = cus;
    }
    if (grid < 0) return;
    const float* x = (const float*)d_in[0]; const float* c = (const float*)d_in[1]; const float* w_ada = (const float*)d_in[2]; const float* b_ada = (const float*)d_in[3];
    const float* g1 = (const float*)d_in[4]; const float* w_in = (const float*)d_in[5];
    const float* gaq = (const float*)d_in[6]; const float* gak = (const float*)d_in[7]; const float* gbq = (const float*)d_in[8]; const float* gbk = (const float*)d_in[9];
    const float* lq1 = (const float*)d_in[10]; const float* lk1 = (const float*)d_in[11]; const float* lq2 = (const float*)d_in[12]; const float* lk2 = (const float*)d_in[13];
    const float* gd = (const float*)d_in[14]; const float* w_out = (const float*)d_in[15]; const float* g2 = (const float*)d_in[16];
    const float* w_router = (const float*)d_in[17]; const float* b_router = (const float*)d_in[18];
    const float* w_gu = (const float*)d_in[19]; const float* b_gu = (const float*)d_in[20]; const float* w_d = (const float*)d_in[21]; const float* b_d = (const float*)d_in[22];
    unsigned char* ws = (unsigned char*)d_ws; float* out = (float*)d_out;
    int* counts = (int*)(ws + WS_CTL + CTL_COUNTS); int* padstart = (int*)(ws + WS_CTL + CTL_PADSTART); float* mod = (float*)(ws + WS_CTL + CTL_MOD);
    bf16_t* Win_t = (bf16_t*)(ws + WS_WIN); bf16_t* Wout_t = (bf16_t*)(ws + WS_WOUT); bf16_t* Wgu_t = (bf16_t*)(ws + WS_WGU); bf16_t* Wd_t = (bf16_t*)(ws + WS_WD);
    bf16_t* XN = (bf16_t*)(ws + WS_XN); bf16_t* QKV = (bf16_t*)(ws + WS_QKV); bf16_t* AO = (bf16_t*)(ws + WS_AO); bf16_t* H2 = (bf16_t*)(ws + WS_H2);
    int* tope = (int*)(ws + WS_TOPE); int* tops = (int*)(ws + WS_TOPS); float* topg = (float*)(ws + WS_TOPG); int* list = (int*)(ws + WS_LIST);
    bf16_t* ACT = (bf16_t*)(ws + WS_ACT); bf16_t* Y = (bf16_t*)(ws + WS_Y); float* OBN = (float*)(ws + WS_OBN);

    (void)hipMemsetAsync(ws + WS_CTL, 0, 32768, stream);
    MArgs a{};
    a.x = x; a.c = c; a.w_ada = w_ada; a.b_ada = b_ada; a.g1 = g1; a.w_in = w_in; a.gaq = gaq; a.gak = gak; a.gbq = gbq; a.gbk = gbk; a.lq1 = lq1; a.lk1 = lk1; a.lq2 = lq2; a.lk2 = lk2;
    a.gd = gd; a.w_out = w_out; a.g2 = g2; a.w_router = w_router; a.b_router = b_router; a.w_gu = w_gu; a.b_gu = b_gu; a.w_d = w_d; a.b_d = b_d; a.out = out; a.ws = ws;
    a.ph_lo = 0; a.ph_hi = NPHASE; hipLaunchKernelGGL(mega, dim3(grid), dim3(NTHREADS), LDS_BYTES, stream, a);
}
```
